# Optimizing an MI355X kernel written in HIP

```python
import jax, jax.numpy as jnp
from jax import lax
import numpy as np

D_MODEL = 1024
BATCH = 4
SEQ = 8192
DEPTH = 1

POOL_WIDTH = D_MODEL // 2
POOL_GROUPS = 4
POOL_GROUP_WIDTH = POOL_WIDTH // POOL_GROUPS
POOL_WINDOWS = (2, 4, 8, 16)
CONV_WIDTH = D_MODEL // 2
CONV_KERNEL = 31
N_BRANCHES = 2
IN_WIDTH = POOL_WIDTH + 2 * CONV_WIDTH + N_BRANCHES * D_MODEL
PEER_HEADS = 8
PEER_KEY_DIM = 256
PEER_HALF_DIM = PEER_KEY_DIM // 2
N_KEYS = 128
N_EXPERTS = N_KEYS * N_KEYS
PEER_TOPK_HALF = 16
PEER_TOPK = 16
PEER_CHUNK = 128
N_MOD = 6
EPS = 1e-6

kernel_name = "hybrid_pool_conformer_peer_adaln"


def rmsnorm(x, g):
    xf = x.astype(jnp.float32)
    y = xf * lax.rsqrt(jnp.mean(xf * xf, axis=-1, keepdims=True) + EPS)
    return (y * g.astype(jnp.float32)).astype(x.dtype)


def layernorm(x, g, b):
    xf = x.astype(jnp.float32)
    mu = jnp.mean(xf, axis=-1, keepdims=True)
    var = jnp.mean(jnp.square(xf - mu), axis=-1, keepdims=True)
    y = (xf - mu) * lax.rsqrt(var + EPS)
    return (y * g.astype(jnp.float32) + b.astype(jnp.float32)).astype(x.dtype)


def causal_window_mean(xg, w):
    s = xg.shape[1]
    xf = xg.astype(jnp.float32)
    cs = jnp.cumsum(xf, axis=1)
    shifted = jnp.pad(cs, ((0, 0), (w, 0), (0, 0)))[:, :s]
    count = jnp.minimum(jnp.arange(1, s + 1), w).astype(jnp.float32)[None, :, None]
    return ((cs - shifted) / count).astype(xg.dtype)


def pool_branch(p, pool_w, pool_scale, pool_up):
    b, s, _ = p.shape
    pooled = jnp.concatenate(
        [causal_window_mean(p[..., i * POOL_GROUP_WIDTH:(i + 1) * POOL_GROUP_WIDTH], w)
         for i, w in enumerate(POOL_WINDOWS)], axis=-1)
    mixed = (pooled - p).reshape(b, s, POOL_GROUPS, POOL_GROUP_WIDTH)
    mixed = jnp.einsum('bsgc,gcd->bsgd', mixed, pool_w).reshape(b, s, POOL_WIDTH)
    return (mixed * pool_scale) @ pool_up


def conformer_branch(a, dw_kernel, dw_bias, ln_g, ln_b, conv_out):
    glu = a[..., :CONV_WIDTH] * jax.nn.sigmoid(a[..., CONV_WIDTH:])
    y = lax.conv_general_dilated(
        glu, dw_kernel[:, None, :].astype(glu.dtype), window_strides=(1,),
        padding=[(CONV_KERNEL - 1, 0)], dimension_numbers=('NWC', 'WIO', 'NWC'),
        feature_group_count=CONV_WIDTH) + dw_bias
    y = layernorm(y, ln_g, ln_b)
    y = y * jax.nn.sigmoid(y)
    return y @ conv_out


def peer(h, w_query, keys_1, keys_2, expert_u, expert_v):
    b, s, d = h.shape
    flat = h.reshape(b * s // PEER_CHUNK, PEER_CHUNK, d)

    def chunk_fn(hc):
        q = (hc @ w_query).reshape(PEER_CHUNK, PEER_HEADS, PEER_KEY_DIM)
        s1 = jnp.einsum('chk,nk->chn', q[..., :PEER_HALF_DIM], keys_1)
        s2 = jnp.einsum('chk,nk->chn', q[..., PEER_HALF_DIM:], keys_2)
        v1, i1 = lax.top_k(s1, PEER_TOPK_HALF)
        v2, i2 = lax.top_k(s2, PEER_TOPK_HALF)
        cand = (v1[..., :, None] + v2[..., None, :]).reshape(PEER_CHUNK, PEER_HEADS, -1)
        cand_idx = (i1[..., :, None] * N_KEYS + i2[..., None, :]).reshape(PEER_CHUNK, PEER_HEADS, -1)
        top_s, pos = lax.top_k(cand, PEER_TOPK)
        experts = jnp.take_along_axis(cand_idx, pos, axis=-1)
        gate = jax.nn.softmax(top_s.astype(jnp.float32), axis=-1).astype(hc.dtype)
        u = jnp.take(expert_u, experts, axis=0)
        act = jax.nn.gelu(jnp.einsum('chkd,cd->chk', u, hc))
        v = jnp.take(expert_v, experts, axis=0)
        return jnp.einsum('chk,chkd->cd', gate * act, v)

    return lax.map(chunk_fn, flat).reshape(b, s, d)


def setup_inputs(seed: int = 0) -> dict:
    key = jax.random.key(seed)
    ks = jax.random.split(key, 24)

    def nrm(k, shape, scale):
        return jax.random.normal(k, shape, jnp.float32) * scale

    def gain(k, shape):
        return 1.0 + 0.05 * jax.random.normal(k, shape, jnp.float32)

    L = DEPTH
    return {
        "x": nrm(ks[0], (BATCH, SEQ, D_MODEL), 1.0),
        "c": nrm(ks[1], (BATCH, D_MODEL), 1.0),
        "ada_w": nrm(ks[2], (L, D_MODEL, N_MOD * D_MODEL), 0.5 * D_MODEL ** -0.5),
        "ada_b": nrm(ks[3], (L, N_MOD * D_MODEL), 0.01),
        "norm1_g": gain(ks[4], (L, D_MODEL)),
        "w_in": nrm(ks[5], (L, D_MODEL, IN_WIDTH), D_MODEL ** -0.5),
        "b_in": nrm(ks[6], (L, IN_WIDTH), 0.01),
        "pool_w": nrm(ks[7], (L, POOL_GROUPS, POOL_GROUP_WIDTH, POOL_GROUP_WIDTH), POOL_GROUP_WIDTH ** -0.5),
        "pool_scale": gain(ks[8], (L, POOL_WIDTH)),
        "pool_up": nrm(ks[9], (L, POOL_WIDTH, D_MODEL), POOL_WIDTH ** -0.5),
        "dw_kernel": nrm(ks[10], (L, CONV_KERNEL, CONV_WIDTH), CONV_KERNEL ** -0.5),
        "dw_bias": nrm(ks[11], (L, CONV_WIDTH), 0.01),
        "conv_ln_g": gain(ks[12], (L, CONV_WIDTH)),
        "conv_ln_b": nrm(ks[13], (L, CONV_WIDTH), 0.01),
        "conv_out": nrm(ks[14], (L, CONV_WIDTH, D_MODEL), CONV_WIDTH ** -0.5),
        "w_out": nrm(ks[15], (L, D_MODEL, D_MODEL), D_MODEL ** -0.5),
        "norm2_g": gain(ks[16], (L, D_MODEL)),
        "w_query": nrm(ks[17], (L, D_MODEL, PEER_HEADS * PEER_KEY_DIM), D_MODEL ** -0.5),
        "sub_keys_1": nrm(ks[18], (L, N_KEYS, PEER_HALF_DIM), PEER_HALF_DIM ** -0.5),
        "sub_keys_2": nrm(ks[19], (L, N_KEYS, PEER_HALF_DIM), PEER_HALF_DIM ** -0.5),
        "expert_u": nrm(ks[20], (L, N_EXPERTS, D_MODEL), D_MODEL ** -0.5),
        "expert_v": nrm(ks[21], (L, N_EXPERTS, D_MODEL), PEER_HEADS ** -0.5),
        "final_g": gain(ks[22], (D_MODEL,)),
    }


def reference(x, c, ada_w, ada_b, norm1_g, w_in, b_in, pool_w, pool_scale, pool_up,
              dw_kernel, dw_bias, conv_ln_g, conv_ln_b, conv_out, w_out, norm2_g,
              w_query, sub_keys_1, sub_keys_2, expert_u, expert_v, final_g):
    c_act = jax.nn.silu(c)
    for l in range(DEPTH):
        mod = c_act @ ada_w[l] + ada_b[l]
        shift1, scale1, gate1, shift2, scale2, gate2 = [
            m[:, None, :] for m in jnp.split(mod, N_MOD, axis=-1)]

        h = rmsnorm(x, norm1_g[l]) * (1.0 + scale1) + shift1
        proj = h @ w_in[l] + b_in[l]
        p = proj[..., :POOL_WIDTH]
        a = proj[..., POOL_WIDTH:POOL_WIDTH + 2 * CONV_WIDTH]
        g = proj[..., POOL_WIDTH + 2 * CONV_WIDTH:]
        y_pool = pool_branch(p, pool_w[l], pool_scale[l], pool_up[l])
        y_conv = conformer_branch(a, dw_kernel[l], dw_bias[l], conv_ln_g[l], conv_ln_b[l], conv_out[l])
        merged = jax.nn.sigmoid(g[..., :D_MODEL]) * y_pool + jax.nn.sigmoid(g[..., D_MODEL:]) * y_conv
        x = x + gate1 * (merged @ w_out[l])

        h2 = rmsnorm(x, norm2_g[l]) * (1.0 + scale2) + shift2
        x = x + gate2 * peer(h2, w_query[l], sub_keys_1[l], sub_keys_2[l], expert_u[l], expert_v[l])
    return rmsnorm(x, final_g)
```

```cpp
#include <hip/hip_runtime.h>
#include <hip/hip_cooperative_groups.h>
#include <cstdio>
#include <cstdint>
namespace cg = cooperative_groups;
#define DBG_NO_DOT2 1
#define DBG_REPEAT 0

#define LAS __attribute__((address_space(3)))
typedef unsigned short bf16_t;
typedef short bf16x8 __attribute__((ext_vector_type(8)));
typedef float f32x4 __attribute__((ext_vector_type(4)));
typedef float f32x2 __attribute__((ext_vector_type(2)));
typedef float f32x16 __attribute__((ext_vector_type(16)));
typedef unsigned u32x4 __attribute__((ext_vector_type(4)));
typedef unsigned u32x2 __attribute__((ext_vector_type(2)));
typedef __bf16 bf16x2_t __attribute__((ext_vector_type(2)));

constexpr int T = 32768, D = 1024, SEQ = 8192, NBATCH = 4, INW = 3584, NMOD = 6 * 1024;
constexpr int NEXP = 16384;
constexpr float EPS = 1e-6f;
constexpr int NTHREADS = 512;
constexpr int LDS_BYTES = 131072 + 1024;
constexpr int LDS_CTL_OFF = 131072;

constexpr size_t MiB = 1024ull * 1024ull;
constexpr size_t WS_CTL = 0;
constexpr size_t WS_MOD = 16384;
constexpr size_t WS_BINP = 114688;
constexpr size_t WS_WIN = 131072;
constexpr size_t WS_WPC = WS_WIN + 7340032;
constexpr size_t WS_WOUT = WS_WPC + 2 * MiB;
constexpr size_t WS_WQ = WS_WOUT + 2 * MiB;
constexpr size_t WS_EU = 16 * MiB;
constexpr size_t WS_EV = 32 * MiB;
constexpr size_t WS_SU = 48 * MiB;
constexpr size_t WS_SV = 48 * MiB + 65536;
constexpr size_t WS_H = 80 * MiB;
constexpr size_t WS_PG = 144 * MiB;
constexpr size_t WS_SG = 208 * MiB;
constexpr size_t WS_MC = 336 * MiB;
constexpr size_t WS_IDX = 400 * MiB;
constexpr size_t WS_GATE = 416 * MiB;
constexpr size_t WS_HB = WS_PG;
constexpr size_t WS_HS = WS_PG + 32 * MiB;
constexpr size_t WS_WG8 = WS_WIN + 1536 * 1024;
constexpr size_t WS_WGS = WS_WIN + 4 * MiB + 1536 * 4;
constexpr size_t WS_X8 = 436 * MiB;
constexpr size_t WS_X8S = 468 * MiB;
constexpr size_t WS_X1B = WS_MC;
constexpr size_t WS_A2 = 432 * MiB;
constexpr size_t WS_BIAS2 = WS_A2 + 16384;
constexpr size_t WS_SSQ = WS_A2 + 65536;
constexpr size_t WS_CO = WS_SG;
constexpr size_t WS_IDP = WS_SG + 16 * MiB;
constexpr size_t WS_COP = WS_SG + 32 * MiB;
constexpr size_t WS_CS = WS_SG + 48 * MiB;
constexpr size_t WS_WP8 = WS_WIN;
constexpr size_t WS_WP8S = WS_WIN + 4 * MiB;
constexpr size_t WS_PMAX = WS_WIN + 5 * MiB;
constexpr size_t WS_END = 469 * MiB;
static_assert(WS_WQ + 4 * MiB <= WS_EU, "weight region overflow");

struct Params;
typedef const __attribute__((address_space(4))) Params* KP;
struct Params {
    const float* in[23];
    float* out;
    unsigned char* ws;
    int ph_lo, ph_hi;
};

typedef __bf16 bf16x2v_t __attribute__((ext_vector_type(2)));
__device__ __forceinline__ unsigned cvt_pk_bf16(float lo, float hi) { return __builtin_bit_cast(unsigned, __builtin_convertvector((f32x2){lo, hi}, bf16x2v_t)); }
__device__ __forceinline__ float bf_lo(unsigned u) { return __uint_as_float(u << 16); }
__device__ __forceinline__ float bf_hi(unsigned u) { return __uint_as_float(u & 0xffff0000u); }
__device__ __forceinline__ float fast_sigmoid(float x) { return __builtin_amdgcn_rcpf(1.0f + __builtin_amdgcn_exp2f(-1.44269504089f * x)); }
__device__ __forceinline__ int lane_id_asm() { int l; asm volatile("v_mbcnt_lo_u32_b32 %0, -1, 0\n\tv_mbcnt_hi_u32_b32 %0, -1, %0" : "=v"(l)); return l; }
__device__ __forceinline__ float wave_sum(float v) {
#pragma unroll
    for (int o = 32; o >= 1; o >>= 1) v += __shfl_xor(v, o);
    return v;
}
__device__ __forceinline__ int in_colmap(int n) {
    if (n < 512) return n;
    if (n < 1536) { const int t = (n - 512) >> 8, r = (n - 512) & 255; return r < 128 ? 512 + 128 * t + r : 1024 + 128 * t + (r - 128); }
    const int t = (n - 1536) >> 8, r = (n - 1536) & 255;
    return r < 128 ? 1536 + 128 * t + r : 2560 + 128 * t + (r - 128);
}

#define XB_TMO      128
#define XB_XCNT(j)  (256  + 64 * (j))
#define XB_XSUB(j)  (1280 + 64 * (j))
#define XB_XGEN(j)  (2304 + 64 * (j))
#define XB_TOP      3328
#define XB_TOPGEN   3392
#define XCD_BAR_WORDS 3456
#define XB_SPIN_CAP (1u << 22)
__device__ __forceinline__ unsigned xb_ld(unsigned* p)              { return __hip_atomic_load(p, __ATOMIC_RELAXED, __HIP_MEMORY_SCOPE_AGENT); }
__device__ __forceinline__ unsigned xb_add(unsigned* p, unsigned v) { return __hip_atomic_fetch_add(p, v, __ATOMIC_RELAXED, __HIP_MEMORY_SCOPE_AGENT); }
__device__ __forceinline__ unsigned xb_xcc_id() { return (unsigned)__builtin_amdgcn_s_getreg((3 << 11) | 20) & 0xFu; }
#define XB_SPIN(cond, bar) do { unsigned _sp = 0; while (cond) { __builtin_amdgcn_s_sleep(1); \
    if ((++_sp & 255u) == 0u) { if (xb_ld(&(bar)[XB_TMO])) break; if (_sp > XB_SPIN_CAP) { atomicAdd(&(bar)[XB_TMO], 1u); break; } } } } while (0)
struct XcdBarrier { unsigned* bar; unsigned x; volatile LAS unsigned* st; };
__device__ __forceinline__ XcdBarrier xcd_barrier_post(unsigned* bar, volatile LAS unsigned* st, int wave_s) {
    XcdBarrier b; b.bar = bar; b.x = xb_xcc_id(); b.st = st;
    if (wave_s == 0 && lane_id_asm() == 0) (void)xb_add(&bar[XB_XCNT(b.x)], 1u);
    return b;
}
__device__ __forceinline__ void xcd_barrier_complete(unsigned* bar, unsigned x, unsigned& nloc, unsigned& nx) {
    const unsigned G = gridDim.x * gridDim.y * gridDim.z;
    unsigned sum, cnt, mine, sp = 0u;
    for (;;) {
        sum = 0u; cnt = 0u; mine = 0u;
#pragma unroll
        for (unsigned j = 0; j < 16; ++j) { const unsigned c = xb_ld(&bar[XB_XCNT(j)]); sum += c; cnt += (c > 0u) ? 1u : 0u; mine = (j == x) ? c : mine; }
        if (sum == G) break;
        __builtin_amdgcn_s_sleep(1);
        if ((++sp & 255u) == 0u) { if (xb_ld(&bar[XB_TMO])) break; if (sp > XB_SPIN_CAP) { atomicAdd(&bar[XB_TMO], 1u); break; } }
    }
    nloc = mine > 0u ? mine : 1u; nx = cnt > 0u ? cnt : 1u;
}
__device__ __forceinline__ void xcd_barrier(const XcdBarrier& b, int wave_s) {
    asm volatile("s_waitcnt vmcnt(0)" ::: "memory");
    __syncthreads();
    if (wave_s == 0 && lane_id_asm() == 0) {
        unsigned* bar = b.bar;
        __builtin_amdgcn_s_waitcnt(0);
        unsigned nloc = b.st[0], nx = b.st[1];
        if (nloc == 0u) { xcd_barrier_complete(bar, b.x, nloc, nx); b.st[0] = nloc; b.st[1] = nx; }
        const unsigned old = xb_add(&bar[XB_XSUB(b.x)], 1u);
        const unsigned gen = old / nloc;
        if (old + 1u == (gen + 1u) * nloc) {
            __builtin_amdgcn_fence(__ATOMIC_RELEASE, "agent");
            asm volatile("s_waitcnt vmcnt(0)" ::: "memory");
            const unsigned og = xb_add(&bar[XB_TOP], 1u);
            const unsigned tg = og / nx;
            if (og + 1u == (tg + 1u) * nx) xb_add(&bar[XB_TOPGEN], 1u);
            else XB_SPIN(xb_ld(&bar[XB_TOPGEN]) == tg, bar);
            __builtin_amdgcn_fence(__ATOMIC_ACQUIRE, "agent");
            xb_add(&bar[XB_XGEN(b.x)], 1u);
            asm volatile("s_waitcnt vmcnt(0)" ::: "memory");
        } else {
            XB_SPIN(xb_ld(&bar[XB_XGEN(b.x)]) == gen, bar);
            __builtin_amdgcn_fence(__ATOMIC_ACQUIRE, "agent");
            asm volatile("s_waitcnt vmcnt(0)" ::: "memory");
        }
    }
    __syncthreads();
}

namespace pg8 {
constexpr int BM = 256, BK = 64, HALF = 128, HTB = HALF * BK * 2, STAGE_BYTES = 8 * HTB, NXCD = 8, WGM = 8;
__host__ __device__ __forceinline__ int lds_byte(int r, int c) { const int st = (r >> 4) * 2 + (c >> 5), rr = r & 15, cc = c & 31, ob = rr * 64 + cc * 2; return st * 1024 + (ob ^ (((ob >> 9) & 1) << 5)); }
__host__ __device__ __forceinline__ void stage_rc(int b, int& R, int& C) { const int st = b / 1024, sb = b % 1024, swz = sb ^ (((sb >> 9) & 1) << 5); R = (st >> 1) * 16 + swz / 64; C = (st & 1) * 32 + (swz % 64) / 2; }
__host__ __device__ __forceinline__ int perm32(int rho) { const int n = rho >> 4, i = rho & 15; return 8 * (i >> 2) + 4 * n + (i & 3); }
struct Unit { int pm, pn; };
struct Gemm { const bf16_t* A; const bf16_t* Bt; int M, N, K; };
struct StaticOrder {
    int nM, nN, nwg, G, c;
    __host__ __device__ void init(int M, int N, int G_, int c_) { nM = M / BM; nN = N / BM; nwg = nM * nN; G = G_; c = c_; }
    __host__ __device__ bool next(int i, Unit& u) const {
        const long L = (long)i * G + c; if (L >= nwg) return false;
        int wgid = (int)L; { const int q = nwg / NXCD, r = nwg % NXCD, xcd = wgid % NXCD, off = wgid / NXCD; wgid = (xcd < r ? xcd * (q + 1) : r * (q + 1) + (xcd - r) * q) + off; }
        const int nig = WGM * nN, gid = wgid / nig, fm = gid * WGM, gsz = (nM - fm) < WGM ? (nM - fm) : WGM;
        u.pm = fm + ((wgid % nig) % gsz); u.pn = (wgid % nig) / gsz; return true;
    }
};
typedef int i32x8_t __attribute__((ext_vector_type(8)));
typedef int i32x4_t __attribute__((ext_vector_type(4)));
template <bool FP8> struct FragT { typedef bf16x8 type[2]; };
template <> struct FragT<true> { typedef i32x8_t type; };
__device__ __forceinline__ void ldfrag(bf16x8 (&d)[2], const LAS unsigned char* p) { d[0] = *(const LAS bf16x8*)p; d[1] = *(const LAS bf16x8*)(p + 1024); }
__device__ __forceinline__ void ldfrag(i32x8_t& d, const LAS unsigned char* p) { const i32x4_t lo = *(const LAS i32x4_t*)p, hi = *(const LAS i32x4_t*)(p + 1024); d = (i32x8_t){lo[0], lo[1], lo[2], lo[3], hi[0], hi[1], hi[2], hi[3]}; }
__device__ __forceinline__ void mma1(f32x4& acc, const bf16x8 (&b)[2], const bf16x8 (&a)[2]) {
    acc = __builtin_amdgcn_mfma_f32_16x16x32_bf16(b[0], a[0], acc, 0, 0, 0); acc = __builtin_amdgcn_mfma_f32_16x16x32_bf16(b[1], a[1], acc, 0, 0, 0); }
__device__ __forceinline__ void mma1(f32x4& acc, const i32x8_t& b, const i32x8_t& a) {
    asm volatile("v_mfma_scale_f32_16x16x128_f8f6f4 %0, %1, %2, %0, %3, %3 op_sel_hi:[0,0,0]" : "+v"(acc) : "v"(b), "v"(a), "v"(0x7f7f7f7f)); }
template <class Epi>
__device__ __forceinline__ void gemm_phase(LAS unsigned char* lds, const Gemm g, const StaticOrder& S, const Epi& E, int wave_s) {
    const int lane = lane_id_asm(), wid = wave_s, tid = wid * 64 + lane, wr = wid >> 2, wc = wid & 3, fr = lane & 15, fq = lane >> 4;
    const int K = g.K, nt = K / BK;
    unsigned voffA[2], voffB[2];
#pragma unroll
    for (int i = 0; i < 2; ++i) { int R, C; stage_rc(tid * 16 + i * 8192, R, C); const int Rb = Epi::PERM ? ((R & ~31) + perm32(R & 31)) : R;
        voffA[i] = (unsigned)(R * K + C) * 2u; voffB[i] = (unsigned)(Rb * K + C) * 2u; }
    const size_t kstep = (size_t)(BK * 2);
    const size_t hstep = (size_t)HALF * K * 2;
    const size_t tstep = 2 * hstep;
    const unsigned ldsw = (unsigned)wid * 1024u;
    const int aoff = lds_byte(wr * 64 + fr, fq * 8), boff = lds_byte(wc * 32 + fr, fq * 8);
#define PG8_SA(b, h) (((b) * 2 + (h)) * HTB)
#define PG8_SB(b, h) ((4 + (b) * 2 + (h)) * HTB)
#define PG8_STAGE(bufoff, gbase, voff) do { _Pragma("unroll") for (int _i = 0; _i < 2; ++_i) \
        __builtin_amdgcn_global_load_lds((const unsigned*)((const char*)(gbase) + (voff)[_i]), (LAS unsigned*)(lds + (bufoff) + ldsw + _i * 8192), 16, 0, 0); } while (0)
#define PG8_LDA(dst, b, h) do { _Pragma("unroll") for (int m = 0; m < 4; ++m) ldfrag(dst[m], lds + PG8_SA(b, h) + aoff + m * 2048); } while (0)
#define PG8_LDB(dst, b, h) do { _Pragma("unroll") for (int n = 0; n < 2; ++n) ldfrag(dst[n], lds + PG8_SB(b, h) + boff + n * 2048); } while (0)
#define PG8_MMA(ai, bj, At, Bt) do { __builtin_amdgcn_s_setprio(1); _Pragma("unroll") for (int m = 0; m < 4; ++m) _Pragma("unroll") for (int n = 0; n < 2; ++n) mma1(acc[ai][bj][m][n], Bt[n], At[m]); __builtin_amdgcn_s_setprio(0); } while (0)
#define PG8_WAIT_V(n) asm volatile("s_waitcnt vmcnt(" #n ")" ::: "memory")
#define PG8_WAIT_L(n) asm volatile("s_waitcnt lgkmcnt(" #n ")" ::: "memory")
#define PG8_BAR __builtin_amdgcn_s_barrier()
#define PG8_SCHED __builtin_amdgcn_sched_barrier(0)
    Unit cur, nxt; int ui = 0;
    if (!S.next(0, cur)) return;
    f32x4 acc[2][2][4][2];
#pragma unroll
    for (int a = 0; a < 2; ++a)
#pragma unroll
        for (int b = 0; b < 2; ++b)
#pragma unroll
            for (int m = 0; m < 4; ++m)
#pragma unroll
                for (int n = 0; n < 2; ++n) acc[a][b][m][n] = (f32x4){0.f, 0.f, 0.f, 0.f};
    typename FragT<Epi::FP8>::type At[4], B0[2], B1[2];
    const char* cA = (const char*)g.A + (size_t)cur.pm * tstep; const char* cB = (const char*)g.Bt + (size_t)cur.pn * tstep;
    PG8_STAGE(PG8_SB(0, 0), cB, voffB); PG8_STAGE(PG8_SB(0, 1), cB + hstep, voffB); PG8_STAGE(PG8_SA(0, 0), cA, voffA); PG8_STAGE(PG8_SA(0, 1), cA + hstep, voffA);
    if (wr == 1) PG8_BAR;
    PG8_WAIT_V(2); PG8_BAR;
    PG8_STAGE(PG8_SB(1, 0), cB + kstep, voffB); PG8_STAGE(PG8_SA(1, 0), cA + kstep, voffA); PG8_STAGE(PG8_SB(1, 1), cB + hstep + kstep, voffB);
    PG8_WAIT_V(6); PG8_BAR;
    for (;;) {
        const bool has_next = S.next(ui + 1, nxt);
        const char* nA = has_next ? (const char*)g.A + (size_t)nxt.pm * tstep : cA; const char* nB = has_next ? (const char*)g.Bt + (size_t)nxt.pn * tstep : cB;
#pragma unroll 1
        for (int t = 0; t < nt; t += 2) {
            const bool last = (t == nt - 2);
            const char* a1 = cA + (size_t)(t + 1) * kstep;
            const char* a2 = last ? nA : cA + (size_t)(t + 2) * kstep; const char* b2 = last ? nB : cB + (size_t)(t + 2) * kstep;
            const char* a3 = a2 + kstep; const char* b3 = b2 + kstep;
            if constexpr (Epi::HAS_MID) { if (t == nt / 2) E.mid(acc, cur, wr, wc, fr, fq); }
            PG8_LDB(B0, 0, 0); PG8_LDB(B1, 0, 1); PG8_SCHED; PG8_LDA(At, 0, 0); PG8_STAGE(PG8_SA(1, 1), a1 + hstep, voffA);
            PG8_WAIT_V(8); PG8_WAIT_L(0); PG8_BAR; PG8_MMA(0, 0, At, B0); PG8_MMA(0, 1, At, B1); PG8_BAR; PG8_SCHED;
            PG8_LDA(At, 0, 1); PG8_STAGE(PG8_SB(0, 0), b2, voffB); PG8_STAGE(PG8_SB(0, 1), b2 + hstep, voffB); PG8_STAGE(PG8_SA(0, 0), a2, voffA);
            PG8_WAIT_V(8); PG8_WAIT_L(0); PG8_BAR; PG8_MMA(1, 0, At, B0); PG8_MMA(1, 1, At, B1); PG8_BAR; PG8_SCHED;
            PG8_LDB(B0, 1, 0); PG8_LDB(B1, 1, 1); PG8_SCHED; PG8_LDA(At, 1, 0); PG8_STAGE(PG8_SA(0, 1), a2 + hstep, voffA);
            PG8_WAIT_V(8); PG8_WAIT_L(0); PG8_BAR; PG8_MMA(0, 0, At, B0); PG8_MMA(0, 1, At, B1); PG8_BAR; PG8_SCHED;
            PG8_LDA(At, 1, 1); PG8_STAGE(PG8_SB(1, 0), b3, voffB); PG8_STAGE(PG8_SB(1, 1), b3 + hstep, voffB); PG8_STAGE(PG8_SA(1, 0), a3, voffA);
            PG8_WAIT_V(8); PG8_WAIT_L(0); PG8_BAR; PG8_MMA(1, 0, At, B0); PG8_MMA(1, 1, At, B1); PG8_BAR; PG8_SCHED;
        }
        if (wr == 0) PG8_BAR;
        E(acc, cur, wr, wc, fr, fq);
        if (!has_next) break;
#pragma unroll
        for (int a = 0; a < 2; ++a)
#pragma unroll
            for (int b = 0; b < 2; ++b)
#pragma unroll
                for (int m = 0; m < 4; ++m)
#pragma unroll
                    for (int n = 0; n < 2; ++n) acc[a][b][m][n] = (f32x4){0.f, 0.f, 0.f, 0.f};
        cur = nxt; cA = nA; cB = nB; ++ui;
        if (wr == 1) PG8_BAR;
    }
    PG8_WAIT_V(0);
    PG8_BAR;
#undef PG8_SA
#undef PG8_SB
#undef PG8_STAGE
#undef PG8_LDA
#undef PG8_LDB
#undef PG8_MMA
#undef PG8_WAIT_V
#undef PG8_WAIT_L
#undef PG8_BAR
#undef PG8_SCHED
}
}
typedef f32x4 AccT[2][2][4][2];

struct EpiProj {
    static constexpr bool PERM = true, HAS_MID = false, FP8 = true;
    const float* bias; bf16_t* PB; bf16_t* GB; const float* RS; const float* CS;
    __device__ __forceinline__ void operator()(const AccT& acc, const pg8::Unit& u, int wr, int wc, int fr, int fq) const {
        const int row0 = u.pm * 256 + wr * 64 + fr, lc0 = wc * 32 + 8 * fq;
        f32x4 bv[2][2], cv[2][2];
#pragma unroll
        for (int bj = 0; bj < 2; ++bj)
#pragma unroll
            for (int n = 0; n < 2; ++n) { bv[bj][n] = *(const f32x4*)(bias + u.pn * 256 + bj * 128 + lc0 + 4 * n); cv[bj][n] = *(const f32x4*)(CS + u.pn * 256 + bj * 128 + lc0 + 4 * n); }
        if (u.pn >= 2 && u.pn < 6) {
            const int t = u.pn - 2;
#pragma unroll
            for (int ai = 0; ai < 2; ++ai)
#pragma unroll
                for (int m = 0; m < 4; ++m) {
                    const int row = row0 + ai * 128 + m * 16; const float rs = RS[row];
                    float o[8];
#pragma unroll
                    for (int n = 0; n < 2; ++n) { const f32x4 v = acc[ai][0][m][n] * (cv[0][n] * rs) + bv[0][n], gt = acc[ai][1][m][n] * (cv[1][n] * rs) + bv[1][n];
#pragma unroll
                        for (int j = 0; j < 4; ++j) o[n * 4 + j] = v[j] * fast_sigmoid(gt[j]); }
                    u32x4 w; w.x = cvt_pk_bf16(o[0], o[1]); w.y = cvt_pk_bf16(o[2], o[3]); w.z = cvt_pk_bf16(o[4], o[5]); w.w = cvt_pk_bf16(o[6], o[7]);
                    *(u32x4*)(GB + (size_t)row * 512 + t * 128 + lc0) = w;
                }
        } else {
            const bool isp = true;
            bf16_t* base = PB; const int ldc = 512; const int colt = u.pn * 256;
#pragma unroll
            for (int ai = 0; ai < 2; ++ai)
#pragma unroll
                for (int m = 0; m < 4; ++m) {
                    const int row = row0 + ai * 128 + m * 16; const float rs = RS[row];
#pragma unroll
                    for (int bj = 0; bj < 2; ++bj) {
                        f32x4 v0 = acc[ai][bj][m][0] * (cv[bj][0] * rs) + bv[bj][0], v1 = acc[ai][bj][m][1] * (cv[bj][1] * rs) + bv[bj][1];
                        if (!isp) {
#pragma unroll
                            for (int j = 0; j < 4; ++j) { v0[j] = fast_sigmoid(v0[j]); v1[j] = fast_sigmoid(v1[j]); }
                        }
                        u32x4 w; w.x = cvt_pk_bf16(v0[0], v0[1]); w.y = cvt_pk_bf16(v0[2], v0[3]); w.z = cvt_pk_bf16(v1[0], v1[1]); w.w = cvt_pk_bf16(v1[2], v1[3]);
                        *(u32x4*)(base + (size_t)row * ldc + colt + bj * 128 + lc0) = w;
                    }
                }
        }
    }
};
struct EpiGate {
    static constexpr bool PERM = true, HAS_MID = false, FP8 = true;
    const float* bias; const float* RS; const float* CS; bf16_t* SG;
    __device__ __forceinline__ void operator()(const AccT& acc, const pg8::Unit& u, int wr, int wc, int fr, int fq) const {
        const int row0 = u.pm * 256 + wr * 64 + fr, lc0 = wc * 32 + 8 * fq, t = u.pn;
        float rs[2][4];
#pragma unroll
        for (int ai = 0; ai < 2; ++ai)
#pragma unroll
            for (int m = 0; m < 4; ++m) rs[ai][m] = RS[row0 + ai * 128 + m * 16];
#pragma unroll
        for (int n = 0; n < 2; ++n) {
            const f32x4 b1 = *(const f32x4*)(bias + 1536 + t * 256 + lc0 + 4 * n), b2 = *(const f32x4*)(bias + 1536 + t * 256 + 128 + lc0 + 4 * n);
            const f32x4 c1 = *(const f32x4*)(CS + t * 256 + lc0 + 4 * n), c2 = *(const f32x4*)(CS + t * 256 + 128 + lc0 + 4 * n);
#pragma unroll
            for (int ai = 0; ai < 2; ++ai)
#pragma unroll
                for (int m = 0; m < 4; ++m) {
                    const int row = row0 + ai * 128 + m * 16;
                    const f32x4 a1 = acc[ai][0][m][n] * (c1 * rs[ai][m]) + b1, a2 = acc[ai][1][m][n] * (c2 * rs[ai][m]) + b2;
                    float ra[4], s2[4];
#pragma unroll
                    for (int j = 0; j < 4; ++j) { const float e1 = __builtin_amdgcn_exp2f(-1.44269504089f * a1[j]), e2 = __builtin_amdgcn_exp2f(-1.44269504089f * a2[j]);
                        ra[j] = (1.0f + e2) * __builtin_amdgcn_rcpf(1.0f + e1); s2[j] = __builtin_amdgcn_rcpf(1.0f + e2); }
                    *(u32x2*)(SG + (size_t)row * 2048 + t * 128 + lc0 + 4 * n) = (u32x2){cvt_pk_bf16(ra[0], ra[1]), cvt_pk_bf16(ra[2], ra[3])};
                    *(u32x2*)(SG + (size_t)row * 2048 + 1024 + t * 128 + lc0 + 4 * n) = (u32x2){cvt_pk_bf16(s2[0], s2[1]), cvt_pk_bf16(s2[2], s2[3])};
                }
        }
    }
};
struct EpiIn {
    static constexpr bool PERM = true, HAS_MID = false, FP8 = true;
    EpiProj P; EpiGate G;
    __device__ __forceinline__ void operator()(const AccT& acc, const pg8::Unit& u, int wr, int wc, int fr, int fq) const {
        if (u.pn < 6) P(acc, u, wr, wc, fr, fq);
        else { pg8::Unit u2 = u; u2.pn = u.pn - 6; G(acc, u2, wr, wc, fr, fq); }
    }
};
struct EpiMerge {
    static constexpr bool PERM = true, HAS_MID = true, FP8 = false;
    const bf16_t* SG; bf16_t* MG;
    __device__ __forceinline__ void mid(AccT& acc, const pg8::Unit& u, int wr, int wc, int fr, int fq) const {
        const int row0 = u.pm * 256 + wr * 64 + fr, col0 = u.pn * 256 + wc * 32 + 8 * fq;
#pragma unroll
        for (int ai = 0; ai < 2; ++ai)
#pragma unroll
            for (int m = 0; m < 4; ++m) {
                const bf16_t* p = SG + (size_t)(row0 + ai * 128 + m * 16) * 2048 + col0;
                const u32x4 r0 = *(const u32x4*)p, r1 = *(const u32x4*)(p + 128);
#pragma unroll
                for (int bj = 0; bj < 2; ++bj) {
                    const unsigned a1[4] = {bj ? r1.x : r0.x, bj ? r1.y : r0.y, bj ? r1.z : r0.z, bj ? r1.w : r0.w};
#pragma unroll
                    for (int n = 0; n < 2; ++n)
#pragma unroll
                        for (int j = 0; j < 4; ++j) { const unsigned w1 = a1[n * 2 + (j >> 1)]; acc[ai][bj][m][n][j] *= (j & 1) ? bf_hi(w1) : bf_lo(w1); }
                }
                if (m & 1) asm volatile("" ::: "memory");
            }
    }
    __device__ __forceinline__ void operator()(const AccT& acc, const pg8::Unit& u, int wr, int wc, int fr, int fq) const {
        const int row0 = u.pm * 256 + wr * 64 + fr, col0 = u.pn * 256 + wc * 32 + 8 * fq;
#pragma unroll
        for (int ai = 0; ai < 2; ++ai)
#pragma unroll
            for (int m = 0; m < 4; ++m)
#pragma unroll
                for (int bj = 0; bj < 2; ++bj) {
                    const int row = row0 + ai * 128 + m * 16;
                    const u32x4 s2 = *(const u32x4*)(SG + (size_t)row * 2048 + 1024 + col0 + bj * 128);
                    const unsigned a2[4] = {s2.x, s2.y, s2.z, s2.w};
                    float o[8];
#pragma unroll
                    for (int n = 0; n < 2; ++n)
#pragma unroll
                        for (int j = 0; j < 4; ++j) {
                            const unsigned w2 = a2[n * 2 + (j >> 1)];
                            const float f2 = fmaxf((j & 1) ? bf_hi(w2) : bf_lo(w2), 1e-20f);
                            o[n * 4 + j] = acc[ai][bj][m][n][j] * f2;
                        }
                    u32x4 w; w.x = cvt_pk_bf16(o[0], o[1]); w.y = cvt_pk_bf16(o[2], o[3]); w.z = cvt_pk_bf16(o[4], o[5]); w.w = cvt_pk_bf16(o[6], o[7]);
                    *(u32x4*)(MG + (size_t)row * 1024 + col0 + bj * 128) = w;
                }
    }
};
struct EpiResid {
    static constexpr bool PERM = true, HAS_MID = false, FP8 = false;
    const float* X; const float* mod; bf16_t* X1B;
    const float* A2; bf16_t* XA; float* SSQ;
    __device__ __forceinline__ void operator()(const AccT& acc, const pg8::Unit& u, int wr, int wc, int fr, int fq) const {
        const int row0 = u.pm * 256 + wr * 64 + fr, col0 = u.pn * 256 + wc * 32 + 8 * fq;
        const int b = (u.pm * 256) / SEQ;
        const float* gt = mod + (size_t)b * NMOD; const float* a2 = A2 + b * 1024;
        f32x4 gv[2][2], av[2][2];
#pragma unroll
        for (int bj = 0; bj < 2; ++bj)
#pragma unroll
            for (int n = 0; n < 2; ++n) { gv[bj][n] = *(const f32x4*)(gt + col0 + bj * 128 + n * 4); av[bj][n] = *(const f32x4*)(a2 + col0 + bj * 128 + n * 4); }
#pragma unroll
        for (int ai = 0; ai < 2; ++ai)
#pragma unroll
            for (int m = 0; m < 4; ++m) {
                const int row = row0 + ai * 128 + m * 16;
                const size_t off = (size_t)row * 1024 + col0;
                float ss = 0.f;
#pragma unroll
                for (int bj = 0; bj < 2; ++bj) {
                    const f32x4 xv0 = *(const f32x4*)(X + off + bj * 128), xv1 = *(const f32x4*)(X + off + bj * 128 + 4);
                    const f32x4 x10 = xv0 + gv[bj][0] * acc[ai][bj][m][0], x11 = xv1 + gv[bj][1] * acc[ai][bj][m][1];
                    { u32x4 wx; wx.x = cvt_pk_bf16(x10[0], x10[1]); wx.y = cvt_pk_bf16(x10[2], x10[3]); wx.z = cvt_pk_bf16(x11[0], x11[1]); wx.w = cvt_pk_bf16(x11[2], x11[3]);
                      *(u32x4*)(X1B + off + bj * 128) = wx; }
                    ss += x10[0] * x10[0] + x10[1] * x10[1] + x10[2] * x10[2] + x10[3] * x10[3] + x11[0] * x11[0] + x11[1] * x11[1] + x11[2] * x11[2] + x11[3] * x11[3];
                    const f32x4 xa0 = x10 * av[bj][0], xa1 = x11 * av[bj][1];
                    u32x4 w; w.x = cvt_pk_bf16(xa0[0], xa0[1]); w.y = cvt_pk_bf16(xa0[2], xa0[3]); w.z = cvt_pk_bf16(xa1[0], xa1[1]); w.w = cvt_pk_bf16(xa1[2], xa1[3]);
                    *(u32x4*)(XA + off + bj * 128) = w;
                }
                ss += __shfl_xor(ss, 16); ss += __shfl_xor(ss, 32);
                if (fq == 0) __hip_atomic_fetch_add(SSQ + row, ss, __ATOMIC_RELAXED, __HIP_MEMORY_SCOPE_AGENT);
            }
    }
};
struct EpiBf16 {
    static constexpr bool PERM = true, HAS_MID = false, FP8 = false;
    bf16_t* O; int ldc;
    __device__ __forceinline__ void operator()(const AccT& acc, const pg8::Unit& u, int wr, int wc, int fr, int fq) const {
        const int row0 = u.pm * 256 + wr * 64 + fr, col0 = u.pn * 256 + wc * 32 + 8 * fq;
#pragma unroll
        for (int ai = 0; ai < 2; ++ai)
#pragma unroll
            for (int m = 0; m < 4; ++m)
#pragma unroll
                for (int bj = 0; bj < 2; ++bj) {
                    const f32x4 v0 = acc[ai][bj][m][0], v1 = acc[ai][bj][m][1];
                    u32x4 w; w.x = cvt_pk_bf16(v0[0], v0[1]); w.y = cvt_pk_bf16(v0[2], v0[3]); w.z = cvt_pk_bf16(v1[0], v1[1]); w.w = cvt_pk_bf16(v1[2], v1[3]);
                    *(u32x4*)(O + (size_t)(row0 + ai * 128 + m * 16) * ldc + col0 + bj * 128) = w;
                }
    }
};

struct EpiQ {
    static constexpr bool PERM = true, HAS_MID = false, FP8 = false;
    bf16_t* O; const float* SSQ; const float* BIAS2;
    __device__ __forceinline__ void operator()(const AccT& acc, const pg8::Unit& u, int wr, int wc, int fr, int fq) const {
        const int row0 = u.pm * 256 + wr * 64 + fr, col0 = u.pn * 256 + wc * 32 + 8 * fq;
        const float* bs = BIAS2 + ((u.pm * 256) / SEQ) * 2048 + col0;
        f32x4 bv[2][2];
#pragma unroll
        for (int bj = 0; bj < 2; ++bj)
#pragma unroll
            for (int n = 0; n < 2; ++n) bv[bj][n] = *(const f32x4*)(bs + bj * 128 + 4 * n);
#pragma unroll
        for (int ai = 0; ai < 2; ++ai)
#pragma unroll
            for (int m = 0; m < 4; ++m) {
                const int row = row0 + ai * 128 + m * 16;
                const float r = rsqrtf(SSQ[row] * (1.0f / D) + EPS);
#pragma unroll
                for (int bj = 0; bj < 2; ++bj) {
                    const f32x4 v0 = acc[ai][bj][m][0] * r + bv[bj][0], v1 = acc[ai][bj][m][1] * r + bv[bj][1];
                    u32x4 w; w.x = cvt_pk_bf16(v0[0], v0[1]); w.y = cvt_pk_bf16(v0[2], v0[3]); w.z = cvt_pk_bf16(v1[0], v1[1]); w.w = cvt_pk_bf16(v1[2], v1[3]);
                    { const int cw = wr * 2 + ai * 4 + (m >> 1), ks = 2 * wc + (fq >> 1), ln = (fq & 1) * 32 + (m & 1) * 16 + fr;
                      *(u32x4*)(O + ((size_t)(u.pm * 8 + u.pn) * 128 + (size_t)((cw * 2 + bj) * 8 + ks)) * 512 + ln * 8) = w; }
                }
            }
    }
};

#ifndef U_BITS
#define U_BITS 4
#endif
#ifndef V_BITS
#define V_BITS 4
#endif
template <int BITS> struct RowFmt;
template <> struct RowFmt<8> { typedef u32x4 row_t; static constexpr float QMAX = 224.0f; };
template <> struct RowFmt<4> { typedef u32x2 row_t; static constexpr float QMAX = 6.0f; };
template <int I> __device__ __forceinline__ f32x2 row_pair(const u32x4& r) {
    const unsigned w = (I >> 1) == 0 ? r.x : (I >> 1) == 1 ? r.y : (I >> 1) == 2 ? r.z : r.w;
    return __builtin_amdgcn_cvt_pk_f32_fp8((int)w, (I & 1) != 0);
}
template <int I> __device__ __forceinline__ f32x2 row_pair(const u32x2& r) {
    const unsigned w = (I >> 2) == 0 ? r.x : r.y;
    return __builtin_amdgcn_cvt_scalef32_pk_f32_fp4(w, 1.0f, I & 3);
}
template <class R> __device__ __forceinline__ float row_dot16(const R& r, const f32x2 (&hf)[8]) {
    f32x2 acc = {0.f, 0.f};
    acc = __builtin_elementwise_fma(row_pair<0>(r), hf[0], acc); acc = __builtin_elementwise_fma(row_pair<1>(r), hf[1], acc);
    acc = __builtin_elementwise_fma(row_pair<2>(r), hf[2], acc); acc = __builtin_elementwise_fma(row_pair<3>(r), hf[3], acc);
    acc = __builtin_elementwise_fma(row_pair<4>(r), hf[4], acc); acc = __builtin_elementwise_fma(row_pair<5>(r), hf[5], acc);
    acc = __builtin_elementwise_fma(row_pair<6>(r), hf[6], acc); acc = __builtin_elementwise_fma(row_pair<7>(r), hf[7], acc);
    return acc.x + acc.y;
}
template <class R> __device__ __forceinline__ void row_axpy16(const R& r, float c, f32x2 (&o)[8]) {
    const f32x2 c2 = {c, c};
    o[0] = __builtin_elementwise_fma(c2, row_pair<0>(r), o[0]); o[1] = __builtin_elementwise_fma(c2, row_pair<1>(r), o[1]);
    o[2] = __builtin_elementwise_fma(c2, row_pair<2>(r), o[2]); o[3] = __builtin_elementwise_fma(c2, row_pair<3>(r), o[3]);
    o[4] = __builtin_elementwise_fma(c2, row_pair<4>(r), o[4]); o[5] = __builtin_elementwise_fma(c2, row_pair<5>(r), o[5]);
    o[6] = __builtin_elementwise_fma(c2, row_pair<6>(r), o[6]); o[7] = __builtin_elementwise_fma(c2, row_pair<7>(r), o[7]);
}
template <int BITS> __device__ __forceinline__ void quant_row(const f32x4 (&v)[4], float qs, unsigned char* dst_row, int lane) {
    if constexpr (BITS == 8) {
#pragma unroll
        for (int q = 0; q < 4; ++q) { int p = 0; p = __builtin_amdgcn_cvt_pk_fp8_f32(v[q][0] * qs, v[q][1] * qs, p, false); p = __builtin_amdgcn_cvt_pk_fp8_f32(v[q][2] * qs, v[q][3] * qs, p, true);
            ((unsigned*)dst_row)[lane + 64 * q] = (unsigned)p; }
    } else {
#pragma unroll
        for (int q = 0; q < 4; ++q) { unsigned p = 0; p = __builtin_amdgcn_cvt_scalef32_pk_fp4_f32(p, v[q][0] * qs, v[q][1] * qs, 1.0f, 0); p = __builtin_amdgcn_cvt_scalef32_pk_fp4_f32(p, v[q][2] * qs, v[q][3] * qs, 1.0f, 1);
            ((unsigned short*)dst_row)[lane + 64 * q] = (unsigned short)(p & 0xffffu); }
    }
}
__device__ __forceinline__ void xpose_tile(const float* src, int ldsrc, int c0, int k0, bf16_t* dst, int lddst, int n0, int kd0, LAS float* tile, int tid) {
    { const int r = tid >> 4, c4 = tid & 15;
#pragma unroll
      for (int ps = 0; ps < 2; ++ps) { const f32x4 v = *(const f32x4*)(src + (size_t)(k0 + r + 32 * ps) * ldsrc + c0 + c4 * 4);
#pragma unroll
          for (int j = 0; j < 4; ++j) tile[(r + 32 * ps) * 65 + c4 * 4 + j] = v[j]; } }
    __syncthreads();
    { const int n = tid >> 3, kg = tid & 7; float f[8];
#pragma unroll
      for (int i = 0; i < 8; ++i) f[i] = tile[(kg * 8 + i) * 65 + n];
      u32x4 w; w.x = cvt_pk_bf16(f[0], f[1]); w.y = cvt_pk_bf16(f[2], f[3]); w.z = cvt_pk_bf16(f[4], f[5]); w.w = cvt_pk_bf16(f[6], f[7]);
      *(u32x4*)(dst + (size_t)(n0 + n) * lddst + kd0 + k0 + kg * 8) = w; }
    __syncthreads();
}
__device__ __forceinline__ void phase_prep(KP kp, LAS unsigned char* lds, int wave_s) {
    const int tid = wave_s * 64 + lane_id_asm(), G = gridDim.x;
    unsigned char* ws = kp->ws;
    const float* cvec = kp->in[1]; const float* ada_w = kp->in[2]; const float* ada_b = kp->in[3];
    float* mod = (float*)(ws + WS_MOD);
    LAS float* cact = (LAS float*)lds;
    LAS float* red = (LAS float*)(lds + 16384);
    LAS float* tile = (LAS float*)(lds + 49152);
    LAS float* pw = (LAS float*)(lds + 49152);
    if ((int)blockIdx.x < 192) {
        for (int i = tid; i < 4096; i += NTHREADS) { const float v = cvec[i]; cact[i] = v * fast_sigmoid(v); }
    }
    if (blockIdx.x == G - 1) {
        float* binp = (float*)(ws + WS_BINP); const float* b_in = kp->in[6];
        for (int i = tid; i < INW; i += NTHREADS) binp[i] = b_in[in_colmap(i)];
    }
    __syncthreads();
    constexpr int N_MOD = 192, N_WIN = 384, N_CO = 128, N_WO = 256, N_WQ = 512, N_WP = 128, N_WG = 512;
    constexpr int I1 = N_MOD, I2 = I1 + N_WIN, I3 = I2 + N_CO, I4 = I3 + N_WO, I5 = I4 + N_WQ, I6 = I5 + N_WP, I7 = I6 + N_WG;
    for (int it = blockIdx.x; it < I7; it += G) {
        if (it < I1) {
            const int n0 = it * 32, c4 = tid & 7, ks = tid >> 3;
            float a[4][4];
#pragma unroll
            for (int b = 0; b < 4; ++b)
#pragma unroll
                for (int j = 0; j < 4; ++j) a[b][j] = 0.f;
#pragma unroll 4
            for (int kk = 0; kk < 16; ++kk) { const int k = ks * 16 + kk; const f32x4 w = *(const f32x4*)(ada_w + (size_t)k * NMOD + n0 + c4 * 4);
#pragma unroll
                for (int b = 0; b < 4; ++b) { const float cv = cact[b * 1024 + k];
#pragma unroll
                    for (int j = 0; j < 4; ++j) a[b][j] += cv * w[j]; } }
#pragma unroll
            for (int b = 0; b < 4; ++b)
#pragma unroll
                for (int j = 0; j < 4; ++j) red[(ks * 4 + b) * 32 + c4 * 4 + j] = a[b][j];
            __syncthreads();
            if (tid < 128) { const int b = tid >> 5, col = tid & 31; float s = 0.f;
                for (int q = 0; q < 64; ++q) s += red[(q * 4 + b) * 32 + col];
                mod[b * NMOD + n0 + col] = s + ada_b[n0 + col]; }
            __syncthreads();
        } else if (it >= I6 || (it >= I1 && it < I2)) {
            const bool isp = it < I2;
            const int i = isp ? it - I1 : it - I6, kt = i & 15, n0 = (i >> 4) * 64 + (isp ? 0 : 1536), c0 = in_colmap(n0);
            const float* win = kp->in[5];
            LAS float* cmx = (LAS float*)(lds + 49152 + 17408);
            { const int r = tid >> 4, c4 = tid & 15;
              const f32x4 v0 = *(const f32x4*)(win + (size_t)(kt * 64 + r) * INW + c0 + c4 * 4), v1 = *(const f32x4*)(win + (size_t)(kt * 64 + r + 32) * INW + c0 + c4 * 4);
#pragma unroll
              for (int j = 0; j < 4; ++j) cmx[r * 64 + c4 * 4 + j] = fmaxf(fabsf(v0[j]), fabsf(v1[j])); }
            __syncthreads();
            if (tid < 64) { float mm = 0.f; for (int q = 0; q < 32; ++q) mm = fmaxf(mm, cmx[q * 64 + tid]); ((float*)(ws + WS_PMAX))[kt * 3584 + n0 + tid] = mm; }
            __syncthreads();
        } else if (it < I3) {
            const int i = it - I2, kt = i & 7, ntl = i >> 3;
            xpose_tile(kp->in[14], 1024, ntl * 64, kt * 64, (bf16_t*)(ws + WS_WPC), 1024, ntl * 64, 512, tile, tid);
        } else if (it < I4) {
            const int i = it - I3, kt = i & 15, ntl = i >> 4;
            xpose_tile(kp->in[15], 1024, ntl * 64, kt * 64, (bf16_t*)(ws + WS_WOUT), 1024, ntl * 64, 0, tile, tid);
        } else if (it < I5) {
            const int i = it - I4, kt = i & 15, ntl = i >> 4;
            xpose_tile(kp->in[17], 2048, ntl * 64, kt * 64, (bf16_t*)(ws + WS_WQ), 1024, ntl * 64, 0, tile, tid);
        } else {
            const int i = it - I5, nb = i & 1, cb = (i >> 1) & 15, g = i >> 5;
            const float* pool_w = kp->in[7]; const float* pool_scale = kp->in[8]; const float* pool_up = kp->in[9];
            for (int e = tid; e < 1024; e += NTHREADS) { const int ci = e >> 7, d = e & 127; pw[e] = pool_w[((size_t)g * 128 + cb * 8 + ci) * 128 + d] * pool_scale[g * 128 + d]; }
            __syncthreads();
            const int n = nb * 512 + tid; float a[8];
#pragma unroll
            for (int q = 0; q < 8; ++q) a[q] = 0.f;
#pragma unroll 4
            for (int d = 0; d < 128; ++d) { const float uv = pool_up[(size_t)(g * 128 + d) * 1024 + n];
#pragma unroll
                for (int q = 0; q < 8; ++q) a[q] += pw[q * 128 + d] * uv; }
            u32x4 w; w.x = cvt_pk_bf16(a[0], a[1]); w.y = cvt_pk_bf16(a[2], a[3]); w.z = cvt_pk_bf16(a[4], a[5]); w.w = cvt_pk_bf16(a[6], a[7]);
            *(u32x4*)((bf16_t*)(ws + WS_WPC) + (size_t)n * 1024 + g * 128 + cb * 8) = w;
            __syncthreads();
        }
    }
    {
        const int lane = tid & 63, wave = tid >> 6;
        f32x4 vn[4];
        { const int r0 = blockIdx.x * 8 + wave;
          if (r0 < 2 * NEXP) { const int tb0 = r0 >= NEXP ? 1 : 0; const f32x4* src = (const f32x4*)((tb0 ? kp->in[21] : kp->in[20]) + (size_t)(r0 - tb0 * NEXP) * D);
#pragma unroll
              for (int q = 0; q < 4; ++q) vn[q] = src[lane + 64 * q]; } }
        for (int r = blockIdx.x * 8 + wave; r < 2 * NEXP; r += G * 8) {
            const int tb = r >= NEXP ? 1 : 0, e = r - tb * NEXP;
            f32x4 v[4]; float m = 0.f;
#pragma unroll
            for (int q = 0; q < 4; ++q) v[q] = vn[q];
            { const int rn = r + G * 8;
              if (rn < 2 * NEXP) { const int tbn = rn >= NEXP ? 1 : 0; const f32x4* src = (const f32x4*)((tbn ? kp->in[21] : kp->in[20]) + (size_t)(rn - tbn * NEXP) * D);
#pragma unroll
                  for (int q = 0; q < 4; ++q) vn[q] = src[lane + 64 * q]; } }
#pragma unroll
            for (int q = 0; q < 4; ++q) m = fmaxf(m, fmaxf(fmaxf(fabsf(v[q][0]), fabsf(v[q][1])), fmaxf(fabsf(v[q][2]), fabsf(v[q][3]))));
#pragma unroll
            for (int o = 32; o >= 1; o >>= 1) m = fmaxf(m, __shfl_xor(m, o));
            const float qmax = tb ? RowFmt<V_BITS>::QMAX : RowFmt<U_BITS>::QMAX;
            const float qs = m > 0.f ? qmax / m : 0.f;
            if (tb) quant_row<V_BITS>(v, qs, ws + WS_EV + (size_t)e * (V_BITS * 128), lane);
            else quant_row<U_BITS>(v, qs, ws + WS_EU + (size_t)e * (U_BITS * 128), lane);
            if (lane == 0) ((float*)(ws + (tb ? WS_SV : WS_SU)))[e] = m / qmax;
        }
    }
}

__device__ __forceinline__ void phase_w8(KP kp, LAS unsigned char* lds, int wave_s) {
    const int tid = wave_s * 64 + lane_id_asm();
    unsigned char* ws = kp->ws;
    const float* win = kp->in[5]; const float* pmax = (const float*)(ws + WS_PMAX);
    LAS float* tile = (LAS float*)(lds + 49152);
    LAS float* csc = (LAS float*)(lds + 49152 + 17408);
    for (int it = blockIdx.x; it < 56 * 16; it += gridDim.x) {
        const int kt = it & 15, n0 = (it >> 4) * 64, c0 = in_colmap(n0);
        if (tid < 64) { float mm = 0.f;
#pragma unroll
            for (int q = 0; q < 16; ++q) mm = fmaxf(mm, pmax[q * 3584 + n0 + tid]);
            csc[tid] = mm > 0.f ? 224.0f / mm : 0.f; if (kt == 0) ((float*)(ws + WS_WP8S))[n0 + tid] = mm * (1.0f / 224.0f); }
        { const int r = tid >> 4, c4 = tid & 15;
#pragma unroll
          for (int ps = 0; ps < 2; ++ps) { const f32x4 v = *(const f32x4*)(win + (size_t)(kt * 64 + r + 32 * ps) * INW + c0 + c4 * 4);
#pragma unroll
              for (int j = 0; j < 4; ++j) tile[(r + 32 * ps) * 65 + c4 * 4 + j] = v[j]; } }
        __syncthreads();
        { const int n = tid >> 3, kg = tid & 7; const float qs = csc[n]; float f[8];
#pragma unroll
          for (int i = 0; i < 8; ++i) f[i] = tile[(kg * 8 + i) * 65 + n] * qs;
          int p0 = 0, p1 = 0;
          p0 = __builtin_amdgcn_cvt_pk_fp8_f32(f[0], f[1], p0, false); p0 = __builtin_amdgcn_cvt_pk_fp8_f32(f[2], f[3], p0, true);
          p1 = __builtin_amdgcn_cvt_pk_fp8_f32(f[4], f[5], p1, false); p1 = __builtin_amdgcn_cvt_pk_fp8_f32(f[6], f[7], p1, true);
          *(u32x2*)(ws + WS_WP8 + (size_t)(n0 + n) * 1024 + kt * 64 + kg * 8) = (u32x2){(unsigned)p0, (unsigned)p1}; }
        __syncthreads();
    }
}

template <bool WITH_FP8>
__device__ __forceinline__ void phase_norm_ada(const float* src, const float* gain, const float* mod, int shift_off, int scale_off, bf16_t* dst, unsigned char* dst8, float* dscale, int wave_s) {
    const int lane = lane_id_asm(), wave = wave_s;
    f32x4 vn[4];
    { const int row0 = blockIdx.x * 8 + wave;
      if (row0 < T) { const f32x4* xr = (const f32x4*)(src + (size_t)row0 * D);
#pragma unroll
          for (int j = 0; j < 4; ++j) vn[j] = xr[lane + 64 * j]; } }
    for (int row = blockIdx.x * 8 + wave; row < T; row += gridDim.x * 8) {
        const int b = row / SEQ;
        f32x4 v[4]; float ss = 0.f;
#pragma unroll
        for (int j = 0; j < 4; ++j) v[j] = vn[j];
        { const int rn = row + gridDim.x * 8;
          if (rn < T) { const f32x4* xr = (const f32x4*)(src + (size_t)rn * D);
#pragma unroll
              for (int j = 0; j < 4; ++j) vn[j] = xr[lane + 64 * j]; } }
#pragma unroll
        for (int j = 0; j < 4; ++j) ss += v[j][0] * v[j][0] + v[j][1] * v[j][1] + v[j][2] * v[j][2] + v[j][3] * v[j][3];
        ss = wave_sum(ss);
        const float r = rsqrtf(ss * (1.0f / D) + EPS);
        float am = 0.f;
#pragma unroll
        for (int j = 0; j < 4; ++j) {
            const int col = 4 * lane + 256 * j;
            const f32x4 g = *(const f32x4*)(gain + col), sc = *(const f32x4*)(mod + (size_t)b * NMOD + scale_off + col), sh = *(const f32x4*)(mod + (size_t)b * NMOD + shift_off + col);
            const f32x4 h = v[j] * r * g * (sc + 1.0f) + sh;
            u32x2 w; w.x = cvt_pk_bf16(h[0], h[1]); w.y = cvt_pk_bf16(h[2], h[3]);
            if (dst) *(u32x2*)(dst + (size_t)row * D + col) = w;
            if (WITH_FP8) { v[j] = h; am = fmaxf(am, fmaxf(fmaxf(fabsf(h[0]), fabsf(h[1])), fmaxf(fabsf(h[2]), fabsf(h[3])))); }
        }
        if (WITH_FP8) {
#pragma unroll
            for (int o = 32; o >= 1; o >>= 1) am = fmaxf(am, __shfl_xor(am, o));
            const float qs = am > 0.f ? 224.0f / am : 0.f;
#pragma unroll
            for (int j = 0; j < 4; ++j) { int p = 0; p = __builtin_amdgcn_cvt_pk_fp8_f32(v[j][0] * qs, v[j][1] * qs, p, false); p = __builtin_amdgcn_cvt_pk_fp8_f32(v[j][2] * qs, v[j][3] * qs, p, true);
                *(unsigned*)(dst8 + (size_t)row * D + 4 * lane + 256 * j) = (unsigned)p; }
            if (lane == 0) dscale[row] = am * (1.0f / 224.0f);
        }
    }
}

__device__ __forceinline__ void phase_aux(KP kp, LAS unsigned char* lds, int wave_s) {
    const int tid = wave_s * 64 + lane_id_asm();
    unsigned char* ws = kp->ws;
    const float* mod = (const float*)(ws + WS_MOD);
    const int bid = blockIdx.x;
    if (bid == 0) {
        float* A2 = (float*)(ws + WS_A2); const float* g2 = kp->in[16];
        for (int i = tid; i < 4096; i += NTHREADS) { const int b = i >> 10, k = i & 1023; A2[i] = g2[k] * (1.0f + mod[(size_t)b * NMOD + 4 * 1024 + k]); }
    } else if (bid <= 8) {
        float* SSQ = (float*)(ws + WS_SSQ) + (bid - 1) * 4096;
        for (int i = tid; i < 4096; i += NTHREADS) SSQ[i] = 0.f;
    } else if (bid <= 24) {
        const int n0 = (bid - 9) * 128, c4 = tid & 31, ks = tid >> 5;
        const float* wq = kp->in[17];
        LAS float* red = (LAS float*)lds;
        float a[4][4];
#pragma unroll
        for (int b = 0; b < 4; ++b)
#pragma unroll
            for (int j = 0; j < 4; ++j) a[b][j] = 0.f;
#pragma unroll 4
        for (int kk = 0; kk < 64; ++kk) { const int k = ks * 64 + kk; const f32x4 w = *(const f32x4*)(wq + (size_t)k * 2048 + n0 + c4 * 4);
#pragma unroll
            for (int b = 0; b < 4; ++b) { const float sv = mod[(size_t)b * NMOD + 3 * 1024 + k];
#pragma unroll
                for (int j = 0; j < 4; ++j) a[b][j] += sv * w[j]; } }
#pragma unroll
        for (int b = 0; b < 4; ++b)
#pragma unroll
            for (int j = 0; j < 4; ++j) red[(ks * 4 + b) * 128 + c4 * 4 + j] = a[b][j];
        __syncthreads();
        { const int b = tid >> 7, col = tid & 127; float sm = 0.f;
          for (int q = 0; q < 16; ++q) sm += red[(q * 4 + b) * 128 + col];
          ((float*)(ws + WS_BIAS2))[b * 2048 + n0 + col] = sm; }
        __syncthreads();
    }
}

template <int W>
__device__ __forceinline__ void pool_window(const float (&x0)[31], const float (&x1)[31], int spos0, bf16_t* dstp) {
#pragma unroll
    for (int i = 0; i < 16; ++i) {
        float s0 = 0.f, s1 = 0.f;
#pragma unroll
        for (int d = 0; d < W; ++d) { s0 += x0[i + 15 - d]; s1 += x1[i + 15 - d]; }
        const int sp = spos0 + i; const float inv = 1.0f / (float)(sp + 1 < W ? sp + 1 : W);
        const float m0 = s0 * inv - x0[i + 15], m1 = s1 * inv - x1[i + 15];
        *(unsigned*)(dstp + (size_t)i * 1024) = cvt_pk_bf16(m0, m1);
    }
}
__device__ __forceinline__ void phase_branches(KP kp, LAS unsigned char* lds, int wave_s) {
    const int lane = lane_id_asm(), wave = wave_s, tid = wave * 64 + lane;
    unsigned char* ws = kp->ws;
    const bf16_t* PB = (const bf16_t*)(ws + WS_PG); const bf16_t* GB = PB + (size_t)T * 512;
    bf16_t* MC = (bf16_t*)(ws + WS_MC);
    const float* dwk = kp->in[10]; const float* dwb = kp->in[11]; const float* lng = kp->in[12]; const float* lnb = kp->in[13];
    LAS unsigned* rows = (LAS unsigned*)lds;
    LAS float* ybuf = (LAS float*)(lds + 63488);
    const int cp = tid & 255, th = tid >> 8;
    float w0[31], w1[31];
#pragma unroll
    for (int j = 0; j < 31; ++j) { const f32x2 w = *(const f32x2*)(dwk + j * 512 + 2 * cp); w0[j] = w.x; w1[j] = w.y; }
    const f32x2 cb = *(const f32x2*)(dwb + 2 * cp);
    u32x4 gpre[8], ppre[6];
#define P3_LOAD_G(t0_, s0_) do { _Pragma("unroll") for (int i_ = 0; i_ < 8; ++i_) { const int e = tid + i_ * NTHREADS; const int r = e >> 6, c = e & 63; u32x4 v = {0u, 0u, 0u, 0u}; \
            if (e < 62 * 64 && (s0_) + r - 30 >= 0) v = *(const u32x4*)(GB + (size_t)((t0_) + r - 30) * 512 + c * 8); gpre[i_] = v; } } while (0)
#define P3_LOAD_P(t0_, s0_) do { _Pragma("unroll") for (int i_ = 0; i_ < 6; ++i_) { const int e = tid + i_ * NTHREADS; const int r = e >> 6, c = e & 63; u32x4 v = {0u, 0u, 0u, 0u}; \
            if (e < 47 * 64 && (s0_) + r - 15 >= 0) v = *(const u32x4*)(PB + (size_t)((t0_) + r - 15) * 512 + c * 8); ppre[i_] = v; } } while (0)
    if ((int)blockIdx.x < T / 32) { const int t0 = blockIdx.x * 32; P3_LOAD_G(t0, t0 % SEQ); }
    for (int tl = blockIdx.x; tl < T / 32; tl += gridDim.x) {
        const int t0 = tl * 32, s0 = t0 % SEQ;
#pragma unroll
        for (int i_ = 0; i_ < 8; ++i_) { const int e = tid + i_ * NTHREADS; if (e < 62 * 64) *(LAS u32x4*)(rows + (e >> 6) * 256 + (e & 63) * 4) = gpre[i_]; }
        __syncthreads();
        P3_LOAD_P(t0, s0);
        {
            float a0[16], a1[16];
#pragma unroll
            for (int i = 0; i < 16; ++i) { a0[i] = cb.x; a1[i] = cb.y; }
#pragma unroll
            for (int r = 0; r < 46; ++r) {
                const unsigned uu = rows[(th * 16 + r) * 256 + cp]; const float x0 = bf_lo(uu), x1 = bf_hi(uu);
#pragma unroll
                for (int i = 0; i < 16; ++i) { const int j = r - i; if (j >= 0 && j <= 30) { a0[i] += x0 * w0[j]; a1[i] += x1 * w1[j]; } }
            }
#pragma unroll
            for (int i = 0; i < 16; ++i) *(LAS f32x2*)(ybuf + (th * 16 + i) * 512 + 2 * cp) = (f32x2){a0[i], a1[i]};
        }
        __syncthreads();
        {
            const f32x4 g0 = *(const f32x4*)(lng + lane * 8), g1 = *(const f32x4*)(lng + lane * 8 + 4), b0 = *(const f32x4*)(lnb + lane * 8), b1 = *(const f32x4*)(lnb + lane * 8 + 4);
#pragma unroll
            for (int q = 0; q < 4; ++q) {
                const int tk = wave * 4 + q;
                const f32x4 y0 = *(const LAS f32x4*)(ybuf + tk * 512 + lane * 8), y1 = *(const LAS f32x4*)(ybuf + tk * 512 + lane * 8 + 4);
                float s = (y0[0] + y0[1]) + (y0[2] + y0[3]) + (y1[0] + y1[1]) + (y1[2] + y1[3]);
                s = wave_sum(s); const float mu = s * (1.0f / 512.0f);
                const f32x4 d0 = y0 - mu, d1 = y1 - mu;
                float qv = d0[0] * d0[0] + d0[1] * d0[1] + d0[2] * d0[2] + d0[3] * d0[3] + d1[0] * d1[0] + d1[1] * d1[1] + d1[2] * d1[2] + d1[3] * d1[3];
                qv = wave_sum(qv); const float rs = rsqrtf(qv * (1.0f / 512.0f) + EPS);
                f32x4 o0 = d0 * rs * g0 + b0, o1 = d1 * rs * g1 + b1;
#pragma unroll
                for (int j = 0; j < 4; ++j) { o0[j] = o0[j] * fast_sigmoid(o0[j]); o1[j] = o1[j] * fast_sigmoid(o1[j]); }
                u32x4 w; w.x = cvt_pk_bf16(o0[0], o0[1]); w.y = cvt_pk_bf16(o0[2], o0[3]); w.z = cvt_pk_bf16(o1[0], o1[1]); w.w = cvt_pk_bf16(o1[2], o1[3]);
                *(u32x4*)(MC + (size_t)(t0 + tk) * 1024 + 512 + lane * 8) = w;
            }
        }
        __syncthreads();
#pragma unroll
        for (int i_ = 0; i_ < 6; ++i_) { const int e = tid + i_ * NTHREADS; if (e < 47 * 64) *(LAS u32x4*)(rows + (e >> 6) * 256 + (e & 63) * 4) = ppre[i_]; }
        __syncthreads();
        { const int tn = tl + gridDim.x; if (tn < T / 32) { const int t0n = tn * 32; P3_LOAD_G(t0n, t0n % SEQ); } }
        {
            float x0[31], x1[31];
#pragma unroll
            for (int r = 0; r < 31; ++r) { const unsigned uu = rows[(th * 16 + r) * 256 + cp]; x0[r] = bf_lo(uu); x1[r] = bf_hi(uu); }
            bf16_t* dstp = MC + (size_t)(t0 + th * 16) * 1024 + 2 * cp;
            const int grp = __builtin_amdgcn_readfirstlane(cp >> 6), sp0 = s0 + th * 16;
            if (grp == 0) pool_window<2>(x0, x1, sp0, dstp);
            else if (grp == 1) pool_window<4>(x0, x1, sp0, dstp);
            else if (grp == 2) pool_window<8>(x0, x1, sp0, dstp);
            else pool_window<16>(x0, x1, sp0, dstp);
        }
        __syncthreads();
    }
}

#define CE_DESC(a, b) do { const int _hi = max(a, b), _lo = min(a, b); a = _hi; b = _lo; } while (0)
#define CE_ASC(a, b)  do { const int _hi = max(a, b), _lo = min(a, b); a = _lo; b = _hi; } while (0)
__device__ __forceinline__ void bitonic_sort16_desc(int (&v)[16]) {
#pragma unroll
    for (int k = 2; k <= 16; k <<= 1)
#pragma unroll
        for (int j = k >> 1; j > 0; j >>= 1)
#pragma unroll
            for (int i = 0; i < 16; ++i) { const int l = i ^ j; if (l > i) { if ((i & k) == 0) CE_DESC(v[i], v[l]); else CE_ASC(v[i], v[l]); } }
}
__device__ __forceinline__ void bitonic_merge16_desc(int (&v)[16]) {
#pragma unroll
    for (int j = 8; j > 0; j >>= 1)
#pragma unroll
        for (int i = 0; i < 16; ++i) { const int l = i ^ j; if (l > i) CE_DESC(v[i], v[l]); }
}
__device__ __forceinline__ void top16_merge(int (&a)[16], const int (&b)[16]) {
#pragma unroll
    for (int i = 0; i < 16; ++i) a[i] = max(a[i], b[15 - i]);
    bitonic_merge16_desc(a);
}
#define CEF_DESC(a, b) do { const float _hi = fmaxf(a, b), _lo = fminf(a, b); a = _hi; b = _lo; } while (0)
#define CEF_ASC(a, b)  do { const float _hi = fmaxf(a, b), _lo = fminf(a, b); a = _lo; b = _hi; } while (0)
__device__ __forceinline__ void fbitonic_sort16_desc(float (&v)[16]) {
#pragma unroll
    for (int k = 2; k <= 16; k <<= 1)
#pragma unroll
        for (int j = k >> 1; j > 0; j >>= 1)
#pragma unroll
            for (int i = 0; i < 16; ++i) { const int l = i ^ j; if (l > i) { if ((i & k) == 0) CEF_DESC(v[i], v[l]); else CEF_ASC(v[i], v[l]); } }
}
__device__ __forceinline__ void fbitonic_merge16_desc(float (&v)[16]) {
#pragma unroll
    for (int j = 8; j > 0; j >>= 1)
#pragma unroll
        for (int i = 0; i < 16; ++i) { const int l = i ^ j; if (l > i) CEF_DESC(v[i], v[l]); }
}
__device__ __forceinline__ void ftop16_merge(float (&a)[16], const float (&b)[16]) {
#pragma unroll
    for (int i = 0; i < 16; ++i) a[i] = fmaxf(a[i], b[15 - i]);
    fbitonic_merge16_desc(a);
}
__device__ __forceinline__ int packkey(float v, int idx) { const int f = __float_as_int(v); const int s = f ^ ((f >> 31) & 0x7fffffff); return (s & ~127) | (127 - idx); }
__device__ __forceinline__ float keyval(int k) { const int s = k & ~127; return __int_as_float(s ^ ((s >> 31) & 0x7fffffff)); }
__device__ __forceinline__ void top16_of_scores(const f32x16 (&acc)[4], int h, int (&L)[16]) {
    int M[16];
#pragma unroll
    for (int kt = 0; kt < 4; ++kt) {
        int v[16];
#pragma unroll
        for (int r = 0; r < 16; ++r) v[r] = packkey(acc[kt][r], kt * 32 + (r & 3) + 8 * (r >> 2) + 4 * h);
        bitonic_sort16_desc(v);
        if (kt == 0) {
#pragma unroll
            for (int i = 0; i < 16; ++i) L[i] = v[i];
        } else top16_merge(L, v);
    }
#pragma unroll
    for (int i = 0; i < 16; ++i) M[i] = __shfl_xor(L[i], 32);
    top16_merge(L, M);
}
__device__ __forceinline__ void phase_topk(KP kp, LAS unsigned char* lds, int wave_s) {
    const int lane = lane_id_asm(), wave = wave_s, tid = wave * 64 + lane;
    unsigned char* ws = kp->ws;
    const bf16_t* Q = (const bf16_t*)(ws + WS_SG);
    int* IDX = (int*)(ws + WS_IDX); float* GATE = (float*)(ws + WS_GATE);
    LAS unsigned* stg = (LAS unsigned*)(lds + 65536);
    for (int e = tid; e < 2 * 32 * 64; e += NTHREADS) {
        const int f = e >> 6, l = e & 63, set = f >> 5, kt = (f >> 3) & 3, ks = f & 7;
        const float* src = (set ? kp->in[19] : kp->in[18]) + (kt * 32 + (l & 31)) * 128 + ks * 16 + 8 * (l >> 5);
        const f32x4 a = *(const f32x4*)src, b = *(const f32x4*)(src + 4);
        u32x4 w; w.x = cvt_pk_bf16(a[0], a[1]); w.y = cvt_pk_bf16(a[2], a[3]); w.z = cvt_pk_bf16(b[0], b[1]); w.w = cvt_pk_bf16(b[2], b[3]);
        *(LAS u32x4*)(lds + (size_t)e * 16) = w;
    }
    __syncthreads();
    const int h = lane >> 5;
    pg8::StaticOrder SO; SO.init(T, 2048, gridDim.x, blockIdx.x);
    pg8::Unit uu;
    for (int ui = 0; SO.next(ui, uu); ++ui) {
        const int tile = uu.pm, head = uu.pn;
        const int tok = tile * 256 + wave * 32 + (lane & 31);
        const bf16_t* qfrag = Q + ((size_t)(tile * 8 + head) * 128 + (size_t)wave * 16) * 512 + lane * 8;
        int L1[16], L2[16];
#pragma unroll
        for (int set = 0; set < 2; ++set) {
            f32x16 acc[4];
#pragma unroll
            for (int kt = 0; kt < 4; ++kt)
#pragma unroll
                for (int r = 0; r < 16; ++r) acc[kt][r] = 0.f;
#pragma unroll
            for (int ks = 0; ks < 8; ++ks) {
                const bf16x8 bq = *(const bf16x8*)(qfrag + (set * 8 + ks) * 512);
#pragma unroll
                for (int kt = 0; kt < 4; ++kt) {
                    const bf16x8 ak = *(const LAS bf16x8*)(lds + (size_t)((((set * 4 + kt) * 8 + ks) * 64) + lane) * 16);
                    acc[kt] = __builtin_amdgcn_mfma_f32_32x32x16_bf16(ak, bq, acc[kt], 0, 0, 0);
                }
            }
#ifdef DBG_VALU_SCORES
            {   const float* keys = set ? kp->in[19] : kp->in[18];
                const bf16_t* qr = Q + (size_t)tok * 2048 + head * 256 + set * 128;
                for (int kt = 0; kt < 4; ++kt)
                    for (int r = 0; r < 16; ++r) {
                        const int idx = kt * 32 + (r & 3) + 8 * (r >> 2) + 4 * h; float sacc = 0.f;
                        for (int k = 0; k < 128; ++k) sacc += __uint_as_float(((unsigned)qr[k]) << 16) * keys[idx * 128 + k];
#pragma unroll
                        for (int kk = 0; kk < 4; ++kk)
#pragma unroll
                            for (int rr = 0; rr < 16; ++rr) if (kk == kt && rr == r) acc[kk][rr] = sacc;
                    }
            }
#endif
            if (set == 0) top16_of_scores(acc, h, L1); else top16_of_scores(acc, h, L2);
        }
        float v1[16], v2[16]; int i1[16], i2[16];
#pragma unroll
        for (int i = 0; i < 16; ++i) { v1[i] = keyval(L1[i]); i1[i] = 127 - (L1[i] & 127); v2[i] = keyval(L2[i]); i2[i] = 127 - (L2[i] & 127); }
        float thr, mx;
        {
            float A[16], B[16], C[16], Dd[16];
#pragma unroll
            for (int j = 0; j < 16; ++j) A[j] = v1[0] + v2[j];
#pragma unroll
            for (int j = 0; j < 8; ++j) { B[j] = v1[1] + v2[j]; B[8 + j] = v1[15 - j] + v2[0]; }
            fbitonic_merge16_desc(B);
            C[0] = v1[2] + v2[0]; C[1] = v1[2] + v2[1]; C[2] = v1[2] + v2[2]; C[3] = v1[2] + v2[3]; C[4] = v1[2] + v2[4];
            C[5] = v1[3] + v2[0]; C[6] = v1[3] + v2[1]; C[7] = v1[3] + v2[2]; C[8] = v1[3] + v2[3];
            C[9] = v1[4] + v2[0]; C[10] = v1[4] + v2[1]; C[11] = v1[4] + v2[2];
            C[12] = v1[5] + v2[0]; C[13] = v1[5] + v2[1]; C[14] = v1[6] + v2[0]; C[15] = v1[6] + v2[1];
            fbitonic_sort16_desc(C);
            Dd[0] = v1[7] + v2[0]; Dd[1] = v1[7] + v2[1];
#pragma unroll
            for (int j = 2; j < 16; ++j) Dd[j] = -3.0e38f;
            ftop16_merge(A, B); ftop16_merge(C, Dd);
            mx = fmaxf(A[0], C[0]);
            float t = fmaxf(A[0], C[15]);
#pragma unroll
            for (int i = 1; i < 16; ++i) t = fminf(t, fmaxf(A[i], C[15 - i]));
            thr = t;
        }
        if (h == 0) {
            LAS unsigned* row = stg + (wave * 32 + (lane & 31)) * 44;
            int cnt = 0; float sum = 0.f;
#pragma unroll
            for (int i = 0; i < 16; ++i)
#pragma unroll
                for (int j = 0; j < 16; ++j) if ((i + 1) * (j + 1) <= 16) {
                    const float x = v1[i] + v2[j];
                    const bool pr = (x >= thr) && (cnt < 16);
                    const float ev = __expf(x - mx);
                    const int pos = pr ? cnt : 16;
                    row[pos] = (unsigned)(i1[i] * 128 + i2[j]); row[20 + pos] = __float_as_uint(ev);
                    sum += pr ? ev : 0.f; cnt += pr ? 1 : 0;
                }
            const float inv = 1.0f / sum;
            u32x4* ip = (u32x4*)(IDX + ((size_t)tok * 8 + head) * 16); f32x4* gp = (f32x4*)(GATE + ((size_t)tok * 8 + head) * 16);
#pragma unroll
            for (int q = 0; q < 4; ++q) {
                ip[q] = *(const LAS u32x4*)(row + 4 * q);
                const u32x4 gu = *(const LAS u32x4*)(row + 20 + 4 * q);
                gp[q] = (f32x4){__uint_as_float(gu.x) * inv, __uint_as_float(gu.y) * inv, __uint_as_float(gu.z) * inv, __uint_as_float(gu.w) * inv};
            }
        }
    }
    {
        const bf16_t* XA = (const bf16_t*)(ws + WS_H); const float* SSQ = (const float*)(ws + WS_SSQ); const float* mod = (const float*)(ws + WS_MOD);
        unsigned char* HB = ws + WS_HB; f32x2* HS = (f32x2*)(ws + WS_HS);
        for (int tk = blockIdx.x * 8 + wave; tk < T; tk += gridDim.x * 8) {
            const u32x4* xp = (const u32x4*)(XA + (size_t)tk * D + 16 * lane); const u32x4 xa0 = xp[0], xa1 = xp[1];
            const f32x4* sp = (const f32x4*)(mod + (size_t)(tk / SEQ) * NMOD + 3 * 1024 + 16 * lane);
            const f32x4 s0v = sp[0], s1v = sp[1], s2v = sp[2], s3v = sp[3];
            const float rr = rsqrtf(SSQ[tk] * (1.0f / D) + EPS);
            const unsigned xw[8] = {xa0.x, xa0.y, xa0.z, xa0.w, xa1.x, xa1.y, xa1.z, xa1.w};
            const float sh[16] = {s0v[0], s0v[1], s0v[2], s0v[3], s1v[0], s1v[1], s1v[2], s1v[3], s2v[0], s2v[1], s2v[2], s2v[3], s3v[0], s3v[1], s3v[2], s3v[3]};
            float hv[16]; float am = 0.f;
#pragma unroll
            for (int i = 0; i < 8; ++i) { hv[2 * i] = bf_lo(xw[i]) * rr + sh[2 * i]; hv[2 * i + 1] = bf_hi(xw[i]) * rr + sh[2 * i + 1]; am = fmaxf(am, fmaxf(fabsf(hv[2 * i]), fabsf(hv[2 * i + 1]))); }
#pragma unroll
            for (int o = 32; o >= 1; o >>= 1) am = fmaxf(am, __shfl_xor(am, o));
            const float q0 = am > 0.f ? 6.0f / am : 0.f, d0 = am * (1.0f / 6.0f);
            unsigned w0[2] = {0u, 0u}, w1[2] = {0u, 0u}; float rv[16]; float am1 = 0.f;
#pragma unroll
            for (int i = 0; i < 8; ++i) {
                const int wi = i >> 2, bs = i & 3;
                if (bs == 0) w0[wi] = __builtin_amdgcn_cvt_scalef32_pk_fp4_f32(w0[wi], hv[2 * i] * q0, hv[2 * i + 1] * q0, 1.0f, 0);
                else if (bs == 1) w0[wi] = __builtin_amdgcn_cvt_scalef32_pk_fp4_f32(w0[wi], hv[2 * i] * q0, hv[2 * i + 1] * q0, 1.0f, 1);
                else if (bs == 2) w0[wi] = __builtin_amdgcn_cvt_scalef32_pk_fp4_f32(w0[wi], hv[2 * i] * q0, hv[2 * i + 1] * q0, 1.0f, 2);
                else w0[wi] = __builtin_amdgcn_cvt_scalef32_pk_fp4_f32(w0[wi], hv[2 * i] * q0, hv[2 * i + 1] * q0, 1.0f, 3);
            }
#pragma unroll
            for (int i = 0; i < 8; ++i) {
                const int wi = i >> 2, bs = i & 3;
                const f32x2 dq = bs == 0 ? __builtin_amdgcn_cvt_scalef32_pk_f32_fp4(w0[wi], 1.0f, 0) : bs == 1 ? __builtin_amdgcn_cvt_scalef32_pk_f32_fp4(w0[wi], 1.0f, 1) : bs == 2 ? __builtin_amdgcn_cvt_scalef32_pk_f32_fp4(w0[wi], 1.0f, 2) : __builtin_amdgcn_cvt_scalef32_pk_f32_fp4(w0[wi], 1.0f, 3);
                rv[2 * i] = hv[2 * i] - dq.x * d0; rv[2 * i + 1] = hv[2 * i + 1] - dq.y * d0;
                am1 = fmaxf(am1, fmaxf(fabsf(rv[2 * i]), fabsf(rv[2 * i + 1])));
            }
#pragma unroll
            for (int o = 32; o >= 1; o >>= 1) am1 = fmaxf(am1, __shfl_xor(am1, o));
            const float q1 = am1 > 0.f ? 6.0f / am1 : 0.f, d1 = am1 * (1.0f / 6.0f);
#pragma unroll
            for (int i = 0; i < 8; ++i) {
                const int wi = i >> 2, bs = i & 3;
                if (bs == 0) w1[wi] = __builtin_amdgcn_cvt_scalef32_pk_fp4_f32(w1[wi], rv[2 * i] * q1, rv[2 * i + 1] * q1, 1.0f, 0);
                else if (bs == 1) w1[wi] = __builtin_amdgcn_cvt_scalef32_pk_fp4_f32(w1[wi], rv[2 * i] * q1, rv[2 * i + 1] * q1, 1.0f, 1);
                else if (bs == 2) w1[wi] = __builtin_amdgcn_cvt_scalef32_pk_fp4_f32(w1[wi], rv[2 * i] * q1, rv[2 * i + 1] * q1, 1.0f, 2);
                else w1[wi] = __builtin_amdgcn_cvt_scalef32_pk_fp4_f32(w1[wi], rv[2 * i] * q1, rv[2 * i + 1] * q1, 1.0f, 3);
            }
            const int sb = lane >> 3, qq = (lane & 7) >> 1, hf8 = lane & 1;
            unsigned char* hb = HB + (size_t)tk * 1024 + (sb * 4 + qq) * 16 + hf8 * 8;
            *(u32x2*)hb = (u32x2){w0[0], w0[1]};
            *(u32x2*)(hb + 512) = (u32x2){w1[0], w1[1]};
            if (lane == 0) HS[tk] = (f32x2){d0, d1};
        }
    }
}

__device__ __forceinline__ float gelu_tanh(float x) {
    const float y = 0.7978845608028654f * (x + 0.044715f * x * x * x);
    return x * fast_sigmoid(2.0f * y);
}
typedef int i32x8 __attribute__((ext_vector_type(8)));
#define DPPF(x, ctrl) __int_as_float(__builtin_amdgcn_update_dpp(0, __float_as_int(x), ctrl, 0xF, 0xF, true))
struct TokMeta { u32x4 hb; f32x2 hs; int e0, e1; float g0, g1, cu0, cu1, sv0, sv1; u32x4 x1[2]; f32x4 g2[4]; };
__device__ __forceinline__ void peer_load_meta(TokMeta& m, int tok, int lane, const unsigned char* HB, const f32x2* HS, const int* IDX, const float* GATE, const bf16_t* X1, const float* modp) {
    { const u32x4* xp = (const u32x4*)(X1 + (size_t)tok * D + 16 * lane); m.x1[0] = xp[0]; m.x1[1] = xp[1];
      const f32x4* gp = (const f32x4*)(modp + (size_t)(tok / SEQ) * NMOD + 5 * 1024 + 16 * lane); m.g2[0] = gp[0]; m.g2[1] = gp[1]; m.g2[2] = gp[2]; m.g2[3] = gp[3]; }
    m.hb = *(const u32x4*)(HB + (size_t)tok * 1024 + ((lane & 15) * 4 + (lane >> 4)) * 16);
    m.hs = HS[tok];
    m.e0 = IDX[(size_t)tok * 128 + lane]; m.e1 = IDX[(size_t)tok * 128 + 64 + lane];
    m.g0 = GATE[(size_t)tok * 128 + lane]; m.g1 = GATE[(size_t)tok * 128 + 64 + lane];
}
__device__ __forceinline__ void peer_load_scales(TokMeta& m, const float* SU, const float* SV) { m.cu0 = SU[m.e0]; m.cu1 = SU[m.e1]; m.sv0 = SV[m.e0]; m.sv1 = SV[m.e1]; }
typedef RowFmt<V_BITS>::row_t vrow_t;
#define PEER_LOAD(UQ, VQ, g) do { const int bb_ = (g) & 15; const bool nx_ = (g) >= 16; \
        const int src_ = bb_ < 8 ? (nx_ ? mn.e0 : m.e0) : (nx_ ? mn.e1 : m.e1); \
        _Pragma("unroll") for (int j_ = 0; j_ < 4; ++j_) { \
            const int ea_ = __builtin_amdgcn_readlane(src_, (8 * bb_ + 2 * j_) & 63), eb_ = __builtin_amdgcn_readlane(src_, (8 * bb_ + 2 * j_ + 1) & 63); \
            UQ[j_] = __builtin_bit_cast(u32x4, __builtin_amdgcn_raw_buffer_load_b128(rsU, ((mhi ? eb_ : ea_) << 9) + uoff, 0, 0)); \
            VQ[2 * j_] = __builtin_bit_cast(u32x2, __builtin_amdgcn_raw_buffer_load_b64(rsV, lane * 8, ea_ << 9, 0)); \
            VQ[2 * j_ + 1] = __builtin_bit_cast(u32x2, __builtin_amdgcn_raw_buffer_load_b64(rsV, lane * 8, eb_ << 9, 0)); } } while (0)
#define PEER_COMPUTE(UQ, VQ, bt) do { \
        float x_[4]; \
        _Pragma("unroll") for (int j_ = 0; j_ < 4; ++j_) { \
            const i32x8 a_ = {(int)UQ[j_].x, (int)UQ[j_].y, (int)UQ[j_].z, (int)UQ[j_].w, 0, 0, 0, 0}; \
            const f32x4 d_ = __builtin_amdgcn_mfma_scale_f32_16x16x128_f8f6f4(a_, hbv, (f32x4){0.f, 0.f, 0.f, 0.f}, 4, 4, 0, 0x7f7f7f7f, 0, 0x7f7f7f7f); \
            const float s_ = r0 ? d_[0] : r1 ? d_[1] : r2 ? d_[2] : d_[3]; \
            x_[j_] = s_ * st; } \
        float y2[2], q1; \
        _Pragma("unroll") for (int k_ = 0; k_ < 2; ++k_) { const float a_ = b4 ? x_[k_ + 2] : x_[k_], sd_ = b4 ? x_[k_] : x_[k_ + 2]; y2[k_] = a_ + __shfl_xor(sd_, 16); } \
        { const float a_ = b3 ? y2[1] : y2[0], sd_ = b3 ? y2[0] : y2[1]; q1 = a_ + DPPF(sd_, 0x128); }                  \
        q1 += DPPF(q1, 0xB1); q1 += DPPF(q1, 0x4E); q1 += DPPF(q1, 0x141);                                            \
        const int slot_ = (8 * (bt) + jj) & 63; \
        const float cu_ = __shfl((bt) < 8 ? m.cu0 : m.cu1, slot_), cv_ = __shfl((bt) < 8 ? m.g0 * m.sv0 : m.g1 * m.sv1, slot_); \
        const float c_ = gelu_tanh(q1 * cu_) * cv_; \
        _Pragma("unroll") for (int j_ = 0; j_ < 8; ++j_) { \
            const float cj_ = __int_as_float(__builtin_amdgcn_readlane(__float_as_int(c_), 32 * (j_ & 1) + 8 * ((j_ >> 1) & 1) + 16 * ((j_ >> 2) & 1))); \
            row_axpy16(VQ[j_], cj_, o); } } while (0)
__device__ __forceinline__ void phase_peer(KP kp, int wave_s) {
    const int lane = lane_id_asm(), wave = wave_s;
    unsigned char* ws = kp->ws;
    const __amdgpu_buffer_rsrc_t rsU = __builtin_amdgcn_make_buffer_rsrc((void*)(ws + WS_EU), 0, NEXP * U_BITS * 128, 0x00020000);
    const __amdgpu_buffer_rsrc_t rsV = __builtin_amdgcn_make_buffer_rsrc((void*)(ws + WS_EV), 0, NEXP * V_BITS * 128, 0x00020000);
    const unsigned char* HB = ws + WS_HB; const f32x2* HS = (const f32x2*)(ws + WS_HS);
    const int* IDX = (const int*)(ws + WS_IDX); const float* GATE = (const float*)(ws + WS_GATE);
    const float* SU = (const float*)(ws + WS_SU); const float* SV = (const float*)(ws + WS_SV);
    const float* mod = (const float*)(ws + WS_MOD); const float* fg = kp->in[22];
    const bf16_t* X1 = (const bf16_t*)(ws + WS_X1B); float* OUT = kp->out;
    const bool b5 = lane & 32, b4 = lane & 16, b3 = lane & 8;
    const int jj = 4 * (b4 ? 1 : 0) + 2 * (b3 ? 1 : 0) + (b5 ? 1 : 0);
    const int nn = lane & 15, qq = lane >> 4;
    const bool mhi = nn >= 8;
    const int uoff = 64 * (nn & 7) + 16 * qq;
    const bool useful = ((nn & 7) >> 2) == (qq & 1);
    const bool r0 = (nn & 3) == 0, r1 = (nn & 3) == 1, r2 = (nn & 3) == 2;
    const int tstride = gridDim.x * 8;
    int tok = blockIdx.x * 8 + wave;
    f32x4 fgv[4];
#pragma unroll
    for (int q = 0; q < 4; ++q) fgv[q] = *(const f32x4*)(fg + 16 * lane + 4 * q);
    TokMeta m, mn;
    u32x4 uqA[4], uqB[4]; vrow_t vqA[8], vqB[8];
    if (tok < T) { peer_load_meta(m, tok, lane, HB, HS, IDX, GATE, X1, mod); peer_load_scales(m, SU, SV); mn = m; PEER_LOAD(uqA, vqA, 0); }
    for (; tok < T; tok += tstride) {
        const int b = tok / SEQ;
        const bool has_next = tok + tstride < T;
        if (has_next) peer_load_meta(mn, tok + tstride, lane, HB, HS, IDX, GATE, X1, mod);
        const i32x8 hbv = {(int)m.hb.x, (int)m.hb.y, (int)m.hb.z, (int)m.hb.w, 0, 0, 0, 0};
        const float st = useful ? ((nn >> 3) ? m.hs.y : m.hs.x) : 0.f;
        f32x2 o[8];
#pragma unroll
        for (int i = 0; i < 8; ++i) o[i] = (f32x2){0.f, 0.f};
#pragma unroll 1
        for (int bt = 0; bt < 16; bt += 2) {
            PEER_LOAD(uqB, vqB, bt + 1);
            PEER_COMPUTE(uqA, vqA, bt);
            PEER_LOAD(uqA, vqA, bt + 2);
            PEER_COMPUTE(uqB, vqB, bt + 1);
        }
        if (has_next) peer_load_scales(mn, SU, SV);
        float* xr = OUT + (size_t)tok * D + 16 * lane;
        const unsigned xw[8] = {m.x1[0].x, m.x1[0].y, m.x1[0].z, m.x1[0].w, m.x1[1].x, m.x1[1].y, m.x1[1].z, m.x1[1].w};
        f32x4 xv[4]; float ss = 0.f;
#pragma unroll
        for (int q = 0; q < 4; ++q) {
            const f32x4 x1v = {bf_lo(xw[2 * q]), bf_hi(xw[2 * q]), bf_lo(xw[2 * q + 1]), bf_hi(xw[2 * q + 1])}, gv = m.g2[q];
            xv[q][0] = x1v[0] + gv[0] * o[2 * q].x; xv[q][1] = x1v[1] + gv[1] * o[2 * q].y; xv[q][2] = x1v[2] + gv[2] * o[2 * q + 1].x; xv[q][3] = x1v[3] + gv[3] * o[2 * q + 1].y;
            ss += xv[q][0] * xv[q][0] + xv[q][1] * xv[q][1] + xv[q][2] * xv[q][2] + xv[q][3] * xv[q][3];
        }
        ss = wave_sum(ss);
        const float r = rsqrtf(ss * (1.0f / D) + EPS);
#pragma unroll
        for (int q = 0; q < 4; ++q) *(f32x4*)(xr + 4 * q) = xv[q] * r * fgv[q];
        m = mn;
    }
}

__device__ __forceinline__ void sort_words(unsigned& w0, unsigned& w1, int lane, LAS unsigned* scr) {
#pragma unroll
    for (int bit = 10; bit < 14; ++bit) {
        const bool z0 = ((w0 >> bit) & 1u) == 0u, z1 = ((w1 >> bit) & 1u) == 0u;
        const unsigned long long m0 = __ballot(z0), m1 = __ballot(z1);
        const int nz0 = __popcll(m0), nz = nz0 + __popcll(m1);
        const int r0 = __builtin_amdgcn_mbcnt_hi((unsigned)(m0 >> 32), __builtin_amdgcn_mbcnt_lo((unsigned)m0, 0u));
        const int r1 = __builtin_amdgcn_mbcnt_hi((unsigned)(m1 >> 32), __builtin_amdgcn_mbcnt_lo((unsigned)m1, 0u));
        const int p0 = z0 ? r0 : nz + lane - r0;
        const int p1 = z1 ? nz0 + r1 : nz + 64 - nz0 + lane - r1;
        scr[p0] = w0; scr[p1] = w1;
        asm volatile("" ::: "memory");
        w0 = scr[lane]; w1 = scr[64 + lane];
        asm volatile("" ::: "memory");
    }
}
struct UTok { u32x4 hb; f32x2 hs; unsigned s0, s1; };
#define PU_LOAD(UQ, k, g) do { const int bb_ = (g) & 15; const bool nx_ = (g) >= 16; \
        const unsigned src_ = bb_ < 8 ? (nx_ ? nxt[k].s0 : cur[k].s0) : (nx_ ? nxt[k].s1 : cur[k].s1); \
        _Pragma("unroll") for (int j_ = 0; j_ < 4; ++j_) { \
            const int id_ = __builtin_amdgcn_ds_bpermute(4 * (((8 * bb_) & 63) + 2 * j_) + slotb, (int)src_) & 0x3fff; \
            UQ[j_] = __builtin_bit_cast(u32x4, __builtin_amdgcn_raw_buffer_load_b128(rsU, (id_ << 9) + uoff, 0, 0)); } } while (0)
#define PU_COMPUTE(UQ, k, bt) do { \
        const i32x8 hbv = {(int)cur[k].hb.x, (int)cur[k].hb.y, (int)cur[k].hb.z, (int)cur[k].hb.w, 0, 0, 0, 0}; const float st = cur[k].hs.x; \
        float x_[4]; \
        _Pragma("unroll") for (int j_ = 0; j_ < 4; ++j_) { \
            const i32x8 a_ = {(int)UQ[j_].x, (int)UQ[j_].y, (int)UQ[j_].z, (int)UQ[j_].w, 0, 0, 0, 0}; \
            const f32x4 d_ = __builtin_amdgcn_mfma_scale_f32_16x16x128_f8f6f4(a_, hbv, (f32x4){0.f, 0.f, 0.f, 0.f}, 4, 4, 0, 0x7f7f7f7f, 0, 0x7f7f7f7f); \
            x_[j_] = (d_[0] * lm0 + d_[1] * lm1 + d_[2] * lm2 + d_[3] * lm3) * st; } \
        float y2[2], q1; \
        _Pragma("unroll") for (int k_ = 0; k_ < 2; ++k_) { const float a_ = b4 ? x_[k_ + 2] : x_[k_], sd_ = b4 ? x_[k_] : x_[k_ + 2]; y2[k_] = a_ + __shfl_xor(sd_, 16); } \
        { const float a_ = b3 ? y2[1] : y2[0], sd_ = b3 ? y2[0] : y2[1]; q1 = a_ + DPPF(sd_, 0x128); } \
        q1 += DPPF(q1, 0xB1); q1 += DPPF(q1, 0x4E); q1 += DPPF(q1, 0x141); \
        const float qs_ = __shfl(q1, srcl);                                     \
        const bool mine_ = (lane >> 3) == ((bt) & 7); \
        if ((bt) < 8) qs0[k] = mine_ ? qs_ : qs0[k]; else qs1[k] = mine_ ? qs_ : qs1[k]; } while (0)
__device__ __forceinline__ void peer_u_raw(UTok& t, int tok, int lane, const unsigned char* HB, const f32x2* HS, const int* IDX) {
    t.hb = *(const u32x4*)(HB + (size_t)tok * 1024 + ((lane & 15) >> 3) * 512 + (lane & 7) * 16 + (lane >> 4) * 128);
    t.hs = HS[tok];
    t.s0 = (unsigned)IDX[(size_t)tok * 128 + lane] | ((unsigned)lane << 14); t.s1 = (unsigned)IDX[(size_t)tok * 128 + 64 + lane] | ((unsigned)(64 + lane) << 14);
}
__device__ __forceinline__ void phase_peer_u(KP kp, LAS unsigned char* lds, int wave_s) {
    const int lane = lane_id_asm(), wave = wave_s;
    unsigned char* ws = kp->ws;
    const __amdgpu_buffer_rsrc_t rsU = __builtin_amdgcn_make_buffer_rsrc((void*)(ws + WS_EU), 0, NEXP * U_BITS * 128, 0x00020000);
    const unsigned char* HB = ws + WS_HB; const f32x2* HS = (const f32x2*)(ws + WS_HS);
    const int* IDX = (const int*)(ws + WS_IDX); const float* GATE = (const float*)(ws + WS_GATE);
    const float* SU = (const float*)(ws + WS_SU); const float* SV = (const float*)(ws + WS_SV);
    LAS unsigned* scr = (LAS unsigned*)(lds + wave * 2048);
    const bool b4 = lane & 16, b3 = lane & 8;
    const int srcl = 32 * (lane & 1) + 16 * ((lane >> 2) & 1) + 8 * ((lane >> 1) & 1);
    const int nn = lane & 15, qq = lane >> 4;
    const int uoff = 16 * (nn & 7) + 128 * qq;
    const int slotb = 4 * (nn >> 3);
    const bool useful = ((nn & 7) >> 2) == (qq & 1);
    const float lm0 = (nn & 3) == 0 ? 1.f : 0.f, lm1 = (nn & 3) == 1 ? 1.f : 0.f, lm2 = (nn & 3) == 2 ? 1.f : 0.f, lm3 = (nn & 3) == 3 ? 1.f : 0.f;
    const int tstride = gridDim.x * 8;
    int tok0 = blockIdx.x * 8 + wave;
    if (tok0 < T) {
        UTok cur[4], nxt[4];
        u32x4 uq[4][4];
#pragma unroll
        for (int k = 0; k < 4; ++k) { const int tk = tok0 + k * tstride; peer_u_raw(cur[k], tk < T ? tk : tok0, lane, HB, HS, IDX); }
#pragma unroll
        for (int k = 0; k < 4; ++k) { sort_words(cur[k].s0, cur[k].s1, lane, scr + k * 128); cur[k].hs.x = useful ? ((nn >> 3) ? cur[k].hs.y : cur[k].hs.x) : 0.f; nxt[k] = cur[k]; }
        PU_LOAD(uq[0], 0, 0); PU_LOAD(uq[1], 1, 0); PU_LOAD(uq[2], 2, 0);
        for (; tok0 < T; tok0 += 4 * tstride) {
            const bool has_next = tok0 + 4 * tstride < T;
            if (has_next) {
#pragma unroll
                for (int k = 0; k < 4; ++k) { const int tk = tok0 + (4 + k) * tstride; peer_u_raw(nxt[k], tk < T ? tk : tok0 + 4 * tstride, lane, HB, HS, IDX); }
            }
            float g0[4], g1[4], cu0[4], cu1[4], sv0[4], sv1[4];
#pragma unroll
            for (int k = 0; k < 4; ++k) { const int tk = tok0 + k * tstride < T ? tok0 + k * tstride : tok0;
                const int i0 = cur[k].s0 & 0x3fff, i1 = cur[k].s1 & 0x3fff;
                g0[k] = GATE[(size_t)tk * 128 + (cur[k].s0 >> 14)]; g1[k] = GATE[(size_t)tk * 128 + (cur[k].s1 >> 14)];
                cu0[k] = SU[i0]; cu1[k] = SU[i1]; sv0[k] = SV[i0]; sv1[k] = SV[i1]; }
            float qs0[4] = {0.f, 0.f, 0.f, 0.f}, qs1[4] = {0.f, 0.f, 0.f, 0.f};
#pragma unroll 1
            for (int bt = 0; bt < 16; ++bt) {
                if (bt == 8 && has_next) {
#pragma unroll
                    for (int k = 0; k < 4; ++k) { sort_words(nxt[k].s0, nxt[k].s1, lane, scr + k * 128); nxt[k].hs.x = useful ? ((nn >> 3) ? nxt[k].hs.y : nxt[k].hs.x) : 0.f; }
                }
                PU_LOAD(uq[3], 3, bt);     PU_COMPUTE(uq[0], 0, bt);
                PU_LOAD(uq[0], 0, bt + 1); PU_COMPUTE(uq[1], 1, bt);
                PU_LOAD(uq[1], 1, bt + 1); PU_COMPUTE(uq[2], 2, bt);
                PU_LOAD(uq[2], 2, bt + 1); PU_COMPUTE(uq[3], 3, bt);
            }
#pragma unroll
            for (int k = 0; k < 4; ++k) { const int tok = tok0 + k * tstride;
                if (tok < T) {
                    const int e0 = (int)(cur[k].s0 & 0x3fff), e1 = (int)(cur[k].s1 & 0x3fff);
                    const float c0 = gelu_tanh(qs0[k] * cu0[k]) * (g0[k] * sv0[k]), c1 = gelu_tanh(qs1[k] * cu1[k]) * (g1[k] * sv1[k]);
                    float cm = fmaxf(fabsf(c0), fabsf(c1));
#pragma unroll
                    for (int o_ = 32; o_ >= 1; o_ >>= 1) cm = fmaxf(cm, __shfl_xor(cm, o_));
                    const float f = cm > 0.f ? 256.0f / cm : 0.f;
                    const unsigned pk = (unsigned)__builtin_amdgcn_cvt_pk_fp8_f32(c0 * f, c1 * f, 0, false) & 0xffffu;
                    const unsigned nbe0 = (unsigned)__builtin_amdgcn_update_dpp(0, e0, 0xB1, 0xF, 0xF, true), nbe1 = (unsigned)__builtin_amdgcn_update_dpp(0, e1, 0xB1, 0xF, 0xF, true);
                    if (!(lane & 1)) {
                        const int p = lane >> 1, o0 = (p & 3) * 16 + (p >> 2), o1 = (p & 3) * 16 + 8 + (p >> 2);
                        unsigned* IDP = (unsigned*)(ws + WS_IDP) + (size_t)tok * 64;
                        IDP[o0] = (unsigned)e0 | (nbe0 << 16); IDP[o1] = (unsigned)e1 | (nbe1 << 16);
                    }
                    const unsigned nb4 = (unsigned)__shfl((int)pk, lane + 4);
                    if ((lane & 7) < 4) {
                        unsigned short* COP = (unsigned short*)(ws + WS_COP) + (size_t)tok * 64 + (lane & 3) * 16 + (lane >> 3);
                        COP[0] = (unsigned short)((pk & 0xffu) | ((nb4 & 0xffu) << 8)); COP[8] = (unsigned short)(((pk >> 8) & 0xffu) | (nb4 & 0xff00u));
                    }
                    if (lane == 0) ((float*)(ws + WS_CS))[tok] = cm * (1.0f / 256.0f);
                }
                cur[k] = nxt[k]; }
        }
    }
}
#define PV_LOADG(RB, k, g) do { const int gg_ = (g) & 15; \
        const unsigned pr_ = ((g) >= 16 ? mnx : mcu)[(k) * 96 + qq * 16 + gg_]; \
        cfr[k] = ((g) >= 16 ? mnx : mcu)[(k) * 96 + 64 + qq * 8 + (gg_ >> 1)]; \
        const int va_ = (int)((pr_ & 0xffffu) << 9) + lanebase, vb_ = (int)((pr_ >> 16) << 9) + lanebase; \
        _Pragma("unroll") for (int blk_ = 0; blk_ < 4; ++blk_) { \
            const u32x2 a_ = __builtin_bit_cast(u32x2, __builtin_amdgcn_raw_buffer_load_b64(rsV, va_ + 8 * (blk_ & 1) + 256 * (blk_ >> 1), 0, 0)); \
            const u32x2 b_ = __builtin_bit_cast(u32x2, __builtin_amdgcn_raw_buffer_load_b64(rsV, vb_ + 8 * (blk_ & 1) + 256 * (blk_ >> 1), 0, 0)); \
            RB[blk_] = (u32x4){a_.x, a_.y, b_.x, b_.y}; } } while (0)
#define PV_COMPG(RB, k, g, CW) do { const unsigned cw_ = (CW); \
        const unsigned ra_ = ((g) & 1) ? __builtin_amdgcn_perm(cw_, cw_, 0x02020202u) : __builtin_amdgcn_perm(cw_, cw_, 0x00000000u); \
        const unsigned rb_ = ((g) & 1) ? __builtin_amdgcn_perm(cw_, cw_, 0x03030303u) : __builtin_amdgcn_perm(cw_, cw_, 0x01010101u); \
        const i32x8 A_ = {(int)(ra_ & mk0), (int)(ra_ & mk1), (int)(ra_ & mk2), (int)(ra_ & mk3), (int)(rb_ & mk0), (int)(rb_ & mk1), (int)(rb_ & mk2), (int)(rb_ & mk3)}; \
        _Pragma("unroll") for (int blk_ = 0; blk_ < 4; ++blk_) { \
            const i32x8 B_ = {(int)RB[blk_].x, (int)RB[blk_].y, (int)RB[blk_].z, (int)RB[blk_].w, 0, 0, 0, 0}; \
            acc[k][blk_] = __builtin_amdgcn_mfma_scale_f32_16x16x128_f8f6f4(A_, B_, acc[k][blk_], 0, 4, 0, 0x7f7f7f7f, 0, 0x7f7f7f7f); } } while (0)
__device__ __forceinline__ void phase_peer_v(KP kp, LAS unsigned char* lds, int wave_s) {
    const int lane = lane_id_asm(), wave = wave_s;
    unsigned char* ws = kp->ws;
    const __amdgpu_buffer_rsrc_t rsV = __builtin_amdgcn_make_buffer_rsrc((void*)(ws + WS_EV), 0, NEXP * V_BITS * 128, 0x00020000);
    const float* mod = (const float*)(ws + WS_MOD); const float* fg = kp->in[22];
    const bf16_t* X1 = (const bf16_t*)(ws + WS_X1B); float* OUT = kp->out;
    const unsigned* IDP = (const unsigned*)(ws + WS_IDP); const unsigned* COP = (const unsigned*)(ws + WS_COP); const float* CS = (const float*)(ws + WS_CS);
    const int nn = lane & 15, qq = lane >> 4;
    const int lanebase = 16 * nn;
    const unsigned msel = 0xFFu << (8 * (nn & 3));
    const unsigned mk0 = (nn >> 2) == 0 ? msel : 0u, mk1 = (nn >> 2) == 1 ? msel : 0u, mk2 = (nn >> 2) == 2 ? msel : 0u, mk3 = (nn >> 2) == 3 ? msel : 0u;
    const int col0 = 32 * nn + 4 * qq;
    const int tstride = gridDim.x * 8;
    int tok0 = blockIdx.x * 8 + wave;
    LAS unsigned* mcu = (LAS unsigned*)(lds + wave * 3072);
    LAS unsigned* mnx = mcu + 384;
    if (tok0 < T) {
        unsigned idw[4], cfw[4]; float csc[4], csn[4];
#pragma unroll
        for (int k = 0; k < 4; ++k) { const int tk = tok0 + k * tstride < T ? tok0 + k * tstride : tok0;
            idw[k] = IDP[(size_t)tk * 64 + lane]; cfw[k] = COP[(size_t)tk * 32 + (lane & 31)]; csc[k] = CS[tk]; csn[k] = csc[k]; }
#pragma unroll
        for (int k = 0; k < 4; ++k) { mcu[k * 96 + lane] = idw[k]; if (lane < 32) mcu[k * 96 + 64 + lane] = cfw[k]; mnx[k * 96 + lane] = idw[k]; if (lane < 32) mnx[k * 96 + 64 + lane] = cfw[k]; }
        asm volatile("" ::: "memory");
        u32x4 rb0[4], rb1[4], rb2[4], rb3[4]; unsigned cfr[4];
        PV_LOADG(rb0, 0, 0); PV_LOADG(rb1, 1, 0); PV_LOADG(rb2, 2, 0);
        for (; tok0 < T; tok0 += 4 * tstride) {
            const bool has_next = tok0 + 4 * tstride < T;
            if (has_next) {
#pragma unroll
                for (int k = 0; k < 4; ++k) { const int tk = tok0 + (4 + k) * tstride < T ? tok0 + (4 + k) * tstride : tok0 + 4 * tstride;
                    idw[k] = IDP[(size_t)tk * 64 + lane]; cfw[k] = COP[(size_t)tk * 32 + (lane & 31)]; csn[k] = CS[tk]; }
            }
            f32x4 acc[4][4]; u32x2 xwa[4], xwb[4]; f32x4 gva[4], gvb[4];
#pragma unroll
            for (int k = 0; k < 4; ++k)
#pragma unroll
                for (int i = 0; i < 4; ++i) acc[k][i] = (f32x4){0.f, 0.f, 0.f, 0.f};
#pragma unroll 1
            for (int G = 0; G < 16; ++G) {
                if (G == 14) {
                    const bf16_t* xp = X1 + (size_t)tok0 * D + col0; const float* gp = mod + (size_t)(tok0 / SEQ) * NMOD + 5 * 1024 + col0;
#pragma unroll
                    for (int blk = 0; blk < 4; ++blk) { xwa[blk] = *(const u32x2*)(xp + 16 * (blk & 1) + 512 * (blk >> 1)); gva[blk] = *(const f32x4*)(gp + 16 * (blk & 1) + 512 * (blk >> 1)); }
                }
                if (G == 8) {
#pragma unroll
                    for (int k = 0; k < 4; ++k) { mnx[k * 96 + lane] = idw[k]; if (lane < 32) mnx[k * 96 + 64 + lane] = cfw[k]; }
                    asm volatile("" ::: "memory");
                }
                { const unsigned c_ = cfr[0]; PV_LOADG(rb3, 3, G);     PV_COMPG(rb0, 0, G, c_); }
                { const unsigned c_ = cfr[1]; PV_LOADG(rb0, 0, G + 1); PV_COMPG(rb1, 1, G, c_); }
                { const unsigned c_ = cfr[2]; PV_LOADG(rb1, 1, G + 1); PV_COMPG(rb2, 2, G, c_); }
                { const unsigned c_ = cfr[3]; PV_LOADG(rb2, 2, G + 1); PV_COMPG(rb3, 3, G, c_); }
            }
            f32x4 fgv[4];
#pragma unroll
            for (int blk = 0; blk < 4; ++blk) fgv[blk] = *(const f32x4*)(fg + col0 + 16 * (blk & 1) + 512 * (blk >> 1));
#pragma unroll
            for (int k = 0; k < 4; ++k) { const int tok = tok0 + k * tstride;
                if (k < 3) { const int tk = tok0 + (k + 1) * tstride < T ? tok0 + (k + 1) * tstride : tok0; const bf16_t* xp = X1 + (size_t)tk * D + col0; const float* gp = mod + (size_t)(tk / SEQ) * NMOD + 5 * 1024 + col0;
#pragma unroll
                    for (int blk = 0; blk < 4; ++blk) { xwb[blk] = *(const u32x2*)(xp + 16 * (blk & 1) + 512 * (blk >> 1)); gvb[blk] = *(const f32x4*)(gp + 16 * (blk & 1) + 512 * (blk >> 1)); } }
                if (tok < T) {
                    float* xr = OUT + (size_t)tok * D + col0;
                    f32x4 xv[4]; float ss = 0.f;
#pragma unroll
                    for (int blk = 0; blk < 4; ++blk) {
                        const f32x4 x1v = {bf_lo(xwa[blk].x), bf_hi(xwa[blk].x), bf_lo(xwa[blk].y), bf_hi(xwa[blk].y)};
                        xv[blk] = x1v + gva[blk] * (acc[k][blk] * csc[k]);
                        ss += xv[blk][0] * xv[blk][0] + xv[blk][1] * xv[blk][1] + xv[blk][2] * xv[blk][2] + xv[blk][3] * xv[blk][3]; }
                    ss = wave_sum(ss);
                    const float r = rsqrtf(ss * (1.0f / D) + EPS);
#pragma unroll
                    for (int blk = 0; blk < 4; ++blk) *(f32x4*)(xr + 16 * (blk & 1) + 512 * (blk >> 1)) = xv[blk] * r * fgv[blk];
                }
#pragma unroll
                for (int blk = 0; blk < 4; ++blk) { gva[blk] = gvb[blk]; xwa[blk] = xwb[blk]; }
                csc[k] = csn[k]; }
            { LAS unsigned* t_ = mcu; mcu = mnx; mnx = t_; }
        }
    }
}

__global__ void __launch_bounds__(NTHREADS, 2) fwd_megakernel(Params P_) {
    extern __shared__ __attribute__((aligned(16))) unsigned char lds_raw[];
    LAS unsigned char* lds = (LAS unsigned char*)lds_raw;
    KP kp = (KP)__builtin_amdgcn_kernarg_segment_ptr();
    volatile LAS unsigned* ctl = (volatile LAS unsigned*)(lds + LDS_CTL_OFF);
    const int wave_s = __builtin_amdgcn_readfirstlane(threadIdx.x >> 6);
    if (threadIdx.x < 4) ctl[threadIdx.x] = 0u;
    __syncthreads();
    { XcdBarrier b0 = xcd_barrier_post((unsigned*)(kp->ws + WS_CTL), ctl, wave_s); (void)b0; }
    const int lo = kp->ph_lo, hi = kp->ph_hi;
#define IN(k) (lo <= (k) && (k) < hi)
#define FRESH() asm volatile("" : "+s"(kp) :: "memory")
#define SEAM(k) do { if (IN(k) && IN((k) + 1)) { { XcdBarrier b_; b_.bar = (unsigned*)(kp->ws + WS_CTL); b_.x = xb_xcc_id(); b_.st = ctl; xcd_barrier(b_, wave_s); } } FRESH(); } while (0)

    if (IN(0)) phase_prep(kp, lds, wave_s);
#if DBG_REPEAT
    FRESH();
    if (IN(0)) phase_prep(kp, lds, wave_s);
#endif
    SEAM(0);
    if (IN(1)) { phase_aux(kp, lds, wave_s); phase_w8(kp, lds, wave_s); unsigned char* ws = kp->ws; phase_norm_ada<true>(kp->in[0], kp->in[4], (const float*)(ws + WS_MOD), 0, 1024, (bf16_t*)nullptr, ws + WS_X8, (float*)(ws + WS_X8S), wave_s); }
#if DBG_REPEAT
    FRESH();
    if (IN(1)) { unsigned char* ws = kp->ws; phase_norm_ada<true>(kp->in[0], kp->in[4], (const float*)(ws + WS_MOD), 0, 1024, (bf16_t*)nullptr, ws + WS_X8, (float*)(ws + WS_X8S), wave_s); }
#endif
    SEAM(1);
    if (IN(2)) {
        unsigned char* ws = kp->ws;
        { pg8::Gemm g{(const bf16_t*)(ws + WS_X8), (const bf16_t*)(ws + WS_WP8), T, 3584, D / 2}; pg8::StaticOrder S; S.init(T, 3584, gridDim.x, blockIdx.x);
          EpiIn E{EpiProj{(const float*)(ws + WS_BINP), (bf16_t*)(ws + WS_PG), (bf16_t*)(ws + WS_PG) + (size_t)T * 512, (const float*)(ws + WS_X8S), (const float*)(ws + WS_WP8S)},
                  EpiGate{(const float*)(ws + WS_BINP), (const float*)(ws + WS_X8S), (const float*)(ws + WS_WGS), (bf16_t*)(ws + WS_SG)}};
          pg8::gemm_phase<EpiIn>(lds, g, S, E, wave_s); }
    }
#if DBG_REPEAT
    FRESH();
    if (IN(2)) {
        unsigned char* ws = kp->ws;
        { pg8::Gemm g{(const bf16_t*)(ws + WS_X8), (const bf16_t*)(ws + WS_WP8), T, 3584, D / 2}; pg8::StaticOrder S; S.init(T, 3584, gridDim.x, blockIdx.x);
          EpiIn E{EpiProj{(const float*)(ws + WS_BINP), (bf16_t*)(ws + WS_PG), (bf16_t*)(ws + WS_PG) + (size_t)T * 512, (const float*)(ws + WS_X8S), (const float*)(ws + WS_WP8S)},
                  EpiGate{(const float*)(ws + WS_BINP), (const float*)(ws + WS_X8S), (const float*)(ws + WS_WGS), (bf16_t*)(ws + WS_SG)}};
          pg8::gemm_phase<EpiIn>(lds, g, S, E, wave_s); }
    }
#endif
    SEAM(2);
    if (IN(3)) phase_branches(kp, lds, wave_s);
#if DBG_REPEAT
    FRESH();
    if (IN(3)) phase_branches(kp, lds, wave_s);
#endif
    SEAM(3);
    if (IN(4)) {
        unsigned char* ws = kp->ws;
        pg8::Gemm g{(const bf16_t*)(ws + WS_MC), (const bf16_t*)(ws + WS_WPC), T, D, D}; pg8::StaticOrder S; S.init(T, D, gridDim.x, blockIdx.x);
        EpiMerge E{(const bf16_t*)(ws + WS_SG), (bf16_t*)(ws + WS_PG)};
        pg8::gemm_phase<EpiMerge>(lds, g, S, E, wave_s);
    }
#if DBG_REPEAT
    FRESH();
    if (IN(4)) {
        unsigned char* ws = kp->ws;
        pg8::Gemm g{(const bf16_t*)(ws + WS_MC), (const bf16_t*)(ws + WS_WPC), T, D, D}; pg8::StaticOrder S; S.init(T, D, gridDim.x, blockIdx.x);
        EpiMerge E{(const bf16_t*)(ws + WS_SG), (bf16_t*)(ws + WS_PG)};
        pg8::gemm_phase<EpiMerge>(lds, g, S, E, wave_s);
    }
#endif
    SEAM(4);
    if (IN(5)) {
        unsigned char* ws = kp->ws;
        pg8::Gemm g{(const bf16_t*)(ws + WS_PG), (const bf16_t*)(ws + WS_WOUT), T, D, D}; pg8::StaticOrder S; S.init(T, D, gridDim.x, blockIdx.x);
        EpiResid E{kp->in[0], (const float*)(ws + WS_MOD) + 2 * 1024, (bf16_t*)(ws + WS_X1B), (const float*)(ws + WS_A2), (bf16_t*)(ws + WS_H), (float*)(ws + WS_SSQ)};
        pg8::gemm_phase<EpiResid>(lds, g, S, E, wave_s);
    }
#if DBG_REPEAT
    FRESH();
    if (IN(5)) {
        unsigned char* ws = kp->ws;
        pg8::Gemm g{(const bf16_t*)(ws + WS_PG), (const bf16_t*)(ws + WS_WOUT), T, D, D}; pg8::StaticOrder S; S.init(T, D, gridDim.x, blockIdx.x);
        EpiResid E{kp->in[0], (const float*)(ws + WS_MOD) + 2 * 1024, (bf16_t*)(ws + WS_X1B), (const float*)(ws + WS_A2), (bf16_t*)(ws + WS_H), (float*)(ws + WS_SSQ)};
        pg8::gemm_phase<EpiResid>(lds, g, S, E, wave_s);
    }
#endif
    SEAM(5);
    if (IN(7)) {
        unsigned char* ws = kp->ws;
        pg8::Gemm g{(const bf16_t*)(ws + WS_H), (const bf16_t*)(ws + WS_WQ), T, 2048, D}; pg8::StaticOrder S; S.init(T, 2048, gridDim.x, blockIdx.x);
        EpiQ E{(bf16_t*)(ws + WS_SG), (const float*)(ws + WS_SSQ), (const float*)(ws + WS_BIAS2)};
        pg8::gemm_phase<EpiQ>(lds, g, S, E, wave_s);
    }
#if DBG_REPEAT
    FRESH();
    if (IN(7)) {
        unsigned char* ws = kp->ws;
        pg8::Gemm g{(const bf16_t*)(ws + WS_H), (const bf16_t*)(ws + WS_WQ), T, 2048, D}; pg8::StaticOrder S; S.init(T, 2048, gridDim.x, blockIdx.x);
        EpiQ E{(bf16_t*)(ws + WS_SG), (const float*)(ws + WS_SSQ), (const float*)(ws + WS_BIAS2)};
        pg8::gemm_phase<EpiQ>(lds, g, S, E, wave_s);
    }
#endif
    if (IN(7) && IN(8)) { asm volatile("s_waitcnt vmcnt(0)" ::: "memory"); __syncthreads();
        if (wave_s == 0 && lane_id_asm() == 0) { __builtin_amdgcn_fence(__ATOMIC_ACQUIRE, "agent"); asm volatile("s_waitcnt vmcnt(0)" ::: "memory"); }
        __syncthreads(); }
    FRESH();
    if (IN(8)) phase_topk(kp, lds, wave_s);
#if DBG_REPEAT
    FRESH();
    if (IN(8)) phase_topk(kp, lds, wave_s);
#endif
    SEAM(8);
    if (IN(9)) phase_peer_u(kp, lds, wave_s);
    SEAM(9);
    if (IN(10)) phase_peer_v(kp, lds, wave_s);
#undef IN
#undef SEAM
#undef FRESH
}

#define DBG_PHASE_SKIP(ph) (0)
#define DBG_LAST 9
#define DBG_DUMP_N ((size_t)3584 * 1024)
#define DBG_DUMP_BF16 1
#ifdef DBG_DUMP_OFF
__global__ void dbg_dump(const unsigned char* ws, float* out) {
    const size_t n = DBG_DUMP_N;
    for (size_t i = (size_t)blockIdx.x * blockDim.x + threadIdx.x; i < (size_t)T * D; i += (size_t)gridDim.x * blockDim.x) {
        const size_t j = (i * 7919ull) % n;
        float v;
        if (DBG_DUMP_BF16) v = __uint_as_float(((unsigned)((const bf16_t*)(ws + DBG_DUMP_OFF))[j]) << 16);
        else v = ((const float*)(ws + DBG_DUMP_OFF))[j];
        out[i] = v;
    }
}
#endif
#ifndef MK_N_LAUNCHES
#define MK_N_LAUNCHES 1
#endif
extern "C" void kernel_launch(void* const* d_in, const int* in_sizes, int n_in, void* d_out, int out_size, void* d_ws, size_t ws_size, hipStream_t stream) {
    static int grid = 0;
    if (grid == 0) {
        if (n_in != 23 || in_sizes[0] != T * D || out_size != T * D || ws_size < WS_END) {
            fprintf(stderr, "kernel_launch: unexpected shapes (n_in %d, in0 %d, out %d, ws %zu); nothing launched\n", n_in, n_in > 0 ? in_sizes[0] : -1, out_size, ws_size); grid = -1; return; }
        int dev = 0, cus = 0, per_cu = 0;
        if (hipGetDevice(&dev) != hipSuccess || hipDeviceGetAttribute(&cus, hipDeviceAttributeMultiprocessorCount, dev) != hipSuccess) { grid = -1; return; }
        if (hipFuncSetAttribute((const void*)fwd_megakernel, hipFuncAttributeMaxDynamicSharedMemorySize, LDS_BYTES) != hipSuccess) { fprintf(stderr, "kernel_launch: hipFuncSetAttribute failed\n"); grid = -1; return; }
        if (hipOccupancyMaxActiveBlocksPerMultiprocessor(&per_cu, (const void*)fwd_megakernel, NTHREADS, LDS_BYTES) != hipSuccess || per_cu < 1) {
            fprintf(stderr, "kernel_launch: occupancy query says %d blocks per CU; nothing launched\n", per_cu); grid = -1; return; }
        grid = cus;
    }
    if (grid < 0) return;
    (void)hipMemsetAsync((char*)d_ws + WS_CTL, 0, 16384, stream);
    Params p{};
    for (int i = 0; i < 23; ++i) p.in[i] = (const float*)d_in[i];
    p.out = (float*)d_out; p.ws = (unsigned char*)d_ws;
#if MK_N_LAUNCHES == 1
    p.ph_lo = 0; p.ph_hi = 11;
    void* args[] = {&p};
    hipError_t e = hipLaunchCooperativeKernel((const void*)fwd_megakernel, dim3(grid), dim3(NTHREADS), args, LDS_BYTES, stream);
    if (e != hipSuccess) fprintf(stderr, "kernel_launch: cooperative launch failed: %s (grid %d)\n", hipGetErrorString(e), grid);
#else
    for (int ph = 0; ph < 11; ++ph) { if (DBG_PHASE_SKIP(ph)) continue; p.ph_lo = ph; p.ph_hi = ph + 1; hipLaunchKernelGGL(fwd_megakernel, dim3(grid), dim3(NTHREADS), LDS_BYTES, stream, p); }
#ifdef DBG_DUMP_OFF
    hipLaunchKernelGGL(dbg_dump, dim3(1024), dim3(256), 0, stream, (const unsigned char*)d_ws, (float*)d_out);
#endif
#endif
}
```

```cpp
#include <hip/hip_runtime.h>
#include <hip/hip_cooperative_groups.h>
#include <cstdio>
#include <cstdint>
namespace cg = cooperative_groups;
#define DBG_NO_DOT2 1
#define DBG_REPEAT 0

#define LAS __attribute__((address_space(3)))
typedef unsigned short bf16_t;
typedef short bf16x8 __attribute__((ext_vector_type(8)));
typedef float f32x4 __attribute__((ext_vector_type(4)));
typedef float f32x2 __attribute__((ext_vector_type(2)));
typedef float f32x16 __attribute__((ext_vector_type(16)));
typedef unsigned u32x4 __attribute__((ext_vector_type(4)));
typedef unsigned u32x2 __attribute__((ext_vector_type(2)));
typedef __bf16 bf16x2_t __attribute__((ext_vector_type(2)));

constexpr int T = 32768, D = 1024, SEQ = 8192, NBATCH = 4, INW = 3584, NMOD = 6 * 1024;
constexpr int NEXP = 16384;
constexpr float EPS = 1e-6f;
constexpr int NTHREADS = 512;
constexpr int LDS_BYTES = 131072 + 1024;
constexpr int LDS_CTL_OFF = 131072;

constexpr size_t MiB = 1024ull * 1024ull;
constexpr size_t WS_CTL = 0;
constexpr size_t WS_MOD = 16384;
constexpr size_t WS_BINP = 114688;
constexpr size_t WS_WIN = 131072;
constexpr size_t WS_WPC = WS_WIN + 7340032;
constexpr size_t WS_WOUT = WS_WPC + 2 * MiB;
constexpr size_t WS_WQ = WS_WOUT + 2 * MiB;
constexpr size_t WS_EU = 16 * MiB;
constexpr size_t WS_EV = 32 * MiB;
constexpr size_t WS_SU = 48 * MiB;
constexpr size_t WS_SV = 48 * MiB + 65536;
constexpr size_t WS_H = 80 * MiB;
constexpr size_t WS_PG = 144 * MiB;
constexpr size_t WS_SG = 208 * MiB;
constexpr size_t WS_MC = 336 * MiB;
constexpr size_t WS_IDX = 400 * MiB;
constexpr size_t WS_GATE = 416 * MiB;
constexpr size_t WS_HB = WS_PG;
constexpr size_t WS_HS = WS_PG + 32 * MiB;
constexpr size_t WS_WG8 = WS_WIN + 1536 * 1024;
constexpr size_t WS_WGS = WS_WIN + 4 * MiB + 1536 * 4;
constexpr size_t WS_X8 = 436 * MiB;
constexpr size_t WS_X8S = 468 * MiB;
constexpr size_t WS_X1B = WS_MC;
constexpr size_t WS_A2 = 432 * MiB;
constexpr size_t WS_BIAS2 = WS_A2 + 16384;
constexpr size_t WS_SSQ = WS_A2 + 65536;
constexpr size_t WS_CO = WS_SG;
constexpr size_t WS_IDP = WS_SG + 16 * MiB;
constexpr size_t WS_COP = WS_SG + 32 * MiB;
constexpr size_t WS_CS = WS_SG + 48 * MiB;
constexpr size_t WS_WP8 = WS_WIN;
constexpr size_t WS_WP8S = WS_WIN + 4 * MiB;
constexpr size_t WS_PMAX = WS_WIN + 5 * MiB;
constexpr size_t WS_END = 469 * MiB;
static_assert(WS_WQ + 4 * MiB <= WS_EU, "weight region overflow");

struct Params;
typedef const __attribute__((address_space(4))) Params* KP;
struct Params {
    const float* in[23];
    float* out;
    unsigned char* ws;
    int ph_lo, ph_hi;
};

typedef __bf16 bf16x2v_t __attribute__((ext_vector_type(2)));
__device__ __forceinline__ unsigned cvt_pk_bf16(float lo, float hi) { return __builtin_bit_cast(unsigned, __builtin_convertvector((f32x2){lo, hi}, bf16x2v_t)); }
__device__ __forceinline__ float bf_lo(unsigned u) { return __uint_as_float(u << 16); }
__device__ __forceinline__ float bf_hi(unsigned u) { return __uint_as_float(u & 0xffff0000u); }
__device__ __forceinline__ float fast_sigmoid(float x) { return __builtin_amdgcn_rcpf(1.0f + __builtin_amdgcn_exp2f(-1.44269504089f * x)); }
__device__ __forceinline__ int lane_id_asm() { int l; asm volatile("v_mbcnt_lo_u32_b32 %0, -1, 0\n\tv_mbcnt_hi_u32_b32 %0, -1, %0" : "=v"(l)); return l; }
__device__ __forceinline__ float wave_sum(float v) {
#pragma unroll
    for (int o = 32; o >= 1; o >>= 1) v += __shfl_xor(v, o);
    return v;
}
__device__ __forceinline__ int in_colmap(int n) {
    if (n < 512) return n;
    if (n < 1536) { const int t = (n - 512) >> 8, r = (n - 512) & 255; return r < 128 ? 512 + 128 * t + r : 1024 + 128 * t + (r - 128); }
    const int t = (n - 1536) >> 8, r = (n - 1536) & 255;
    return r < 128 ? 1536 + 128 * t + r : 2560 + 128 * t + (r - 128);
}

#define XB_TMO      128
#define XB_XCNT(j)  (256  + 64 * (j))
#define XB_XSUB(j)  (1280 + 64 * (j))
#define XB_XGEN(j)  (2304 + 64 * (j))
#define XB_TOP      3328
#define XB_TOPGEN   3392
#define XCD_BAR_WORDS 3456
#define XB_SPIN_CAP (1u << 22)
__device__ __forceinline__ unsigned xb_ld(unsigned* p)              { return __hip_atomic_load(p, __ATOMIC_RELAXED, __HIP_MEMORY_SCOPE_AGENT); }
__device__ __forceinline__ unsigned xb_add(unsigned* p, unsigned v) { return __hip_atomic_fetch_add(p, v, __ATOMIC_RELAXED, __HIP_MEMORY_SCOPE_AGENT); }
__device__ __forceinline__ unsigned xb_xcc_id() { return (unsigned)__builtin_amdgcn_s_getreg((3 << 11) | 20) & 0xFu; }
#define XB_SPIN(cond, bar) do { unsigned _sp = 0; while (cond) { __builtin_amdgcn_s_sleep(1); \
    if ((++_sp & 255u) == 0u) { if (xb_ld(&(bar)[XB_TMO])) break; if (_sp > XB_SPIN_CAP) { atomicAdd(&(bar)[XB_TMO], 1u); break; } } } } while (0)
struct XcdBarrier { unsigned* bar; unsigned x; volatile LAS unsigned* st; };
__device__ __forceinline__ XcdBarrier xcd_barrier_post(unsigned* bar, volatile LAS unsigned* st, int wave_s) {
    XcdBarrier b; b.bar = bar; b.x = xb_xcc_id(); b.st = st;
    if (wave_s == 0 && lane_id_asm() == 0) (void)xb_add(&bar[XB_XCNT(b.x)], 1u);
    return b;
}
__device__ __forceinline__ void xcd_barrier_complete(unsigned* bar, unsigned x, unsigned& nloc, unsigned& nx) {
    const unsigned G = gridDim.x * gridDim.y * gridDim.z;
    unsigned sum, cnt, mine, sp = 0u;
    for (;;) {
        sum = 0u; cnt = 0u; mine = 0u;
#pragma unroll
        for (unsigned j = 0; j < 16; ++j) { const unsigned c = xb_ld(&bar[XB_XCNT(j)]); sum += c; cnt += (c > 0u) ? 1u : 0u; mine = (j == x) ? c : mine; }
        if (sum == G) break;
        __builtin_amdgcn_s_sleep(1);
        if ((++sp & 255u) == 0u) { if (xb_ld(&bar[XB_TMO])) break; if (sp > XB_SPIN_CAP) { atomicAdd(&bar[XB_TMO], 1u); break; } }
    }
    nloc = mine > 0u ? mine : 1u; nx = cnt > 0u ? cnt : 1u;
}
__device__ __forceinline__ void xcd_barrier(const XcdBarrier& b, int wave_s) {
    asm volatile("s_waitcnt vmcnt(0)" ::: "memory");
    __syncthreads();
    if (wave_s == 0 && lane_id_asm() == 0) {
        unsigned* bar = b.bar;
        __builtin_amdgcn_s_waitcnt(0);
        unsigned nloc = b.st[0], nx = b.st[1];
        if (nloc == 0u) { xcd_barrier_complete(bar, b.x, nloc, nx); b.st[0] = nloc; b.st[1] = nx; }
        const unsigned old = xb_add(&bar[XB_XSUB(b.x)], 1u);
        const unsigned gen = old / nloc;
        if (old + 1u == (gen + 1u) * nloc) {
            __builtin_amdgcn_fence(__ATOMIC_RELEASE, "agent");
            asm volatile("s_waitcnt vmcnt(0)" ::: "memory");
            const unsigned og = xb_add(&bar[XB_TOP], 1u);
            const unsigned tg = og / nx;
            if (og + 1u == (tg + 1u) * nx) xb_add(&bar[XB_TOPGEN], 1u);
            else XB_SPIN(xb_ld(&bar[XB_TOPGEN]) == tg, bar);
            __builtin_amdgcn_fence(__ATOMIC_ACQUIRE, "agent");
            xb_add(&bar[XB_XGEN(b.x)], 1u);
            asm volatile("s_waitcnt vmcnt(0)" ::: "memory");
        } else {
            XB_SPIN(xb_ld(&bar[XB_XGEN(b.x)]) == gen, bar);
            __builtin_amdgcn_fence(__ATOMIC_ACQUIRE, "agent");
            asm volatile("s_waitcnt vmcnt(0)" ::: "memory");
        }
    }
    __syncthreads();
}

namespace pg8 {
constexpr int BM = 256, BK = 64, HALF = 128, HTB = HALF * BK * 2, STAGE_BYTES = 8 * HTB, NXCD = 8, WGM = 8;
__host__ __device__ __forceinline__ int lds_byte(int r, int c) { const int st = (r >> 4) * 2 + (c >> 5), rr = r & 15, cc = c & 31, ob = rr * 64 + cc * 2; return st * 1024 + (ob ^ (((ob >> 9) & 1) << 5)); }
__host__ __device__ __forceinline__ void stage_rc(int b, int& R, int& C) { const int st = b / 1024, sb = b % 1024, swz = sb ^ (((sb >> 9) & 1) << 5); R = (st >> 1) * 16 + swz / 64; C = (st & 1) * 32 + (swz % 64) / 2; }
__host__ __device__ __forceinline__ int perm32(int rho) { const int n = rho >> 4, i = rho & 15; return 8 * (i >> 2) + 4 * n + (i & 3); }
struct Unit { int pm, pn; };
struct Gemm { const bf16_t* A; const bf16_t* Bt; int M, N, K; };
struct StaticOrder {
    int nM, nN, nwg, G, c;
    __host__ __device__ void init(int M, int N, int G_, int c_) { nM = M / BM; nN = N / BM; nwg = nM * nN; G = G_; c = c_; }
    __host__ __device__ bool next(int i, Unit& u) const {
        const long L = (long)i * G + c; if (L >= nwg) return false;
        int wgid = (int)L; { const int q = nwg / NXCD, r = nwg % NXCD, xcd = wgid % NXCD, off = wgid / NXCD; wgid = (xcd < r ? xcd * (q + 1) : r * (q + 1) + (xcd - r) * q) + off; }
        const int nig = WGM * nN, gid = wgid / nig, fm = gid * WGM, gsz = (nM - fm) < WGM ? (nM - fm) : WGM;
        u.pm = fm + ((wgid % nig) % gsz); u.pn = (wgid % nig) / gsz; return true;
    }
};
typedef int i32x8_t __attribute__((ext_vector_type(8)));
typedef int i32x4_t __attribute__((ext_vector_type(4)));
template <bool FP8> struct FragT { typedef bf16x8 type[2]; };
template <> struct FragT<true> { typedef i32x8_t type; };
__device__ __forceinline__ void ldfrag(bf16x8 (&d)[2], const LAS unsigned char* p) { d[0] = *(const LAS bf16x8*)p; d[1] = *(const LAS bf16x8*)(p + 1024); }
__device__ __forceinline__ void ldfrag(i32x8_t& d, const LAS unsigned char* p) { const i32x4_t lo = *(const LAS i32x4_t*)p, hi = *(const LAS i32x4_t*)(p + 1024); d = (i32x8_t){lo[0], lo[1], lo[2], lo[3], hi[0], hi[1], hi[2], hi[3]}; }
__device__ __forceinline__ void mma1(f32x4& acc, const bf16x8 (&b)[2], const bf16x8 (&a)[2]) {
    acc = __builtin_amdgcn_mfma_f32_16x16x32_bf16(b[0], a[0], acc, 0, 0, 0); acc = __builtin_amdgcn_mfma_f32_16x16x32_bf16(b[1], a[1], acc, 0, 0, 0); }
__device__ __forceinline__ void mma1(f32x4& acc, const i32x8_t& b, const i32x8_t& a) {
    asm volatile("v_mfma_scale_f32_16x16x128_f8f6f4 %0, %1, %2, %0, %3, %3 op_sel_hi:[0,0,0]" : "+v"(acc) : "v"(b), "v"(a), "v"(0x7f7f7f7f)); }
template <class Epi>
__device__ __forceinline__ void gemm_phase(LAS unsigned char* lds, const Gemm g, const StaticOrder& S, const Epi& E, int wave_s) {
    const int lane = lane_id_asm(), wid = wave_s, tid = wid * 64 + lane, wr = wid >> 2, wc = wid & 3, fr = lane & 15, fq = lane >> 4;
    const int K = g.K, nt = K / BK;
    unsigned voffA[2], voffB[2];
#pragma unroll
    for (int i = 0; i < 2; ++i) { int R, C; stage_rc(tid * 16 + i * 8192, R, C); const int Rb = Epi::PERM ? ((R & ~31) + perm32(R & 31)) : R;
        voffA[i] = (unsigned)(R * K + C) * 2u; voffB[i] = (unsigned)(Rb * K + C) * 2u; }
    const size_t kstep = (size_t)(BK * 2);
    const size_t hstep = (size_t)HALF * K * 2;
    const size_t tstep = 2 * hstep;
    const unsigned ldsw = (unsigned)wid * 1024u;
    const int aoff = lds_byte(wr * 64 + fr, fq * 8), boff = lds_byte(wc * 32 + fr, fq * 8);
#define PG8_SA(b, h) (((b) * 2 + (h)) * HTB)
#define PG8_SB(b, h) ((4 + (b) * 2 + (h)) * HTB)
#define PG8_STAGE(bufoff, gbase, voff) do { _Pragma("unroll") for (int _i = 0; _i < 2; ++_i) \
        __builtin_amdgcn_global_load_lds((const unsigned*)((const char*)(gbase) + (voff)[_i]), (LAS unsigned*)(lds + (bufoff) + ldsw + _i * 8192), 16, 0, 0); } while (0)
#define PG8_LDA(dst, b, h) do { _Pragma("unroll") for (int m = 0; m < 4; ++m) ldfrag(dst[m], lds + PG8_SA(b, h) + aoff + m * 2048); } while (0)
#define PG8_LDB(dst, b, h) do { _Pragma("unroll") for (int n = 0; n < 2; ++n) ldfrag(dst[n], lds + PG8_SB(b, h) + boff + n * 2048); } while (0)
#define PG8_MMA(ai, bj, At, Bt) do { __builtin_amdgcn_s_setprio(1); _Pragma("unroll") for (int m = 0; m < 4; ++m) _Pragma("unroll") for (int n = 0; n < 2; ++n) mma1(acc[ai][bj][m][n], Bt[n], At[m]); __builtin_amdgcn_s_setprio(0); } while (0)
#define PG8_WAIT_V(n) asm volatile("s_waitcnt vmcnt(" #n ")" ::: "memory")
#define PG8_WAIT_L(n) asm volatile("s_waitcnt lgkmcnt(" #n ")" ::: "memory")
#define PG8_BAR __builtin_amdgcn_s_barrier()
#define PG8_SCHED __builtin_amdgcn_sched_barrier(0)
    Unit cur, nxt; int ui = 0;
    if (!S.next(0, cur)) return;
    f32x4 acc[2][2][4][2];
#pragma unroll
    for (int a = 0; a < 2; ++a)
#pragma unroll
        for (int b = 0; b < 2; ++b)
#pragma unroll
            for (int m = 0; m < 4; ++m)
#pragma unroll
                for (int n = 0; n < 2; ++n) acc[a][b][m][n] = (f32x4){0.f, 0.f, 0.f, 0.f};
    typename FragT<Epi::FP8>::type At[4], B0[2], B1[2];
    const char* cA = (const char*)g.A + (size_t)cur.pm * tstep; const char* cB = (const char*)g.Bt + (size_t)cur.pn * tstep;
    PG8_STAGE(PG8_SB(0, 0), cB, voffB); PG8_STAGE(PG8_SB(0, 1), cB + hstep, voffB); PG8_STAGE(PG8_SA(0, 0), cA, voffA); PG8_STAGE(PG8_SA(0, 1), cA + hstep, voffA);
    if (wr == 1) PG8_BAR;
    PG8_WAIT_V(2); PG8_BAR;
    PG8_STAGE(PG8_SB(1, 0), cB + kstep, voffB); PG8_STAGE(PG8_SA(1, 0), cA + kstep, voffA); PG8_STAGE(PG8_SB(1, 1), cB + hstep + kstep, voffB);
    PG8_WAIT_V(6); PG8_BAR;
    for (;;) {
        const bool has_next = S.next(ui + 1, nxt);
        const char* nA = has_next ? (const char*)g.A + (size_t)nxt.pm * tstep : cA; const char* nB = has_next ? (const char*)g.Bt + (size_t)nxt.pn * tstep : cB;
#pragma unroll 1
        for (int t = 0; t < nt; t += 2) {
            const bool last = (t == nt - 2);
            const char* a1 = cA + (size_t)(t + 1) * kstep;
            const char* a2 = last ? nA : cA + (size_t)(t + 2) * kstep; const char* b2 = last ? nB : cB + (size_t)(t + 2) * kstep;
            const char* a3 = a2 + kstep; const char* b3 = b2 + kstep;
            if constexpr (Epi::HAS_MID) { if (t == nt / 2) E.mid(acc, cur, wr, wc, fr, fq); }
            PG8_LDB(B0, 0, 0); PG8_LDB(B1, 0, 1); PG8_SCHED; PG8_LDA(At, 0, 0); PG8_STAGE(PG8_SA(1, 1), a1 + hstep, voffA);
            PG8_WAIT_V(8); PG8_WAIT_L(0); PG8_BAR; PG8_MMA(0, 0, At, B0); PG8_MMA(0, 1, At, B1); PG8_BAR; PG8_SCHED;
            PG8_LDA(At, 0, 1); PG8_STAGE(PG8_SB(0, 0), b2, voffB); PG8_STAGE(PG8_SB(0, 1), b2 + hstep, voffB); PG8_STAGE(PG8_SA(0, 0), a2, voffA);
            PG8_WAIT_V(8); PG8_WAIT_L(0); PG8_BAR; PG8_MMA(1, 0, At, B0); PG8_MMA(1, 1, At, B1); PG8_BAR; PG8_SCHED;
            PG8_LDB(B0, 1, 0); PG8_LDB(B1, 1, 1); PG8_SCHED; PG8_LDA(At, 1, 0); PG8_STAGE(PG8_SA(0, 1), a2 + hstep, voffA);
            PG8_WAIT_V(8); PG8_WAIT_L(0); PG8_BAR; PG8_MMA(0, 0, At, B0); PG8_MMA(0, 1, At, B1); PG8_BAR; PG8_SCHED;
            PG8_LDA(At, 1, 1); PG8_STAGE(PG8_SB(1, 0), b3, voffB); PG8_STAGE(PG8_SB(1, 1), b3 + hstep, voffB); PG8_STAGE(PG8_SA(1, 0), a3, voffA);
            PG8_WAIT_V(8); PG8_WAIT_L(0); PG8_BAR; PG8_MMA(1, 0, At, B0); PG8_MMA(1, 1, At, B1); PG8_BAR; PG8_SCHED;
        }
        if (wr == 0) PG8_BAR;
        E(acc, cur, wr, wc, fr, fq);
        if (!has_next) break;
#pragma unroll
        for (int a = 0; a < 2; ++a)
#pragma unroll
            for (int b = 0; b < 2; ++b)
#pragma unroll
                for (int m = 0; m < 4; ++m)
#pragma unroll
                    for (int n = 0; n < 2; ++n) acc[a][b][m][n] = (f32x4){0.f, 0.f, 0.f, 0.f};
        cur = nxt; cA = nA; cB = nB; ++ui;
        if (wr == 1) PG8_BAR;
    }
    PG8_WAIT_V(0);
    PG8_BAR;
#undef PG8_SA
#undef PG8_SB
#undef PG8_STAGE
#undef PG8_LDA
#undef PG8_LDB
#undef PG8_MMA
#undef PG8_WAIT_V
#undef PG8_WAIT_L
#undef PG8_BAR
#undef PG8_SCHED
}
}
typedef f32x4 AccT[2][2][4][2];

struct EpiProj {
    static constexpr bool PERM = true, HAS_MID = false, FP8 = true;
    const float* bias; bf16_t* PB; bf16_t* GB; const float* RS; const float* CS;
    __device__ __forceinline__ void operator()(const AccT& acc, const pg8::Unit& u, int wr, int wc, int fr, int fq) const {
        const int row0 = u.pm * 256 + wr * 64 + fr, lc0 = wc * 32 + 8 * fq;
        f32x4 bv[2][2], cv[2][2];
#pragma unroll
        for (int bj = 0; bj < 2; ++bj)
#pragma unroll
            for (int n = 0; n < 2; ++n) { bv[bj][n] = *(const f32x4*)(bias + u.pn * 256 + bj * 128 + lc0 + 4 * n); cv[bj][n] = *(const f32x4*)(CS + u.pn * 256 + bj * 128 + lc0 + 4 * n); }
        if (u.pn >= 2 && u.pn < 6) {
            const int t = u.pn - 2;
#pragma unroll
            for (int ai = 0; ai < 2; ++ai)
#pragma unroll
                for (int m = 0; m < 4; ++m) {
                    const int row = row0 + ai * 128 + m * 16; const float rs = RS[row];
                    float o[8];
#pragma unroll
                    for (int n = 0; n < 2; ++n) { const f32x4 v = acc[ai][0][m][n] * (cv[0][n] * rs) + bv[0][n], gt = acc[ai][1][m][n] * (cv[1][n] * rs) + bv[1][n];
#pragma unroll
                        for (int j = 0; j < 4; ++j) o[n * 4 + j] = v[j] * fast_sigmoid(gt[j]); }
                    u32x4 w; w.x = cvt_pk_bf16(o[0], o[1]); w.y = cvt_pk_bf16(o[2], o[3]); w.z = cvt_pk_bf16(o[4], o[5]); w.w = cvt_pk_bf16(o[6], o[7]);
                    *(u32x4*)(GB + (size_t)row * 512 + t * 128 + lc0) = w;
                }
        } else {
            const bool isp = true;
            bf16_t* base = PB; const int ldc = 512; const int colt = u.pn * 256;
#pragma unroll
            for (int ai = 0; ai < 2; ++ai)
#pragma unroll
                for (int m = 0; m < 4; ++m) {
                    const int row = row0 + ai * 128 + m * 16; const float rs = RS[row];
#pragma unroll
                    for (int bj = 0; bj < 2; ++bj) {
                        f32x4 v0 = acc[ai][bj][m][0] * (cv[bj][0] * rs) + bv[bj][0], v1 = acc[ai][bj][m][1] * (cv[bj][1] * rs) + bv[bj][1];
                        if (!isp) {
#pragma unroll
                            for (int j = 0; j < 4; ++j) { v0[j] = fast_sigmoid(v0[j]); v1[j] = fast_sigmoid(v1[j]); }
                        }
                        u32x4 w; w.x = cvt_pk_bf16(v0[0], v0[1]); w.y = cvt_pk_bf16(v0[2], v0[3]); w.z = cvt_pk_bf16(v1[0], v1[1]); w.w = cvt_pk_bf16(v1[2], v1[3]);
                        *(u32x4*)(base + (size_t)row * ldc + colt + bj * 128 + lc0) = w;
                    }
                }
        }
    }
};
struct EpiGate {
    static constexpr bool PERM = true, HAS_MID = false, FP8 = true;
    const float* bias; const float* RS; const float* CS; bf16_t* SG;
    __device__ __forceinline__ void operator()(const AccT& acc, const pg8::Unit& u, int wr, int wc, int fr, int fq) const {
        const int row0 = u.pm * 256 + wr * 64 + fr, lc0 = wc * 32 + 8 * fq, t = u.pn;
        float rs[2][4];
#pragma unroll
        for (int ai = 0; ai < 2; ++ai)
#pragma unroll
            for (int m = 0; m < 4; ++m) rs[ai][m] = RS[row0 + ai * 128 + m * 16];
#pragma unroll
        for (int n = 0; n < 2; ++n) {
            const f32x4 b1 = *(const f32x4*)(bias + 1536 + t * 256 + lc0 + 4 * n), b2 = *(const f32x4*)(bias + 1536 + t * 256 + 128 + lc0 + 4 * n);
            const f32x4 c1 = *(const f32x4*)(CS + t * 256 + lc0 + 4 * n), c2 = *(const f32x4*)(CS + t * 256 + 128 + lc0 + 4 * n);
#pragma unroll
            for (int ai = 0; ai < 2; ++ai)
#pragma unroll
                for (int m = 0; m < 4; ++m) {
                    const int row = row0 + ai * 128 + m * 16;
                    const f32x4 a1 = acc[ai][0][m][n] * (c1 * rs[ai][m]) + b1, a2 = acc[ai][1][m][n] * (c2 * rs[ai][m]) + b2;
                    float ra[4], s2[4];
#pragma unroll
                    for (int j = 0; j < 4; ++j) { const float e1 = __builtin_amdgcn_exp2f(-1.44269504089f * a1[j]), e2 = __builtin_amdgcn_exp2f(-1.44269504089f * a2[j]);
                        ra[j] = (1.0f + e2) * __builtin_amdgcn_rcpf(1.0f + e1); s2[j] = __builtin_amdgcn_rcpf(1.0f + e2); }
                    *(u32x2*)(SG + (size_t)row * 2048 + t * 128 + lc0 + 4 * n) = (u32x2){cvt_pk_bf16(ra[0], ra[1]), cvt_pk_bf16(ra[2], ra[3])};
                    *(u32x2*)(SG + (size_t)row * 2048 + 1024 + t * 128 + lc0 + 4 * n) = (u32x2){cvt_pk_bf16(s2[0], s2[1]), cvt_pk_bf16(s2[2], s2[3])};
                }
        }
    }
};
struct EpiIn {
    static constexpr bool PERM = true, HAS_MID = false, FP8 = true;
    EpiProj P; EpiGate G;
    __device__ __forceinline__ void operator()(const AccT& acc, const pg8::Unit& u, int wr, int wc, int fr, int fq) const {
        if (u.pn < 6) P(acc, u, wr, wc, fr, fq);
        else { pg8::Unit u2 = u; u2.pn = u.pn - 6; G(acc, u2, wr, wc, fr, fq); }
    }
};
struct EpiMerge {
    static constexpr bool PERM = true, HAS_MID = true, FP8 = false;
    const bf16_t* SG; bf16_t* MG;
    __device__ __forceinline__ void mid(AccT& acc, const pg8::Unit& u, int wr, int wc, int fr, int fq) const {
        const int row0 = u.pm * 256 + wr * 64 + fr, col0 = u.pn * 256 + wc * 32 + 8 * fq;
#pragma unroll
        for (int ai = 0; ai < 2; ++ai)
#pragma unroll
            for (int m = 0; m < 4; ++m) {
                const bf16_t* p = SG + (size_t)(row0 + ai * 128 + m * 16) * 2048 + col0;
                const u32x4 r0 = *(const u32x4*)p, r1 = *(const u32x4*)(p + 128);
#pragma unroll
                for (int bj = 0; bj < 2; ++bj) {
                    const unsigned a1[4] = {bj ? r1.x : r0.x, bj ? r1.y : r0.y, bj ? r1.z : r0.z, bj ? r1.w : r0.w};
#pragma unroll
                    for (int n = 0; n < 2; ++n)
#pragma unroll
                        for (int j = 0; j < 4; ++j) { const unsigned w1 = a1[n * 2 + (j >> 1)]; acc[ai][bj][m][n][j] *= (j & 1) ? bf_hi(w1) : bf_lo(w1); }
                }
                if (m & 1) asm volatile("" ::: "memory");
            }
    }
    __device__ __forceinline__ void operator()(const AccT& acc, const pg8::Unit& u, int wr, int wc, int fr, int fq) const {
        const int row0 = u.pm * 256 + wr * 64 + fr, col0 = u.pn * 256 + wc * 32 + 8 * fq;
#pragma unroll
        for (int ai = 0; ai < 2; ++ai)
#pragma unroll
            for (int m = 0; m < 4; ++m)
#pragma unroll
                for (int bj = 0; bj < 2; ++bj) {
                    const int row = row0 + ai * 128 + m * 16;
                    const u32x4 s2 = *(const u32x4*)(SG + (size_t)row * 2048 + 1024 + col0 + bj * 128);
                    const unsigned a2[4] = {s2.x, s2.y, s2.z, s2.w};
                    float o[8];
#pragma unroll
                    for (int n = 0; n < 2; ++n)
#pragma unroll
                        for (int j = 0; j < 4; ++j) {
                            const unsigned w2 = a2[n * 2 + (j >> 1)];
                            const float f2 = fmaxf((j & 1) ? bf_hi(w2) : bf_lo(w2), 1e-20f);
                            o[n * 4 + j] = acc[ai][bj][m][n][j] * f2;
                        }
                    u32x4 w; w.x = cvt_pk_bf16(o[0], o[1]); w.y = cvt_pk_bf16(o[2], o[3]); w.z = cvt_pk_bf16(o[4], o[5]); w.w = cvt_pk_bf16(o[6], o[7]);
                    *(u32x4*)(MG + (size_t)row * 1024 + col0 + bj * 128) = w;
                }
    }
};
struct EpiResid {
    static constexpr bool PERM = true, HAS_MID = false, FP8 = false;
    const float* X; const float* mod; bf16_t* X1B;
    const float* A2; bf16_t* XA; float* SSQ;
    __device__ __forceinline__ void operator()(const AccT& acc, const pg8::Unit& u, int wr, int wc, int fr, int fq) const {
        const int row0 = u.pm * 256 + wr * 64 + fr, col0 = u.pn * 256 + wc * 32 + 8 * fq;
        const int b = (u.pm * 256) / SEQ;
        const float* gt = mod + (size_t)b * NMOD; const float* a2 = A2 + b * 1024;
        f32x4 gv[2][2], av[2][2];
#pragma unroll
        for (int bj = 0; bj < 2; ++bj)
#pragma unroll
            for (int n = 0; n < 2; ++n) { gv[bj][n] = *(const f32x4*)(gt + col0 + bj * 128 + n * 4); av[bj][n] = *(const f32x4*)(a2 + col0 + bj * 128 + n * 4); }
#pragma unroll
        for (int ai = 0; ai < 2; ++ai)
#pragma unroll
            for (int m = 0; m < 4; ++m) {
                const int row = row0 + ai * 128 + m * 16;
                const size_t off = (size_t)row * 1024 + col0;
                float ss = 0.f;
#pragma unroll
                for (int bj = 0; bj < 2; ++bj) {
                    const f32x4 xv0 = *(const f32x4*)(X + off + bj * 128), xv1 = *(const f32x4*)(X + off + bj * 128 + 4);
                    const f32x4 x10 = xv0 + gv[bj][0] * acc[ai][bj][m][0], x11 = xv1 + gv[bj][1] * acc[ai][bj][m][1];
                    { u32x4 wx; wx.x = cvt_pk_bf16(x10[0], x10[1]); wx.y = cvt_pk_bf16(x10[2], x10[3]); wx.z = cvt_pk_bf16(x11[0], x11[1]); wx.w = cvt_pk_bf16(x11[2], x11[3]);
                      *(u32x4*)(X1B + off + bj * 128) = wx; }
                    ss += x10[0] * x10[0] + x10[1] * x10[1] + x10[2] * x10[2] + x10[3] * x10[3] + x11[0] * x11[0] + x11[1] * x11[1] + x11[2] * x11[2] + x11[3] * x11[3];
                    const f32x4 xa0 = x10 * av[bj][0], xa1 = x11 * av[bj][1];
                    u32x4 w; w.x = cvt_pk_bf16(xa0[0], xa0[1]); w.y = cvt_pk_bf16(xa0[2], xa0[3]); w.z = cvt_pk_bf16(xa1[0], xa1[1]); w.w = cvt_pk_bf16(xa1[2], xa1[3]);
                    *(u32x4*)(XA + off + bj * 128) = w;
                }
                ss += __shfl_xor(ss, 16); ss += __shfl_xor(ss, 32);
                if (fq == 0) __hip_atomic_fetch_add(SSQ + row, ss, __ATOMIC_RELAXED, __HIP_MEMORY_SCOPE_AGENT);
            }
    }
};
struct EpiBf16 {
    static constexpr bool PERM = true, HAS_MID = false, FP8 = false;
    bf16_t* O; int ldc;
    __device__ __forceinline__ void operator()(const AccT& acc, const pg8::Unit& u, int wr, int wc, int fr, int fq) const {
        const int row0 = u.pm * 256 + wr * 64 + fr, col0 = u.pn * 256 + wc * 32 + 8 * fq;
#pragma unroll
        for (int ai = 0; ai < 2; ++ai)
#pragma unroll
            for (int m = 0; m < 4; ++m)
#pragma unroll
                for (int bj = 0; bj < 2; ++bj) {
                    const f32x4 v0 = acc[ai][bj][m][0], v1 = acc[ai][bj][m][1];
                    u32x4 w; w.x = cvt_pk_bf16(v0[0], v0[1]); w.y = cvt_pk_bf16(v0[2], v0[3]); w.z = cvt_pk_bf16(v1[0], v1[1]); w.w = cvt_pk_bf16(v1[2], v1[3]);
                    *(u32x4*)(O + (size_t)(row0 + ai * 128 + m * 16) * ldc + col0 + bj * 128) = w;
                }
    }
};

struct EpiQ {
    static constexpr bool PERM = true, HAS_MID = false, FP8 = false;
    bf16_t* O; const float* SSQ; const float* BIAS2;
    __device__ __forceinline__ void operator()(const AccT& acc, const pg8::Unit& u, int wr, int wc, int fr, int fq) const {
        const int row0 = u.pm * 256 + wr * 64 + fr, col0 = u.pn * 256 + wc * 32 + 8 * fq;
        const float* bs = BIAS2 + ((u.pm * 256) / SEQ) * 2048 + col0;
        f32x4 bv[2][2];
#pragma unroll
        for (int bj = 0; bj < 2; ++bj)
#pragma unroll
            for (int n = 0; n < 2; ++n) bv[bj][n] = *(const f32x4*)(bs + bj * 128 + 4 * n);
#pragma unroll
        for (int ai = 0; ai < 2; ++ai)
#pragma unroll
            for (int m = 0; m < 4; ++m) {
                const int row = row0 + ai * 128 + m * 16;
                const float r = rsqrtf(SSQ[row] * (1.0f / D) + EPS);
#pragma unroll
                for (int bj = 0; bj < 2; ++bj) {
                    const f32x4 v0 = acc[ai][bj][m][0] * r + bv[bj][0], v1 = acc[ai][bj][m][1] * r + bv[bj][1];
                    u32x4 w; w.x = cvt_pk_bf16(v0[0], v0[1]); w.y = cvt_pk_bf16(v0[2], v0[3]); w.z = cvt_pk_bf16(v1[0], v1[1]); w.w = cvt_pk_bf16(v1[2], v1[3]);
                    { const int cw = wr * 2 + ai * 4 + (m >> 1), ks = 2 * wc + (fq >> 1), ln = (fq & 1) * 32 + (m & 1) * 16 + fr;
                      *(u32x4*)(O + ((size_t)(u.pm * 8 + u.pn) * 128 + (size_t)((cw * 2 + bj) * 8 + ks)) * 512 + ln * 8) = w; }
                }
            }
    }
};

#ifndef U_BITS
#define U_BITS 4
#endif
#ifndef V_BITS
#define V_BITS 4
#endif
template <int BITS> struct RowFmt;
template <> struct RowFmt<8> { typedef u32x4 row_t; static constexpr float QMAX = 224.0f; };
template <> struct RowFmt<4> { typedef u32x2 row_t; static constexpr float QMAX = 6.0f; };
template <int I> __device__ __forceinline__ f32x2 row_pair(const u32x4& r) {
    const unsigned w = (I >> 1) == 0 ? r.x : (I >> 1) == 1 ? r.y : (I >> 1) == 2 ? r.z : r.w;
    return __builtin_amdgcn_cvt_pk_f32_fp8((int)w, (I & 1) != 0);
}
template <int I> __device__ __forceinline__ f32x2 row_pair(const u32x2& r) {
    const unsigned w = (I >> 2) == 0 ? r.x : r.y;
    return __builtin_amdgcn_cvt_scalef32_pk_f32_fp4(w, 1.0f, I & 3);
}
template <class R> __device__ __forceinline__ float row_dot16(const R& r, const f32x2 (&hf)[8]) {
    f32x2 acc = {0.f, 0.f};
    acc = __builtin_elementwise_fma(row_pair<0>(r), hf[0], acc); acc = __builtin_elementwise_fma(row_pair<1>(r), hf[1], acc);
    acc = __builtin_elementwise_fma(row_pair<2>(r), hf[2], acc); acc = __builtin_elementwise_fma(row_pair<3>(r), hf[3], acc);
    acc = __builtin_elementwise_fma(row_pair<4>(r), hf[4], acc); acc = __builtin_elementwise_fma(row_pair<5>(r), hf[5], acc);
    acc = __builtin_elementwise_fma(row_pair<6>(r), hf[6], acc); acc = __builtin_elementwise_fma(row_pair<7>(r), hf[7], acc);
    return acc.x + acc.y;
}
template <class R> __device__ __forceinline__ void row_axpy16(const R& r, float c, f32x2 (&o)[8]) {
    const f32x2 c2 = {c, c};
    o[0] = __builtin_elementwise_fma(c2, row_pair<0>(r), o[0]); o[1] = __builtin_elementwise_fma(c2, row_pair<1>(r), o[1]);
    o[2] = __builtin_elementwise_fma(c2, row_pair<2>(r), o[2]); o[3] = __builtin_elementwise_fma(c2, row_pair<3>(r), o[3]);
    o[4] = __builtin_elementwise_fma(c2, row_pair<4>(r), o[4]); o[5] = __builtin_elementwise_fma(c2, row_pair<5>(r), o[5]);
    o[6] = __builtin_elementwise_fma(c2, row_pair<6>(r), o[6]); o[7] = __builtin_elementwise_fma(c2, row_pair<7>(r), o[7]);
}
template <int BITS> __device__ __forceinline__ void quant_row(const f32x4 (&v)[4], float qs, unsigned char* dst_row, int lane) {
    if constexpr (BITS == 8) {
#pragma unroll
        for (int q = 0; q < 4; ++q) { int p = 0; p = __builtin_amdgcn_cvt_pk_fp8_f32(v[q][0] * qs, v[q][1] * qs, p, false); p = __builtin_amdgcn_cvt_pk_fp8_f32(v[q][2] * qs, v[q][3] * qs, p, true);
            ((unsigned*)dst_row)[lane + 64 * q] = (unsigned)p; }
    } else {
#pragma unroll
        for (int q = 0; q < 4; ++q) { unsigned p = 0; p = __builtin_amdgcn_cvt_scalef32_pk_fp4_f32(p, v[q][0] * qs, v[q][1] * qs, 1.0f, 0); p = __builtin_amdgcn_cvt_scalef32_pk_fp4_f32(p, v[q][2] * qs, v[q][3] * qs, 1.0f, 1);
            ((unsigned short*)dst_row)[lane + 64 * q] = (unsigned short)(p & 0xffffu); }
    }
}
__device__ __forceinline__ void xpose_tile(const float* src, int ldsrc, int c0, int k0, bf16_t* dst, int lddst, int n0, int kd0, LAS float* tile, int tid) {
    { const int r = tid >> 4, c4 = tid & 15;
#pragma unroll
      for (int ps = 0; ps < 2; ++ps) { const f32x4 v = *(const f32x4*)(src + (size_t)(k0 + r + 32 * ps) * ldsrc + c0 + c4 * 4);
#pragma unroll
          for (int j = 0; j < 4; ++j) tile[(r + 32 * ps) * 65 + c4 * 4 + j] = v[j]; } }
    __syncthreads();
    { const int n = tid >> 3, kg = tid & 7; float f[8];
#pragma unroll
      for (int i = 0; i < 8; ++i) f[i] = tile[(kg * 8 + i) * 65 + n];
      u32x4 w; w.x = cvt_pk_bf16(f[0], f[1]); w.y = cvt_pk_bf16(f[2], f[3]); w.z = cvt_pk_bf16(f[4], f[5]); w.w = cvt_pk_bf16(f[6], f[7]);
      *(u32x4*)(dst + (size_t)(n0 + n) * lddst + kd0 + k0 + kg * 8) = w; }
    __syncthreads();
}
__device__ __forceinline__ void phase_prep(KP kp, LAS unsigned char* lds, int wave_s) {
    const int tid = wave_s * 64 + lane_id_asm(), G = gridDim.x;
    unsigned char* ws = kp->ws;
    const float* cvec = kp->in[1]; const float* ada_w = kp->in[2]; const float* ada_b = kp->in[3];
    float* mod = (float*)(ws + WS_MOD);
    LAS float* cact = (LAS float*)lds;
    LAS float* red = (LAS float*)(lds + 16384);
    LAS float* tile = (LAS float*)(lds + 49152);
    LAS float* pw = (LAS float*)(lds + 49152);
    if ((int)blockIdx.x < 192) {
        for (int i = tid; i < 4096; i += NTHREADS) { const float v = cvec[i]; cact[i] = v * fast_sigmoid(v); }
    }
    if (blockIdx.x == G - 1) {
        float* binp = (float*)(ws + WS_BINP); const float* b_in = kp->in[6];
        for (int i = tid; i < INW; i += NTHREADS) binp[i] = b_in[in_colmap(i)];
    }
    __syncthreads();
    constexpr int N_MOD = 192, N_WIN = 384, N_CO = 128, N_WO = 256, N_WQ = 512, N_WP = 128, N_WG = 512;
    constexpr int I1 = N_MOD, I2 = I1 + N_WIN, I3 = I2 + N_CO, I4 = I3 + N_WO, I5 = I4 + N_WQ, I6 = I5 + N_WP, I7 = I6 + N_WG;
    for (int it = blockIdx.x; it < I7; it += G) {
        if (it < I1) {
            const int n0 = it * 32, c4 = tid & 7, ks = tid >> 3;
            float a[4][4];
#pragma unroll
            for (int b = 0; b < 4; ++b)
#pragma unroll
                for (int j = 0; j < 4; ++j) a[b][j] = 0.f;
#pragma unroll 4
            for (int kk = 0; kk < 16; ++kk) { const int k = ks * 16 + kk; const f32x4 w = *(const f32x4*)(ada_w + (size_t)k * NMOD + n0 + c4 * 4);
#pragma unroll
                for (int b = 0; b < 4; ++b) { const float cv = cact[b * 1024 + k];
#pragma unroll
                    for (int j = 0; j < 4; ++j) a[b][j] += cv * w[j]; } }
#pragma unroll
            for (int b = 0; b < 4; ++b)
#pragma unroll
                for (int j = 0; j < 4; ++j) red[(ks * 4 + b) * 32 + c4 * 4 + j] = a[b][j];
            __syncthreads();
            if (tid < 128) { const int b = tid >> 5, col = tid & 31; float s = 0.f;
                for (int q = 0; q < 64; ++q) s += red[(q * 4 + b) * 32 + col];
                mod[b * NMOD + n0 + col] = s + ada_b[n0 + col]; }
            __syncthreads();
        } else if (it >= I6 || (it >= I1 && it < I2)) {
            const bool isp = it < I2;
            const int i = isp ? it - I1 : it - I6, kt = i & 15, n0 = (i >> 4) * 64 + (isp ? 0 : 1536), c0 = in_colmap(n0);
            const float* win = kp->in[5];
            LAS float* cmx = (LAS float*)(lds + 49152 + 17408);
            { const int r = tid >> 4, c4 = tid & 15;
              const f32x4 v0 = *(const f32x4*)(win + (size_t)(kt * 64 + r) * INW + c0 + c4 * 4), v1 = *(const f32x4*)(win + (size_t)(kt * 64 + r + 32) * INW + c0 + c4 * 4);
#pragma unroll
              for (int j = 0; j < 4; ++j) cmx[r * 64 + c4 * 4 + j] = fmaxf(fabsf(v0[j]), fabsf(v1[j])); }
            __syncthreads();
            if (tid < 64) { float mm = 0.f; for (int q = 0; q < 32; ++q) mm = fmaxf(mm, cmx[q * 64 + tid]); ((float*)(ws + WS_PMAX))[kt * 3584 + n0 + tid] = mm; }
            __syncthreads();
        } else if (it < I3) {
            const int i = it - I2, kt = i & 7, ntl = i >> 3;
            xpose_tile(kp->in[14], 1024, ntl * 64, kt * 64, (bf16_t*)(ws + WS_WPC), 1024, ntl * 64, 512, tile, tid);
        } else if (it < I4) {
            const int i = it - I3, kt = i & 15, ntl = i >> 4;
            xpose_tile(kp->in[15], 1024, ntl * 64, kt * 64, (bf16_t*)(ws + WS_WOUT), 1024, ntl * 64, 0, tile, tid);
        } else if (it < I5) {
            const int i = it - I4, kt = i & 15, ntl = i >> 4;
            xpose_tile(kp->in[17], 2048, ntl * 64, kt * 64, (bf16_t*)(ws + WS_WQ), 1024, ntl * 64, 0, tile, tid);
        } else {
            const int i = it - I5, nb = i & 1, cb = (i >> 1) & 15, g = i >> 5;
            const float* pool_w = kp->in[7]; const float* pool_scale = kp->in[8]; const float* pool_up = kp->in[9];
            for (int e = tid; e < 1024; e += NTHREADS) { const int ci = e >> 7, d = e & 127; pw[e] = pool_w[((size_t)g * 128 + cb * 8 + ci) * 128 + d] * pool_scale[g * 128 + d]; }
            __syncthreads();
            const int n = nb * 512 + tid; float a[8];
#pragma unroll
            for (int q = 0; q < 8; ++q) a[q] = 0.f;
#pragma unroll 4
            for (int d = 0; d < 128; ++d) { const float uv = pool_up[(size_t)(g * 128 + d) * 1024 + n];
#pragma unroll
                for (int q = 0; q < 8; ++q) a[q] += pw[q * 128 + d] * uv; }
            u32x4 w; w.x = cvt_pk_bf16(a[0], a[1]); w.y = cvt_pk_bf16(a[2], a[3]); w.z = cvt_pk_bf16(a[4], a[5]); w.w = cvt_pk_bf16(a[6], a[7]);
            *(u32x4*)((bf16_t*)(ws + WS_WPC) + (size_t)n * 1024 + g * 128 + cb * 8) = w;
            __syncthreads();
        }
    }
    {
        const int lane = tid & 63, wave = tid >> 6;
        f32x4 vn[4];
        { const int r0 = blockIdx.x * 8 + wave;
          if (r0 < 2 * NEXP) { const int tb0 = r0 >= NEXP ? 1 : 0; const f32x4* src = (const f32x4*)((tb0 ? kp->in[21] : kp->in[20]) + (size_t)(r0 - tb0 * NEXP) * D);
#pragma unroll
              for (int q = 0; q < 4; ++q) vn[q] = src[lane + 64 * q]; } }
        for (int r = blockIdx.x * 8 + wave; r < 2 * NEXP; r += G * 8) {
            const int tb = r >= NEXP ? 1 : 0, e = r - tb * NEXP;
            f32x4 v[4]; float m = 0.f;
#pragma unroll
            for (int q = 0; q < 4; ++q) v[q] = vn[q];
            { const int rn = r + G * 8;
              if (rn < 2 * NEXP) { const int tbn = rn >= NEXP ? 1 : 0; const f32x4* src = (const f32x4*)((tbn ? kp->in[21] : kp->in[20]) + (size_t)(rn - tbn * NEXP) * D);
#pragma unroll
                  for (int q = 0; q < 4; ++q) vn[q] = src[lane + 64 * q]; } }
#pragma unroll
            for (int q = 0; q < 4; ++q) m = fmaxf(m, fmaxf(fmaxf(fabsf(v[q][0]), fabsf(v[q][1])), fmaxf(fabsf(v[q][2]), fabsf(v[q][3]))));
#pragma unroll
            for (int o = 32; o >= 1; o >>= 1) m = fmaxf(m, __shfl_xor(m, o));
            const float qmax = tb ? RowFmt<V_BITS>::QMAX : RowFmt<U_BITS>::QMAX;
            const float qs = m > 0.f ? qmax / m : 0.f;
            if (tb) quant_row<V_BITS>(v, qs, ws + WS_EV + (size_t)e * (V_BITS * 128), lane);
            else quant_row<U_BITS>(v, qs, ws + WS_EU + (size_t)e * (U_BITS * 128), lane);
            if (lane == 0) ((float*)(ws + (tb ? WS_SV : WS_SU)))[e] = m / qmax;
        }
    }
}

__device__ __forceinline__ void phase_w8(KP kp, LAS unsigned char* lds, int wave_s) {
    const int tid = wave_s * 64 + lane_id_asm();
    unsigned char* ws = kp->ws;
    const float* win = kp->in[5]; const float* pmax = (const float*)(ws + WS_PMAX);
    LAS float* tile = (LAS float*)(lds + 49152);
    LAS float* csc = (LAS float*)(lds + 49152 + 17408);
    for (int it = blockIdx.x; it < 56 * 16; it += gridDim.x) {
        const int kt = it & 15, n0 = (it >> 4) * 64, c0 = in_colmap(n0);
        if (tid < 64) { float mm = 0.f;
#pragma unroll
            for (int q = 0; q < 16; ++q) mm = fmaxf(mm, pmax[q * 3584 + n0 + tid]);
            csc[tid] = mm > 0.f ? 224.0f / mm : 0.f; if (kt == 0) ((float*)(ws + WS_WP8S))[n0 + tid] = mm * (1.0f / 224.0f); }
        { const int r = tid >> 4, c4 = tid & 15;
#pragma unroll
          for (int ps = 0; ps < 2; ++ps) { const f32x4 v = *(const f32x4*)(win + (size_t)(kt * 64 + r + 32 * ps) * INW + c0 + c4 * 4);
#pragma unroll
              for (int j = 0; j < 4; ++j) tile[(r + 32 * ps) * 65 + c4 * 4 + j] = v[j]; } }
        __syncthreads();
        { const int n = tid >> 3, kg = tid & 7; const float qs = csc[n]; float f[8];
#pragma unroll
          for (int i = 0; i < 8; ++i) f[i] = tile[(kg * 8 + i) * 65 + n] * qs;
          int p0 = 0, p1 = 0;
          p0 = __builtin_amdgcn_cvt_pk_fp8_f32(f[0], f[1], p0, false); p0 = __builtin_amdgcn_cvt_pk_fp8_f32(f[2], f[3], p0, true);
          p1 = __builtin_amdgcn_cvt_pk_fp8_f32(f[4], f[5], p1, false); p1 = __builtin_amdgcn_cvt_pk_fp8_f32(f[6], f[7], p1, true);
          *(u32x2*)(ws + WS_WP8 + (size_t)(n0 + n) * 1024 + kt * 64 + kg * 8) = (u32x2){(unsigned)p0, (unsigned)p1}; }
        __syncthreads();
    }
}

template <bool WITH_FP8>
__device__ __forceinline__ void phase_norm_ada(const float* src, const float* gain, const float* mod, int shift_off, int scale_off, bf16_t* dst, unsigned char* dst8, float* dscale, int wave_s) {
    const int lane = lane_id_asm(), wave = wave_s;
    f32x4 vn[4];
    { const int row0 = blockIdx.x * 8 + wave;
      if (row0 < T) { const f32x4* xr = (const f32x4*)(src + (size_t)row0 * D);
#pragma unroll
          for (int j = 0; j < 4; ++j) vn[j] = xr[lane + 64 * j]; } }
    for (int row = blockIdx.x * 8 + wave; row < T; row += gridDim.x * 8) {
        const int b = row / SEQ;
        f32x4 v[4]; float ss = 0.f;
#pragma unroll
        for (int j = 0; j < 4; ++j) v[j] = vn[j];
        { const int rn = row + gridDim.x * 8;
          if (rn < T) { const f32x4* xr = (const f32x4*)(src + (size_t)rn * D);
#pragma unroll
              for (int j = 0; j < 4; ++j) vn[j] = xr[lane + 64 * j]; } }
#pragma unroll
        for (int j = 0; j < 4; ++j) ss += v[j][0] * v[j][0] + v[j][1] * v[j][1] + v[j][2] * v[j][2] + v[j][3] * v[j][3];
        ss = wave_sum(ss);
        const float r = rsqrtf(ss * (1.0f / D) + EPS);
        float am = 0.f;
#pragma unroll
        for (int j = 0; j < 4; ++j) {
            const int col = 4 * lane + 256 * j;
            const f32x4 g = *(const f32x4*)(gain + col), sc = *(const f32x4*)(mod + (size_t)b * NMOD + scale_off + col), sh = *(const f32x4*)(mod + (size_t)b * NMOD + shift_off + col);
            const f32x4 h = v[j] * r * g * (sc + 1.0f) + sh;
            u32x2 w; w.x = cvt_pk_bf16(h[0], h[1]); w.y = cvt_pk_bf16(h[2], h[3]);
            if (dst) *(u32x2*)(dst + (size_t)row * D + col) = w;
            if (WITH_FP8) { v[j] = h; am = fmaxf(am, fmaxf(fmaxf(fabsf(h[0]), fabsf(h[1])), fmaxf(fabsf(h[2]), fabsf(h[3])))); }
        }
        if (WITH_FP8) {
#pragma unroll
            for (int o = 32; o >= 1; o >>= 1) am = fmaxf(am, __shfl_xor(am, o));
            const float qs = am > 0.f ? 224.0f / am : 0.f;
#pragma unroll
            for (int j = 0; j < 4; ++j) { int p = 0; p = __builtin_amdgcn_cvt_pk_fp8_f32(v[j][0] * qs, v[j][1] * qs, p, false); p = __builtin_amdgcn_cvt_pk_fp8_f32(v[j][2] * qs, v[j][3] * qs, p, true);
                *(unsigned*)(dst8 + (size_t)row * D + 4 * lane + 256 * j) = (unsigned)p; }
            if (lane == 0) dscale[row] = am * (1.0f / 224.0f);
        }
    }
}

__device__ __forceinline__ void phase_aux(KP kp, LAS unsigned char* lds, int wave_s) {
    const int tid = wave_s * 64 + lane_id_asm();
    unsigned char* ws = kp->ws;
    const float* mod = (const float*)(ws + WS_MOD);
    const int bid = blockIdx.x;
    if (bid == 0) {
        float* A2 = (float*)(ws + WS_A2); const float* g2 = kp->in[16];
        for (int i = tid; i < 4096; i += NTHREADS) { const int b = i >> 10, k = i & 1023; A2[i] = g2[k] * (1.0f + mod[(size_t)b * NMOD + 4 * 1024 + k]); }
    } else if (bid <= 8) {
        float* SSQ = (float*)(ws + WS_SSQ) + (bid - 1) * 4096;
        for (int i = tid; i < 4096; i += NTHREADS) SSQ[i] = 0.f;
    } else if (bid <= 24) {
        const int n0 = (bid - 9) * 128, c4 = tid & 31, ks = tid >> 5;
        const float* wq = kp->in[17];
        LAS float* red = (LAS float*)lds;
        float a[4][4];
#pragma unroll
        for (int b = 0; b < 4; ++b)
#pragma unroll
            for (int j = 0; j < 4; ++j) a[b][j] = 0.f;
#pragma unroll 4
        for (int kk = 0; kk < 64; ++kk) { const int k = ks * 64 + kk; const f32x4 w = *(const f32x4*)(wq + (size_t)k * 2048 + n0 + c4 * 4);
#pragma unroll
            for (int b = 0; b < 4; ++b) { const float sv = mod[(size_t)b * NMOD + 3 * 1024 + k];
#pragma unroll
                for (int j = 0; j < 4; ++j) a[b][j] += sv * w[j]; } }
#pragma unroll
        for (int b = 0; b < 4; ++b)
#pragma unroll
            for (int j = 0; j < 4; ++j) red[(ks * 4 + b) * 128 + c4 * 4 + j] = a[b][j];
        __syncthreads();
        { const int b = tid >> 7, col = tid & 127; float sm = 0.f;
          for (int q = 0; q < 16; ++q) sm += red[(q * 4 + b) * 128 + col];
          ((float*)(ws + WS_BIAS2))[b * 2048 + n0 + col] = sm; }
        __syncthreads();
    }
}

template <int W>
__device__ __forceinline__ void pool_window(const float (&x0)[31], const float (&x1)[31], int spos0, bf16_t* dstp) {
#pragma unroll
    for (int i = 0; i < 16; ++i) {
        float s0 = 0.f, s1 = 0.f;
#pragma unroll
        for (int d = 0; d < W; ++d) { s0 += x0[i + 15 - d]; s1 += x1[i + 15 - d]; }
        const int sp = spos0 + i; const float inv = 1.0f / (float)(sp + 1 < W ? sp + 1 : W);
        const float m0 = s0 * inv - x0[i + 15], m1 = s1 * inv - x1[i + 15];
        *(unsigned*)(dstp + (size_t)i * 1024) = cvt_pk_bf16(m0, m1);
    }
}
__device__ __forceinline__ void phase_branches(KP kp, LAS unsigned char* lds, int wave_s) {
    const int lane = lane_id_asm(), wave = wave_s, tid = wave * 64 + lane;
    unsigned char* ws = kp->ws;
    const bf16_t* PB = (const bf16_t*)(ws + WS_PG); const bf16_t* GB = PB + (size_t)T * 512;
    bf16_t* MC = (bf16_t*)(ws + WS_MC);
    const float* dwk = kp->in[10]; const float* dwb = kp->in[11]; const float* lng = kp->in[12]; const float* lnb = kp->in[13];
    LAS unsigned* rows = (LAS unsigned*)lds;
    LAS float* ybuf = (LAS float*)(lds + 63488);
    const int cp = tid & 255, th = tid >> 8;
    float w0[31], w1[31];
#pragma unroll
    for (int j = 0; j < 31; ++j) { const f32x2 w = *(const f32x2*)(dwk + j * 512 + 2 * cp); w0[j] = w.x; w1[j] = w.y; }
    const f32x2 cb = *(const f32x2*)(dwb + 2 * cp);
    u32x4 gpre[8], ppre[6];
#define P3_LOAD_G(t0_, s0_) do { _Pragma("unroll") for (int i_ = 0; i_ < 8; ++i_) { const int e = tid + i_ * NTHREADS; const int r = e >> 6, c = e & 63; u32x4 v = {0u, 0u, 0u, 0u}; \
            if (e < 62 * 64 && (s0_) + r - 30 >= 0) v = *(const u32x4*)(GB + (size_t)((t0_) + r - 30) * 512 + c * 8); gpre[i_] = v; } } while (0)
#define P3_LOAD_P(t0_, s0_) do { _Pragma("unroll") for (int i_ = 0; i_ < 6; ++i_) { const int e = tid + i_ * NTHREADS; const int r = e >> 6, c = e & 63; u32x4 v = {0u, 0u, 0u, 0u}; \
            if (e < 47 * 64 && (s0_) + r - 15 >= 0) v = *(const u32x4*)(PB + (size_t)((t0_) + r - 15) * 512 + c * 8); ppre[i_] = v; } } while (0)
    if ((int)blockIdx.x < T / 32) { const int t0 = blockIdx.x * 32; P3_LOAD_G(t0, t0 % SEQ); }
    for (int tl = blockIdx.x; tl < T / 32; tl += gridDim.x) {
        const int t0 = tl * 32, s0 = t0 % SEQ;
#pragma unroll
        for (int i_ = 0; i_ < 8; ++i_) { const int e = tid + i_ * NTHREADS; if (e < 62 * 64) *(LAS u32x4*)(rows + (e >> 6) * 256 + (e & 63) * 4) = gpre[i_]; }
        __syncthreads();
        P3_LOAD_P(t0, s0);
        {
            float a0[16], a1[16];
#pragma unroll
            for (int i = 0; i < 16; ++i) { a0[i] = cb.x; a1[i] = cb.y; }
#pragma unroll
            for (int r = 0; r < 46; ++r) {
                const unsigned uu = rows[(th * 16 + r) * 256 + cp]; const float x0 = bf_lo(uu), x1 = bf_hi(uu);
#pragma unroll
                for (int i = 0; i < 16; ++i) { const int j = r - i; if (j >= 0 && j <= 30) { a0[i] += x0 * w0[j]; a1[i] += x1 * w1[j]; } }
            }
#pragma unroll
            for (int i = 0; i < 16; ++i) *(LAS f32x2*)(ybuf + (th * 16 + i) * 512 + 2 * cp) = (f32x2){a0[i], a1[i]};
        }
        __syncthreads();
        {
            const f32x4 g0 = *(const f32x4*)(lng + lane * 8), g1 = *(const f32x4*)(lng + lane * 8 + 4), b0 = *(const f32x4*)(lnb + lane * 8), b1 = *(const f32x4*)(lnb + lane * 8 + 4);
#pragma unroll
            for (int q = 0; q < 4; ++q) {
                const int tk = wave * 4 + q;
                const f32x4 y0 = *(const LAS f32x4*)(ybuf + tk * 512 + lane * 8), y1 = *(const LAS f32x4*)(ybuf + tk * 512 + lane * 8 + 4);
                float s = (y0[0] + y0[1]) + (y0[2] + y0[3]) + (y1[0] + y1[1]) + (y1[2] + y1[3]);
                s = wave_sum(s); const float mu = s * (1.0f / 512.0f);
                const f32x4 d0 = y0 - mu, d1 = y1 - mu;
                float qv = d0[0] * d0[0] + d0[1] * d0[1] + d0[2] * d0[2] + d0[3] * d0[3] + d1[0] * d1[0] + d1[1] * d1[1] + d1[2] * d1[2] + d1[3] * d1[3];
                qv = wave_sum(qv); const float rs = rsqrtf(qv * (1.0f / 512.0f) + EPS);
                f32x4 o0 = d0 * rs * g0 + b0, o1 = d1 * rs * g1 + b1;
#pragma unroll
                for (int j = 0; j < 4; ++j) { o0[j] = o0[j] * fast_sigmoid(o0[j]); o1[j] = o1[j] * fast_sigmoid(o1[j]); }
                u32x4 w; w.x = cvt_pk_bf16(o0[0], o0[1]); w.y = cvt_pk_bf16(o0[2], o0[3]); w.z = cvt_pk_bf16(o1[0], o1[1]); w.w = cvt_pk_bf16(o1[2], o1[3]);
                *(u32x4*)(MC + (size_t)(t0 + tk) * 1024 + 512 + lane * 8) = w;
            }
        }
        __syncthreads();
#pragma unroll
        for (int i_ = 0; i_ < 6; ++i_) { const int e = tid + i_ * NTHREADS; if (e < 47 * 64) *(LAS u32x4*)(rows + (e >> 6) * 256 + (e & 63) * 4) = ppre[i_]; }
        __syncthreads();
        { const int tn = tl + gridDim.x; if (tn < T / 32) { const int t0n = tn * 32; P3_LOAD_G(t0n, t0n % SEQ); } }
        {
            float x0[31], x1[31];
#pragma unroll
            for (int r = 0; r < 31; ++r) { const unsigned uu = rows[(th * 16 + r) * 256 + cp]; x0[r] = bf_lo(uu); x1[r] = bf_hi(uu); }
            bf16_t* dstp = MC + (size_t)(t0 + th * 16) * 1024 + 2 * cp;
            const int grp = __builtin_amdgcn_readfirstlane(cp >> 6), sp0 = s0 + th * 16;
            if (grp == 0) pool_window<2>(x0, x1, sp0, dstp);
            else if (grp == 1) pool_window<4>(x0, x1, sp0, dstp);
            else if (grp == 2) pool_window<8>(x0, x1, sp0, dstp);
            else pool_window<16>(x0, x1, sp0, dstp);
        }
        __syncthreads();
    }
}

#define CE_DESC(a, b) do { const int _hi = max(a, b), _lo = min(a, b); a = _hi; b = _lo; } while (0)
#define CE_ASC(a, b)  do { const int _hi = max(a, b), _lo = min(a, b); a = _lo; b = _hi; } while (0)
__device__ __forceinline__ void bitonic_sort16_desc(int (&v)[16]) {
#pragma unroll
    for (int k = 2; k <= 16; k <<= 1)
#pragma unroll
        for (int j = k >> 1; j > 0; j >>= 1)
#pragma unroll
            for (int i = 0; i < 16; ++i) { const int l = i ^ j; if (l > i) { if ((i & k) == 0) CE_DESC(v[i], v[l]); else CE_ASC(v[i], v[l]); } }
}
__device__ __forceinline__ void bitonic_merge16_desc(int (&v)[16]) {
#pragma unroll
    for (int j = 8; j > 0; j >>= 1)
#pragma unroll
        for (int i = 0; i < 16; ++i) { const int l = i ^ j; if (l > i) CE_DESC(v[i], v[l]); }
}
__device__ __forceinline__ void top16_merge(int (&a)[16], const int (&b)[16]) {
#pragma unroll
    for (int i = 0; i < 16; ++i) a[i] = max(a[i], b[15 - i]);
    bitonic_merge16_desc(a);
}
#define CEF_DESC(a, b) do { const float _hi = fmaxf(a, b), _lo = fminf(a, b); a = _hi; b = _lo; } while (0)
#define CEF_ASC(a, b)  do { const float _hi = fmaxf(a, b), _lo = fminf(a, b); a = _lo; b = _hi; } while (0)
__device__ __forceinline__ void fbitonic_sort16_desc(float (&v)[16]) {
#pragma unroll
    for (int k = 2; k <= 16; k <<= 1)
#pragma unroll
        for (int j = k >> 1; j > 0; j >>= 1)
#pragma unroll
            for (int i = 0; i < 16; ++i) { const int l = i ^ j; if (l > i) { if ((i & k) == 0) CEF_DESC(v[i], v[l]); else CEF_ASC(v[i], v[l]); } }
}
__device__ __forceinline__ void fsort16_desc(float (&v)[16]) {
    CEF_DESC(v[0], v[13]); CEF_DESC(v[1], v[12]); CEF_DESC(v[2], v[15]); CEF_DESC(v[3], v[14]); CEF_DESC(v[4], v[8]); CEF_DESC(v[5], v[6]); CEF_DESC(v[7], v[11]); CEF_DESC(v[9], v[10]); CEF_DESC(v[0], v[5]); CEF_DESC(v[1], v[7]); CEF_DESC(v[2], v[9]); CEF_DESC(v[3], v[4]); CEF_DESC(v[6], v[13]); CEF_DESC(v[8], v[14]); CEF_DESC(v[10], v[15]); CEF_DESC(v[11], v[12]); CEF_DESC(v[0], v[1]); CEF_DESC(v[2], v[3]); CEF_DESC(v[4], v[5]); CEF_DESC(v[6], v[8]); CEF_DESC(v[7], v[9]); CEF_DESC(v[10], v[11]); CEF_DESC(v[12], v[13]); CEF_DESC(v[14], v[15]); CEF_DESC(v[0], v[2]); CEF_DESC(v[1], v[3]); CEF_DESC(v[4], v[10]); CEF_DESC(v[5], v[11]); CEF_DESC(v[6], v[7]); CEF_DESC(v[8], v[9]); CEF_DESC(v[12], v[14]); CEF_DESC(v[13], v[15]); CEF_DESC(v[1], v[2]); CEF_DESC(v[3], v[12]); CEF_DESC(v[4], v[6]); CEF_DESC(v[5], v[7]); CEF_DESC(v[8], v[10]); CEF_DESC(v[9], v[11]); CEF_DESC(v[13], v[14]); CEF_DESC(v[1], v[4]); CEF_DESC(v[2], v[6]); CEF_DESC(v[5], v[8]); CEF_DESC(v[7], v[10]); CEF_DESC(v[9], v[13]); CEF_DESC(v[11], v[14]); CEF_DESC(v[2], v[4]); CEF_DESC(v[3], v[6]); CEF_DESC(v[9], v[12]); CEF_DESC(v[11], v[13]); CEF_DESC(v[3], v[5]); CEF_DESC(v[6], v[8]); CEF_DESC(v[7], v[9]); CEF_DESC(v[10], v[12]); CEF_DESC(v[3], v[4]); CEF_DESC(v[5], v[6]); CEF_DESC(v[7], v[8]); CEF_DESC(v[9], v[10]); CEF_DESC(v[11], v[12]); CEF_DESC(v[6], v[7]); CEF_DESC(v[8], v[9]);
}
__device__ __forceinline__ void fbitonic_merge16_desc(float (&v)[16]) {
#pragma unroll
    for (int j = 8; j > 0; j >>= 1)
#pragma unroll
        for (int i = 0; i < 16; ++i) { const int l = i ^ j; if (l > i) CEF_DESC(v[i], v[l]); }
}
__device__ __forceinline__ void ftop16_merge(float (&a)[16], const float (&b)[16]) {
#pragma unroll
    for (int i = 0; i < 16; ++i) a[i] = fmaxf(a[i], b[15 - i]);
    fbitonic_merge16_desc(a);
}
__device__ __forceinline__ int packkey(float v, int idx) { const int f = __float_as_int(v); const int s = f ^ ((f >> 31) & 0x7fffffff); return (s & ~127) | (127 - idx); }
__device__ __forceinline__ float keyval(int k) { const int s = k & ~127; return __int_as_float(s ^ ((s >> 31) & 0x7fffffff)); }
__device__ __forceinline__ void top16_of_scores(const f32x16 (&acc)[4], int hclr, float (&L)[16]) {
    float M[16];
#pragma unroll
    for (int kt = 0; kt < 4; ++kt) {
        float v[16];
#pragma unroll
        for (int r = 0; r < 16; ++r) v[r] = __int_as_float(((__float_as_int(acc[kt][r]) & ~127) | (127 - (kt * 32 + (r & 3) + 8 * (r >> 2)))) & hclr);
        fsort16_desc(v);
        if (kt == 0) {
#pragma unroll
            for (int i = 0; i < 16; ++i) L[i] = v[i];
        } else ftop16_merge(L, v);
    }
#pragma unroll
    for (int i = 0; i < 16; ++i) M[i] = __shfl_xor(L[i], 32);
    ftop16_merge(L, M);
}
__device__ __forceinline__ void phase_topk(KP kp, LAS unsigned char* lds, int wave_s) {
    const int lane = lane_id_asm(), wave = wave_s, tid = wave * 64 + lane;
    unsigned char* ws = kp->ws;
    const bf16_t* Q = (const bf16_t*)(ws + WS_SG);
    int* IDX = (int*)(ws + WS_IDX); float* GATE = (float*)(ws + WS_GATE);
    LAS unsigned* stg = (LAS unsigned*)(lds + 65536);
    for (int e = tid; e < 2 * 32 * 64; e += NTHREADS) {
        const int f = e >> 6, l = e & 63, set = f >> 5, kt = (f >> 3) & 3, ks = f & 7;
        const float* src = (set ? kp->in[19] : kp->in[18]) + (kt * 32 + (l & 31)) * 128 + ks * 16 + 8 * (l >> 5);
        const f32x4 a = *(const f32x4*)src, b = *(const f32x4*)(src + 4);
        u32x4 w; w.x = cvt_pk_bf16(a[0], a[1]); w.y = cvt_pk_bf16(a[2], a[3]); w.z = cvt_pk_bf16(b[0], b[1]); w.w = cvt_pk_bf16(b[2], b[3]);
        *(LAS u32x4*)(lds + (size_t)e * 16) = w;
    }
    __syncthreads();
    const int h = lane >> 5;
    pg8::StaticOrder SO; SO.init(T, 2048, gridDim.x, blockIdx.x);
    pg8::Unit uu;
    for (int ui = 0; SO.next(ui, uu); ++ui) {
        const int tile = uu.pm, head = uu.pn;
        const int tok = tile * 256 + wave * 32 + (lane & 31);
        const bf16_t* qfrag = Q + ((size_t)(tile * 8 + head) * 128 + (size_t)wave * 16) * 512 + lane * 8;
        float L1[16], L2[16];
#pragma unroll
        for (int set = 0; set < 2; ++set) {
            f32x16 acc[4];
#pragma unroll
            for (int kt = 0; kt < 4; ++kt)
#pragma unroll
                for (int r = 0; r < 16; ++r) acc[kt][r] = 0.f;
#pragma unroll
            for (int ks = 0; ks < 8; ++ks) {
                const bf16x8 bq = *(const bf16x8*)(qfrag + (set * 8 + ks) * 512);
#pragma unroll
                for (int kt = 0; kt < 4; ++kt) {
                    const bf16x8 ak = *(const LAS bf16x8*)(lds + (size_t)((((set * 4 + kt) * 8 + ks) * 64) + lane) * 16);
                    acc[kt] = __builtin_amdgcn_mfma_f32_32x32x16_bf16(ak, bq, acc[kt], 0, 0, 0);
                }
            }
#ifdef DBG_VALU_SCORES
            {   const float* keys = set ? kp->in[19] : kp->in[18];
                const bf16_t* qr = Q + (size_t)tok * 2048 + head * 256 + set * 128;
                for (int kt = 0; kt < 4; ++kt)
                    for (int r = 0; r < 16; ++r) {
                        const int idx = kt * 32 + (r & 3) + 8 * (r >> 2) + 4 * h; float sacc = 0.f;
                        for (int k = 0; k < 128; ++k) sacc += __uint_as_float(((unsigned)qr[k]) << 16) * keys[idx * 128 + k];
#pragma unroll
                        for (int kk = 0; kk < 4; ++kk)
#pragma unroll
                            for (int rr = 0; rr < 16; ++rr) if (kk == kt && rr == r) acc[kk][rr] = sacc;
                    }
            }
#endif
            if (set == 0) top16_of_scores(acc, ~(4 * h), L1); else top16_of_scores(acc, ~(4 * h), L2);
        }
        float v1[16], v2[16]; int i1[16], i2[16];
#pragma unroll
        for (int i = 0; i < 16; ++i) { const int k1 = __float_as_int(L1[i]), k2 = __float_as_int(L2[i]); v1[i] = __int_as_float(k1 & ~127); i1[i] = 127 - (k1 & 127); v2[i] = __int_as_float(k2 & ~127); i2[i] = 127 - (k2 & 127); }
        float thr, mx;
        {
            float A[16], B[16], C[16], Dd[16];
#pragma unroll
            for (int j = 0; j < 16; ++j) A[j] = v1[0] + v2[j];
#pragma unroll
            for (int j = 0; j < 8; ++j) { B[j] = v1[1] + v2[j]; B[8 + j] = v1[15 - j] + v2[0]; }
            fbitonic_merge16_desc(B);
            C[0] = v1[2] + v2[0]; C[1] = v1[2] + v2[1]; C[2] = v1[2] + v2[2]; C[3] = v1[2] + v2[3]; C[4] = v1[2] + v2[4];
            C[5] = v1[3] + v2[0]; C[6] = v1[3] + v2[1]; C[7] = v1[3] + v2[2]; C[8] = v1[3] + v2[3];
            C[9] = v1[4] + v2[0]; C[10] = v1[4] + v2[1]; C[11] = v1[4] + v2[2];
            C[12] = v1[5] + v2[0]; C[13] = v1[5] + v2[1]; C[14] = v1[6] + v2[0]; C[15] = v1[6] + v2[1];
            fsort16_desc(C);
            Dd[0] = v1[7] + v2[0]; Dd[1] = v1[7] + v2[1];
#pragma unroll
            for (int j = 2; j < 16; ++j) Dd[j] = -3.0e38f;
            ftop16_merge(A, B); ftop16_merge(C, Dd);
            mx = fmaxf(A[0], C[0]);
            float t = fmaxf(A[0], C[15]);
#pragma unroll
            for (int i = 1; i < 16; ++i) t = fminf(t, fmaxf(A[i], C[15 - i]));
            thr = t;
        }
        if (h == 0) {
            LAS unsigned* row = stg + (wave * 32 + (lane & 31)) * 44;
            int cnt = 0; float sum = 0.f;
#pragma unroll
            for (int i = 0; i < 16; ++i)
#pragma unroll
                for (int j = 0; j < 16; ++j) if ((i + 1) * (j + 1) <= 16) {
                    const float x = v1[i] + v2[j];
                    const bool pr = (x >= thr) && (cnt < 16);
                    const float ev = __expf(x - mx);
                    const int pos = pr ? cnt : 16;
                    row[pos] = (unsigned)(i1[i] * 128 + i2[j]); row[20 + pos] = __float_as_uint(ev);
                    sum += pr ? ev : 0.f; cnt += pr ? 1 : 0;
                }
            const float inv = 1.0f / sum;
            u32x4* ip = (u32x4*)(IDX + ((size_t)tok * 8 + head) * 16); f32x4* gp = (f32x4*)(GATE + ((size_t)tok * 8 + head) * 16);
#pragma unroll
            for (int q = 0; q < 4; ++q) {
                ip[q] = *(const LAS u32x4*)(row + 4 * q);
                const u32x4 gu = *(const LAS u32x4*)(row + 20 + 4 * q);
                gp[q] = (f32x4){__uint_as_float(gu.x) * inv, __uint_as_float(gu.y) * inv, __uint_as_float(gu.z) * inv, __uint_as_float(gu.w) * inv};
            }
        }
    }
    {
        const bf16_t* XA = (const bf16_t*)(ws + WS_H); const float* SSQ = (const float*)(ws + WS_SSQ); const float* mod = (const float*)(ws + WS_MOD);
        unsigned char* HB = ws + WS_HB; f32x2* HS = (f32x2*)(ws + WS_HS);
        for (int tk = blockIdx.x * 8 + wave; tk < T; tk += gridDim.x * 8) {
            const u32x4* xp = (const u32x4*)(XA + (size_t)tk * D + 16 * lane); const u32x4 xa0 = xp[0], xa1 = xp[1];
            const f32x4* sp = (const f32x4*)(mod + (size_t)(tk / SEQ) * NMOD + 3 * 1024 + 16 * lane);
            const f32x4 s0v = sp[0], s1v = sp[1], s2v = sp[2], s3v = sp[3];
            const float rr = rsqrtf(SSQ[tk] * (1.0f / D) + EPS);
            const unsigned xw[8] = {xa0.x, xa0.y, xa0.z, xa0.w, xa1.x, xa1.y, xa1.z, xa1.w};
            const float sh[16] = {s0v[0], s0v[1], s0v[2], s0v[3], s1v[0], s1v[1], s1v[2], s1v[3], s2v[0], s2v[1], s2v[2], s2v[3], s3v[0], s3v[1], s3v[2], s3v[3]};
            float hv[16]; float am = 0.f;
#pragma unroll
            for (int i = 0; i < 8; ++i) { hv[2 * i] = bf_lo(xw[i]) * rr + sh[2 * i]; hv[2 * i + 1] = bf_hi(xw[i]) * rr + sh[2 * i + 1]; am = fmaxf(am, fmaxf(fabsf(hv[2 * i]), fabsf(hv[2 * i + 1]))); }
#pragma unroll
            for (int o = 32; o >= 1; o >>= 1) am = fmaxf(am, __shfl_xor(am, o));
            const float q0 = am > 0.f ? 6.0f / am : 0.f, d0 = am * (1.0f / 6.0f);
            unsigned w0[2] = {0u, 0u}, w1[2] = {0u, 0u}; float rv[16]; float am1 = 0.f;
#pragma unroll
            for (int i = 0; i < 8; ++i) {
                const int wi = i >> 2, bs = i & 3;
                if (bs == 0) w0[wi] = __builtin_amdgcn_cvt_scalef32_pk_fp4_f32(w0[wi], hv[2 * i] * q0, hv[2 * i + 1] * q0, 1.0f, 0);
                else if (bs == 1) w0[wi] = __builtin_amdgcn_cvt_scalef32_pk_fp4_f32(w0[wi], hv[2 * i] * q0, hv[2 * i + 1] * q0, 1.0f, 1);
                else if (bs == 2) w0[wi] = __builtin_amdgcn_cvt_scalef32_pk_fp4_f32(w0[wi], hv[2 * i] * q0, hv[2 * i + 1] * q0, 1.0f, 2);
                else w0[wi] = __builtin_amdgcn_cvt_scalef32_pk_fp4_f32(w0[wi], hv[2 * i] * q0, hv[2 * i + 1] * q0, 1.0f, 3);
            }
#pragma unroll
            for (int i = 0; i < 8; ++i) {
                const int wi = i >> 2, bs = i & 3;
                const f32x2 dq = bs == 0 ? __builtin_amdgcn_cvt_scalef32_pk_f32_fp4(w0[wi], 1.0f, 0) : bs == 1 ? __builtin_amdgcn_cvt_scalef32_pk_f32_fp4(w0[wi], 1.0f, 1) : bs == 2 ? __builtin_amdgcn_cvt_scalef32_pk_f32_fp4(w0[wi], 1.0f, 2) : __builtin_amdgcn_cvt_scalef32_pk_f32_fp4(w0[wi], 1.0f, 3);
                rv[2 * i] = hv[2 * i] - dq.x * d0; rv[2 * i + 1] = hv[2 * i + 1] - dq.y * d0;
                am1 = fmaxf(am1, fmaxf(fabsf(rv[2 * i]), fabsf(rv[2 * i + 1])));
            }
#pragma unroll
            for (int o = 32; o >= 1; o >>= 1) am1 = fmaxf(am1, __shfl_xor(am1, o));
            const float q1 = am1 > 0.f ? 6.0f / am1 : 0.f, d1 = am1 * (1.0f / 6.0f);
#pragma unroll
            for (int i = 0; i < 8; ++i) {
                const int wi = i >> 2, bs = i & 3;
                if (bs == 0) w1[wi] = __builtin_amdgcn_cvt_scalef32_pk_fp4_f32(w1[wi], rv[2 * i] * q1, rv[2 * i + 1] * q1, 1.0f, 0);
                else if (bs == 1) w1[wi] = __builtin_amdgcn_cvt_scalef32_pk_fp4_f32(w1[wi], rv[2 * i] * q1, rv[2 * i + 1] * q1, 1.0f, 1);
                else if (bs == 2) w1[wi] = __builtin_amdgcn_cvt_scalef32_pk_fp4_f32(w1[wi], rv[2 * i] * q1, rv[2 * i + 1] * q1, 1.0f, 2);
                else w1[wi] = __builtin_amdgcn_cvt_scalef32_pk_fp4_f32(w1[wi], rv[2 * i] * q1, rv[2 * i + 1] * q1, 1.0f, 3);
            }
            const int sb = lane >> 3, qq = (lane & 7) >> 1, hf8 = lane & 1;
            unsigned char* hb = HB + (size_t)tk * 1024 + (sb * 4 + qq) * 16 + hf8 * 8;
            *(u32x2*)hb = (u32x2){w0[0], w0[1]};
            *(u32x2*)(hb + 512) = (u32x2){w1[0], w1[1]};
            if (lane == 0) HS[tk] = (f32x2){d0, d1};
        }
    }
}

__device__ __forceinline__ float gelu_tanh(float x) {
    const float y = 0.7978845608028654f * (x + 0.044715f * x * x * x);
    return x * fast_sigmoid(2.0f * y);
}
typedef int i32x8 __attribute__((ext_vector_type(8)));
#define DPPF(x, ctrl) __int_as_float(__builtin_amdgcn_update_dpp(0, __float_as_int(x), ctrl, 0xF, 0xF, true))
struct TokMeta { u32x4 hb; f32x2 hs; int e0, e1; float g0, g1, cu0, cu1, sv0, sv1; u32x4 x1[2]; f32x4 g2[4]; };
__device__ __forceinline__ void peer_load_meta(TokMeta& m, int tok, int lane, const unsigned char* HB, const f32x2* HS, const int* IDX, const float* GATE, const bf16_t* X1, const float* modp) {
    { const u32x4* xp = (const u32x4*)(X1 + (size_t)tok * D + 16 * lane); m.x1[0] = xp[0]; m.x1[1] = xp[1];
      const f32x4* gp = (const f32x4*)(modp + (size_t)(tok / SEQ) * NMOD + 5 * 1024 + 16 * lane); m.g2[0] = gp[0]; m.g2[1] = gp[1]; m.g2[2] = gp[2]; m.g2[3] = gp[3]; }
    m.hb = *(const u32x4*)(HB + (size_t)tok * 1024 + ((lane & 15) * 4 + (lane >> 4)) * 16);
    m.hs = HS[tok];
    m.e0 = IDX[(size_t)tok * 128 + lane]; m.e1 = IDX[(size_t)tok * 128 + 64 + lane];
    m.g0 = GATE[(size_t)tok * 128 + lane]; m.g1 = GATE[(size_t)tok * 128 + 64 + lane];
}
__device__ __forceinline__ void peer_load_scales(TokMeta& m, const float* SU, const float* SV) { m.cu0 = SU[m.e0]; m.cu1 = SU[m.e1]; m.sv0 = SV[m.e0]; m.sv1 = SV[m.e1]; }
typedef RowFmt<V_BITS>::row_t vrow_t;
#define PEER_LOAD(UQ, VQ, g) do { const int bb_ = (g) & 15; const bool nx_ = (g) >= 16; \
        const int src_ = bb_ < 8 ? (nx_ ? mn.e0 : m.e0) : (nx_ ? mn.e1 : m.e1); \
        _Pragma("unroll") for (int j_ = 0; j_ < 4; ++j_) { \
            const int ea_ = __builtin_amdgcn_readlane(src_, (8 * bb_ + 2 * j_) & 63), eb_ = __builtin_amdgcn_readlane(src_, (8 * bb_ + 2 * j_ + 1) & 63); \
            UQ[j_] = __builtin_bit_cast(u32x4, __builtin_amdgcn_raw_buffer_load_b128(rsU, ((mhi ? eb_ : ea_) << 9) + uoff, 0, 0)); \
            VQ[2 * j_] = __builtin_bit_cast(u32x2, __builtin_amdgcn_raw_buffer_load_b64(rsV, lane * 8, ea_ << 9, 0)); \
            VQ[2 * j_ + 1] = __builtin_bit_cast(u32x2, __builtin_amdgcn_raw_buffer_load_b64(rsV, lane * 8, eb_ << 9, 0)); } } while (0)
#define PEER_COMPUTE(UQ, VQ, bt) do { \
        float x_[4]; \
        _Pragma("unroll") for (int j_ = 0; j_ < 4; ++j_) { \
            const i32x8 a_ = {(int)UQ[j_].x, (int)UQ[j_].y, (int)UQ[j_].z, (int)UQ[j_].w, 0, 0, 0, 0}; \
            const f32x4 d_ = __builtin_amdgcn_mfma_scale_f32_16x16x128_f8f6f4(a_, hbv, (f32x4){0.f, 0.f, 0.f, 0.f}, 4, 4, 0, 0x7f7f7f7f, 0, 0x7f7f7f7f); \
            const float s_ = r0 ? d_[0] : r1 ? d_[1] : r2 ? d_[2] : d_[3]; \
            x_[j_] = s_ * st; } \
        float y2[2], q1; \
        _Pragma("unroll") for (int k_ = 0; k_ < 2; ++k_) { const float a_ = b4 ? x_[k_ + 2] : x_[k_], sd_ = b4 ? x_[k_] : x_[k_ + 2]; y2[k_] = a_ + __shfl_xor(sd_, 16); } \
        { const float a_ = b3 ? y2[1] : y2[0], sd_ = b3 ? y2[0] : y2[1]; q1 = a_ + DPPF(sd_, 0x128); }                  \
        q1 += DPPF(q1, 0xB1); q1 += DPPF(q1, 0x4E); q1 += DPPF(q1, 0x141);                                            \
        const int slot_ = (8 * (bt) + jj) & 63; \
        const float cu_ = __shfl((bt) < 8 ? m.cu0 : m.cu1, slot_), cv_ = __shfl((bt) < 8 ? m.g0 * m.sv0 : m.g1 * m.sv1, slot_); \
        const float c_ = gelu_tanh(q1 * cu_) * cv_; \
        _Pragma("unroll") for (int j_ = 0; j_ < 8; ++j_) { \
            const float cj_ = __int_as_float(__builtin_amdgcn_readlane(__float_as_int(c_), 32 * (j_ & 1) + 8 * ((j_ >> 1) & 1) + 16 * ((j_ >> 2) & 1))); \
            row_axpy16(VQ[j_], cj_, o); } } while (0)
__device__ __forceinline__ void phase_peer(KP kp, int wave_s) {
    const int lane = lane_id_asm(), wave = wave_s;
    unsigned char* ws = kp->ws;
    const __amdgpu_buffer_rsrc_t rsU = __builtin_amdgcn_make_buffer_rsrc((void*)(ws + WS_EU), 0, NEXP * U_BITS * 128, 0x00020000);
    const __amdgpu_buffer_rsrc_t rsV = __builtin_amdgcn_make_buffer_rsrc((void*)(ws + WS_EV), 0, NEXP * V_BITS * 128, 0x00020000);
    const unsigned char* HB = ws + WS_HB; const f32x2* HS = (const f32x2*)(ws + WS_HS);
    const int* IDX = (const int*)(ws + WS_IDX); const float* GATE = (const float*)(ws + WS_GATE);
    const float* SU = (const float*)(ws + WS_SU); const float* SV = (const float*)(ws + WS_SV);
    const float* mod = (const float*)(ws + WS_MOD); const float* fg = kp->in[22];
    const bf16_t* X1 = (const bf16_t*)(ws + WS_X1B); float* OUT = kp->out;
    const bool b5 = lane & 32, b4 = lane & 16, b3 = lane & 8;
    const int jj = 4 * (b4 ? 1 : 0) + 2 * (b3 ? 1 : 0) + (b5 ? 1 : 0);
    const int nn = lane & 15, qq = lane >> 4;
    const bool mhi = nn >= 8;
    const int uoff = 64 * (nn & 7) + 16 * qq;
    const bool useful = ((nn & 7) >> 2) == (qq & 1);
    const bool r0 = (nn & 3) == 0, r1 = (nn & 3) == 1, r2 = (nn & 3) == 2;
    const int tstride = gridDim.x * 8;
    int tok = blockIdx.x * 8 + wave;
    f32x4 fgv[4];
#pragma unroll
    for (int q = 0; q < 4; ++q) fgv[q] = *(const f32x4*)(fg + 16 * lane + 4 * q);
    TokMeta m, mn;
    u32x4 uqA[4], uqB[4]; vrow_t vqA[8], vqB[8];
    if (tok < T) { peer_load_meta(m, tok, lane, HB, HS, IDX, GATE, X1, mod); peer_load_scales(m, SU, SV); mn = m; PEER_LOAD(uqA, vqA, 0); }
    for (; tok < T; tok += tstride) {
        const int b = tok / SEQ;
        const bool has_next = tok + tstride < T;
        if (has_next) peer_load_meta(mn, tok + tstride, lane, HB, HS, IDX, GATE, X1, mod);
        const i32x8 hbv = {(int)m.hb.x, (int)m.hb.y, (int)m.hb.z, (int)m.hb.w, 0, 0, 0, 0};
        const float st = useful ? ((nn >> 3) ? m.hs.y : m.hs.x) : 0.f;
        f32x2 o[8];
#pragma unroll
        for (int i = 0; i < 8; ++i) o[i] = (f32x2){0.f, 0.f};
#pragma unroll 1
        for (int bt = 0; bt < 16; bt += 2) {
            PEER_LOAD(uqB, vqB, bt + 1);
            PEER_COMPUTE(uqA, vqA, bt);
            PEER_LOAD(uqA, vqA, bt + 2);
            PEER_COMPUTE(uqB, vqB, bt + 1);
        }
        if (has_next) peer_load_scales(mn, SU, SV);
        float* xr = OUT + (size_t)tok * D + 16 * lane;
        const unsigned xw[8] = {m.x1[0].x, m.x1[0].y, m.x1[0].z, m.x1[0].w, m.x1[1].x, m.x1[1].y, m.x1[1].z, m.x1[1].w};
        f32x4 xv[4]; float ss = 0.f;
#pragma unroll
        for (int q = 0; q < 4; ++q) {
            const f32x4 x1v = {bf_lo(xw[2 * q]), bf_hi(xw[2 * q]), bf_lo(xw[2 * q + 1]), bf_hi(xw[2 * q + 1])}, gv = m.g2[q];
            xv[q][0] = x1v[0] + gv[0] * o[2 * q].x; xv[q][1] = x1v[1] + gv[1] * o[2 * q].y; xv[q][2] = x1v[2] + gv[2] * o[2 * q + 1].x; xv[q][3] = x1v[3] + gv[3] * o[2 * q + 1].y;
            ss += xv[q][0] * xv[q][0] + xv[q][1] * xv[q][1] + xv[q][2] * xv[q][2] + xv[q][3] * xv[q][3];
        }
        ss = wave_sum(ss);
        const float r = rsqrtf(ss * (1.0f / D) + EPS);
#pragma unroll
        for (int q = 0; q < 4; ++q) *(f32x4*)(xr + 4 * q) = xv[q] * r * fgv[q];
        m = mn;
    }
}

__device__ __forceinline__ void sort_words(unsigned& w0, unsigned& w1, int lane, LAS unsigned* scr) {
#pragma unroll
    for (int bit = 10; bit < 14; ++bit) {
        const bool z0 = ((w0 >> bit) & 1u) == 0u, z1 = ((w1 >> bit) & 1u) == 0u;
        const unsigned long long m0 = __ballot(z0), m1 = __ballot(z1);
        const int nz0 = __popcll(m0), nz = nz0 + __popcll(m1);
        const int r0 = __builtin_amdgcn_mbcnt_hi((unsigned)(m0 >> 32), __builtin_amdgcn_mbcnt_lo((unsigned)m0, 0u));
        const int r1 = __builtin_amdgcn_mbcnt_hi((unsigned)(m1 >> 32), __builtin_amdgcn_mbcnt_lo((unsigned)m1, 0u));
        const int p0 = z0 ? r0 : nz + lane - r0;
        const int p1 = z1 ? nz0 + r1 : nz + 64 - nz0 + lane - r1;
        scr[p0] = w0; scr[p1] = w1;
        asm volatile("" ::: "memory");
        w0 = scr[lane]; w1 = scr[64 + lane];
        asm volatile("" ::: "memory");
    }
}
struct UTok { u32x4 hb; f32x2 hs; unsigned s0, s1; };
#define PU_LOAD(UQ, k, g) do { const int bb_ = (g) & 15; const bool nx_ = (g) >= 16; \
        const unsigned src_ = bb_ < 8 ? (nx_ ? nxt[k].s0 : cur[k].s0) : (nx_ ? nxt[k].s1 : cur[k].s1); \
        _Pragma("unroll") for (int j_ = 0; j_ < 4; ++j_) { \
            const int id_ = __builtin_amdgcn_ds_bpermute(4 * (((8 * bb_) & 63) + 2 * j_) + slotb, (int)src_) & 0x3fff; \
            UQ[j_] = __builtin_bit_cast(u32x4, __builtin_amdgcn_raw_buffer_load_b128(rsU, (id_ << 9) + uoff, 0, 0)); } } while (0)
#define PU_COMPUTE(UQ, k, bt) do { \
        const i32x8 hbv = {(int)cur[k].hb.x, (int)cur[k].hb.y, (int)cur[k].hb.z, (int)cur[k].hb.w, 0, 0, 0, 0}; const float st = cur[k].hs.x; \
        float x_[4]; \
        _Pragma("unroll") for (int j_ = 0; j_ < 4; ++j_) { \
            const i32x8 a_ = {(int)UQ[j_].x, (int)UQ[j_].y, (int)UQ[j_].z, (int)UQ[j_].w, 0, 0, 0, 0}; \
            const f32x4 d_ = __builtin_amdgcn_mfma_scale_f32_16x16x128_f8f6f4(a_, hbv, (f32x4){0.f, 0.f, 0.f, 0.f}, 4, 4, 0, 0x7f7f7f7f, 0, 0x7f7f7f7f); \
            x_[j_] = (d_[0] * lm0 + d_[1] * lm1 + d_[2] * lm2 + d_[3] * lm3) * st; } \
        float y2[2], q1; \
        _Pragma("unroll") for (int k_ = 0; k_ < 2; ++k_) { const float a_ = b4 ? x_[k_ + 2] : x_[k_], sd_ = b4 ? x_[k_] : x_[k_ + 2]; y2[k_] = a_ + __shfl_xor(sd_, 16); } \
        { const float a_ = b3 ? y2[1] : y2[0], sd_ = b3 ? y2[0] : y2[1]; q1 = a_ + DPPF(sd_, 0x128); } \
        q1 += DPPF(q1, 0xB1); q1 += DPPF(q1, 0x4E); q1 += DPPF(q1, 0x141); \
        const float qs_ = __shfl(q1, srcl);                                     \
        const bool mine_ = (lane >> 3) == ((bt) & 7); \
        if ((bt) < 8) qs0[k] = mine_ ? qs_ : qs0[k]; else qs1[k] = mine_ ? qs_ : qs1[k]; } while (0)
__device__ __forceinline__ void peer_u_raw(UTok& t, int tok, int lane, const unsigned char* HB, const f32x2* HS, const int* IDX) {
    t.hb = *(const u32x4*)(HB + (size_t)tok * 1024 + ((lane & 15) >> 3) * 512 + (lane & 7) * 16 + (lane >> 4) * 128);
    t.hs = HS[tok];
    t.s0 = (unsigned)IDX[(size_t)tok * 128 + lane] | ((unsigned)lane << 14); t.s1 = (unsigned)IDX[(size_t)tok * 128 + 64 + lane] | ((unsigned)(64 + lane) << 14);
}
__device__ __forceinline__ void phase_peer_u(KP kp, LAS unsigned char* lds, int wave_s) {
    const int lane = lane_id_asm(), wave = wave_s;
    unsigned char* ws = kp->ws;
    const __amdgpu_buffer_rsrc_t rsU = __builtin_amdgcn_make_buffer_rsrc((void*)(ws + WS_EU), 0, NEXP * U_BITS * 128, 0x00020000);
    const unsigned char* HB = ws + WS_HB; const f32x2* HS = (const f32x2*)(ws + WS_HS);
    const int* IDX = (const int*)(ws + WS_IDX); const float* GATE = (const float*)(ws + WS_GATE);
    const float* SU = (const float*)(ws + WS_SU); const float* SV = (const float*)(ws + WS_SV);
    LAS unsigned* scr = (LAS unsigned*)(lds + wave * 2048);
    const bool b4 = lane & 16, b3 = lane & 8;
    const int srcl = 32 * (lane & 1) + 16 * ((lane >> 2) & 1) + 8 * ((lane >> 1) & 1);
    const int nn = lane & 15, qq = lane >> 4;
    const int uoff = 16 * (nn & 7) + 128 * qq;
    const int slotb = 4 * (nn >> 3);
    const bool useful = ((nn & 7) >> 2) == (qq & 1);
    const float lm0 = (nn & 3) == 0 ? 1.f : 0.f, lm1 = (nn & 3) == 1 ? 1.f : 0.f, lm2 = (nn & 3) == 2 ? 1.f : 0.f, lm3 = (nn & 3) == 3 ? 1.f : 0.f;
    const int tstride = gridDim.x * 8;
    int tok0 = blockIdx.x * 8 + wave;
    if (tok0 < T) {
        UTok cur[4], nxt[4];
        u32x4 uq[4][4];
#pragma unroll
        for (int k = 0; k < 4; ++k) { const int tk = tok0 + k * tstride; peer_u_raw(cur[k], tk < T ? tk : tok0, lane, HB, HS, IDX); }
#pragma unroll
        for (int k = 0; k < 4; ++k) { sort_words(cur[k].s0, cur[k].s1, lane, scr + k * 128); cur[k].hs.x = useful ? ((nn >> 3) ? cur[k].hs.y : cur[k].hs.x) : 0.f; nxt[k] = cur[k]; }
        PU_LOAD(uq[0], 0, 0); PU_LOAD(uq[1], 1, 0); PU_LOAD(uq[2], 2, 0);
        for (; tok0 < T; tok0 += 4 * tstride) {
            const bool has_next = tok0 + 4 * tstride < T;
            if (has_next) {
#pragma unroll
                for (int k = 0; k < 4; ++k) { const int tk = tok0 + (4 + k) * tstride; peer_u_raw(nxt[k], tk < T ? tk : tok0 + 4 * tstride, lane, HB, HS, IDX); }
            }
            float g0[4], g1[4], cu0[4], cu1[4], sv0[4], sv1[4];
#pragma unroll
            for (int k = 0; k < 4; ++k) { const int tk = tok0 + k * tstride < T ? tok0 + k * tstride : tok0;
                const int i0 = cur[k].s0 & 0x3fff, i1 = cur[k].s1 & 0x3fff;
                g0[k] = GATE[(size_t)tk * 128 + (cur[k].s0 >> 14)]; g1[k] = GATE[(size_t)tk * 128 + (cur[k].s1 >> 14)];
                cu0[k] = SU[i0]; cu1[k] = SU[i1]; sv0[k] = SV[i0]; sv1[k] = SV[i1]; }
            float qs0[4] = {0.f, 0.f, 0.f, 0.f}, qs1[4] = {0.f, 0.f, 0.f, 0.f};
#pragma unroll 1
            for (int bt = 0; bt < 16; ++bt) {
                if (bt == 8 && has_next) {
#pragma unroll
                    for (int k = 0; k < 4; ++k) { sort_words(nxt[k].s0, nxt[k].s1, lane, scr + k * 128); nxt[k].hs.x = useful ? ((nn >> 3) ? nxt[k].hs.y : nxt[k].hs.x) : 0.f; }
                }
                PU_LOAD(uq[3], 3, bt);     PU_COMPUTE(uq[0], 0, bt);
                PU_LOAD(uq[0], 0, bt + 1); PU_COMPUTE(uq[1], 1, bt);
                PU_LOAD(uq[1], 1, bt + 1); PU_COMPUTE(uq[2], 2, bt);
                PU_LOAD(uq[2], 2, bt + 1); PU_COMPUTE(uq[3], 3, bt);
            }
#pragma unroll
            for (int k = 0; k < 4; ++k) { const int tok = tok0 + k * tstride;
                if (tok < T) {
                    const int e0 = (int)(cur[k].s0 & 0x3fff), e1 = (int)(cur[k].s1 & 0x3fff);
                    const float c0 = gelu_tanh(qs0[k] * cu0[k]) * (g0[k] * sv0[k]), c1 = gelu_tanh(qs1[k] * cu1[k]) * (g1[k] * sv1[k]);
                    float cm = fmaxf(fabsf(c0), fabsf(c1));
#pragma unroll
                    for (int o_ = 32; o_ >= 1; o_ >>= 1) cm = fmaxf(cm, __shfl_xor(cm, o_));
                    const float f = cm > 0.f ? 256.0f / cm : 0.f;
                    const unsigned pk = (unsigned)__builtin_amdgcn_cvt_pk_fp8_f32(c0 * f, c1 * f, 0, false) & 0xffffu;
                    const unsigned nbe0 = (unsigned)__builtin_amdgcn_update_dpp(0, e0, 0xB1, 0xF, 0xF, true), nbe1 = (unsigned)__builtin_amdgcn_update_dpp(0, e1, 0xB1, 0xF, 0xF, true);
                    if (!(lane & 1)) {
                        const int p = lane >> 1, o0 = (p & 3) * 16 + (p >> 2), o1 = (p & 3) * 16 + 8 + (p >> 2);
                        unsigned* IDP = (unsigned*)(ws + WS_IDP) + (size_t)tok * 64;
                        IDP[o0] = (unsigned)e0 | (nbe0 << 16); IDP[o1] = (unsigned)e1 | (nbe1 << 16);
                    }
                    const unsigned nb4 = (unsigned)__shfl((int)pk, lane + 4);
                    if ((lane & 7) < 4) {
                        unsigned short* COP = (unsigned short*)(ws + WS_COP) + (size_t)tok * 64 + (lane & 3) * 16 + (lane >> 3);
                        COP[0] = (unsigned short)((pk & 0xffu) | ((nb4 & 0xffu) << 8)); COP[8] = (unsigned short)(((pk >> 8) & 0xffu) | (nb4 & 0xff00u));
                    }
                    if (lane == 0) ((float*)(ws + WS_CS))[tok] = cm * (1.0f / 256.0f);
                }
                cur[k] = nxt[k]; }
        }
    }
}
#define PV_LOADG(RB, k, g) do { const int gg_ = (g) & 15; \
        const unsigned pr_ = ((g) >= 16 ? mnx : mcu)[(k) * 96 + qq * 16 + gg_]; \
        cfr[k] = ((g) >= 16 ? mnx : mcu)[(k) * 96 + 64 + qq * 8 + (gg_ >> 1)]; \
        const int va_ = (int)((pr_ & 0xffffu) << 9) + lanebase, vb_ = (int)((pr_ >> 16) << 9) + lanebase; \
        _Pragma("unroll") for (int blk_ = 0; blk_ < 4; ++blk_) { \
            const u32x2 a_ = __builtin_bit_cast(u32x2, __builtin_amdgcn_raw_buffer_load_b64(rsV, va_ + 8 * (blk_ & 1) + 256 * (blk_ >> 1), 0, 0)); \
            const u32x2 b_ = __builtin_bit_cast(u32x2, __builtin_amdgcn_raw_buffer_load_b64(rsV, vb_ + 8 * (blk_ & 1) + 256 * (blk_ >> 1), 0, 0)); \
            RB[blk_] = (u32x4){a_.x, a_.y, b_.x, b_.y}; } } while (0)
#define PV_COMPG(RB, k, g, CW) do { const unsigned cw_ = (CW); \
        const unsigned ra_ = ((g) & 1) ? __builtin_amdgcn_perm(cw_, cw_, 0x02020202u) : __builtin_amdgcn_perm(cw_, cw_, 0x00000000u); \
        const unsigned rb_ = ((g) & 1) ? __builtin_amdgcn_perm(cw_, cw_, 0x03030303u) : __builtin_amdgcn_perm(cw_, cw_, 0x01010101u); \
        const i32x8 A_ = {(int)(ra_ & mk0), (int)(ra_ & mk1), (int)(ra_ & mk2), (int)(ra_ & mk3), (int)(rb_ & mk0), (int)(rb_ & mk1), (int)(rb_ & mk2), (int)(rb_ & mk3)}; \
        _Pragma("unroll") for (int blk_ = 0; blk_ < 4; ++blk_) { \
            const i32x8 B_ = {(int)RB[blk_].x, (int)RB[blk_].y, (int)RB[blk_].z, (int)RB[blk_].w, 0, 0, 0, 0}; \
            acc[k][blk_] = __builtin_amdgcn_mfma_scale_f32_16x16x128_f8f6f4(A_, B_, acc[k][blk_], 0, 4, 0, 0x7f7f7f7f, 0, 0x7f7f7f7f); } } while (0)
__device__ __forceinline__ void phase_peer_v(KP kp, LAS unsigned char* lds, int wave_s) {
    const int lane = lane_id_asm(), wave = wave_s;
    unsigned char* ws = kp->ws;
    const __amdgpu_buffer_rsrc_t rsV = __builtin_amdgcn_make_buffer_rsrc((void*)(ws + WS_EV), 0, NEXP * V_BITS * 128, 0x00020000);
    const float* mod = (const float*)(ws + WS_MOD); const float* fg = kp->in[22];
    const bf16_t* X1 = (const bf16_t*)(ws + WS_X1B); float* OUT = kp->out;
    const unsigned* IDP = (const unsigned*)(ws + WS_IDP); const unsigned* COP = (const unsigned*)(ws + WS_COP); const float* CS = (const float*)(ws + WS_CS);
    const int nn = lane & 15, qq = lane >> 4;
    const int lanebase = 16 * nn;
    const unsigned msel = 0xFFu << (8 * (nn & 3));
    const unsigned mk0 = (nn >> 2) == 0 ? msel : 0u, mk1 = (nn >> 2) == 1 ? msel : 0u, mk2 = (nn >> 2) == 2 ? msel : 0u, mk3 = (nn >> 2) == 3 ? msel : 0u;
    const int col0 = 32 * nn + 4 * qq;
    const int tstride = gridDim.x * 8;
    int tok0 = blockIdx.x * 8 + wave;
    LAS unsigned* mcu = (LAS unsigned*)(lds + wave * 3072);
    LAS unsigned* mnx = mcu + 384;
    if (tok0 < T) {
        unsigned idw[4], cfw[4]; float csc[4], csn[4];
#pragma unroll
        for (int k = 0; k < 4; ++k) { const int tk = tok0 + k * tstride < T ? tok0 + k * tstride : tok0;
            idw[k] = IDP[(size_t)tk * 64 + lane]; cfw[k] = COP[(size_t)tk * 32 + (lane & 31)]; csc[k] = CS[tk]; csn[k] = csc[k]; }
#pragma unroll
        for (int k = 0; k < 4; ++k) { mcu[k * 96 + lane] = idw[k]; if (lane < 32) mcu[k * 96 + 64 + lane] = cfw[k]; mnx[k * 96 + lane] = idw[k]; if (lane < 32) mnx[k * 96 + 64 + lane] = cfw[k]; }
        asm volatile("" ::: "memory");
        u32x4 rb0[4], rb1[4], rb2[4], rb3[4]; unsigned cfr[4];
        PV_LOADG(rb0, 0, 0); PV_LOADG(rb1, 1, 0); PV_LOADG(rb2, 2, 0);
        for (; tok0 < T; tok0 += 4 * tstride) {
            const bool has_next = tok0 + 4 * tstride < T;
            if (has_next) {
#pragma unroll
                for (int k = 0; k < 4; ++k) { const int tk = tok0 + (4 + k) * tstride < T ? tok0 + (4 + k) * tstride : tok0 + 4 * tstride;
                    idw[k] = IDP[(size_t)tk * 64 + lane]; cfw[k] = COP[(size_t)tk * 32 + (lane & 31)]; csn[k] = CS[tk]; }
            }
            f32x4 acc[4][4]; u32x2 xwa[4], xwb[4]; f32x4 gva[4], gvb[4];
#pragma unroll
            for (int k = 0; k < 4; ++k)
#pragma unroll
                for (int i = 0; i < 4; ++i) acc[k][i] = (f32x4){0.f, 0.f, 0.f, 0.f};
#pragma unroll 1
            for (int G = 0; G < 16; ++G) {
                if (G == 14) {
                    const bf16_t* xp = X1 + (size_t)tok0 * D + col0; const float* gp = mod + (size_t)(tok0 / SEQ) * NMOD + 5 * 1024 + col0;
#pragma unroll
                    for (int blk = 0; blk < 4; ++blk) { xwa[blk] = *(const u32x2*)(xp + 16 * (blk & 1) + 512 * (blk >> 1)); gva[blk] = *(const f32x4*)(gp + 16 * (blk & 1) + 512 * (blk >> 1)); }
                }
                if (G == 8) {
#pragma unroll
                    for (int k = 0; k < 4; ++k) { mnx[k * 96 + lane] = idw[k]; if (lane < 32) mnx[k * 96 + 64 + lane] = cfw[k]; }
                    asm volatile("" ::: "memory");
                }
                { const unsigned c_ = cfr[0]; PV_LOADG(rb3, 3, G);     PV_COMPG(rb0, 0, G, c_); }
                { const unsigned c_ = cfr[1]; PV_LOADG(rb0, 0, G + 1); PV_COMPG(rb1, 1, G, c_); }
                { const unsigned c_ = cfr[2]; PV_LOADG(rb1, 1, G + 1); PV_COMPG(rb2, 2, G, c_); }
                { const unsigned c_ = cfr[3]; PV_LOADG(rb2, 2, G + 1); PV_COMPG(rb3, 3, G, c_); }
            }
            f32x4 fgv[4];
#pragma unroll
            for (int blk = 0; blk < 4; ++blk) fgv[blk] = *(const f32x4*)(fg + col0 + 16 * (blk & 1) + 512 * (blk >> 1));
#pragma unroll
            for (int k = 0; k < 4; ++k) { const int tok = tok0 + k * tstride;
                if (k < 3) { const int tk = tok0 + (k + 1) * tstride < T ? tok0 + (k + 1) * tstride : tok0; const bf16_t* xp = X1 + (size_t)tk * D + col0; const float* gp = mod + (size_t)(tk / SEQ) * NMOD + 5 * 1024 + col0;
#pragma unroll
                    for (int blk = 0; blk < 4; ++blk) { xwb[blk] = *(const u32x2*)(xp + 16 * (blk & 1) + 512 * (blk >> 1)); gvb[blk] = *(const f32x4*)(gp + 16 * (blk & 1) + 512 * (blk >> 1)); } }
                if (tok < T) {
                    float* xr = OUT + (size_t)tok * D + col0;
                    f32x4 xv[4]; float ss = 0.f;
#pragma unroll
                    for (int blk = 0; blk < 4; ++blk) {
                        const f32x4 x1v = {bf_lo(xwa[blk].x), bf_hi(xwa[blk].x), bf_lo(xwa[blk].y), bf_hi(xwa[blk].y)};
                        xv[blk] = x1v + gva[blk] * (acc[k][blk] * csc[k]);
                        ss += xv[blk][0] * xv[blk][0] + xv[blk][1] * xv[blk][1] + xv[blk][2] * xv[blk][2] + xv[blk][3] * xv[blk][3]; }
                    ss = wave_sum(ss);
                    const float r = rsqrtf(ss * (1.0f / D) + EPS);
#pragma unroll
                    for (int blk = 0; blk < 4; ++blk) *(f32x4*)(xr + 16 * (blk & 1) + 512 * (blk >> 1)) = xv[blk] * r * fgv[blk];
                }
#pragma unroll
                for (int blk = 0; blk < 4; ++blk) { gva[blk] = gvb[blk]; xwa[blk] = xwb[blk]; }
                csc[k] = csn[k]; }
            { LAS unsigned* t_ = mcu; mcu = mnx; mnx = t_; }
        }
    }
}

__global__ void __launch_bounds__(NTHREADS, 2) fwd_megakernel(Params P_) {
    extern __shared__ __attribute__((aligned(16))) unsigned char lds_raw[];
    LAS unsigned char* lds = (LAS unsigned char*)lds_raw;
    KP kp = (KP)__builtin_amdgcn_kernarg_segment_ptr();
    volatile LAS unsigned* ctl = (volatile LAS unsigned*)(lds + LDS_CTL_OFF);
    const int wave_s = __builtin_amdgcn_readfirstlane(threadIdx.x >> 6);
    if (threadIdx.x < 4) ctl[threadIdx.x] = 0u;
    __syncthreads();
    { XcdBarrier b0 = xcd_barrier_post((unsigned*)(kp->ws + WS_CTL), ctl, wave_s); (void)b0; }
    const int lo = kp->ph_lo, hi = kp->ph_hi;
#define IN(k) (lo <= (k) && (k) < hi)
#define FRESH() asm volatile("" : "+s"(kp) :: "memory")
#define SEAM(k) do { if (IN(k) && IN((k) + 1)) { { XcdBarrier b_; b_.bar = (unsigned*)(kp->ws + WS_CTL); b_.x = xb_xcc_id(); b_.st = ctl; xcd_barrier(b_, wave_s); } } FRESH(); } while (0)

    if (IN(0)) phase_prep(kp, lds, wave_s);
#if DBG_REPEAT
    FRESH();
    if (IN(0)) phase_prep(kp, lds, wave_s);
#endif
    SEAM(0);
    if (IN(1)) { phase_aux(kp, lds, wave_s); phase_w8(kp, lds, wave_s); unsigned char* ws = kp->ws; phase_norm_ada<true>(kp->in[0], kp->in[4], (const float*)(ws + WS_MOD), 0, 1024, (bf16_t*)nullptr, ws + WS_X8, (float*)(ws + WS_X8S), wave_s); }
#if DBG_REPEAT
    FRESH();
    if (IN(1)) { unsigned char* ws = kp->ws; phase_norm_ada<true>(kp->in[0], kp->in[4], (const float*)(ws + WS_MOD), 0, 1024, (bf16_t*)nullptr, ws + WS_X8, (float*)(ws + WS_X8S), wave_s); }
#endif
    SEAM(1);
    if (IN(2)) {
        unsigned char* ws = kp->ws;
        { pg8::Gemm g{(const bf16_t*)(ws + WS_X8), (const bf16_t*)(ws + WS_WP8), T, 3584, D / 2}; pg8::StaticOrder S; S.init(T, 3584, gridDim.x, blockIdx.x);
          EpiIn E{EpiProj{(const float*)(ws + WS_BINP), (bf16_t*)(ws + WS_PG), (bf16_t*)(ws + WS_PG) + (size_t)T * 512, (const float*)(ws + WS_X8S), (const float*)(ws + WS_WP8S)},
                  EpiGate{(const float*)(ws + WS_BINP), (const float*)(ws + WS_X8S), (const float*)(ws + WS_WGS), (bf16_t*)(ws + WS_SG)}};
          pg8::gemm_phase<EpiIn>(lds, g, S, E, wave_s); }
    }
#if DBG_REPEAT
    FRESH();
    if (IN(2)) {
        unsigned char* ws = kp->ws;
        { pg8::Gemm g{(const bf16_t*)(ws + WS_X8), (const bf16_t*)(ws + WS_WP8), T, 3584, D / 2}; pg8::StaticOrder S; S.init(T, 3584, gridDim.x, blockIdx.x);
          EpiIn E{EpiProj{(const float*)(ws + WS_BINP), (bf16_t*)(ws + WS_PG), (bf16_t*)(ws + WS_PG) + (size_t)T * 512, (const float*)(ws + WS_X8S), (const float*)(ws + WS_WP8S)},
                  EpiGate{(const float*)(ws + WS_BINP), (const float*)(ws + WS_X8S), (const float*)(ws + WS_WGS), (bf16_t*)(ws + WS_SG)}};
          pg8::gemm_phase<EpiIn>(lds, g, S, E, wave_s); }
    }
#endif
    SEAM(2);
    if (IN(3)) phase_branches(kp, lds, wave_s);
#if DBG_REPEAT
    FRESH();
    if (IN(3)) phase_branches(kp, lds, wave_s);
#endif
    SEAM(3);
    if (IN(4)) {
        unsigned char* ws = kp->ws;
        pg8::Gemm g{(const bf16_t*)(ws + WS_MC), (const bf16_t*)(ws + WS_WPC), T, D, D}; pg8::StaticOrder S; S.init(T, D, gridDim.x, blockIdx.x);
        EpiMerge E{(const bf16_t*)(ws + WS_SG), (bf16_t*)(ws + WS_PG)};
        pg8::gemm_phase<EpiMerge>(lds, g, S, E, wave_s);
    }
#if DBG_REPEAT
    FRESH();
    if (IN(4)) {
        unsigned char* ws = kp->ws;
        pg8::Gemm g{(const bf16_t*)(ws + WS_MC), (const bf16_t*)(ws + WS_WPC), T, D, D}; pg8::StaticOrder S; S.init(T, D, gridDim.x, blockIdx.x);
        EpiMerge E{(const bf16_t*)(ws + WS_SG), (bf16_t*)(ws + WS_PG)};
        pg8::gemm_phase<EpiMerge>(lds, g, S, E, wave_s);
    }
#endif
    SEAM(4);
    if (IN(5)) {
        unsigned char* ws = kp->ws;
        pg8::Gemm g{(const bf16_t*)(ws + WS_PG), (const bf16_t*)(ws + WS_WOUT), T, D, D}; pg8::StaticOrder S; S.init(T, D, gridDim.x, blockIdx.x);
        EpiResid E{kp->in[0], (const float*)(ws + WS_MOD) + 2 * 1024, (bf16_t*)(ws + WS_X1B), (const float*)(ws + WS_A2), (bf16_t*)(ws + WS_H), (float*)(ws + WS_SSQ)};
        pg8::gemm_phase<EpiResid>(lds, g, S, E, wave_s);
    }
#if DBG_REPEAT
    FRESH();
    if (IN(5)) {
        unsigned char* ws = kp->ws;
        pg8::Gemm g{(const bf16_t*)(ws + WS_PG), (const bf16_t*)(ws + WS_WOUT), T, D, D}; pg8::StaticOrder S; S.init(T, D, gridDim.x, blockIdx.x);
        EpiResid E{kp->in[0], (const float*)(ws + WS_MOD) + 2 * 1024, (bf16_t*)(ws + WS_X1B), (const float*)(ws + WS_A2), (bf16_t*)(ws + WS_H), (float*)(ws + WS_SSQ)};
        pg8::gemm_phase<EpiResid>(lds, g, S, E, wave_s);
    }
#endif
    SEAM(5);
    if (IN(7)) {
        unsigned char* ws = kp->ws;
        pg8::Gemm g{(const bf16_t*)(ws + WS_H), (const bf16_t*)(ws + WS_WQ), T, 2048, D}; pg8::StaticOrder S; S.init(T, 2048, gridDim.x, blockIdx.x);
        EpiQ E{(bf16_t*)(ws + WS_SG), (const float*)(ws + WS_SSQ), (const float*)(ws + WS_BIAS2)};
        pg8::gemm_phase<EpiQ>(lds, g, S, E, wave_s);
    }
#if DBG_REPEAT
    FRESH();
    if (IN(7)) {
        unsigned char* ws = kp->ws;
        pg8::Gemm g{(const bf16_t*)(ws + WS_H), (const bf16_t*)(ws + WS_WQ), T, 2048, D}; pg8::StaticOrder S; S.init(T, 2048, gridDim.x, blockIdx.x);
        EpiQ E{(bf16_t*)(ws + WS_SG), (const float*)(ws + WS_SSQ), (const float*)(ws + WS_BIAS2)};
        pg8::gemm_phase<EpiQ>(lds, g, S, E, wave_s);
    }
#endif
    if (IN(7) && IN(8)) { asm volatile("s_waitcnt vmcnt(0)" ::: "memory"); __syncthreads();
        if (wave_s == 0 && lane_id_asm() == 0) { __builtin_amdgcn_fence(__ATOMIC_ACQUIRE, "agent"); asm volatile("s_waitcnt vmcnt(0)" ::: "memory"); }
        __syncthreads(); }
    FRESH();
    if (IN(8)) phase_topk(kp, lds, wave_s);
#if DBG_REPEAT
    FRESH();
    if (IN(8)) phase_topk(kp, lds, wave_s);
#endif
    SEAM(8);
    if (IN(9)) phase_peer_u(kp, lds, wave_s);
    SEAM(9);
    if (IN(10)) phase_peer_v(kp, lds, wave_s);
#undef IN
#undef SEAM
#undef FRESH
}

#define DBG_PHASE_SKIP(ph) (0)
#define DBG_LAST 9
#define DBG_DUMP_N ((size_t)3584 * 1024)
#define DBG_DUMP_BF16 1
#ifdef DBG_DUMP_OFF
__global__ void dbg_dump(const unsigned char* ws, float* out) {
    const size_t n = DBG_DUMP_N;
    for (size_t i = (size_t)blockIdx.x * blockDim.x + threadIdx.x; i < (size_t)T * D; i += (size_t)gridDim.x * blockDim.x) {
        const size_t j = (i * 7919ull) % n;
        float v;
        if (DBG_DUMP_BF16) v = __uint_as_float(((unsigned)((const bf16_t*)(ws + DBG_DUMP_OFF))[j]) << 16);
        else v = ((const float*)(ws + DBG_DUMP_OFF))[j];
        out[i] = v;
    }
}
#endif
#ifndef MK_N_LAUNCHES
#define MK_N_LAUNCHES 1
#endif
extern "C" void kernel_launch(void* const* d_in, const int* in_sizes, int n_in, void* d_out, int out_size, void* d_ws, size_t ws_size, hipStream_t stream) {
    static int grid = 0;
    if (grid == 0) {
        if (n_in != 23 || in_sizes[0] != T * D || out_size != T * D || ws_size < WS_END) {
            fprintf(stderr, "kernel_launch: unexpected shapes (n_in %d, in0 %d, out %d, ws %zu); nothing launched\n", n_in, n_in > 0 ? in_sizes[0] : -1, out_size, ws_size); grid = -1; return; }
        int dev = 0, cus = 0, per_cu = 0;
        if (hipGetDevice(&dev) != hipSuccess || hipDeviceGetAttribute(&cus, hipDeviceAttributeMultiprocessorCount, dev) != hipSuccess) { grid = -1; return; }
        if (hipFuncSetAttribute((const void*)fwd_megakernel, hipFuncAttributeMaxDynamicSharedMemorySize, LDS_BYTES) != hipSuccess) { fprintf(stderr, "kernel_launch: hipFuncSetAttribute failed\n"); grid = -1; return; }
        if (hipOccupancyMaxActiveBlocksPerMultiprocessor(&per_cu, (const void*)fwd_megakernel, NTHREADS, LDS_BYTES) != hipSuccess || per_cu < 1) {
            fprintf(stderr, "kernel_launch: occupancy query says %d blocks per CU; nothing launched\n", per_cu); grid = -1; return; }
        grid = cus;
    }
    if (grid < 0) return;
    (void)hipMemsetAsync((char*)d_ws + WS_CTL, 0, 16384, stream);
    Params p{};
    for (int i = 0; i < 23; ++i) p.in[i] = (const float*)d_in[i];
    p.out = (float*)d_out; p.ws = (unsigned char*)d_ws;
#if MK_N_LAUNCHES == 1
    p.ph_lo = 0; p.ph_hi = 11;
    void* args[] = {&p};
    hipError_t e = hipLaunchCooperativeKernel((const void*)fwd_megakernel, dim3(grid), dim3(NTHREADS), args, LDS_BYTES, stream);
    if (e != hipSuccess) fprintf(stderr, "kernel_launch: cooperative launch failed: %s (grid %d)\n", hipGetErrorString(e), grid);
#else
    for (int ph = 0; ph < 11; ++ph) { if (DBG_PHASE_SKIP(ph)) continue; p.ph_lo = ph; p.ph_hi = ph + 1; hipLaunchKernelGGL(fwd_megakernel, dim3(grid), dim3(NTHREADS), LDS_BYTES, stream, p); }
#ifdef DBG_DUMP_OFF
    hipLaunchKernelGGL(dbg_dump, dim3(1024), dim3(256), 0, stream, (const unsigned char*)d_ws, (float*)d_out);
#endif
#endif
}
```

```cpp
#include <hip/hip_runtime.h>
#include <hip/hip_cooperative_groups.h>
#include <cstdio>
#include <cstdint>
namespace cg = cooperative_groups;
#define DBG_NO_DOT2 1
#define DBG_REPEAT 0

#define LAS __attribute__((address_space(3)))
typedef unsigned short bf16_t;
typedef short bf16x8 __attribute__((ext_vector_type(8)));
typedef float f32x4 __attribute__((ext_vector_type(4)));
typedef float f32x2 __attribute__((ext_vector_type(2)));
typedef float f32x16 __attribute__((ext_vector_type(16)));
typedef unsigned u32x4 __attribute__((ext_vector_type(4)));
typedef unsigned u32x2 __attribute__((ext_vector_type(2)));
typedef __bf16 bf16x2_t __attribute__((ext_vector_type(2)));

constexpr int T = 32768, D = 1024, SEQ = 8192, NBATCH = 4, INW = 3584, NMOD = 6 * 1024;
constexpr int NEXP = 16384;
constexpr float EPS = 1e-6f;
constexpr int NTHREADS = 512;
constexpr int LDS_BYTES = 131072 + 1024;
constexpr int LDS_CTL_OFF = 131072;

constexpr size_t MiB = 1024ull * 1024ull;
constexpr size_t WS_CTL = 0;
constexpr size_t WS_MOD = 16384;
constexpr size_t WS_BINP = 114688;
constexpr size_t WS_WIN = 131072;
constexpr size_t WS_WPC = WS_WIN + 7340032;
constexpr size_t WS_WOUT = WS_WPC + 2 * MiB;
constexpr size_t WS_WQ = WS_WOUT + 2 * MiB;
constexpr size_t WS_EU = 16 * MiB;
constexpr size_t WS_EV = 32 * MiB;
constexpr size_t WS_SU = 48 * MiB;
constexpr size_t WS_SV = 48 * MiB + 65536;
constexpr size_t WS_H = 80 * MiB;
constexpr size_t WS_PG = 144 * MiB;
constexpr size_t WS_SG = 208 * MiB;
constexpr size_t WS_MC = 336 * MiB;
constexpr size_t WS_IDX = 400 * MiB;
constexpr size_t WS_GATE = 416 * MiB;
constexpr size_t WS_HB = WS_PG;
constexpr size_t WS_HS = WS_PG + 32 * MiB;
constexpr size_t WS_WG8 = WS_WIN + 1536 * 1024;
constexpr size_t WS_WGS = WS_WIN + 4 * MiB + 1536 * 4;
constexpr size_t WS_X8 = 436 * MiB;
constexpr size_t WS_X8S = 468 * MiB;
constexpr size_t WS_X1B = WS_MC;
constexpr size_t WS_A2 = 432 * MiB;
constexpr size_t WS_BIAS2 = WS_A2 + 16384;
constexpr size_t WS_SSQ = WS_A2 + 65536;
constexpr size_t WS_CO = WS_SG;
constexpr size_t WS_IDP = WS_SG + 16 * MiB;
constexpr size_t WS_COP = WS_SG + 32 * MiB;
constexpr size_t WS_CS = WS_SG + 48 * MiB;
constexpr size_t WS_WP8 = WS_WIN;
constexpr size_t WS_WP8S = WS_WIN + 4 * MiB;
constexpr size_t WS_PMAX = WS_WIN + 5 * MiB;
constexpr size_t WS_END = 469 * MiB;
static_assert(WS_WQ + 4 * MiB <= WS_EU, "weight region overflow");

struct Params;
typedef const __attribute__((address_space(4))) Params* KP;
struct Params {
    const float* in[23];
    float* out;
    unsigned char* ws;
    int ph_lo, ph_hi;
};

typedef __bf16 bf16x2v_t __attribute__((ext_vector_type(2)));
__device__ __forceinline__ unsigned cvt_pk_bf16(float lo, float hi) { return __builtin_bit_cast(unsigned, __builtin_convertvector((f32x2){lo, hi}, bf16x2v_t)); }
__device__ __forceinline__ float bf_lo(unsigned u) { return __uint_as_float(u << 16); }
__device__ __forceinline__ float bf_hi(unsigned u) { return __uint_as_float(u & 0xffff0000u); }
__device__ __forceinline__ float fast_sigmoid(float x) { return __builtin_amdgcn_rcpf(1.0f + __builtin_amdgcn_exp2f(-1.44269504089f * x)); }
__device__ __forceinline__ int lane_id_asm() { int l; asm volatile("v_mbcnt_lo_u32_b32 %0, -1, 0\n\tv_mbcnt_hi_u32_b32 %0, -1, %0" : "=v"(l)); return l; }
#define DPPI(old, x, ctrl, rmask, bc) __builtin_amdgcn_update_dpp((old), (x), (ctrl), (rmask), 0xF, (bc))
__device__ __forceinline__ float wave_sum(float v) {
    v += __int_as_float(DPPI(0, __float_as_int(v), 0xB1, 0xF, true)); v += __int_as_float(DPPI(0, __float_as_int(v), 0x4E, 0xF, true));
    v += __int_as_float(DPPI(0, __float_as_int(v), 0x141, 0xF, true)); v += __int_as_float(DPPI(0, __float_as_int(v), 0x140, 0xF, true));
    v += __int_as_float(DPPI(0, __float_as_int(v), 0x142, 0xA, false)); v += __int_as_float(DPPI(0, __float_as_int(v), 0x143, 0xC, false));
    return __int_as_float(__builtin_amdgcn_readlane(__float_as_int(v), 63));
}
__device__ __forceinline__ float wave_max(float v) {
    v = fmaxf(v, __int_as_float(DPPI(0, __float_as_int(v), 0xB1, 0xF, true))); v = fmaxf(v, __int_as_float(DPPI(0, __float_as_int(v), 0x4E, 0xF, true)));
    v = fmaxf(v, __int_as_float(DPPI(0, __float_as_int(v), 0x141, 0xF, true))); v = fmaxf(v, __int_as_float(DPPI(0, __float_as_int(v), 0x140, 0xF, true)));
    v = fmaxf(v, __int_as_float(DPPI(0, __float_as_int(v), 0x142, 0xA, false))); v = fmaxf(v, __int_as_float(DPPI(0, __float_as_int(v), 0x143, 0xC, false)));
    return __int_as_float(__builtin_amdgcn_readlane(__float_as_int(v), 63));
}
__device__ __forceinline__ int in_colmap(int n) {
    if (n < 512) return n;
    if (n < 1536) { const int t = (n - 512) >> 8, r = (n - 512) & 255; return r < 128 ? 512 + 128 * t + r : 1024 + 128 * t + (r - 128); }
    const int t = (n - 1536) >> 8, r = (n - 1536) & 255;
    return r < 128 ? 1536 + 128 * t + r : 2560 + 128 * t + (r - 128);
}

#define XB_TMO      128
#define XB_XCNT(j)  (256  + 64 * (j))
#define XB_XSUB(j)  (1280 + 64 * (j))
#define XB_XGEN(j)  (2304 + 64 * (j))
#define XB_TOP      3328
#define XB_TOPGEN   3392
#define XCD_BAR_WORDS 3456
#define XB_SPIN_CAP (1u << 22)
__device__ __forceinline__ unsigned xb_ld(unsigned* p)              { return __hip_atomic_load(p, __ATOMIC_RELAXED, __HIP_MEMORY_SCOPE_AGENT); }
__device__ __forceinline__ unsigned xb_add(unsigned* p, unsigned v) { return __hip_atomic_fetch_add(p, v, __ATOMIC_RELAXED, __HIP_MEMORY_SCOPE_AGENT); }
__device__ __forceinline__ unsigned xb_xcc_id() { return (unsigned)__builtin_amdgcn_s_getreg((3 << 11) | 20) & 0xFu; }
#define XB_SPIN(cond, bar) do { unsigned _sp = 0; while (cond) { __builtin_amdgcn_s_sleep(1); \
    if ((++_sp & 255u) == 0u) { if (xb_ld(&(bar)[XB_TMO])) break; if (_sp > XB_SPIN_CAP) { atomicAdd(&(bar)[XB_TMO], 1u); break; } } } } while (0)
struct XcdBarrier { unsigned* bar; unsigned x; volatile LAS unsigned* st; };
__device__ __forceinline__ XcdBarrier xcd_barrier_post(unsigned* bar, volatile LAS unsigned* st, int wave_s) {
    XcdBarrier b; b.bar = bar; b.x = xb_xcc_id(); b.st = st;
    if (wave_s == 0 && lane_id_asm() == 0) (void)xb_add(&bar[XB_XCNT(b.x)], 1u);
    return b;
}
__device__ __forceinline__ void xcd_barrier_complete(unsigned* bar, unsigned x, unsigned& nloc, unsigned& nx) {
    const unsigned G = gridDim.x * gridDim.y * gridDim.z;
    unsigned sum, cnt, mine, sp = 0u;
    for (;;) {
        sum = 0u; cnt = 0u; mine = 0u;
#pragma unroll
        for (unsigned j = 0; j < 16; ++j) { const unsigned c = xb_ld(&bar[XB_XCNT(j)]); sum += c; cnt += (c > 0u) ? 1u : 0u; mine = (j == x) ? c : mine; }
        if (sum == G) break;
        __builtin_amdgcn_s_sleep(1);
        if ((++sp & 255u) == 0u) { if (xb_ld(&bar[XB_TMO])) break; if (sp > XB_SPIN_CAP) { atomicAdd(&bar[XB_TMO], 1u); break; } }
    }
    nloc = mine > 0u ? mine : 1u; nx = cnt > 0u ? cnt : 1u;
}
__device__ __forceinline__ void xcd_barrier(const XcdBarrier& b, int wave_s) {
    asm volatile("s_waitcnt vmcnt(0)" ::: "memory");
    __syncthreads();
    if (wave_s == 0 && lane_id_asm() == 0) {
        unsigned* bar = b.bar;
        __builtin_amdgcn_s_waitcnt(0);
        unsigned nloc = b.st[0], nx = b.st[1];
        if (nloc == 0u) { xcd_barrier_complete(bar, b.x, nloc, nx); b.st[0] = nloc; b.st[1] = nx; }
        const unsigned old = xb_add(&bar[XB_XSUB(b.x)], 1u);
        const unsigned gen = old / nloc;
        if (old + 1u == (gen + 1u) * nloc) {
            __builtin_amdgcn_fence(__ATOMIC_RELEASE, "agent");
            asm volatile("s_waitcnt vmcnt(0)" ::: "memory");
            const unsigned og = xb_add(&bar[XB_TOP], 1u);
            const unsigned tg = og / nx;
            if (og + 1u == (tg + 1u) * nx) xb_add(&bar[XB_TOPGEN], 1u);
            else XB_SPIN(xb_ld(&bar[XB_TOPGEN]) == tg, bar);
            __builtin_amdgcn_fence(__ATOMIC_ACQUIRE, "agent");
            xb_add(&bar[XB_XGEN(b.x)], 1u);
            asm volatile("s_waitcnt vmcnt(0)" ::: "memory");
        } else {
            XB_SPIN(xb_ld(&bar[XB_XGEN(b.x)]) == gen, bar);
            __builtin_amdgcn_fence(__ATOMIC_ACQUIRE, "agent");
            asm volatile("s_waitcnt vmcnt(0)" ::: "memory");
        }
    }
    __syncthreads();
}

namespace pg8 {
constexpr int BM = 256, BK = 64, HALF = 128, HTB = HALF * BK * 2, STAGE_BYTES = 8 * HTB, NXCD = 8, WGM = 8;
__host__ __device__ __forceinline__ int lds_byte(int r, int c) { const int st = (r >> 4) * 2 + (c >> 5), rr = r & 15, cc = c & 31, ob = rr * 64 + cc * 2; return st * 1024 + (ob ^ (((ob >> 9) & 1) << 5)); }
__host__ __device__ __forceinline__ void stage_rc(int b, int& R, int& C) { const int st = b / 1024, sb = b % 1024, swz = sb ^ (((sb >> 9) & 1) << 5); R = (st >> 1) * 16 + swz / 64; C = (st & 1) * 32 + (swz % 64) / 2; }
__host__ __device__ __forceinline__ int perm32(int rho) { const int n = rho >> 4, i = rho & 15; return 8 * (i >> 2) + 4 * n + (i & 3); }
struct Unit { int pm, pn; };
struct Gemm { const bf16_t* A; const bf16_t* Bt; int M, N, K; };
struct StaticOrder {
    int nM, nN, nwg, G, c;
    __host__ __device__ void init(int M, int N, int G_, int c_) { nM = M / BM; nN = N / BM; nwg = nM * nN; G = G_; c = c_; }
    __host__ __device__ bool next(int i, Unit& u) const {
        const long L = (long)i * G + c; if (L >= nwg) return false;
        int wgid = (int)L; { const int q = nwg / NXCD, r = nwg % NXCD, xcd = wgid % NXCD, off = wgid / NXCD; wgid = (xcd < r ? xcd * (q + 1) : r * (q + 1) + (xcd - r) * q) + off; }
        const int nig = WGM * nN, gid = wgid / nig, fm = gid * WGM, gsz = (nM - fm) < WGM ? (nM - fm) : WGM;
        u.pm = fm + ((wgid % nig) % gsz); u.pn = (wgid % nig) / gsz; return true;
    }
};
typedef int i32x8_t __attribute__((ext_vector_type(8)));
typedef int i32x4_t __attribute__((ext_vector_type(4)));
template <bool FP8> struct FragT { typedef bf16x8 type[2]; };
template <> struct FragT<true> { typedef i32x8_t type; };
__device__ __forceinline__ void ldfrag(bf16x8 (&d)[2], const LAS unsigned char* p) { d[0] = *(const LAS bf16x8*)p; d[1] = *(const LAS bf16x8*)(p + 1024); }
__device__ __forceinline__ void ldfrag(i32x8_t& d, const LAS unsigned char* p) { const i32x4_t lo = *(const LAS i32x4_t*)p, hi = *(const LAS i32x4_t*)(p + 1024); d = (i32x8_t){lo[0], lo[1], lo[2], lo[3], hi[0], hi[1], hi[2], hi[3]}; }
__device__ __forceinline__ void mma1(f32x4& acc, const bf16x8 (&b)[2], const bf16x8 (&a)[2]) {
    acc = __builtin_amdgcn_mfma_f32_16x16x32_bf16(b[0], a[0], acc, 0, 0, 0); acc = __builtin_amdgcn_mfma_f32_16x16x32_bf16(b[1], a[1], acc, 0, 0, 0); }
__device__ __forceinline__ void mma1(f32x4& acc, const i32x8_t& b, const i32x8_t& a) {
    asm volatile("v_mfma_scale_f32_16x16x128_f8f6f4 %0, %1, %2, %0, %3, %3 op_sel_hi:[0,0,0]" : "+v"(acc) : "v"(b), "v"(a), "v"(0x7f7f7f7f)); }
template <class Epi>
__device__ __forceinline__ void gemm_phase(LAS unsigned char* lds, const Gemm g, const StaticOrder& S, const Epi& E, int wave_s) {
    const int lane = lane_id_asm(), wid = wave_s, tid = wid * 64 + lane, wr = wid >> 2, wc = wid & 3, fr = lane & 15, fq = lane >> 4;
    const int K = g.K, nt = K / BK;
    unsigned voffA[2], voffB[2];
#pragma unroll
    for (int i = 0; i < 2; ++i) { int R, C; stage_rc(tid * 16 + i * 8192, R, C); const int Rb = Epi::PERM ? ((R & ~31) + perm32(R & 31)) : R;
        voffA[i] = (unsigned)(R * K + C) * 2u; voffB[i] = (unsigned)(Rb * K + C) * 2u; }
    const size_t kstep = (size_t)(BK * 2);
    const size_t hstep = (size_t)HALF * K * 2;
    const size_t tstep = 2 * hstep;
    const unsigned ldsw = (unsigned)wid * 1024u;
    const int aoff = lds_byte(wr * 64 + fr, fq * 8), boff = lds_byte(wc * 32 + fr, fq * 8);
#define PG8_SA(b, h) (((b) * 2 + (h)) * HTB)
#define PG8_SB(b, h) ((4 + (b) * 2 + (h)) * HTB)
#define PG8_STAGE(bufoff, gbase, voff) do { _Pragma("unroll") for (int _i = 0; _i < 2; ++_i) \
        __builtin_amdgcn_global_load_lds((const unsigned*)((const char*)(gbase) + (voff)[_i]), (LAS unsigned*)(lds + (bufoff) + ldsw + _i * 8192), 16, 0, 0); } while (0)
#define PG8_LDA(dst, b, h) do { _Pragma("unroll") for (int m = 0; m < 4; ++m) ldfrag(dst[m], lds + PG8_SA(b, h) + aoff + m * 2048); } while (0)
#define PG8_LDB(dst, b, h) do { _Pragma("unroll") for (int n = 0; n < 2; ++n) ldfrag(dst[n], lds + PG8_SB(b, h) + boff + n * 2048); } while (0)
#define PG8_MMA(ai, bj, At, Bt) do { __builtin_amdgcn_s_setprio(1); _Pragma("unroll") for (int m = 0; m < 4; ++m) _Pragma("unroll") for (int n = 0; n < 2; ++n) mma1(acc[ai][bj][m][n], Bt[n], At[m]); __builtin_amdgcn_s_setprio(0); } while (0)
#define PG8_WAIT_V(n) asm volatile("s_waitcnt vmcnt(" #n ")" ::: "memory")
#define PG8_WAIT_L(n) asm volatile("s_waitcnt lgkmcnt(" #n ")" ::: "memory")
#define PG8_BAR __builtin_amdgcn_s_barrier()
#define PG8_SCHED __builtin_amdgcn_sched_barrier(0)
    Unit cur, nxt; int ui = 0;
    if (!S.next(0, cur)) return;
    f32x4 acc[2][2][4][2];
#pragma unroll
    for (int a = 0; a < 2; ++a)
#pragma unroll
        for (int b = 0; b < 2; ++b)
#pragma unroll
            for (int m = 0; m < 4; ++m)
#pragma unroll
                for (int n = 0; n < 2; ++n) acc[a][b][m][n] = (f32x4){0.f, 0.f, 0.f, 0.f};
    typename FragT<Epi::FP8>::type At[4], B0[2], B1[2];
    const char* cA = (const char*)g.A + (size_t)cur.pm * tstep; const char* cB = (const char*)g.Bt + (size_t)cur.pn * tstep;
    PG8_STAGE(PG8_SB(0, 0), cB, voffB); PG8_STAGE(PG8_SB(0, 1), cB + hstep, voffB); PG8_STAGE(PG8_SA(0, 0), cA, voffA); PG8_STAGE(PG8_SA(0, 1), cA + hstep, voffA);
    if (wr == 1) PG8_BAR;
    PG8_WAIT_V(2); PG8_BAR;
    PG8_STAGE(PG8_SB(1, 0), cB + kstep, voffB); PG8_STAGE(PG8_SA(1, 0), cA + kstep, voffA); PG8_STAGE(PG8_SB(1, 1), cB + hstep + kstep, voffB);
    PG8_WAIT_V(6); PG8_BAR;
    for (;;) {
        const bool has_next = S.next(ui + 1, nxt);
        const char* nA = has_next ? (const char*)g.A + (size_t)nxt.pm * tstep : cA; const char* nB = has_next ? (const char*)g.Bt + (size_t)nxt.pn * tstep : cB;
#pragma unroll 1
        for (int t = 0; t < nt; t += 2) {
            const bool last = (t == nt - 2);
            const char* a1 = cA + (size_t)(t + 1) * kstep;
            const char* a2 = last ? nA : cA + (size_t)(t + 2) * kstep; const char* b2 = last ? nB : cB + (size_t)(t + 2) * kstep;
            const char* a3 = a2 + kstep; const char* b3 = b2 + kstep;
            if constexpr (Epi::HAS_MID) { if (t == nt / 2) E.mid(acc, cur, wr, wc, fr, fq); }
            PG8_LDB(B0, 0, 0); PG8_LDB(B1, 0, 1); PG8_SCHED; PG8_LDA(At, 0, 0); PG8_STAGE(PG8_SA(1, 1), a1 + hstep, voffA);
            PG8_WAIT_V(8); PG8_WAIT_L(0); PG8_BAR; PG8_MMA(0, 0, At, B0); PG8_MMA(0, 1, At, B1); PG8_BAR; PG8_SCHED;
            PG8_LDA(At, 0, 1); PG8_STAGE(PG8_SB(0, 0), b2, voffB); PG8_STAGE(PG8_SB(0, 1), b2 + hstep, voffB); PG8_STAGE(PG8_SA(0, 0), a2, voffA);
            PG8_WAIT_V(8); PG8_WAIT_L(0); PG8_BAR; PG8_MMA(1, 0, At, B0); PG8_MMA(1, 1, At, B1); PG8_BAR; PG8_SCHED;
            PG8_LDB(B0, 1, 0); PG8_LDB(B1, 1, 1); PG8_SCHED; PG8_LDA(At, 1, 0); PG8_STAGE(PG8_SA(0, 1), a2 + hstep, voffA);
            PG8_WAIT_V(8); PG8_WAIT_L(0); PG8_BAR; PG8_MMA(0, 0, At, B0); PG8_MMA(0, 1, At, B1); PG8_BAR; PG8_SCHED;
            PG8_LDA(At, 1, 1); PG8_STAGE(PG8_SB(1, 0), b3, voffB); PG8_STAGE(PG8_SB(1, 1), b3 + hstep, voffB); PG8_STAGE(PG8_SA(1, 0), a3, voffA);
            PG8_WAIT_V(8); PG8_WAIT_L(0); PG8_BAR; PG8_MMA(1, 0, At, B0); PG8_MMA(1, 1, At, B1); PG8_BAR; PG8_SCHED;
        }
        if (wr == 0) PG8_BAR;
        E(acc, cur, wr, wc, fr, fq);
        if (!has_next) break;
#pragma unroll
        for (int a = 0; a < 2; ++a)
#pragma unroll
            for (int b = 0; b < 2; ++b)
#pragma unroll
                for (int m = 0; m < 4; ++m)
#pragma unroll
                    for (int n = 0; n < 2; ++n) acc[a][b][m][n] = (f32x4){0.f, 0.f, 0.f, 0.f};
        cur = nxt; cA = nA; cB = nB; ++ui;
        if (wr == 1) PG8_BAR;
    }
    PG8_WAIT_V(0);
    PG8_BAR;
#undef PG8_SA
#undef PG8_SB
#undef PG8_STAGE
#undef PG8_LDA
#undef PG8_LDB
#undef PG8_MMA
#undef PG8_WAIT_V
#undef PG8_WAIT_L
#undef PG8_BAR
#undef PG8_SCHED
}
}
typedef f32x4 AccT[2][2][4][2];

struct EpiProj {
    static constexpr bool PERM = true, HAS_MID = false, FP8 = true;
    const float* bias; bf16_t* PB; bf16_t* GB; const float* RS; const float* CS;
    __device__ __forceinline__ void operator()(const AccT& acc, const pg8::Unit& u, int wr, int wc, int fr, int fq) const {
        const int row0 = u.pm * 256 + wr * 64 + fr, lc0 = wc * 32 + 8 * fq;
        f32x4 bv[2][2], cv[2][2];
#pragma unroll
        for (int bj = 0; bj < 2; ++bj)
#pragma unroll
            for (int n = 0; n < 2; ++n) { bv[bj][n] = *(const f32x4*)(bias + u.pn * 256 + bj * 128 + lc0 + 4 * n); cv[bj][n] = *(const f32x4*)(CS + u.pn * 256 + bj * 128 + lc0 + 4 * n); }
        if (u.pn >= 2 && u.pn < 6) {
            const int t = u.pn - 2;
#pragma unroll
            for (int ai = 0; ai < 2; ++ai)
#pragma unroll
                for (int m = 0; m < 4; ++m) {
                    const int row = row0 + ai * 128 + m * 16; const float rs = RS[row];
                    float o[8];
#pragma unroll
                    for (int n = 0; n < 2; ++n) { const f32x4 v = acc[ai][0][m][n] * (cv[0][n] * rs) + bv[0][n], gt = acc[ai][1][m][n] * (cv[1][n] * rs) + bv[1][n];
#pragma unroll
                        for (int j = 0; j < 4; ++j) o[n * 4 + j] = v[j] * fast_sigmoid(gt[j]); }
                    u32x4 w; w.x = cvt_pk_bf16(o[0], o[1]); w.y = cvt_pk_bf16(o[2], o[3]); w.z = cvt_pk_bf16(o[4], o[5]); w.w = cvt_pk_bf16(o[6], o[7]);
                    *(u32x4*)(GB + (size_t)row * 512 + t * 128 + lc0) = w;
                }
        } else {
            const bool isp = true;
            bf16_t* base = PB; const int ldc = 512; const int colt = u.pn * 256;
#pragma unroll
            for (int ai = 0; ai < 2; ++ai)
#pragma unroll
                for (int m = 0; m < 4; ++m) {
                    const int row = row0 + ai * 128 + m * 16; const float rs = RS[row];
#pragma unroll
                    for (int bj = 0; bj < 2; ++bj) {
                        f32x4 v0 = acc[ai][bj][m][0] * (cv[bj][0] * rs) + bv[bj][0], v1 = acc[ai][bj][m][1] * (cv[bj][1] * rs) + bv[bj][1];
                        if (!isp) {
#pragma unroll
                            for (int j = 0; j < 4; ++j) { v0[j] = fast_sigmoid(v0[j]); v1[j] = fast_sigmoid(v1[j]); }
                        }
                        u32x4 w; w.x = cvt_pk_bf16(v0[0], v0[1]); w.y = cvt_pk_bf16(v0[2], v0[3]); w.z = cvt_pk_bf16(v1[0], v1[1]); w.w = cvt_pk_bf16(v1[2], v1[3]);
                        *(u32x4*)(base + (size_t)row * ldc + colt + bj * 128 + lc0) = w;
                    }
                }
        }
    }
};
struct EpiGate {
    static constexpr bool PERM = true, HAS_MID = false, FP8 = true;
    const float* bias; const float* RS; const float* CS; bf16_t* SG;
    __device__ __forceinline__ void operator()(const AccT& acc, const pg8::Unit& u, int wr, int wc, int fr, int fq) const {
        const int row0 = u.pm * 256 + wr * 64 + fr, lc0 = wc * 32 + 8 * fq, t = u.pn;
        float rs[2][4];
#pragma unroll
        for (int ai = 0; ai < 2; ++ai)
#pragma unroll
            for (int m = 0; m < 4; ++m) rs[ai][m] = RS[row0 + ai * 128 + m * 16];
#pragma unroll
        for (int n = 0; n < 2; ++n) {
            const f32x4 b1 = *(const f32x4*)(bias + 1536 + t * 256 + lc0 + 4 * n), b2 = *(const f32x4*)(bias + 1536 + t * 256 + 128 + lc0 + 4 * n);
            const f32x4 c1 = *(const f32x4*)(CS + t * 256 + lc0 + 4 * n), c2 = *(const f32x4*)(CS + t * 256 + 128 + lc0 + 4 * n);
#pragma unroll
            for (int ai = 0; ai < 2; ++ai)
#pragma unroll
                for (int m = 0; m < 4; ++m) {
                    const int row = row0 + ai * 128 + m * 16;
                    const f32x4 a1 = acc[ai][0][m][n] * (c1 * rs[ai][m]) + b1, a2 = acc[ai][1][m][n] * (c2 * rs[ai][m]) + b2;
                    float ra[4], s2[4];
#pragma unroll
                    for (int j = 0; j < 4; ++j) { const float e1 = __builtin_amdgcn_exp2f(-1.44269504089f * a1[j]), e2 = __builtin_amdgcn_exp2f(-1.44269504089f * a2[j]);
                        ra[j] = (1.0f + e2) * __builtin_amdgcn_rcpf(1.0f + e1); s2[j] = __builtin_amdgcn_rcpf(1.0f + e2); }
                    *(u32x2*)(SG + (size_t)row * 2048 + t * 128 + lc0 + 4 * n) = (u32x2){cvt_pk_bf16(ra[0], ra[1]), cvt_pk_bf16(ra[2], ra[3])};
                    *(u32x2*)(SG + (size_t)row * 2048 + 1024 + t * 128 + lc0 + 4 * n) = (u32x2){cvt_pk_bf16(s2[0], s2[1]), cvt_pk_bf16(s2[2], s2[3])};
                }
        }
    }
};
struct EpiIn {
    static constexpr bool PERM = true, HAS_MID = false, FP8 = true;
    EpiProj P; EpiGate G;
    __device__ __forceinline__ void operator()(const AccT& acc, const pg8::Unit& u, int wr, int wc, int fr, int fq) const {
        if (u.pn < 6) P(acc, u, wr, wc, fr, fq);
        else { pg8::Unit u2 = u; u2.pn = u.pn - 6; G(acc, u2, wr, wc, fr, fq); }
    }
};
struct EpiMerge {
    static constexpr bool PERM = true, HAS_MID = true, FP8 = false;
    const bf16_t* SG; bf16_t* MG;
    __device__ __forceinline__ void mid(AccT& acc, const pg8::Unit& u, int wr, int wc, int fr, int fq) const {
        const int row0 = u.pm * 256 + wr * 64 + fr, col0 = u.pn * 256 + wc * 32 + 8 * fq;
#pragma unroll
        for (int ai = 0; ai < 2; ++ai)
#pragma unroll
            for (int m = 0; m < 4; ++m) {
                const bf16_t* p = SG + (size_t)(row0 + ai * 128 + m * 16) * 2048 + col0;
                const u32x4 r0 = *(const u32x4*)p, r1 = *(const u32x4*)(p + 128);
#pragma unroll
                for (int bj = 0; bj < 2; ++bj) {
                    const unsigned a1[4] = {bj ? r1.x : r0.x, bj ? r1.y : r0.y, bj ? r1.z : r0.z, bj ? r1.w : r0.w};
#pragma unroll
                    for (int n = 0; n < 2; ++n)
#pragma unroll
                        for (int j = 0; j < 4; ++j) { const unsigned w1 = a1[n * 2 + (j >> 1)]; acc[ai][bj][m][n][j] *= (j & 1) ? bf_hi(w1) : bf_lo(w1); }
                }
                if (m & 1) asm volatile("" ::: "memory");
            }
    }
    __device__ __forceinline__ void operator()(const AccT& acc, const pg8::Unit& u, int wr, int wc, int fr, int fq) const {
        const int row0 = u.pm * 256 + wr * 64 + fr, col0 = u.pn * 256 + wc * 32 + 8 * fq;
#pragma unroll
        for (int ai = 0; ai < 2; ++ai)
#pragma unroll
            for (int m = 0; m < 4; ++m)
#pragma unroll
                for (int bj = 0; bj < 2; ++bj) {
                    const int row = row0 + ai * 128 + m * 16;
                    const u32x4 s2 = *(const u32x4*)(SG + (size_t)row * 2048 + 1024 + col0 + bj * 128);
                    const unsigned a2[4] = {s2.x, s2.y, s2.z, s2.w};
                    float o[8];
#pragma unroll
                    for (int n = 0; n < 2; ++n)
#pragma unroll
                        for (int j = 0; j < 4; ++j) {
                            const unsigned w2 = a2[n * 2 + (j >> 1)];
                            const float f2 = fmaxf((j & 1) ? bf_hi(w2) : bf_lo(w2), 1e-20f);
                            o[n * 4 + j] = acc[ai][bj][m][n][j] * f2;
                        }
                    u32x4 w; w.x = cvt_pk_bf16(o[0], o[1]); w.y = cvt_pk_bf16(o[2], o[3]); w.z = cvt_pk_bf16(o[4], o[5]); w.w = cvt_pk_bf16(o[6], o[7]);
                    *(u32x4*)(MG + (size_t)row * 1024 + col0 + bj * 128) = w;
                }
    }
};
struct EpiResid {
    static constexpr bool PERM = true, HAS_MID = false, FP8 = false;
    const float* X; const float* mod; bf16_t* X1B;
    const float* A2; bf16_t* XA; float* SSQ;
    __device__ __forceinline__ void operator()(const AccT& acc, const pg8::Unit& u, int wr, int wc, int fr, int fq) const {
        const int row0 = u.pm * 256 + wr * 64 + fr, col0 = u.pn * 256 + wc * 32 + 8 * fq;
        const int b = (u.pm * 256) / SEQ;
        const float* gt = mod + (size_t)b * NMOD; const float* a2 = A2 + b * 1024;
        f32x4 gv[2][2], av[2][2];
#pragma unroll
        for (int bj = 0; bj < 2; ++bj)
#pragma unroll
            for (int n = 0; n < 2; ++n) { gv[bj][n] = *(const f32x4*)(gt + col0 + bj * 128 + n * 4); av[bj][n] = *(const f32x4*)(a2 + col0 + bj * 128 + n * 4); }
#pragma unroll
        for (int ai = 0; ai < 2; ++ai)
#pragma unroll
            for (int m = 0; m < 4; ++m) {
                const int row = row0 + ai * 128 + m * 16;
                const size_t off = (size_t)row * 1024 + col0;
                float ss = 0.f;
#pragma unroll
                for (int bj = 0; bj < 2; ++bj) {
                    const f32x4 xv0 = *(const f32x4*)(X + off + bj * 128), xv1 = *(const f32x4*)(X + off + bj * 128 + 4);
                    const f32x4 x10 = xv0 + gv[bj][0] * acc[ai][bj][m][0], x11 = xv1 + gv[bj][1] * acc[ai][bj][m][1];
                    { u32x4 wx; wx.x = cvt_pk_bf16(x10[0], x10[1]); wx.y = cvt_pk_bf16(x10[2], x10[3]); wx.z = cvt_pk_bf16(x11[0], x11[1]); wx.w = cvt_pk_bf16(x11[2], x11[3]);
                      *(u32x4*)(X1B + off + bj * 128) = wx; }
                    ss += x10[0] * x10[0] + x10[1] * x10[1] + x10[2] * x10[2] + x10[3] * x10[3] + x11[0] * x11[0] + x11[1] * x11[1] + x11[2] * x11[2] + x11[3] * x11[3];
                    const f32x4 xa0 = x10 * av[bj][0], xa1 = x11 * av[bj][1];
                    u32x4 w; w.x = cvt_pk_bf16(xa0[0], xa0[1]); w.y = cvt_pk_bf16(xa0[2], xa0[3]); w.z = cvt_pk_bf16(xa1[0], xa1[1]); w.w = cvt_pk_bf16(xa1[2], xa1[3]);
                    *(u32x4*)(XA + off + bj * 128) = w;
                }
                ss += __shfl_xor(ss, 16); ss += __shfl_xor(ss, 32);
                if (fq == 0) __hip_atomic_fetch_add(SSQ + row, ss, __ATOMIC_RELAXED, __HIP_MEMORY_SCOPE_AGENT);
            }
    }
};
struct EpiBf16 {
    static constexpr bool PERM = true, HAS_MID = false, FP8 = false;
    bf16_t* O; int ldc;
    __device__ __forceinline__ void operator()(const AccT& acc, const pg8::Unit& u, int wr, int wc, int fr, int fq) const {
        const int row0 = u.pm * 256 + wr * 64 + fr, col0 = u.pn * 256 + wc * 32 + 8 * fq;
#pragma unroll
        for (int ai = 0; ai < 2; ++ai)
#pragma unroll
            for (int m = 0; m < 4; ++m)
#pragma unroll
                for (int bj = 0; bj < 2; ++bj) {
                    const f32x4 v0 = acc[ai][bj][m][0], v1 = acc[ai][bj][m][1];
                    u32x4 w; w.x = cvt_pk_bf16(v0[0], v0[1]); w.y = cvt_pk_bf16(v0[2], v0[3]); w.z = cvt_pk_bf16(v1[0], v1[1]); w.w = cvt_pk_bf16(v1[2], v1[3]);
                    *(u32x4*)(O + (size_t)(row0 + ai * 128 + m * 16) * ldc + col0 + bj * 128) = w;
                }
    }
};

struct EpiQ {
    static constexpr bool PERM = true, HAS_MID = false, FP8 = false;
    bf16_t* O; const float* SSQ; const float* BIAS2;
    __device__ __forceinline__ void operator()(const AccT& acc, const pg8::Unit& u, int wr, int wc, int fr, int fq) const {
        const int row0 = u.pm * 256 + wr * 64 + fr, col0 = u.pn * 256 + wc * 32 + 8 * fq;
        const float* bs = BIAS2 + ((u.pm * 256) / SEQ) * 2048 + col0;
        f32x4 bv[2][2];
#pragma unroll
        for (int bj = 0; bj < 2; ++bj)
#pragma unroll
            for (int n = 0; n < 2; ++n) bv[bj][n] = *(const f32x4*)(bs + bj * 128 + 4 * n);
#pragma unroll
        for (int ai = 0; ai < 2; ++ai)
#pragma unroll
            for (int m = 0; m < 4; ++m) {
                const int row = row0 + ai * 128 + m * 16;
                const float r = rsqrtf(SSQ[row] * (1.0f / D) + EPS);
#pragma unroll
                for (int bj = 0; bj < 2; ++bj) {
                    const f32x4 v0 = acc[ai][bj][m][0] * r + bv[bj][0], v1 = acc[ai][bj][m][1] * r + bv[bj][1];
                    u32x4 w; w.x = cvt_pk_bf16(v0[0], v0[1]); w.y = cvt_pk_bf16(v0[2], v0[3]); w.z = cvt_pk_bf16(v1[0], v1[1]); w.w = cvt_pk_bf16(v1[2], v1[3]);
                    { const int cw = wr * 2 + ai * 4 + (m >> 1), ks = 2 * wc + (fq >> 1), ln = (fq & 1) * 32 + (m & 1) * 16 + fr;
                      *(u32x4*)(O + ((size_t)(u.pm * 8 + u.pn) * 128 + (size_t)((cw * 2 + bj) * 8 + ks)) * 512 + ln * 8) = w; }
                }
            }
    }
};

#ifndef U_BITS
#define U_BITS 4
#endif
#ifndef V_BITS
#define V_BITS 4
#endif
template <int BITS> struct RowFmt;
template <> struct RowFmt<8> { typedef u32x4 row_t; static constexpr float QMAX = 224.0f; };
template <> struct RowFmt<4> { typedef u32x2 row_t; static constexpr float QMAX = 6.0f; };
template <int I> __device__ __forceinline__ f32x2 row_pair(const u32x4& r) {
    const unsigned w = (I >> 1) == 0 ? r.x : (I >> 1) == 1 ? r.y : (I >> 1) == 2 ? r.z : r.w;
    return __builtin_amdgcn_cvt_pk_f32_fp8((int)w, (I & 1) != 0);
}
template <int I> __device__ __forceinline__ f32x2 row_pair(const u32x2& r) {
    const unsigned w = (I >> 2) == 0 ? r.x : r.y;
    return __builtin_amdgcn_cvt_scalef32_pk_f32_fp4(w, 1.0f, I & 3);
}
template <class R> __device__ __forceinline__ float row_dot16(const R& r, const f32x2 (&hf)[8]) {
    f32x2 acc = {0.f, 0.f};
    acc = __builtin_elementwise_fma(row_pair<0>(r), hf[0], acc); acc = __builtin_elementwise_fma(row_pair<1>(r), hf[1], acc);
    acc = __builtin_elementwise_fma(row_pair<2>(r), hf[2], acc); acc = __builtin_elementwise_fma(row_pair<3>(r), hf[3], acc);
    acc = __builtin_elementwise_fma(row_pair<4>(r), hf[4], acc); acc = __builtin_elementwise_fma(row_pair<5>(r), hf[5], acc);
    acc = __builtin_elementwise_fma(row_pair<6>(r), hf[6], acc); acc = __builtin_elementwise_fma(row_pair<7>(r), hf[7], acc);
    return acc.x + acc.y;
}
template <class R> __device__ __forceinline__ void row_axpy16(const R& r, float c, f32x2 (&o)[8]) {
    const f32x2 c2 = {c, c};
    o[0] = __builtin_elementwise_fma(c2, row_pair<0>(r), o[0]); o[1] = __builtin_elementwise_fma(c2, row_pair<1>(r), o[1]);
    o[2] = __builtin_elementwise_fma(c2, row_pair<2>(r), o[2]); o[3] = __builtin_elementwise_fma(c2, row_pair<3>(r), o[3]);
    o[4] = __builtin_elementwise_fma(c2, row_pair<4>(r), o[4]); o[5] = __builtin_elementwise_fma(c2, row_pair<5>(r), o[5]);
    o[6] = __builtin_elementwise_fma(c2, row_pair<6>(r), o[6]); o[7] = __builtin_elementwise_fma(c2, row_pair<7>(r), o[7]);
}
template <int BITS> __device__ __forceinline__ void quant_row(const f32x4 (&v)[4], float qs, unsigned char* dst_row, int lane) {
    if constexpr (BITS == 8) {
#pragma unroll
        for (int q = 0; q < 4; ++q) { int p = 0; p = __builtin_amdgcn_cvt_pk_fp8_f32(v[q][0] * qs, v[q][1] * qs, p, false); p = __builtin_amdgcn_cvt_pk_fp8_f32(v[q][2] * qs, v[q][3] * qs, p, true);
            ((unsigned*)dst_row)[lane + 64 * q] = (unsigned)p; }
    } else {
#pragma unroll
        for (int q = 0; q < 4; ++q) { unsigned p = 0; p = __builtin_amdgcn_cvt_scalef32_pk_fp4_f32(p, v[q][0] * qs, v[q][1] * qs, 1.0f, 0); p = __builtin_amdgcn_cvt_scalef32_pk_fp4_f32(p, v[q][2] * qs, v[q][3] * qs, 1.0f, 1);
            ((unsigned short*)dst_row)[lane + 64 * q] = (unsigned short)(p & 0xffffu); }
    }
}
__device__ __forceinline__ void xpose_tile(const float* src, int ldsrc, int c0, int k0, bf16_t* dst, int lddst, int n0, int kd0, LAS float* tile, int tid) {
    { const int r = tid >> 4, c4 = tid & 15;
#pragma unroll
      for (int ps = 0; ps < 2; ++ps) { const f32x4 v = *(const f32x4*)(src + (size_t)(k0 + r + 32 * ps) * ldsrc + c0 + c4 * 4);
#pragma unroll
          for (int j = 0; j < 4; ++j) tile[(r + 32 * ps) * 65 + c4 * 4 + j] = v[j]; } }
    __syncthreads();
    { const int n = tid >> 3, kg = tid & 7; float f[8];
#pragma unroll
      for (int i = 0; i < 8; ++i) f[i] = tile[(kg * 8 + i) * 65 + n];
      u32x4 w; w.x = cvt_pk_bf16(f[0], f[1]); w.y = cvt_pk_bf16(f[2], f[3]); w.z = cvt_pk_bf16(f[4], f[5]); w.w = cvt_pk_bf16(f[6], f[7]);
      *(u32x4*)(dst + (size_t)(n0 + n) * lddst + kd0 + k0 + kg * 8) = w; }
    __syncthreads();
}
__device__ __forceinline__ void phase_prep(KP kp, LAS unsigned char* lds, int wave_s) {
    const int tid = wave_s * 64 + lane_id_asm(), G = gridDim.x;
    unsigned char* ws = kp->ws;
    const float* cvec = kp->in[1]; const float* ada_w = kp->in[2]; const float* ada_b = kp->in[3];
    float* mod = (float*)(ws + WS_MOD);
    LAS float* cact = (LAS float*)lds;
    LAS float* red = (LAS float*)(lds + 16384);
    LAS float* tile = (LAS float*)(lds + 49152);
    LAS float* pw = (LAS float*)(lds + 49152);
    if ((int)blockIdx.x < 192) {
        for (int i = tid; i < 4096; i += NTHREADS) { const float v = cvec[i]; cact[i] = v * fast_sigmoid(v); }
    }
    if (blockIdx.x == G - 1) {
        float* binp = (float*)(ws + WS_BINP); const float* b_in = kp->in[6];
        for (int i = tid; i < INW; i += NTHREADS) binp[i] = b_in[in_colmap(i)];
    }
    __syncthreads();
    constexpr int N_MOD = 192, N_WIN = 384, N_CO = 128, N_WO = 256, N_WQ = 512, N_WP = 128, N_WG = 512;
    constexpr int I1 = N_MOD, I2 = I1 + N_WIN, I3 = I2 + N_CO, I4 = I3 + N_WO, I5 = I4 + N_WQ, I6 = I5 + N_WP, I7 = I6 + N_WG;
    for (int it = blockIdx.x; it < I7; it += G) {
        if (it < I1) {
            const int n0 = it * 32, c4 = tid & 7, ks = tid >> 3;
            float a[4][4];
#pragma unroll
            for (int b = 0; b < 4; ++b)
#pragma unroll
                for (int j = 0; j < 4; ++j) a[b][j] = 0.f;
#pragma unroll 4
            for (int kk = 0; kk < 16; ++kk) { const int k = ks * 16 + kk; const f32x4 w = *(const f32x4*)(ada_w + (size_t)k * NMOD + n0 + c4 * 4);
#pragma unroll
                for (int b = 0; b < 4; ++b) { const float cv = cact[b * 1024 + k];
#pragma unroll
                    for (int j = 0; j < 4; ++j) a[b][j] += cv * w[j]; } }
#pragma unroll
            for (int b = 0; b < 4; ++b)
#pragma unroll
                for (int j = 0; j < 4; ++j) red[(ks * 4 + b) * 32 + c4 * 4 + j] = a[b][j];
            __syncthreads();
            if (tid < 128) { const int b = tid >> 5, col = tid & 31; float s = 0.f;
                for (int q = 0; q < 64; ++q) s += red[(q * 4 + b) * 32 + col];
                mod[b * NMOD + n0 + col] = s + ada_b[n0 + col]; }
            __syncthreads();
        } else if (it >= I6 || (it >= I1 && it < I2)) {
            const bool isp = it < I2;
            const int i = isp ? it - I1 : it - I6, kt = i & 15, n0 = (i >> 4) * 64 + (isp ? 0 : 1536), c0 = in_colmap(n0);
            const float* win = kp->in[5];
            LAS float* cmx = (LAS float*)(lds + 49152 + 17408);
            { const int r = tid >> 4, c4 = tid & 15;
              const f32x4 v0 = *(const f32x4*)(win + (size_t)(kt * 64 + r) * INW + c0 + c4 * 4), v1 = *(const f32x4*)(win + (size_t)(kt * 64 + r + 32) * INW + c0 + c4 * 4);
#pragma unroll
              for (int j = 0; j < 4; ++j) cmx[r * 64 + c4 * 4 + j] = fmaxf(fabsf(v0[j]), fabsf(v1[j])); }
            __syncthreads();
            if (tid < 64) { float mm = 0.f; for (int q = 0; q < 32; ++q) mm = fmaxf(mm, cmx[q * 64 + tid]); ((float*)(ws + WS_PMAX))[kt * 3584 + n0 + tid] = mm; }
            __syncthreads();
        } else if (it < I3) {
            const int i = it - I2, kt = i & 7, ntl = i >> 3;
            xpose_tile(kp->in[14], 1024, ntl * 64, kt * 64, (bf16_t*)(ws + WS_WPC), 1024, ntl * 64, 512, tile, tid);
        } else if (it < I4) {
            const int i = it - I3, kt = i & 15, ntl = i >> 4;
            xpose_tile(kp->in[15], 1024, ntl * 64, kt * 64, (bf16_t*)(ws + WS_WOUT), 1024, ntl * 64, 0, tile, tid);
        } else if (it < I5) {
            const int i = it - I4, kt = i & 15, ntl = i >> 4;
            xpose_tile(kp->in[17], 2048, ntl * 64, kt * 64, (bf16_t*)(ws + WS_WQ), 1024, ntl * 64, 0, tile, tid);
        } else {
            const int i = it - I5, nb = i & 1, cb = (i >> 1) & 15, g = i >> 5;
            const float* pool_w = kp->in[7]; const float* pool_scale = kp->in[8]; const float* pool_up = kp->in[9];
            for (int e = tid; e < 1024; e += NTHREADS) { const int ci = e >> 7, d = e & 127; pw[e] = pool_w[((size_t)g * 128 + cb * 8 + ci) * 128 + d] * pool_scale[g * 128 + d]; }
            __syncthreads();
            const int n = nb * 512 + tid; float a[8];
#pragma unroll
            for (int q = 0; q < 8; ++q) a[q] = 0.f;
#pragma unroll 4
            for (int d = 0; d < 128; ++d) { const float uv = pool_up[(size_t)(g * 128 + d) * 1024 + n];
#pragma unroll
                for (int q = 0; q < 8; ++q) a[q] += pw[q * 128 + d] * uv; }
            u32x4 w; w.x = cvt_pk_bf16(a[0], a[1]); w.y = cvt_pk_bf16(a[2], a[3]); w.z = cvt_pk_bf16(a[4], a[5]); w.w = cvt_pk_bf16(a[6], a[7]);
            *(u32x4*)((bf16_t*)(ws + WS_WPC) + (size_t)n * 1024 + g * 128 + cb * 8) = w;
            __syncthreads();
        }
    }
    {
        const int lane = tid & 63, wave = tid >> 6;
        f32x4 vn[4];
        { const int r0 = blockIdx.x * 8 + wave;
          if (r0 < 2 * NEXP) { const int tb0 = r0 >= NEXP ? 1 : 0; const f32x4* src = (const f32x4*)((tb0 ? kp->in[21] : kp->in[20]) + (size_t)(r0 - tb0 * NEXP) * D);
#pragma unroll
              for (int q = 0; q < 4; ++q) vn[q] = src[lane + 64 * q]; } }
        for (int r = blockIdx.x * 8 + wave; r < 2 * NEXP; r += G * 8) {
            const int tb = r >= NEXP ? 1 : 0, e = r - tb * NEXP;
            f32x4 v[4]; float m = 0.f;
#pragma unroll
            for (int q = 0; q < 4; ++q) v[q] = vn[q];
            { const int rn = r + G * 8;
              if (rn < 2 * NEXP) { const int tbn = rn >= NEXP ? 1 : 0; const f32x4* src = (const f32x4*)((tbn ? kp->in[21] : kp->in[20]) + (size_t)(rn - tbn * NEXP) * D);
#pragma unroll
                  for (int q = 0; q < 4; ++q) vn[q] = src[lane + 64 * q]; } }
#pragma unroll
            for (int q = 0; q < 4; ++q) m = fmaxf(m, fmaxf(fmaxf(fabsf(v[q][0]), fabsf(v[q][1])), fmaxf(fabsf(v[q][2]), fabsf(v[q][3]))));
            m = wave_max(m);
            const float qmax = tb ? RowFmt<V_BITS>::QMAX : RowFmt<U_BITS>::QMAX;
            const float qs = m > 0.f ? qmax / m : 0.f;
            if (tb) quant_row<V_BITS>(v, qs, ws + WS_EV + (size_t)e * (V_BITS * 128), lane);
            else quant_row<U_BITS>(v, qs, ws + WS_EU + (size_t)e * (U_BITS * 128), lane);
            if (lane == 0) ((float*)(ws + (tb ? WS_SV : WS_SU)))[e] = m / qmax;
        }
    }
}

__device__ __forceinline__ void phase_w8(KP kp, LAS unsigned char* lds, int wave_s) {
    const int tid = wave_s * 64 + lane_id_asm();
    unsigned char* ws = kp->ws;
    const float* win = kp->in[5]; const float* pmax = (const float*)(ws + WS_PMAX);
    LAS float* tile = (LAS float*)(lds + 49152);
    LAS float* csc = (LAS float*)(lds + 49152 + 17408);
    for (int it = blockIdx.x; it < 56 * 16; it += gridDim.x) {
        const int kt = it & 15, n0 = (it >> 4) * 64, c0 = in_colmap(n0);
        if (tid < 64) { float mm = 0.f;
#pragma unroll
            for (int q = 0; q < 16; ++q) mm = fmaxf(mm, pmax[q * 3584 + n0 + tid]);
            csc[tid] = mm > 0.f ? 224.0f / mm : 0.f; if (kt == 0) ((float*)(ws + WS_WP8S))[n0 + tid] = mm * (1.0f / 224.0f); }
        { const int r = tid >> 4, c4 = tid & 15;
#pragma unroll
          for (int ps = 0; ps < 2; ++ps) { const f32x4 v = *(const f32x4*)(win + (size_t)(kt * 64 + r + 32 * ps) * INW + c0 + c4 * 4);
#pragma unroll
              for (int j = 0; j < 4; ++j) tile[(r + 32 * ps) * 65 + c4 * 4 + j] = v[j]; } }
        __syncthreads();
        { const int n = tid >> 3, kg = tid & 7; const float qs = csc[n]; float f[8];
#pragma unroll
          for (int i = 0; i < 8; ++i) f[i] = tile[(kg * 8 + i) * 65 + n] * qs;
          int p0 = 0, p1 = 0;
          p0 = __builtin_amdgcn_cvt_pk_fp8_f32(f[0], f[1], p0, false); p0 = __builtin_amdgcn_cvt_pk_fp8_f32(f[2], f[3], p0, true);
          p1 = __builtin_amdgcn_cvt_pk_fp8_f32(f[4], f[5], p1, false); p1 = __builtin_amdgcn_cvt_pk_fp8_f32(f[6], f[7], p1, true);
          *(u32x2*)(ws + WS_WP8 + (size_t)(n0 + n) * 1024 + kt * 64 + kg * 8) = (u32x2){(unsigned)p0, (unsigned)p1}; }
        __syncthreads();
    }
}

template <bool WITH_FP8>
__device__ __forceinline__ void phase_norm_ada(const float* src, const float* gain, const float* mod, int shift_off, int scale_off, bf16_t* dst, unsigned char* dst8, float* dscale, int wave_s) {
    const int lane = lane_id_asm(), wave = wave_s;
    f32x4 vn[4];
    { const int row0 = blockIdx.x * 8 + wave;
      if (row0 < T) { const f32x4* xr = (const f32x4*)(src + (size_t)row0 * D);
#pragma unroll
          for (int j = 0; j < 4; ++j) vn[j] = xr[lane + 64 * j]; } }
    for (int row = blockIdx.x * 8 + wave; row < T; row += gridDim.x * 8) {
        const int b = row / SEQ;
        f32x4 v[4]; float ss = 0.f;
#pragma unroll
        for (int j = 0; j < 4; ++j) v[j] = vn[j];
        { const int rn = row + gridDim.x * 8;
          if (rn < T) { const f32x4* xr = (const f32x4*)(src + (size_t)rn * D);
#pragma unroll
              for (int j = 0; j < 4; ++j) vn[j] = xr[lane + 64 * j]; } }
#pragma unroll
        for (int j = 0; j < 4; ++j) ss += v[j][0] * v[j][0] + v[j][1] * v[j][1] + v[j][2] * v[j][2] + v[j][3] * v[j][3];
        ss = wave_sum(ss);
        const float r = rsqrtf(ss * (1.0f / D) + EPS);
        float am = 0.f;
#pragma unroll
        for (int j = 0; j < 4; ++j) {
            const int col = 4 * lane + 256 * j;
            const f32x4 g = *(const f32x4*)(gain + col), sc = *(const f32x4*)(mod + (size_t)b * NMOD + scale_off + col), sh = *(const f32x4*)(mod + (size_t)b * NMOD + shift_off + col);
            const f32x4 h = v[j] * r * g * (sc + 1.0f) + sh;
            u32x2 w; w.x = cvt_pk_bf16(h[0], h[1]); w.y = cvt_pk_bf16(h[2], h[3]);
            if (dst) *(u32x2*)(dst + (size_t)row * D + col) = w;
            if (WITH_FP8) { v[j] = h; am = fmaxf(am, fmaxf(fmaxf(fabsf(h[0]), fabsf(h[1])), fmaxf(fabsf(h[2]), fabsf(h[3])))); }
        }
        if (WITH_FP8) {
            am = wave_max(am);
            const float qs = am > 0.f ? 224.0f / am : 0.f;
#pragma unroll
            for (int j = 0; j < 4; ++j) { int p = 0; p = __builtin_amdgcn_cvt_pk_fp8_f32(v[j][0] * qs, v[j][1] * qs, p, false); p = __builtin_amdgcn_cvt_pk_fp8_f32(v[j][2] * qs, v[j][3] * qs, p, true);
                *(unsigned*)(dst8 + (size_t)row * D + 4 * lane + 256 * j) = (unsigned)p; }
            if (lane == 0) dscale[row] = am * (1.0f / 224.0f);
        }
    }
}

__device__ __forceinline__ void phase_aux(KP kp, LAS unsigned char* lds, int wave_s) {
    const int tid = wave_s * 64 + lane_id_asm();
    unsigned char* ws = kp->ws;
    const float* mod = (const float*)(ws + WS_MOD);
    const int bid = blockIdx.x;
    if (bid == 0) {
        float* A2 = (float*)(ws + WS_A2); const float* g2 = kp->in[16];
        for (int i = tid; i < 4096; i += NTHREADS) { const int b = i >> 10, k = i & 1023; A2[i] = g2[k] * (1.0f + mod[(size_t)b * NMOD + 4 * 1024 + k]); }
    } else if (bid <= 8) {
        float* SSQ = (float*)(ws + WS_SSQ) + (bid - 1) * 4096;
        for (int i = tid; i < 4096; i += NTHREADS) SSQ[i] = 0.f;
    } else if (bid <= 24) {
        const int n0 = (bid - 9) * 128, c4 = tid & 31, ks = tid >> 5;
        const float* wq = kp->in[17];
        LAS float* red = (LAS float*)lds;
        float a[4][4];
#pragma unroll
        for (int b = 0; b < 4; ++b)
#pragma unroll
            for (int j = 0; j < 4; ++j) a[b][j] = 0.f;
#pragma unroll 4
        for (int kk = 0; kk < 64; ++kk) { const int k = ks * 64 + kk; const f32x4 w = *(const f32x4*)(wq + (size_t)k * 2048 + n0 + c4 * 4);
#pragma unroll
            for (int b = 0; b < 4; ++b) { const float sv = mod[(size_t)b * NMOD + 3 * 1024 + k];
#pragma unroll
                for (int j = 0; j < 4; ++j) a[b][j] += sv * w[j]; } }
#pragma unroll
        for (int b = 0; b < 4; ++b)
#pragma unroll
            for (int j = 0; j < 4; ++j) red[(ks * 4 + b) * 128 + c4 * 4 + j] = a[b][j];
        __syncthreads();
        { const int b = tid >> 7, col = tid & 127; float sm = 0.f;
          for (int q = 0; q < 16; ++q) sm += red[(q * 4 + b) * 128 + col];
          ((float*)(ws + WS_BIAS2))[b * 2048 + n0 + col] = sm; }
        __syncthreads();
    }
}

template <int W>
__device__ __forceinline__ void pool_window(const float (&x0)[31], const float (&x1)[31], int spos0, bf16_t* dstp) {
#pragma unroll
    for (int i = 0; i < 16; ++i) {
        float s0 = 0.f, s1 = 0.f;
#pragma unroll
        for (int d = 0; d < W; ++d) { s0 += x0[i + 15 - d]; s1 += x1[i + 15 - d]; }
        const int sp = spos0 + i; const float inv = 1.0f / (float)(sp + 1 < W ? sp + 1 : W);
        const float m0 = s0 * inv - x0[i + 15], m1 = s1 * inv - x1[i + 15];
        *(unsigned*)(dstp + (size_t)i * 1024) = cvt_pk_bf16(m0, m1);
    }
}
__device__ __forceinline__ void phase_branches(KP kp, LAS unsigned char* lds, int wave_s) {
    const int lane = lane_id_asm(), wave = wave_s, tid = wave * 64 + lane;
    unsigned char* ws = kp->ws;
    const bf16_t* PB = (const bf16_t*)(ws + WS_PG); const bf16_t* GB = PB + (size_t)T * 512;
    bf16_t* MC = (bf16_t*)(ws + WS_MC);
    const float* dwk = kp->in[10]; const float* dwb = kp->in[11]; const float* lng = kp->in[12]; const float* lnb = kp->in[13];
    LAS unsigned* rows = (LAS unsigned*)lds;
    LAS float* ybuf = (LAS float*)(lds + 63488);
    const int cp = tid & 255, th = tid >> 8;
    float w0[31], w1[31];
#pragma unroll
    for (int j = 0; j < 31; ++j) { const f32x2 w = *(const f32x2*)(dwk + j * 512 + 2 * cp); w0[j] = w.x; w1[j] = w.y; }
    const f32x2 cb = *(const f32x2*)(dwb + 2 * cp);
    u32x4 gpre[8], ppre[6];
#define P3_LOAD_G(t0_, s0_) do { _Pragma("unroll") for (int i_ = 0; i_ < 8; ++i_) { const int e = tid + i_ * NTHREADS; const int r = e >> 6, c = e & 63; u32x4 v = {0u, 0u, 0u, 0u}; \
            if (e < 62 * 64 && (s0_) + r - 30 >= 0) v = *(const u32x4*)(GB + (size_t)((t0_) + r - 30) * 512 + c * 8); gpre[i_] = v; } } while (0)
#define P3_LOAD_P(t0_, s0_) do { _Pragma("unroll") for (int i_ = 0; i_ < 6; ++i_) { const int e = tid + i_ * NTHREADS; const int r = e >> 6, c = e & 63; u32x4 v = {0u, 0u, 0u, 0u}; \
            if (e < 47 * 64 && (s0_) + r - 15 >= 0) v = *(const u32x4*)(PB + (size_t)((t0_) + r - 15) * 512 + c * 8); ppre[i_] = v; } } while (0)
    if ((int)blockIdx.x < T / 32) { const int t0 = blockIdx.x * 32; P3_LOAD_G(t0, t0 % SEQ); }
    for (int tl = blockIdx.x; tl < T / 32; tl += gridDim.x) {
        const int t0 = tl * 32, s0 = t0 % SEQ;
#pragma unroll
        for (int i_ = 0; i_ < 8; ++i_) { const int e = tid + i_ * NTHREADS; if (e < 62 * 64) *(LAS u32x4*)(rows + (e >> 6) * 256 + (e & 63) * 4) = gpre[i_]; }
        __syncthreads();
        P3_LOAD_P(t0, s0);
        {
            float a0[16], a1[16];
#pragma unroll
            for (int i = 0; i < 16; ++i) { a0[i] = cb.x; a1[i] = cb.y; }
#pragma unroll
            for (int r = 0; r < 46; ++r) {
                const unsigned uu = rows[(th * 16 + r) * 256 + cp]; const float x0 = bf_lo(uu), x1 = bf_hi(uu);
#pragma unroll
                for (int i = 0; i < 16; ++i) { const int j = r - i; if (j >= 0 && j <= 30) { a0[i] += x0 * w0[j]; a1[i] += x1 * w1[j]; } }
            }
#pragma unroll
            for (int i = 0; i < 16; ++i) *(LAS f32x2*)(ybuf + (th * 16 + i) * 512 + 2 * cp) = (f32x2){a0[i], a1[i]};
        }
        __syncthreads();
        {
            const f32x4 g0 = *(const f32x4*)(lng + lane * 8), g1 = *(const f32x4*)(lng + lane * 8 + 4), b0 = *(const f32x4*)(lnb + lane * 8), b1 = *(const f32x4*)(lnb + lane * 8 + 4);
#pragma unroll
            for (int q = 0; q < 4; ++q) {
                const int tk = wave * 4 + q;
                const f32x4 y0 = *(const LAS f32x4*)(ybuf + tk * 512 + lane * 8), y1 = *(const LAS f32x4*)(ybuf + tk * 512 + lane * 8 + 4);
                float s = (y0[0] + y0[1]) + (y0[2] + y0[3]) + (y1[0] + y1[1]) + (y1[2] + y1[3]);
                s = wave_sum(s); const float mu = s * (1.0f / 512.0f);
                const f32x4 d0 = y0 - mu, d1 = y1 - mu;
                float qv = d0[0] * d0[0] + d0[1] * d0[1] + d0[2] * d0[2] + d0[3] * d0[3] + d1[0] * d1[0] + d1[1] * d1[1] + d1[2] * d1[2] + d1[3] * d1[3];
                qv = wave_sum(qv); const float rs = rsqrtf(qv * (1.0f / 512.0f) + EPS);
                f32x4 o0 = d0 * rs * g0 + b0, o1 = d1 * rs * g1 + b1;
#pragma unroll
                for (int j = 0; j < 4; ++j) { o0[j] = o0[j] * fast_sigmoid(o0[j]); o1[j] = o1[j] * fast_sigmoid(o1[j]); }
                u32x4 w; w.x = cvt_pk_bf16(o0[0], o0[1]); w.y = cvt_pk_bf16(o0[2], o0[3]); w.z = cvt_pk_bf16(o1[0], o1[1]); w.w = cvt_pk_bf16(o1[2], o1[3]);
                *(u32x4*)(MC + (size_t)(t0 + tk) * 1024 + 512 + lane * 8) = w;
            }
        }
        __syncthreads();
#pragma unroll
        for (int i_ = 0; i_ < 6; ++i_) { const int e = tid + i_ * NTHREADS; if (e < 47 * 64) *(LAS u32x4*)(rows + (e >> 6) * 256 + (e & 63) * 4) = ppre[i_]; }
        __syncthreads();
        { const int tn = tl + gridDim.x; if (tn < T / 32) { const int t0n = tn * 32; P3_LOAD_G(t0n, t0n % SEQ); } }
        {
            float x0[31], x1[31];
#pragma unroll
            for (int r = 0; r < 31; ++r) { const unsigned uu = rows[(th * 16 + r) * 256 + cp]; x0[r] = bf_lo(uu); x1[r] = bf_hi(uu); }
            bf16_t* dstp = MC + (size_t)(t0 + th * 16) * 1024 + 2 * cp;
            const int grp = __builtin_amdgcn_readfirstlane(cp >> 6), sp0 = s0 + th * 16;
            if (grp == 0) pool_window<2>(x0, x1, sp0, dstp);
            else if (grp == 1) pool_window<4>(x0, x1, sp0, dstp);
            else if (grp == 2) pool_window<8>(x0, x1, sp0, dstp);
            else pool_window<16>(x0, x1, sp0, dstp);
        }
        __syncthreads();
    }
}

#define CE_DESC(a, b) do { const int _hi = max(a, b), _lo = min(a, b); a = _hi; b = _lo; } while (0)
#define CE_ASC(a, b)  do { const int _hi = max(a, b), _lo = min(a, b); a = _lo; b = _hi; } while (0)
__device__ __forceinline__ void bitonic_sort16_desc(int (&v)[16]) {
#pragma unroll
    for (int k = 2; k <= 16; k <<= 1)
#pragma unroll
        for (int j = k >> 1; j > 0; j >>= 1)
#pragma unroll
            for (int i = 0; i < 16; ++i) { const int l = i ^ j; if (l > i) { if ((i & k) == 0) CE_DESC(v[i], v[l]); else CE_ASC(v[i], v[l]); } }
}
__device__ __forceinline__ void bitonic_merge16_desc(int (&v)[16]) {
#pragma unroll
    for (int j = 8; j > 0; j >>= 1)
#pragma unroll
        for (int i = 0; i < 16; ++i) { const int l = i ^ j; if (l > i) CE_DESC(v[i], v[l]); }
}
__device__ __forceinline__ void top16_merge(int (&a)[16], const int (&b)[16]) {
#pragma unroll
    for (int i = 0; i < 16; ++i) a[i] = max(a[i], b[15 - i]);
    bitonic_merge16_desc(a);
}
#define CEF_DESC(a, b) do { const float _hi = fmaxf(a, b), _lo = fminf(a, b); a = _hi; b = _lo; } while (0)
#define CEF_ASC(a, b)  do { const float _hi = fmaxf(a, b), _lo = fminf(a, b); a = _lo; b = _hi; } while (0)
__device__ __forceinline__ void fbitonic_sort16_desc(float (&v)[16]) {
#pragma unroll
    for (int k = 2; k <= 16; k <<= 1)
#pragma unroll
        for (int j = k >> 1; j > 0; j >>= 1)
#pragma unroll
            for (int i = 0; i < 16; ++i) { const int l = i ^ j; if (l > i) { if ((i & k) == 0) CEF_DESC(v[i], v[l]); else CEF_ASC(v[i], v[l]); } }
}
__device__ __forceinline__ void fsort16_desc(float (&v)[16]) {
    CEF_DESC(v[0], v[13]); CEF_DESC(v[1], v[12]); CEF_DESC(v[2], v[15]); CEF_DESC(v[3], v[14]); CEF_DESC(v[4], v[8]); CEF_DESC(v[5], v[6]); CEF_DESC(v[7], v[11]); CEF_DESC(v[9], v[10]); CEF_DESC(v[0], v[5]); CEF_DESC(v[1], v[7]); CEF_DESC(v[2], v[9]); CEF_DESC(v[3], v[4]); CEF_DESC(v[6], v[13]); CEF_DESC(v[8], v[14]); CEF_DESC(v[10], v[15]); CEF_DESC(v[11], v[12]); CEF_DESC(v[0], v[1]); CEF_DESC(v[2], v[3]); CEF_DESC(v[4], v[5]); CEF_DESC(v[6], v[8]); CEF_DESC(v[7], v[9]); CEF_DESC(v[10], v[11]); CEF_DESC(v[12], v[13]); CEF_DESC(v[14], v[15]); CEF_DESC(v[0], v[2]); CEF_DESC(v[1], v[3]); CEF_DESC(v[4], v[10]); CEF_DESC(v[5], v[11]); CEF_DESC(v[6], v[7]); CEF_DESC(v[8], v[9]); CEF_DESC(v[12], v[14]); CEF_DESC(v[13], v[15]); CEF_DESC(v[1], v[2]); CEF_DESC(v[3], v[12]); CEF_DESC(v[4], v[6]); CEF_DESC(v[5], v[7]); CEF_DESC(v[8], v[10]); CEF_DESC(v[9], v[11]); CEF_DESC(v[13], v[14]); CEF_DESC(v[1], v[4]); CEF_DESC(v[2], v[6]); CEF_DESC(v[5], v[8]); CEF_DESC(v[7], v[10]); CEF_DESC(v[9], v[13]); CEF_DESC(v[11], v[14]); CEF_DESC(v[2], v[4]); CEF_DESC(v[3], v[6]); CEF_DESC(v[9], v[12]); CEF_DESC(v[11], v[13]); CEF_DESC(v[3], v[5]); CEF_DESC(v[6], v[8]); CEF_DESC(v[7], v[9]); CEF_DESC(v[10], v[12]); CEF_DESC(v[3], v[4]); CEF_DESC(v[5], v[6]); CEF_DESC(v[7], v[8]); CEF_DESC(v[9], v[10]); CEF_DESC(v[11], v[12]); CEF_DESC(v[6], v[7]); CEF_DESC(v[8], v[9]);
}
__device__ __forceinline__ void fbitonic_merge16_desc(float (&v)[16]) {
#pragma unroll
    for (int j = 8; j > 0; j >>= 1)
#pragma unroll
        for (int i = 0; i < 16; ++i) { const int l = i ^ j; if (l > i) CEF_DESC(v[i], v[l]); }
}
__device__ __forceinline__ void ftop16_merge(float (&a)[16], const float (&b)[16]) {
#pragma unroll
    for (int i = 0; i < 16; ++i) a[i] = fmaxf(a[i], b[15 - i]);
    fbitonic_merge16_desc(a);
}
__device__ __forceinline__ int packkey(float v, int idx) { const int f = __float_as_int(v); const int s = f ^ ((f >> 31) & 0x7fffffff); return (s & ~127) | (127 - idx); }
__device__ __forceinline__ float keyval(int k) { const int s = k & ~127; return __int_as_float(s ^ ((s >> 31) & 0x7fffffff)); }
__device__ __forceinline__ void top16_of_scores(const f32x16 (&acc)[4], int hclr, float (&L)[16]) {
    float M[16];
#pragma unroll
    for (int kt = 0; kt < 4; ++kt) {
        float v[16];
#pragma unroll
        for (int r = 0; r < 16; ++r) v[r] = __int_as_float(((__float_as_int(acc[kt][r]) & ~127) | (127 - (kt * 32 + (r & 3) + 8 * (r >> 2)))) & hclr);
        fsort16_desc(v);
        if (kt == 0) {
#pragma unroll
            for (int i = 0; i < 16; ++i) L[i] = v[i];
        } else ftop16_merge(L, v);
    }
#pragma unroll
    for (int i = 0; i < 16; ++i) M[i] = __shfl_xor(L[i], 32);
    ftop16_merge(L, M);
}
__device__ __forceinline__ void phase_topk(KP kp, LAS unsigned char* lds, int wave_s) {
    const int lane = lane_id_asm(), wave = wave_s, tid = wave * 64 + lane;
    unsigned char* ws = kp->ws;
    const bf16_t* Q = (const bf16_t*)(ws + WS_SG);
    int* IDX = (int*)(ws + WS_IDX); float* GATE = (float*)(ws + WS_GATE);
    LAS unsigned* stg = (LAS unsigned*)(lds + 65536);
    for (int e = tid; e < 2 * 32 * 64; e += NTHREADS) {
        const int f = e >> 6, l = e & 63, set = f >> 5, kt = (f >> 3) & 3, ks = f & 7;
        const float* src = (set ? kp->in[19] : kp->in[18]) + (kt * 32 + (l & 31)) * 128 + ks * 16 + 8 * (l >> 5);
        const f32x4 a = *(const f32x4*)src, b = *(const f32x4*)(src + 4);
        u32x4 w; w.x = cvt_pk_bf16(a[0], a[1]); w.y = cvt_pk_bf16(a[2], a[3]); w.z = cvt_pk_bf16(b[0], b[1]); w.w = cvt_pk_bf16(b[2], b[3]);
        *(LAS u32x4*)(lds + (size_t)e * 16) = w;
    }
    __syncthreads();
    const int h = lane >> 5;
    pg8::StaticOrder SO; SO.init(T, 2048, gridDim.x, blockIdx.x);
    pg8::Unit uu;
    for (int ui = 0; SO.next(ui, uu); ++ui) {
        const int tile = uu.pm, head = uu.pn;
        const int tok = tile * 256 + wave * 32 + (lane & 31);
        const bf16_t* qfrag = Q + ((size_t)(tile * 8 + head) * 128 + (size_t)wave * 16) * 512 + lane * 8;
        float L1[16], L2[16];
#pragma unroll
        for (int set = 0; set < 2; ++set) {
            f32x16 acc[4];
#pragma unroll
            for (int kt = 0; kt < 4; ++kt)
#pragma unroll
                for (int r = 0; r < 16; ++r) acc[kt][r] = 0.f;
#pragma unroll
            for (int ks = 0; ks < 8; ++ks) {
                const bf16x8 bq = *(const bf16x8*)(qfrag + (set * 8 + ks) * 512);
#pragma unroll
                for (int kt = 0; kt < 4; ++kt) {
                    const bf16x8 ak = *(const LAS bf16x8*)(lds + (size_t)((((set * 4 + kt) * 8 + ks) * 64) + lane) * 16);
                    acc[kt] = __builtin_amdgcn_mfma_f32_32x32x16_bf16(ak, bq, acc[kt], 0, 0, 0);
                }
            }
#ifdef DBG_VALU_SCORES
            {   const float* keys = set ? kp->in[19] : kp->in[18];
                const bf16_t* qr = Q + (size_t)tok * 2048 + head * 256 + set * 128;
                for (int kt = 0; kt < 4; ++kt)
                    for (int r = 0; r < 16; ++r) {
                        const int idx = kt * 32 + (r & 3) + 8 * (r >> 2) + 4 * h; float sacc = 0.f;
                        for (int k = 0; k < 128; ++k) sacc += __uint_as_float(((unsigned)qr[k]) << 16) * keys[idx * 128 + k];
#pragma unroll
                        for (int kk = 0; kk < 4; ++kk)
#pragma unroll
                            for (int rr = 0; rr < 16; ++rr) if (kk == kt && rr == r) acc[kk][rr] = sacc;
                    }
            }
#endif
            if (set == 0) top16_of_scores(acc, ~(4 * h), L1); else top16_of_scores(acc, ~(4 * h), L2);
        }
        float v1[16], v2[16]; int i1[16], i2[16];
#pragma unroll
        for (int i = 0; i < 16; ++i) { const int k1 = __float_as_int(L1[i]), k2 = __float_as_int(L2[i]); v1[i] = __int_as_float(k1 & ~127); i1[i] = 127 - (k1 & 127); v2[i] = __int_as_float(k2 & ~127); i2[i] = 127 - (k2 & 127); }
        float thr, mx;
        {
            float A[16], B[16], C[16], Dd[16];
#pragma unroll
            for (int j = 0; j < 16; ++j) A[j] = v1[0] + v2[j];
#pragma unroll
            for (int j = 0; j < 8; ++j) { B[j] = v1[1] + v2[j]; B[8 + j] = v1[15 - j] + v2[0]; }
            fbitonic_merge16_desc(B);
            C[0] = v1[2] + v2[0]; C[1] = v1[2] + v2[1]; C[2] = v1[2] + v2[2]; C[3] = v1[2] + v2[3]; C[4] = v1[2] + v2[4];
            C[5] = v1[3] + v2[0]; C[6] = v1[3] + v2[1]; C[7] = v1[3] + v2[2]; C[8] = v1[3] + v2[3];
            C[9] = v1[4] + v2[0]; C[10] = v1[4] + v2[1]; C[11] = v1[4] + v2[2];
            C[12] = v1[5] + v2[0]; C[13] = v1[5] + v2[1]; C[14] = v1[6] + v2[0]; C[15] = v1[6] + v2[1];
            fsort16_desc(C);
            Dd[0] = v1[7] + v2[0]; Dd[1] = v1[7] + v2[1];
#pragma unroll
            for (int j = 2; j < 16; ++j) Dd[j] = -3.0e38f;
            ftop16_merge(A, B); ftop16_merge(C, Dd);
            mx = fmaxf(A[0], C[0]);
            float t = fmaxf(A[0], C[15]);
#pragma unroll
            for (int i = 1; i < 16; ++i) t = fminf(t, fmaxf(A[i], C[15 - i]));
            thr = t;
        }
        if (h == 0) {
            LAS unsigned* row = stg + (wave * 32 + (lane & 31)) * 44;
            int cnt = 0; float sum = 0.f;
#pragma unroll
            for (int i = 0; i < 16; ++i)
#pragma unroll
                for (int j = 0; j < 16; ++j) if ((i + 1) * (j + 1) <= 16) {
                    const float x = v1[i] + v2[j];
                    const bool pr = (x >= thr) && (cnt < 16);
                    const float ev = __expf(x - mx);
                    const int pos = pr ? cnt : 16;
                    row[pos] = (unsigned)(i1[i] * 128 + i2[j]); row[20 + pos] = __float_as_uint(ev);
                    sum += pr ? ev : 0.f; cnt += pr ? 1 : 0;
                }
            const float inv = 1.0f / sum;
            u32x4* ip = (u32x4*)(IDX + ((size_t)tok * 8 + head) * 16); f32x4* gp = (f32x4*)(GATE + ((size_t)tok * 8 + head) * 16);
#pragma unroll
            for (int q = 0; q < 4; ++q) {
                ip[q] = *(const LAS u32x4*)(row + 4 * q);
                const u32x4 gu = *(const LAS u32x4*)(row + 20 + 4 * q);
                gp[q] = (f32x4){__uint_as_float(gu.x) * inv, __uint_as_float(gu.y) * inv, __uint_as_float(gu.z) * inv, __uint_as_float(gu.w) * inv};
            }
        }
    }
    {
        const bf16_t* XA = (const bf16_t*)(ws + WS_H); const float* SSQ = (const float*)(ws + WS_SSQ); const float* mod = (const float*)(ws + WS_MOD);
        unsigned char* HB = ws + WS_HB; f32x2* HS = (f32x2*)(ws + WS_HS);
        for (int tk = blockIdx.x * 8 + wave; tk < T; tk += gridDim.x * 8) {
            const u32x4* xp = (const u32x4*)(XA + (size_t)tk * D + 16 * lane); const u32x4 xa0 = xp[0], xa1 = xp[1];
            const f32x4* sp = (const f32x4*)(mod + (size_t)(tk / SEQ) * NMOD + 3 * 1024 + 16 * lane);
            const f32x4 s0v = sp[0], s1v = sp[1], s2v = sp[2], s3v = sp[3];
            const float rr = rsqrtf(SSQ[tk] * (1.0f / D) + EPS);
            const unsigned xw[8] = {xa0.x, xa0.y, xa0.z, xa0.w, xa1.x, xa1.y, xa1.z, xa1.w};
            const float sh[16] = {s0v[0], s0v[1], s0v[2], s0v[3], s1v[0], s1v[1], s1v[2], s1v[3], s2v[0], s2v[1], s2v[2], s2v[3], s3v[0], s3v[1], s3v[2], s3v[3]};
            float hv[16]; float am = 0.f;
#pragma unroll
            for (int i = 0; i < 8; ++i) { hv[2 * i] = bf_lo(xw[i]) * rr + sh[2 * i]; hv[2 * i + 1] = bf_hi(xw[i]) * rr + sh[2 * i + 1]; am = fmaxf(am, fmaxf(fabsf(hv[2 * i]), fabsf(hv[2 * i + 1]))); }
            am = wave_max(am);
            const float q0 = am > 0.f ? 6.0f / am : 0.f, d0 = am * (1.0f / 6.0f);
            unsigned w0[2] = {0u, 0u}, w1[2] = {0u, 0u}; float rv[16]; float am1 = 0.f;
#pragma unroll
            for (int i = 0; i < 8; ++i) {
                const int wi = i >> 2, bs = i & 3;
                if (bs == 0) w0[wi] = __builtin_amdgcn_cvt_scalef32_pk_fp4_f32(w0[wi], hv[2 * i] * q0, hv[2 * i + 1] * q0, 1.0f, 0);
                else if (bs == 1) w0[wi] = __builtin_amdgcn_cvt_scalef32_pk_fp4_f32(w0[wi], hv[2 * i] * q0, hv[2 * i + 1] * q0, 1.0f, 1);
                else if (bs == 2) w0[wi] = __builtin_amdgcn_cvt_scalef32_pk_fp4_f32(w0[wi], hv[2 * i] * q0, hv[2 * i + 1] * q0, 1.0f, 2);
                else w0[wi] = __builtin_amdgcn_cvt_scalef32_pk_fp4_f32(w0[wi], hv[2 * i] * q0, hv[2 * i + 1] * q0, 1.0f, 3);
            }
#pragma unroll
            for (int i = 0; i < 8; ++i) {
                const int wi = i >> 2, bs = i & 3;
                const f32x2 dq = bs == 0 ? __builtin_amdgcn_cvt_scalef32_pk_f32_fp4(w0[wi], 1.0f, 0) : bs == 1 ? __builtin_amdgcn_cvt_scalef32_pk_f32_fp4(w0[wi], 1.0f, 1) : bs == 2 ? __builtin_amdgcn_cvt_scalef32_pk_f32_fp4(w0[wi], 1.0f, 2) : __builtin_amdgcn_cvt_scalef32_pk_f32_fp4(w0[wi], 1.0f, 3);
                rv[2 * i] = hv[2 * i] - dq.x * d0; rv[2 * i + 1] = hv[2 * i + 1] - dq.y * d0;
                am1 = fmaxf(am1, fmaxf(fabsf(rv[2 * i]), fabsf(rv[2 * i + 1])));
            }
            am1 = wave_max(am1);
            const float q1 = am1 > 0.f ? 6.0f / am1 : 0.f, d1 = am1 * (1.0f / 6.0f);
#pragma unroll
            for (int i = 0; i < 8; ++i) {
                const int wi = i >> 2, bs = i & 3;
                if (bs == 0) w1[wi] = __builtin_amdgcn_cvt_scalef32_pk_fp4_f32(w1[wi], rv[2 * i] * q1, rv[2 * i + 1] * q1, 1.0f, 0);
                else if (bs == 1) w1[wi] = __builtin_amdgcn_cvt_scalef32_pk_fp4_f32(w1[wi], rv[2 * i] * q1, rv[2 * i + 1] * q1, 1.0f, 1);
                else if (bs == 2) w1[wi] = __builtin_amdgcn_cvt_scalef32_pk_fp4_f32(w1[wi], rv[2 * i] * q1, rv[2 * i + 1] * q1, 1.0f, 2);
                else w1[wi] = __builtin_amdgcn_cvt_scalef32_pk_fp4_f32(w1[wi], rv[2 * i] * q1, rv[2 * i + 1] * q1, 1.0f, 3);
            }
            const int sb = lane >> 3, qq = (lane & 7) >> 1, hf8 = lane & 1;
            unsigned char* hb = HB + (size_t)tk * 1024 + (sb * 4 + qq) * 16 + hf8 * 8;
            *(u32x2*)hb = (u32x2){w0[0], w0[1]};
            *(u32x2*)(hb + 512) = (u32x2){w1[0], w1[1]};
            if (lane == 0) HS[tk] = (f32x2){d0, d1};
        }
    }
}

__device__ __forceinline__ float gelu_tanh(float x) {
    const float y = 0.7978845608028654f * (x + 0.044715f * x * x * x);
    return x * fast_sigmoid(2.0f * y);
}
typedef int i32x8 __attribute__((ext_vector_type(8)));
#define DPPF(x, ctrl) __int_as_float(__builtin_amdgcn_update_dpp(0, __float_as_int(x), ctrl, 0xF, 0xF, true))
struct TokMeta { u32x4 hb; f32x2 hs; int e0, e1; float g0, g1, cu0, cu1, sv0, sv1; u32x4 x1[2]; f32x4 g2[4]; };
__device__ __forceinline__ void peer_load_meta(TokMeta& m, int tok, int lane, const unsigned char* HB, const f32x2* HS, const int* IDX, const float* GATE, const bf16_t* X1, const float* modp) {
    { const u32x4* xp = (const u32x4*)(X1 + (size_t)tok * D + 16 * lane); m.x1[0] = xp[0]; m.x1[1] = xp[1];
      const f32x4* gp = (const f32x4*)(modp + (size_t)(tok / SEQ) * NMOD + 5 * 1024 + 16 * lane); m.g2[0] = gp[0]; m.g2[1] = gp[1]; m.g2[2] = gp[2]; m.g2[3] = gp[3]; }
    m.hb = *(const u32x4*)(HB + (size_t)tok * 1024 + ((lane & 15) * 4 + (lane >> 4)) * 16);
    m.hs = HS[tok];
    m.e0 = IDX[(size_t)tok * 128 + lane]; m.e1 = IDX[(size_t)tok * 128 + 64 + lane];
    m.g0 = GATE[(size_t)tok * 128 + lane]; m.g1 = GATE[(size_t)tok * 128 + 64 + lane];
}
__device__ __forceinline__ void peer_load_scales(TokMeta& m, const float* SU, const float* SV) { m.cu0 = SU[m.e0]; m.cu1 = SU[m.e1]; m.sv0 = SV[m.e0]; m.sv1 = SV[m.e1]; }
typedef RowFmt<V_BITS>::row_t vrow_t;
#define PEER_LOAD(UQ, VQ, g) do { const int bb_ = (g) & 15; const bool nx_ = (g) >= 16; \
        const int src_ = bb_ < 8 ? (nx_ ? mn.e0 : m.e0) : (nx_ ? mn.e1 : m.e1); \
        _Pragma("unroll") for (int j_ = 0; j_ < 4; ++j_) { \
            const int ea_ = __builtin_amdgcn_readlane(src_, (8 * bb_ + 2 * j_) & 63), eb_ = __builtin_amdgcn_readlane(src_, (8 * bb_ + 2 * j_ + 1) & 63); \
            UQ[j_] = __builtin_bit_cast(u32x4, __builtin_amdgcn_raw_buffer_load_b128(rsU, ((mhi ? eb_ : ea_) << 9) + uoff, 0, 0)); \
            VQ[2 * j_] = __builtin_bit_cast(u32x2, __builtin_amdgcn_raw_buffer_load_b64(rsV, lane * 8, ea_ << 9, 0)); \
            VQ[2 * j_ + 1] = __builtin_bit_cast(u32x2, __builtin_amdgcn_raw_buffer_load_b64(rsV, lane * 8, eb_ << 9, 0)); } } while (0)
#define PEER_COMPUTE(UQ, VQ, bt) do { \
        float x_[4]; \
        _Pragma("unroll") for (int j_ = 0; j_ < 4; ++j_) { \
            const i32x8 a_ = {(int)UQ[j_].x, (int)UQ[j_].y, (int)UQ[j_].z, (int)UQ[j_].w, 0, 0, 0, 0}; \
            const f32x4 d_ = __builtin_amdgcn_mfma_scale_f32_16x16x128_f8f6f4(a_, hbv, (f32x4){0.f, 0.f, 0.f, 0.f}, 4, 4, 0, 0x7f7f7f7f, 0, 0x7f7f7f7f); \
            const float s_ = r0 ? d_[0] : r1 ? d_[1] : r2 ? d_[2] : d_[3]; \
            x_[j_] = s_ * st; } \
        float y2[2], q1; \
        _Pragma("unroll") for (int k_ = 0; k_ < 2; ++k_) { const float a_ = b4 ? x_[k_ + 2] : x_[k_], sd_ = b4 ? x_[k_] : x_[k_ + 2]; y2[k_] = a_ + __shfl_xor(sd_, 16); } \
        { const float a_ = b3 ? y2[1] : y2[0], sd_ = b3 ? y2[0] : y2[1]; q1 = a_ + DPPF(sd_, 0x128); }                  \
        q1 += DPPF(q1, 0xB1); q1 += DPPF(q1, 0x4E); q1 += DPPF(q1, 0x141);                                            \
        const int slot_ = (8 * (bt) + jj) & 63; \
        const float cu_ = __shfl((bt) < 8 ? m.cu0 : m.cu1, slot_), cv_ = __shfl((bt) < 8 ? m.g0 * m.sv0 : m.g1 * m.sv1, slot_); \
        const float c_ = gelu_tanh(q1 * cu_) * cv_; \
        _Pragma("unroll") for (int j_ = 0; j_ < 8; ++j_) { \
            const float cj_ = __int_as_float(__builtin_amdgcn_readlane(__float_as_int(c_), 32 * (j_ & 1) + 8 * ((j_ >> 1) & 1) + 16 * ((j_ >> 2) & 1))); \
            row_axpy16(VQ[j_], cj_, o); } } while (0)
__device__ __forceinline__ void phase_peer(KP kp, int wave_s) {
    const int lane = lane_id_asm(), wave = wave_s;
    unsigned char* ws = kp->ws;
    const __amdgpu_buffer_rsrc_t rsU = __builtin_amdgcn_make_buffer_rsrc((void*)(ws + WS_EU), 0, NEXP * U_BITS * 128, 0x00020000);
    const __amdgpu_buffer_rsrc_t rsV = __builtin_amdgcn_make_buffer_rsrc((void*)(ws + WS_EV), 0, NEXP * V_BITS * 128, 0x00020000);
    const unsigned char* HB = ws + WS_HB; const f32x2* HS = (const f32x2*)(ws + WS_HS);
    const int* IDX = (const int*)(ws + WS_IDX); const float* GATE = (const float*)(ws + WS_GATE);
    const float* SU = (const float*)(ws + WS_SU); const float* SV = (const float*)(ws + WS_SV);
    const float* mod = (const float*)(ws + WS_MOD); const float* fg = kp->in[22];
    const bf16_t* X1 = (const bf16_t*)(ws + WS_X1B); float* OUT = kp->out;
    const bool b5 = lane & 32, b4 = lane & 16, b3 = lane & 8;
    const int jj = 4 * (b4 ? 1 : 0) + 2 * (b3 ? 1 : 0) + (b5 ? 1 : 0);
    const int nn = lane & 15, qq = lane >> 4;
    const bool mhi = nn >= 8;
    const int uoff = 64 * (nn & 7) + 16 * qq;
    const bool useful = ((nn & 7) >> 2) == (qq & 1);
    const bool r0 = (nn & 3) == 0, r1 = (nn & 3) == 1, r2 = (nn & 3) == 2;
    const int tstride = gridDim.x * 8;
    int tok = blockIdx.x * 8 + wave;
    f32x4 fgv[4];
#pragma unroll
    for (int q = 0; q < 4; ++q) fgv[q] = *(const f32x4*)(fg + 16 * lane + 4 * q);
    TokMeta m, mn;
    u32x4 uqA[4], uqB[4]; vrow_t vqA[8], vqB[8];
    if (tok < T) { peer_load_meta(m, tok, lane, HB, HS, IDX, GATE, X1, mod); peer_load_scales(m, SU, SV); mn = m; PEER_LOAD(uqA, vqA, 0); }
    for (; tok < T; tok += tstride) {
        const int b = tok / SEQ;
        const bool has_next = tok + tstride < T;
        if (has_next) peer_load_meta(mn, tok + tstride, lane, HB, HS, IDX, GATE, X1, mod);
        const i32x8 hbv = {(int)m.hb.x, (int)m.hb.y, (int)m.hb.z, (int)m.hb.w, 0, 0, 0, 0};
        const float st = useful ? ((nn >> 3) ? m.hs.y : m.hs.x) : 0.f;
        f32x2 o[8];
#pragma unroll
        for (int i = 0; i < 8; ++i) o[i] = (f32x2){0.f, 0.f};
#pragma unroll 1
        for (int bt = 0; bt < 16; bt += 2) {
            PEER_LOAD(uqB, vqB, bt + 1);
            PEER_COMPUTE(uqA, vqA, bt);
            PEER_LOAD(uqA, vqA, bt + 2);
            PEER_COMPUTE(uqB, vqB, bt + 1);
        }
        if (has_next) peer_load_scales(mn, SU, SV);
        float* xr = OUT + (size_t)tok * D + 16 * lane;
        const unsigned xw[8] = {m.x1[0].x, m.x1[0].y, m.x1[0].z, m.x1[0].w, m.x1[1].x, m.x1[1].y, m.x1[1].z, m.x1[1].w};
        f32x4 xv[4]; float ss = 0.f;
#pragma unroll
        for (int q = 0; q < 4; ++q) {
            const f32x4 x1v = {bf_lo(xw[2 * q]), bf_hi(xw[2 * q]), bf_lo(xw[2 * q + 1]), bf_hi(xw[2 * q + 1])}, gv = m.g2[q];
            xv[q][0] = x1v[0] + gv[0] * o[2 * q].x; xv[q][1] = x1v[1] + gv[1] * o[2 * q].y; xv[q][2] = x1v[2] + gv[2] * o[2 * q + 1].x; xv[q][3] = x1v[3] + gv[3] * o[2 * q + 1].y;
            ss += xv[q][0] * xv[q][0] + xv[q][1] * xv[q][1] + xv[q][2] * xv[q][2] + xv[q][3] * xv[q][3];
        }
        ss = wave_sum(ss);
        const float r = rsqrtf(ss * (1.0f / D) + EPS);
#pragma unroll
        for (int q = 0; q < 4; ++q) *(f32x4*)(xr + 4 * q) = xv[q] * r * fgv[q];
        m = mn;
    }
}

__device__ __forceinline__ void sort_words(unsigned& w0, unsigned& w1, int lane, LAS unsigned* scr) {
#pragma unroll
    for (int bit = 10; bit < 14; ++bit) {
        const bool z0 = ((w0 >> bit) & 1u) == 0u, z1 = ((w1 >> bit) & 1u) == 0u;
        const unsigned long long m0 = __ballot(z0), m1 = __ballot(z1);
        const int nz0 = __popcll(m0), nz = nz0 + __popcll(m1);
        const int r0 = __builtin_amdgcn_mbcnt_hi((unsigned)(m0 >> 32), __builtin_amdgcn_mbcnt_lo((unsigned)m0, 0u));
        const int r1 = __builtin_amdgcn_mbcnt_hi((unsigned)(m1 >> 32), __builtin_amdgcn_mbcnt_lo((unsigned)m1, 0u));
        const int p0 = z0 ? r0 : nz + lane - r0;
        const int p1 = z1 ? nz0 + r1 : nz + 64 - nz0 + lane - r1;
        scr[p0] = w0; scr[p1] = w1;
        asm volatile("" ::: "memory");
        w0 = scr[lane]; w1 = scr[64 + lane];
        asm volatile("" ::: "memory");
    }
}
struct UTok { u32x4 hb; f32x2 hs; unsigned s0, s1; };
#define PU_LOAD(UQ, k, g) do { const int bb_ = (g) & 15; const bool nx_ = (g) >= 16; \
        const unsigned src_ = bb_ < 8 ? (nx_ ? nxt[k].s0 : cur[k].s0) : (nx_ ? nxt[k].s1 : cur[k].s1); \
        _Pragma("unroll") for (int j_ = 0; j_ < 4; ++j_) { \
            const int id_ = __builtin_amdgcn_ds_bpermute(4 * (((8 * bb_) & 63) + 2 * j_) + slotb, (int)src_) & 0x3fff; \
            UQ[j_] = __builtin_bit_cast(u32x4, __builtin_amdgcn_raw_buffer_load_b128(rsU, (id_ << 9) + uoff, 0, 0)); } } while (0)
#define PU_COMPUTE(UQ, k, bt) do { \
        const i32x8 hbv = {(int)cur[k].hb.x, (int)cur[k].hb.y, (int)cur[k].hb.z, (int)cur[k].hb.w, 0, 0, 0, 0}; const float st = cur[k].hs.x; \
        float x_[4]; \
        _Pragma("unroll") for (int j_ = 0; j_ < 4; ++j_) { \
            const i32x8 a_ = {(int)UQ[j_].x, (int)UQ[j_].y, (int)UQ[j_].z, (int)UQ[j_].w, 0, 0, 0, 0}; \
            const f32x4 d_ = __builtin_amdgcn_mfma_scale_f32_16x16x128_f8f6f4(a_, hbv, (f32x4){0.f, 0.f, 0.f, 0.f}, 4, 4, 0, 0x7f7f7f7f, 0, 0x7f7f7f7f); \
            x_[j_] = (d_[0] * lm0 + d_[1] * lm1 + d_[2] * lm2 + d_[3] * lm3) * st; } \
        float y2[2], q1; \
        _Pragma("unroll") for (int k_ = 0; k_ < 2; ++k_) { const float a_ = b4 ? x_[k_ + 2] : x_[k_], sd_ = b4 ? x_[k_] : x_[k_ + 2]; y2[k_] = a_ + __shfl_xor(sd_, 16); } \
        { const float a_ = b3 ? y2[1] : y2[0], sd_ = b3 ? y2[0] : y2[1]; q1 = a_ + DPPF(sd_, 0x128); } \
        q1 += DPPF(q1, 0xB1); q1 += DPPF(q1, 0x4E); q1 += DPPF(q1, 0x141); \
        const float qs_ = __shfl(q1, srcl);                                     \
        const bool mine_ = (lane >> 3) == ((bt) & 7); \
        if ((bt) < 8) qs0[k] = mine_ ? qs_ : qs0[k]; else qs1[k] = mine_ ? qs_ : qs1[k]; } while (0)
__device__ __forceinline__ void peer_u_raw(UTok& t, int tok, int lane, const unsigned char* HB, const f32x2* HS, const int* IDX) {
    t.hb = *(const u32x4*)(HB + (size_t)tok * 1024 + ((lane & 15) >> 3) * 512 + (lane & 7) * 16 + (lane >> 4) * 128);
    t.hs = HS[tok];
    t.s0 = (unsigned)IDX[(size_t)tok * 128 + lane] | ((unsigned)lane << 14); t.s1 = (unsigned)IDX[(size_t)tok * 128 + 64 + lane] | ((unsigned)(64 + lane) << 14);
}
__device__ __forceinline__ void phase_peer_u(KP kp, LAS unsigned char* lds, int wave_s) {
    const int lane = lane_id_asm(), wave = wave_s;
    unsigned char* ws = kp->ws;
    const __amdgpu_buffer_rsrc_t rsU = __builtin_amdgcn_make_buffer_rsrc((void*)(ws + WS_EU), 0, NEXP * U_BITS * 128, 0x00020000);
    const unsigned char* HB = ws + WS_HB; const f32x2* HS = (const f32x2*)(ws + WS_HS);
    const int* IDX = (const int*)(ws + WS_IDX); const float* GATE = (const float*)(ws + WS_GATE);
    const float* SU = (const float*)(ws + WS_SU); const float* SV = (const float*)(ws + WS_SV);
    LAS unsigned* scr = (LAS unsigned*)(lds + wave * 2048);
    const bool b4 = lane & 16, b3 = lane & 8;
    const int srcl = 32 * (lane & 1) + 16 * ((lane >> 2) & 1) + 8 * ((lane >> 1) & 1);
    const int nn = lane & 15, qq = lane >> 4;
    const int uoff = 16 * (nn & 7) + 128 * qq;
    const int slotb = 4 * (nn >> 3);
    const bool useful = ((nn & 7) >> 2) == (qq & 1);
    const float lm0 = (nn & 3) == 0 ? 1.f : 0.f, lm1 = (nn & 3) == 1 ? 1.f : 0.f, lm2 = (nn & 3) == 2 ? 1.f : 0.f, lm3 = (nn & 3) == 3 ? 1.f : 0.f;
    const int tstride = gridDim.x * 8;
    int tok0 = blockIdx.x * 8 + wave;
    if (tok0 < T) {
        UTok cur[4], nxt[4];
        u32x4 uq[4][4];
#pragma unroll
        for (int k = 0; k < 4; ++k) { const int tk = tok0 + k * tstride; peer_u_raw(cur[k], tk < T ? tk : tok0, lane, HB, HS, IDX); }
#pragma unroll
        for (int k = 0; k < 4; ++k) { sort_words(cur[k].s0, cur[k].s1, lane, scr + k * 128); cur[k].hs.x = useful ? ((nn >> 3) ? cur[k].hs.y : cur[k].hs.x) : 0.f; nxt[k] = cur[k]; }
        PU_LOAD(uq[0], 0, 0); PU_LOAD(uq[1], 1, 0); PU_LOAD(uq[2], 2, 0);
        for (; tok0 < T; tok0 += 4 * tstride) {
            const bool has_next = tok0 + 4 * tstride < T;
            if (has_next) {
#pragma unroll
                for (int k = 0; k < 4; ++k) { const int tk = tok0 + (4 + k) * tstride; peer_u_raw(nxt[k], tk < T ? tk : tok0 + 4 * tstride, lane, HB, HS, IDX); }
            }
            float g0[4], g1[4], cu0[4], cu1[4], sv0[4], sv1[4];
#pragma unroll
            for (int k = 0; k < 4; ++k) { const int tk = tok0 + k * tstride < T ? tok0 + k * tstride : tok0;
                const int i0 = cur[k].s0 & 0x3fff, i1 = cur[k].s1 & 0x3fff;
                g0[k] = GATE[(size_t)tk * 128 + (cur[k].s0 >> 14)]; g1[k] = GATE[(size_t)tk * 128 + (cur[k].s1 >> 14)];
                cu0[k] = SU[i0]; cu1[k] = SU[i1]; sv0[k] = SV[i0]; sv1[k] = SV[i1]; }
            float qs0[4] = {0.f, 0.f, 0.f, 0.f}, qs1[4] = {0.f, 0.f, 0.f, 0.f};
#pragma unroll 1
            for (int bt = 0; bt < 16; ++bt) {
                if (bt == 8 && has_next) {
#pragma unroll
                    for (int k = 0; k < 4; ++k) { sort_words(nxt[k].s0, nxt[k].s1, lane, scr + k * 128); nxt[k].hs.x = useful ? ((nn >> 3) ? nxt[k].hs.y : nxt[k].hs.x) : 0.f; }
                }
                PU_LOAD(uq[3], 3, bt);     PU_COMPUTE(uq[0], 0, bt);
                PU_LOAD(uq[0], 0, bt + 1); PU_COMPUTE(uq[1], 1, bt);
                PU_LOAD(uq[1], 1, bt + 1); PU_COMPUTE(uq[2], 2, bt);
                PU_LOAD(uq[2], 2, bt + 1); PU_COMPUTE(uq[3], 3, bt);
            }
#pragma unroll
            for (int k = 0; k < 4; ++k) { const int tok = tok0 + k * tstride;
                if (tok < T) {
                    const int e0 = (int)(cur[k].s0 & 0x3fff), e1 = (int)(cur[k].s1 & 0x3fff);
                    const float c0 = gelu_tanh(qs0[k] * cu0[k]) * (g0[k] * sv0[k]), c1 = gelu_tanh(qs1[k] * cu1[k]) * (g1[k] * sv1[k]);
                    float cm = fmaxf(fabsf(c0), fabsf(c1));
            cm = wave_max(cm);
                    const float f = cm > 0.f ? 256.0f / cm : 0.f;
                    const unsigned pk = (unsigned)__builtin_amdgcn_cvt_pk_fp8_f32(c0 * f, c1 * f, 0, false) & 0xffffu;
                    const unsigned nbe0 = (unsigned)__builtin_amdgcn_update_dpp(0, e0, 0xB1, 0xF, 0xF, true), nbe1 = (unsigned)__builtin_amdgcn_update_dpp(0, e1, 0xB1, 0xF, 0xF, true);
                    if (!(lane & 1)) {
                        const int p = lane >> 1, o0 = (p & 3) * 16 + (p >> 2), o1 = (p & 3) * 16 + 8 + (p >> 2);
                        unsigned* IDP = (unsigned*)(ws + WS_IDP) + (size_t)tok * 64;
                        IDP[o0] = (unsigned)e0 | (nbe0 << 16); IDP[o1] = (unsigned)e1 | (nbe1 << 16);
                    }
                    const unsigned nb4 = (unsigned)__shfl((int)pk, lane + 4);
                    if ((lane & 7) < 4) {
                        unsigned short* COP = (unsigned short*)(ws + WS_COP) + (size_t)tok * 64 + (lane & 3) * 16 + (lane >> 3);
                        COP[0] = (unsigned short)((pk & 0xffu) | ((nb4 & 0xffu) << 8)); COP[8] = (unsigned short)(((pk >> 8) & 0xffu) | (nb4 & 0xff00u));
                    }
                    if (lane == 0) ((float*)(ws + WS_CS))[tok] = cm * (1.0f / 256.0f);
                }
                cur[k] = nxt[k]; }
        }
    }
}
#define PV_LOADG(RB, k, g) do { const int gg_ = (g) & 15; \
        const unsigned pr_ = ((g) >= 16 ? mnx : mcu)[(k) * 96 + qq * 16 + gg_]; \
        cfr[k] = ((g) >= 16 ? mnx : mcu)[(k) * 96 + 64 + qq * 8 + (gg_ >> 1)]; \
        const int va_ = (int)((pr_ & 0xffffu) << 9) + lanebase, vb_ = (int)((pr_ >> 16) << 9) + lanebase; \
        _Pragma("unroll") for (int blk_ = 0; blk_ < 4; ++blk_) { \
            const u32x2 a_ = __builtin_bit_cast(u32x2, __builtin_amdgcn_raw_buffer_load_b64(rsV, va_ + 8 * (blk_ & 1) + 256 * (blk_ >> 1), 0, 0)); \
            const u32x2 b_ = __builtin_bit_cast(u32x2, __builtin_amdgcn_raw_buffer_load_b64(rsV, vb_ + 8 * (blk_ & 1) + 256 * (blk_ >> 1), 0, 0)); \
            RB[blk_] = (u32x4){a_.x, a_.y, b_.x, b_.y}; } } while (0)
#define PV_COMPG(RB, k, g, CW) do { const unsigned cw_ = (CW); \
        const unsigned ra_ = ((g) & 1) ? __builtin_amdgcn_perm(cw_, cw_, 0x02020202u) : __builtin_amdgcn_perm(cw_, cw_, 0x00000000u); \
        const unsigned rb_ = ((g) & 1) ? __builtin_amdgcn_perm(cw_, cw_, 0x03030303u) : __builtin_amdgcn_perm(cw_, cw_, 0x01010101u); \
        const i32x8 A_ = {(int)(ra_ & mk0), (int)(ra_ & mk1), (int)(ra_ & mk2), (int)(ra_ & mk3), (int)(rb_ & mk0), (int)(rb_ & mk1), (int)(rb_ & mk2), (int)(rb_ & mk3)}; \
        _Pragma("unroll") for (int blk_ = 0; blk_ < 4; ++blk_) { \
            const i32x8 B_ = {(int)RB[blk_].x, (int)RB[blk_].y, (int)RB[blk_].z, (int)RB[blk_].w, 0, 0, 0, 0}; \
            acc[k][blk_] = __builtin_amdgcn_mfma_scale_f32_16x16x128_f8f6f4(A_, B_, acc[k][blk_], 0, 4, 0, 0x7f7f7f7f, 0, 0x7f7f7f7f); } } while (0)
__device__ __forceinline__ void phase_peer_v(KP kp, LAS unsigned char* lds, int wave_s) {
    const int lane = lane_id_asm(), wave = wave_s;
    unsigned char* ws = kp->ws;
    const __amdgpu_buffer_rsrc_t rsV = __builtin_amdgcn_make_buffer_rsrc((void*)(ws + WS_EV), 0, NEXP * V_BITS * 128, 0x00020000);
    const float* mod = (const float*)(ws + WS_MOD); const float* fg = kp->in[22];
    const bf16_t* X1 = (const bf16_t*)(ws + WS_X1B); float* OUT = kp->out;
    const unsigned* IDP = (const unsigned*)(ws + WS_IDP); const unsigned* COP = (const unsigned*)(ws + WS_COP); const float* CS = (const float*)(ws + WS_CS);
    const int nn = lane & 15, qq = lane >> 4;
    const int lanebase = 16 * nn;
    const unsigned msel = 0xFFu << (8 * (nn & 3));
    const unsigned mk0 = (nn >> 2) == 0 ? msel : 0u, mk1 = (nn >> 2) == 1 ? msel : 0u, mk2 = (nn >> 2) == 2 ? msel : 0u, mk3 = (nn >> 2) == 3 ? msel : 0u;
    const int col0 = 32 * nn + 4 * qq;
    const int tstride = gridDim.x * 8;
    int tok0 = blockIdx.x * 8 + wave;
    LAS unsigned* mcu = (LAS unsigned*)(lds + wave * 3072);
    LAS unsigned* mnx = mcu + 384;
    if (tok0 < T) {
        unsigned idw[4], cfw[4]; float csc[4], csn[4];
#pragma unroll
        for (int k = 0; k < 4; ++k) { const int tk = tok0 + k * tstride < T ? tok0 + k * tstride : tok0;
            idw[k] = IDP[(size_t)tk * 64 + lane]; cfw[k] = COP[(size_t)tk * 32 + (lane & 31)]; csc[k] = CS[tk]; csn[k] = csc[k]; }
#pragma unroll
        for (int k = 0; k < 4; ++k) { mcu[k * 96 + lane] = idw[k]; if (lane < 32) mcu[k * 96 + 64 + lane] = cfw[k]; mnx[k * 96 + lane] = idw[k]; if (lane < 32) mnx[k * 96 + 64 + lane] = cfw[k]; }
        asm volatile("" ::: "memory");
        u32x4 rb0[4], rb1[4], rb2[4], rb3[4]; unsigned cfr[4];
        PV_LOADG(rb0, 0, 0); PV_LOADG(rb1, 1, 0); PV_LOADG(rb2, 2, 0);
        for (; tok0 < T; tok0 += 4 * tstride) {
            const bool has_next = tok0 + 4 * tstride < T;
            if (has_next) {
#pragma unroll
                for (int k = 0; k < 4; ++k) { const int tk = tok0 + (4 + k) * tstride < T ? tok0 + (4 + k) * tstride : tok0 + 4 * tstride;
                    idw[k] = IDP[(size_t)tk * 64 + lane]; cfw[k] = COP[(size_t)tk * 32 + (lane & 31)]; csn[k] = CS[tk]; }
            }
            f32x4 acc[4][4]; u32x2 xwa[4], xwb[4]; f32x4 gva[4], gvb[4];
#pragma unroll
            for (int k = 0; k < 4; ++k)
#pragma unroll
                for (int i = 0; i < 4; ++i) acc[k][i] = (f32x4){0.f, 0.f, 0.f, 0.f};
#pragma unroll 1
            for (int G = 0; G < 16; ++G) {
                if (G == 14) {
                    const bf16_t* xp = X1 + (size_t)tok0 * D + col0; const float* gp = mod + (size_t)(tok0 / SEQ) * NMOD + 5 * 1024 + col0;
#pragma unroll
                    for (int blk = 0; blk < 4; ++blk) { xwa[blk] = *(const u32x2*)(xp + 16 * (blk & 1) + 512 * (blk >> 1)); gva[blk] = *(const f32x4*)(gp + 16 * (blk & 1) + 512 * (blk >> 1)); }
                }
                if (G == 8) {
#pragma unroll
                    for (int k = 0; k < 4; ++k) { mnx[k * 96 + lane] = idw[k]; if (lane < 32) mnx[k * 96 + 64 + lane] = cfw[k]; }
                    asm volatile("" ::: "memory");
                }
                { const unsigned c_ = cfr[0]; PV_LOADG(rb3, 3, G);     PV_COMPG(rb0, 0, G, c_); }
                { const unsigned c_ = cfr[1]; PV_LOADG(rb0, 0, G + 1); PV_COMPG(rb1, 1, G, c_); }
                { const unsigned c_ = cfr[2]; PV_LOADG(rb1, 1, G + 1); PV_COMPG(rb2, 2, G, c_); }
                { const unsigned c_ = cfr[3]; PV_LOADG(rb2, 2, G + 1); PV_COMPG(rb3, 3, G, c_); }
            }
            f32x4 fgv[4];
#pragma unroll
            for (int blk = 0; blk < 4; ++blk) fgv[blk] = *(const f32x4*)(fg + col0 + 16 * (blk & 1) + 512 * (blk >> 1));
#pragma unroll
            for (int k = 0; k < 4; ++k) { const int tok = tok0 + k * tstride;
                if (k < 3) { const int tk = tok0 + (k + 1) * tstride < T ? tok0 + (k + 1) * tstride : tok0; const bf16_t* xp = X1 + (size_t)tk * D + col0; const float* gp = mod + (size_t)(tk / SEQ) * NMOD + 5 * 1024 + col0;
#pragma unroll
                    for (int blk = 0; blk < 4; ++blk) { xwb[blk] = *(const u32x2*)(xp + 16 * (blk & 1) + 512 * (blk >> 1)); gvb[blk] = *(const f32x4*)(gp + 16 * (blk & 1) + 512 * (blk >> 1)); } }
                if (tok < T) {
                    float* xr = OUT + (size_t)tok * D + col0;
                    f32x4 xv[4]; float ss = 0.f;
#pragma unroll
                    for (int blk = 0; blk < 4; ++blk) {
                        const f32x4 x1v = {bf_lo(xwa[blk].x), bf_hi(xwa[blk].x), bf_lo(xwa[blk].y), bf_hi(xwa[blk].y)};
                        xv[blk] = x1v + gva[blk] * (acc[k][blk] * csc[k]);
                        ss += xv[blk][0] * xv[blk][0] + xv[blk][1] * xv[blk][1] + xv[blk][2] * xv[blk][2] + xv[blk][3] * xv[blk][3]; }
                    ss = wave_sum(ss);
                    const float r = rsqrtf(ss * (1.0f / D) + EPS);
#pragma unroll
                    for (int blk = 0; blk < 4; ++blk) *(f32x4*)(xr + 16 * (blk & 1) + 512 * (blk >> 1)) = xv[blk] * r * fgv[blk];
                }
#pragma unroll
                for (int blk = 0; blk < 4; ++blk) { gva[blk] = gvb[blk]; xwa[blk] = xwb[blk]; }
                csc[k] = csn[k]; }
            { LAS unsigned* t_ = mcu; mcu = mnx; mnx = t_; }
        }
    }
}

__global__ void __launch_bounds__(NTHREADS, 2) fwd_megakernel(Params P_) {
    extern __shared__ __attribute__((aligned(16))) unsigned char lds_raw[];
    LAS unsigned char* lds = (LAS unsigned char*)lds_raw;
    KP kp = (KP)__builtin_amdgcn_kernarg_segment_ptr();
    volatile LAS unsigned* ctl = (volatile LAS unsigned*)(lds + LDS_CTL_OFF);
    const int wave_s = __builtin_amdgcn_readfirstlane(threadIdx.x >> 6);
    if (threadIdx.x < 4) ctl[threadIdx.x] = 0u;
    __syncthreads();
    { XcdBarrier b0 = xcd_barrier_post((unsigned*)(kp->ws + WS_CTL), ctl, wave_s); (void)b0; }
    const int lo = kp->ph_lo, hi = kp->ph_hi;
#define IN(k) (lo <= (k) && (k) < hi)
#define FRESH() asm volatile("" : "+s"(kp) :: "memory")
#define SEAM(k) do { if (IN(k) && IN((k) + 1)) { { XcdBarrier b_; b_.bar = (unsigned*)(kp->ws + WS_CTL); b_.x = xb_xcc_id(); b_.st = ctl; xcd_barrier(b_, wave_s); } } FRESH(); } while (0)

    if (IN(0)) phase_prep(kp, lds, wave_s);
#if DBG_REPEAT
    FRESH();
    if (IN(0)) phase_prep(kp, lds, wave_s);
#endif
    SEAM(0);
    if (IN(1)) { phase_aux(kp, lds, wave_s); phase_w8(kp, lds, wave_s); unsigned char* ws = kp->ws; phase_norm_ada<true>(kp->in[0], kp->in[4], (const float*)(ws + WS_MOD), 0, 1024, (bf16_t*)nullptr, ws + WS_X8, (float*)(ws + WS_X8S), wave_s); }
#if DBG_REPEAT
    FRESH();
    if (IN(1)) { unsigned char* ws = kp->ws; phase_norm_ada<true>(kp->in[0], kp->in[4], (const float*)(ws + WS_MOD), 0, 1024, (bf16_t*)nullptr, ws + WS_X8, (float*)(ws + WS_X8S), wave_s); }
#endif
    SEAM(1);
    if (IN(2)) {
        unsigned char* ws = kp->ws;
        { pg8::Gemm g{(const bf16_t*)(ws + WS_X8), (const bf16_t*)(ws + WS_WP8), T, 3584, D / 2}; pg8::StaticOrder S; S.init(T, 3584, gridDim.x, blockIdx.x);
          EpiIn E{EpiProj{(const float*)(ws + WS_BINP), (bf16_t*)(ws + WS_PG), (bf16_t*)(ws + WS_PG) + (size_t)T * 512, (const float*)(ws + WS_X8S), (const float*)(ws + WS_WP8S)},
                  EpiGate{(const float*)(ws + WS_BINP), (const float*)(ws + WS_X8S), (const float*)(ws + WS_WGS), (bf16_t*)(ws + WS_SG)}};
          pg8::gemm_phase<EpiIn>(lds, g, S, E, wave_s); }
    }
#if DBG_REPEAT
    FRESH();
    if (IN(2)) {
        unsigned char* ws = kp->ws;
        { pg8::Gemm g{(const bf16_t*)(ws + WS_X8), (const bf16_t*)(ws + WS_WP8), T, 3584, D / 2}; pg8::StaticOrder S; S.init(T, 3584, gridDim.x, blockIdx.x);
          EpiIn E{EpiProj{(const float*)(ws + WS_BINP), (bf16_t*)(ws + WS_PG), (bf16_t*)(ws + WS_PG) + (size_t)T * 512, (const float*)(ws + WS_X8S), (const float*)(ws + WS_WP8S)},
                  EpiGate{(const float*)(ws + WS_BINP), (const float*)(ws + WS_X8S), (const float*)(ws + WS_WGS), (bf16_t*)(ws + WS_SG)}};
          pg8::gemm_phase<EpiIn>(lds, g, S, E, wave_s); }
    }
#endif
    SEAM(2);
    if (IN(3)) phase_branches(kp, lds, wave_s);
#if DBG_REPEAT
    FRESH();
    if (IN(3)) phase_branches(kp, lds, wave_s);
#endif
    SEAM(3);
    if (IN(4)) {
        unsigned char* ws = kp->ws;
        pg8::Gemm g{(const bf16_t*)(ws + WS_MC), (const bf16_t*)(ws + WS_WPC), T, D, D}; pg8::StaticOrder S; S.init(T, D, gridDim.x, blockIdx.x);
        EpiMerge E{(const bf16_t*)(ws + WS_SG), (bf16_t*)(ws + WS_PG)};
        pg8::gemm_phase<EpiMerge>(lds, g, S, E, wave_s);
    }
#if DBG_REPEAT
    FRESH();
    if (IN(4)) {
        unsigned char* ws = kp->ws;
        pg8::Gemm g{(const bf16_t*)(ws + WS_MC), (const bf16_t*)(ws + WS_WPC), T, D, D}; pg8::StaticOrder S; S.init(T, D, gridDim.x, blockIdx.x);
        EpiMerge E{(const bf16_t*)(ws + WS_SG), (bf16_t*)(ws + WS_PG)};
        pg8::gemm_phase<EpiMerge>(lds, g, S, E, wave_s);
    }
#endif
    SEAM(4);
    if (IN(5)) {
        unsigned char* ws = kp->ws;
        pg8::Gemm g{(const bf16_t*)(ws + WS_PG), (const bf16_t*)(ws + WS_WOUT), T, D, D}; pg8::StaticOrder S; S.init(T, D, gridDim.x, blockIdx.x);
        EpiResid E{kp->in[0], (const float*)(ws + WS_MOD) + 2 * 1024, (bf16_t*)(ws + WS_X1B), (const float*)(ws + WS_A2), (bf16_t*)(ws + WS_H), (float*)(ws + WS_SSQ)};
        pg8::gemm_phase<EpiResid>(lds, g, S, E, wave_s);
    }
#if DBG_REPEAT
    FRESH();
    if (IN(5)) {
        unsigned char* ws = kp->ws;
        pg8::Gemm g{(const bf16_t*)(ws + WS_PG), (const bf16_t*)(ws + WS_WOUT), T, D, D}; pg8::StaticOrder S; S.init(T, D, gridDim.x, blockIdx.x);
        EpiResid E{kp->in[0], (const float*)(ws + WS_MOD) + 2 * 1024, (bf16_t*)(ws + WS_X1B), (const float*)(ws + WS_A2), (bf16_t*)(ws + WS_H), (float*)(ws + WS_SSQ)};
        pg8::gemm_phase<EpiResid>(lds, g, S, E, wave_s);
    }
#endif
    SEAM(5);
    if (IN(7)) {
        unsigned char* ws = kp->ws;
        pg8::Gemm g{(const bf16_t*)(ws + WS_H), (const bf16_t*)(ws + WS_WQ), T, 2048, D}; pg8::StaticOrder S; S.init(T, 2048, gridDim.x, blockIdx.x);
        EpiQ E{(bf16_t*)(ws + WS_SG), (const float*)(ws + WS_SSQ), (const float*)(ws + WS_BIAS2)};
        pg8::gemm_phase<EpiQ>(lds, g, S, E, wave_s);
    }
#if DBG_REPEAT
    FRESH();
    if (IN(7)) {
        unsigned char* ws = kp->ws;
        pg8::Gemm g{(const bf16_t*)(ws + WS_H), (const bf16_t*)(ws + WS_WQ), T, 2048, D}; pg8::StaticOrder S; S.init(T, 2048, gridDim.x, blockIdx.x);
        EpiQ E{(bf16_t*)(ws + WS_SG), (const float*)(ws + WS_SSQ), (const float*)(ws + WS_BIAS2)};
        pg8::gemm_phase<EpiQ>(lds, g, S, E, wave_s);
    }
#endif
    if (IN(7) && IN(8)) { asm volatile("s_waitcnt vmcnt(0)" ::: "memory"); __syncthreads();
        if (wave_s == 0 && lane_id_asm() == 0) { __builtin_amdgcn_fence(__ATOMIC_ACQUIRE, "agent"); asm volatile("s_waitcnt vmcnt(0)" ::: "memory"); }
        __syncthreads(); }
    FRESH();
    if (IN(8)) phase_topk(kp, lds, wave_s);
#if DBG_REPEAT
    FRESH();
    if (IN(8)) phase_topk(kp, lds, wave_s);
#endif
    SEAM(8);
    if (IN(9)) phase_peer_u(kp, lds, wave_s);
    SEAM(9);
    if (IN(10)) phase_peer_v(kp, lds, wave_s);
#undef IN
#undef SEAM
#undef FRESH
}

#define DBG_PHASE_SKIP(ph) (0)
#define DBG_LAST 9
#define DBG_DUMP_N ((size_t)3584 * 1024)
#define DBG_DUMP_BF16 1
#ifdef DBG_DUMP_OFF
__global__ void dbg_dump(const unsigned char* ws, float* out) {
    const size_t n = DBG_DUMP_N;
    for (size_t i = (size_t)blockIdx.x * blockDim.x + threadIdx.x; i < (size_t)T * D; i += (size_t)gridDim.x * blockDim.x) {
        const size_t j = (i * 7919ull) % n;
        float v;
        if (DBG_DUMP_BF16) v = __uint_as_float(((unsigned)((const bf16_t*)(ws + DBG_DUMP_OFF))[j]) << 16);
        else v = ((const float*)(ws + DBG_DUMP_OFF))[j];
        out[i] = v;
    }
}
#endif
#ifndef MK_N_LAUNCHES
#define MK_N_LAUNCHES 1
#endif
extern "C" void kernel_launch(void* const* d_in, const int* in_sizes, int n_in, void* d_out, int out_size, void* d_ws, size_t ws_size, hipStream_t stream) {
    static int grid = 0;
    if (grid == 0) {
        if (n_in != 23 || in_sizes[0] != T * D || out_size != T * D || ws_size < WS_END) {
            fprintf(stderr, "kernel_launch: unexpected shapes (n_in %d, in0 %d, out %d, ws %zu); nothing launched\n", n_in, n_in > 0 ? in_sizes[0] : -1, out_size, ws_size); grid = -1; return; }
        int dev = 0, cus = 0, per_cu = 0;
        if (hipGetDevice(&dev) != hipSuccess || hipDeviceGetAttribute(&cus, hipDeviceAttributeMultiprocessorCount, dev) != hipSuccess) { grid = -1; return; }
        if (hipFuncSetAttribute((const void*)fwd_megakernel, hipFuncAttributeMaxDynamicSharedMemorySize, LDS_BYTES) != hipSuccess) { fprintf(stderr, "kernel_launch: hipFuncSetAttribute failed\n"); grid = -1; return; }
        if (hipOccupancyMaxActiveBlocksPerMultiprocessor(&per_cu, (const void*)fwd_megakernel, NTHREADS, LDS_BYTES) != hipSuccess || per_cu < 1) {
            fprintf(stderr, "kernel_launch: occupancy query says %d blocks per CU; nothing launched\n", per_cu); grid = -1; return; }
        grid = cus;
    }
    if (grid < 0) return;
    (void)hipMemsetAsync((char*)d_ws + WS_CTL, 0, 16384, stream);
    Params p{};
    for (int i = 0; i < 23; ++i) p.in[i] = (const float*)d_in[i];
    p.out = (float*)d_out; p.ws = (unsigned char*)d_ws;
#if MK_N_LAUNCHES == 1
    p.ph_lo = 0; p.ph_hi = 11;
    void* args[] = {&p};
    hipError_t e = hipLaunchCooperativeKernel((const void*)fwd_megakernel, dim3(grid), dim3(NTHREADS), args, LDS_BYTES, stream);
    if (e != hipSuccess) fprintf(stderr, "kernel_launch: cooperative launch failed: %s (grid %d)\n", hipGetErrorString(e), grid);
#else
    for (int ph = 0; ph < 11; ++ph) { if (DBG_PHASE_SKIP(ph)) continue; p.ph_lo = ph; p.ph_hi = ph + 1; hipLaunchKernelGGL(fwd_megakernel, dim3(grid), dim3(NTHREADS), LDS_BYTES, stream, p); }
#ifdef DBG_DUMP_OFF
    hipLaunchKernelGGL(dbg_dump, dim3(1024), dim3(256), 0, stream, (const unsigned char*)d_ws, (float*)d_out);
#endif
#endif
}
```

```cpp
#include <hip/hip_runtime.h>
#include <hip/hip_cooperative_groups.h>
#include <cstdio>
#include <cstdint>
namespace cg = cooperative_groups;
#define DBG_NO_DOT2 1
#define DBG_REPEAT 0

#define LAS __attribute__((address_space(3)))
typedef unsigned short bf16_t;
typedef short bf16x8 __attribute__((ext_vector_type(8)));
typedef float f32x4 __attribute__((ext_vector_type(4)));
typedef float f32x2 __attribute__((ext_vector_type(2)));
typedef float f32x16 __attribute__((ext_vector_type(16)));
typedef unsigned u32x4 __attribute__((ext_vector_type(4)));
typedef unsigned u32x2 __attribute__((ext_vector_type(2)));
typedef __bf16 bf16x2_t __attribute__((ext_vector_type(2)));

constexpr int T = 32768, D = 1024, SEQ = 8192, NBATCH = 4, INW = 3584, NMOD = 6 * 1024;
constexpr int NEXP = 16384;
constexpr float EPS = 1e-6f;
constexpr int NTHREADS = 512;
constexpr int LDS_BYTES = 131072 + 1024;
constexpr int LDS_CTL_OFF = 131072;

constexpr size_t MiB = 1024ull * 1024ull;
constexpr size_t WS_CTL = 0;
constexpr size_t WS_MOD = 16384;
constexpr size_t WS_BINP = 114688;
constexpr size_t WS_WIN = 131072;
constexpr size_t WS_WPC = WS_WIN + 7340032;
constexpr size_t WS_WOUT = WS_WPC + 2 * MiB;
constexpr size_t WS_WQ = WS_WOUT + 2 * MiB;
constexpr size_t WS_EU = 16 * MiB;
constexpr size_t WS_EV = 32 * MiB;
constexpr size_t WS_SU = 48 * MiB;
constexpr size_t WS_SV = 48 * MiB + 65536;
constexpr size_t WS_H = 80 * MiB;
constexpr size_t WS_PG = 144 * MiB;
constexpr size_t WS_SG = 208 * MiB;
constexpr size_t WS_MC = 336 * MiB;
constexpr size_t WS_IDX = 400 * MiB;
constexpr size_t WS_GATE = 416 * MiB;
constexpr size_t WS_HB = WS_PG;
constexpr size_t WS_HS = WS_PG + 32 * MiB;
constexpr size_t WS_WG8 = WS_WIN + 1536 * 1024;
constexpr size_t WS_WGS = WS_WIN + 4 * MiB + 1536 * 4;
constexpr size_t WS_X8 = 436 * MiB;
constexpr size_t WS_X8S = 468 * MiB;
constexpr size_t WS_X1B = WS_MC;
constexpr size_t WS_A2 = 432 * MiB;
constexpr size_t WS_BIAS2 = WS_A2 + 16384;
constexpr size_t WS_SSQ = WS_A2 + 65536;
constexpr size_t WS_CO = WS_SG;
constexpr size_t WS_IDP = WS_SG + 16 * MiB;
constexpr size_t WS_COP = WS_SG + 32 * MiB;
constexpr size_t WS_CS = WS_SG + 48 * MiB;
constexpr size_t WS_WP8 = WS_WIN;
constexpr size_t WS_WP8S = WS_WIN + 4 * MiB;
constexpr size_t WS_PMAX = WS_WIN + 5 * MiB;
constexpr size_t WS_END = 469 * MiB;
static_assert(WS_WQ + 4 * MiB <= WS_EU, "weight region overflow");

struct Params;
typedef const __attribute__((address_space(4))) Params* KP;
struct Params {
    const float* in[23];
    float* out;
    unsigned char* ws;
    int ph_lo, ph_hi;
};

typedef __bf16 bf16x2v_t __attribute__((ext_vector_type(2)));
__device__ __forceinline__ unsigned cvt_pk_bf16(float lo, float hi) { return __builtin_bit_cast(unsigned, __builtin_convertvector((f32x2){lo, hi}, bf16x2v_t)); }
__device__ __forceinline__ float bf_lo(unsigned u) { return __uint_as_float(u << 16); }
__device__ __forceinline__ float bf_hi(unsigned u) { return __uint_as_float(u & 0xffff0000u); }
__device__ __forceinline__ float fast_sigmoid(float x) { return __builtin_amdgcn_rcpf(1.0f + __builtin_amdgcn_exp2f(-1.44269504089f * x)); }
__device__ __forceinline__ int lane_id_asm() { int l; asm volatile("v_mbcnt_lo_u32_b32 %0, -1, 0\n\tv_mbcnt_hi_u32_b32 %0, -1, %0" : "=v"(l)); return l; }
#define DPPI(old, x, ctrl, rmask, bc) __builtin_amdgcn_update_dpp((old), (x), (ctrl), (rmask), 0xF, (bc))
__device__ __forceinline__ float wave_sum(float v) {
    v += __int_as_float(DPPI(0, __float_as_int(v), 0xB1, 0xF, true)); v += __int_as_float(DPPI(0, __float_as_int(v), 0x4E, 0xF, true));
    v += __int_as_float(DPPI(0, __float_as_int(v), 0x141, 0xF, true)); v += __int_as_float(DPPI(0, __float_as_int(v), 0x140, 0xF, true));
    v += __int_as_float(DPPI(0, __float_as_int(v), 0x142, 0xA, false)); v += __int_as_float(DPPI(0, __float_as_int(v), 0x143, 0xC, false));
    return __int_as_float(__builtin_amdgcn_readlane(__float_as_int(v), 63));
}
__device__ __forceinline__ float wave_max(float v) {
    v = fmaxf(v, __int_as_float(DPPI(0, __float_as_int(v), 0xB1, 0xF, true))); v = fmaxf(v, __int_as_float(DPPI(0, __float_as_int(v), 0x4E, 0xF, true)));
    v = fmaxf(v, __int_as_float(DPPI(0, __float_as_int(v), 0x141, 0xF, true))); v = fmaxf(v, __int_as_float(DPPI(0, __float_as_int(v), 0x140, 0xF, true)));
    v = fmaxf(v, __int_as_float(DPPI(0, __float_as_int(v), 0x142, 0xA, false))); v = fmaxf(v, __int_as_float(DPPI(0, __float_as_int(v), 0x143, 0xC, false)));
    return __int_as_float(__builtin_amdgcn_readlane(__float_as_int(v), 63));
}
__device__ __forceinline__ int in_colmap(int n) {
    if (n < 512) return n;
    if (n < 1536) { const int t = (n - 512) >> 8, r = (n - 512) & 255; return r < 128 ? 512 + 128 * t + r : 1024 + 128 * t + (r - 128); }
    const int t = (n - 1536) >> 8, r = (n - 1536) & 255;
    return r < 128 ? 1536 + 128 * t + r : 2560 + 128 * t + (r - 128);
}

#define XB_TMO      128
#define XB_XCNT(j)  (256  + 64 * (j))
#define XB_XSUB(j)  (1280 + 64 * (j))
#define XB_XGEN(j)  (2304 + 64 * (j))
#define XB_TOP      3328
#define XB_TOPGEN   3392
#define XCD_BAR_WORDS 3456
#define XB_SPIN_CAP (1u << 22)
__device__ __forceinline__ unsigned xb_ld(unsigned* p)              { return __hip_atomic_load(p, __ATOMIC_RELAXED, __HIP_MEMORY_SCOPE_AGENT); }
__device__ __forceinline__ unsigned xb_add(unsigned* p, unsigned v) { return __hip_atomic_fetch_add(p, v, __ATOMIC_RELAXED, __HIP_MEMORY_SCOPE_AGENT); }
__device__ __forceinline__ unsigned xb_xcc_id() { return (unsigned)__builtin_amdgcn_s_getreg((3 << 11) | 20) & 0xFu; }
#define XB_SPIN(cond, bar) do { unsigned _sp = 0; while (cond) { __builtin_amdgcn_s_sleep(1); \
    if ((++_sp & 255u) == 0u) { if (xb_ld(&(bar)[XB_TMO])) break; if (_sp > XB_SPIN_CAP) { atomicAdd(&(bar)[XB_TMO], 1u); break; } } } } while (0)
struct XcdBarrier { unsigned* bar; unsigned x; volatile LAS unsigned* st; };
__device__ __forceinline__ XcdBarrier xcd_barrier_post(unsigned* bar, volatile LAS unsigned* st, int wave_s) {
    XcdBarrier b; b.bar = bar; b.x = xb_xcc_id(); b.st = st;
    if (wave_s == 0 && lane_id_asm() == 0) (void)xb_add(&bar[XB_XCNT(b.x)], 1u);
    return b;
}
__device__ __forceinline__ void xcd_barrier_complete(unsigned* bar, unsigned x, unsigned& nloc, unsigned& nx) {
    const unsigned G = gridDim.x * gridDim.y * gridDim.z;
    unsigned sum, cnt, mine, sp = 0u;
    for (;;) {
        sum = 0u; cnt = 0u; mine = 0u;
#pragma unroll
        for (unsigned j = 0; j < 16; ++j) { const unsigned c = xb_ld(&bar[XB_XCNT(j)]); sum += c; cnt += (c > 0u) ? 1u : 0u; mine = (j == x) ? c : mine; }
        if (sum == G) break;
        __builtin_amdgcn_s_sleep(1);
        if ((++sp & 255u) == 0u) { if (xb_ld(&bar[XB_TMO])) break; if (sp > XB_SPIN_CAP) { atomicAdd(&bar[XB_TMO], 1u); break; } }
    }
    nloc = mine > 0u ? mine : 1u; nx = cnt > 0u ? cnt : 1u;
}
__device__ __forceinline__ void xcd_barrier(const XcdBarrier& b, int wave_s) {
    asm volatile("s_waitcnt vmcnt(0)" ::: "memory");
    __syncthreads();
    if (wave_s == 0 && lane_id_asm() == 0) {
        unsigned* bar = b.bar;
        __builtin_amdgcn_s_waitcnt(0);
        unsigned nloc = b.st[0], nx = b.st[1];
        if (nloc == 0u) { xcd_barrier_complete(bar, b.x, nloc, nx); b.st[0] = nloc; b.st[1] = nx; }
        const unsigned old = xb_add(&bar[XB_XSUB(b.x)], 1u);
        const unsigned gen = old / nloc;
        if (old + 1u == (gen + 1u) * nloc) {
            __builtin_amdgcn_fence(__ATOMIC_RELEASE, "agent");
            asm volatile("s_waitcnt vmcnt(0)" ::: "memory");
            const unsigned og = xb_add(&bar[XB_TOP], 1u);
            const unsigned tg = og / nx;
            if (og + 1u == (tg + 1u) * nx) xb_add(&bar[XB_TOPGEN], 1u);
            else XB_SPIN(xb_ld(&bar[XB_TOPGEN]) == tg, bar);
            __builtin_amdgcn_fence(__ATOMIC_ACQUIRE, "agent");
            xb_add(&bar[XB_XGEN(b.x)], 1u);
            asm volatile("s_waitcnt vmcnt(0)" ::: "memory");
        } else {
            XB_SPIN(xb_ld(&bar[XB_XGEN(b.x)]) == gen, bar);
            __builtin_amdgcn_fence(__ATOMIC_ACQUIRE, "agent");
            asm volatile("s_waitcnt vmcnt(0)" ::: "memory");
        }
    }
    __syncthreads();
}

namespace pg8 {
constexpr int BM = 256, BK = 64, HALF = 128, HTB = HALF * BK * 2, STAGE_BYTES = 8 * HTB, NXCD = 8, WGM = 8;
__host__ __device__ __forceinline__ int lds_byte(int r, int c) { const int st = (r >> 4) * 2 + (c >> 5), rr = r & 15, cc = c & 31, ob = rr * 64 + cc * 2; return st * 1024 + (ob ^ (((ob >> 9) & 1) << 5)); }
__host__ __device__ __forceinline__ void stage_rc(int b, int& R, int& C) { const int st = b / 1024, sb = b % 1024, swz = sb ^ (((sb >> 9) & 1) << 5); R = (st >> 1) * 16 + swz / 64; C = (st & 1) * 32 + (swz % 64) / 2; }
__host__ __device__ __forceinline__ int perm32(int rho) { const int n = rho >> 4, i = rho & 15; return 8 * (i >> 2) + 4 * n + (i & 3); }
struct Unit { int pm, pn; };
struct Gemm { const bf16_t* A; const bf16_t* Bt; int M, N, K; };
struct StaticOrder {
    int nM, nN, nwg, G, c;
    __host__ __device__ void init(int M, int N, int G_, int c_) { nM = M / BM; nN = N / BM; nwg = nM * nN; G = G_; c = c_; }
    __host__ __device__ bool next(int i, Unit& u) const {
        const long L = (long)i * G + c; if (L >= nwg) return false;
        int wgid = (int)L; { const int q = nwg / NXCD, r = nwg % NXCD, xcd = wgid % NXCD, off = wgid / NXCD; wgid = (xcd < r ? xcd * (q + 1) : r * (q + 1) + (xcd - r) * q) + off; }
        const int nig = WGM * nN, gid = wgid / nig, fm = gid * WGM, gsz = (nM - fm) < WGM ? (nM - fm) : WGM;
        u.pm = fm + ((wgid % nig) % gsz); u.pn = (wgid % nig) / gsz; return true;
    }
};
typedef int i32x8_t __attribute__((ext_vector_type(8)));
typedef int i32x4_t __attribute__((ext_vector_type(4)));
template <bool FP8> struct FragT { typedef bf16x8 type[2]; };
template <> struct FragT<true> { typedef i32x8_t type; };
__device__ __forceinline__ void ldfrag(bf16x8 (&d)[2], const LAS unsigned char* p) { d[0] = *(const LAS bf16x8*)p; d[1] = *(const LAS bf16x8*)(p + 1024); }
__device__ __forceinline__ void ldfrag(i32x8_t& d, const LAS unsigned char* p) { const i32x4_t lo = *(const LAS i32x4_t*)p, hi = *(const LAS i32x4_t*)(p + 1024); d = (i32x8_t){lo[0], lo[1], lo[2], lo[3], hi[0], hi[1], hi[2], hi[3]}; }
__device__ __forceinline__ void mma1(f32x4& acc, const bf16x8 (&b)[2], const bf16x8 (&a)[2]) {
    acc = __builtin_amdgcn_mfma_f32_16x16x32_bf16(b[0], a[0], acc, 0, 0, 0); acc = __builtin_amdgcn_mfma_f32_16x16x32_bf16(b[1], a[1], acc, 0, 0, 0); }
__device__ __forceinline__ void mma1(f32x4& acc, const i32x8_t& b, const i32x8_t& a) {
    asm volatile("v_mfma_scale_f32_16x16x128_f8f6f4 %0, %1, %2, %0, %3, %3 op_sel_hi:[0,0,0]" : "+v"(acc) : "v"(b), "v"(a), "v"(0x7f7f7f7f)); }
template <class Epi>
__device__ __forceinline__ void gemm_phase(LAS unsigned char* lds, const Gemm g, const StaticOrder& S, const Epi& E, int wave_s) {
    const int lane = lane_id_asm(), wid = wave_s, tid = wid * 64 + lane, wr = wid >> 2, wc = wid & 3, fr = lane & 15, fq = lane >> 4;
    const int K = g.K, nt = K / BK;
    unsigned voffA[2], voffB[2];
#pragma unroll
    for (int i = 0; i < 2; ++i) { int R, C; stage_rc(tid * 16 + i * 8192, R, C); const int Rb = Epi::PERM ? ((R & ~31) + perm32(R & 31)) : R;
        voffA[i] = (unsigned)(R * K + C) * 2u; voffB[i] = (unsigned)(Rb * K + C) * 2u; }
    const size_t kstep = (size_t)(BK * 2);
    const size_t hstep = (size_t)HALF * K * 2;
    const size_t tstep = 2 * hstep;
    const unsigned ldsw = (unsigned)wid * 1024u;
    const int aoff = lds_byte(wr * 64 + fr, fq * 8), boff = lds_byte(wc * 32 + fr, fq * 8);
#define PG8_SA(b, h) (((b) * 2 + (h)) * HTB)
#define PG8_SB(b, h) ((4 + (b) * 2 + (h)) * HTB)
#define PG8_STAGE(bufoff, gbase, voff) do { _Pragma("unroll") for (int _i = 0; _i < 2; ++_i) \
        __builtin_amdgcn_global_load_lds((const unsigned*)((const char*)(gbase) + (voff)[_i]), (LAS unsigned*)(lds + (bufoff) + ldsw + _i * 8192), 16, 0, 0); } while (0)
#define PG8_LDA(dst, b, h) do { _Pragma("unroll") for (int m = 0; m < 4; ++m) ldfrag(dst[m], lds + PG8_SA(b, h) + aoff + m * 2048); } while (0)
#define PG8_LDB(dst, b, h) do { _Pragma("unroll") for (int n = 0; n < 2; ++n) ldfrag(dst[n], lds + PG8_SB(b, h) + boff + n * 2048); } while (0)
#define PG8_MMA(ai, bj, At, Bt) do { __builtin_amdgcn_s_setprio(1); _Pragma("unroll") for (int m = 0; m < 4; ++m) _Pragma("unroll") for (int n = 0; n < 2; ++n) mma1(acc[ai][bj][m][n], Bt[n], At[m]); __builtin_amdgcn_s_setprio(0); } while (0)
#define PG8_WAIT_V(n) asm volatile("s_waitcnt vmcnt(" #n ")" ::: "memory")
#define PG8_WAIT_L(n) asm volatile("s_waitcnt lgkmcnt(" #n ")" ::: "memory")
#define PG8_BAR __builtin_amdgcn_s_barrier()
#define PG8_SCHED __builtin_amdgcn_sched_barrier(0)
    Unit cur, nxt; int ui = 0;
    if (!S.next(0, cur)) return;
    f32x4 acc[2][2][4][2];
#pragma unroll
    for (int a = 0; a < 2; ++a)
#pragma unroll
        for (int b = 0; b < 2; ++b)
#pragma unroll
            for (int m = 0; m < 4; ++m)
#pragma unroll
                for (int n = 0; n < 2; ++n) acc[a][b][m][n] = (f32x4){0.f, 0.f, 0.f, 0.f};
    typename FragT<Epi::FP8>::type At[4], B0[2], B1[2];
    const char* cA = (const char*)g.A + (size_t)cur.pm * tstep; const char* cB = (const char*)g.Bt + (size_t)cur.pn * tstep;
    PG8_STAGE(PG8_SB(0, 0), cB, voffB); PG8_STAGE(PG8_SB(0, 1), cB + hstep, voffB); PG8_STAGE(PG8_SA(0, 0), cA, voffA); PG8_STAGE(PG8_SA(0, 1), cA + hstep, voffA);
    if (wr == 1) PG8_BAR;
    PG8_WAIT_V(2); PG8_BAR;
    PG8_STAGE(PG8_SB(1, 0), cB + kstep, voffB); PG8_STAGE(PG8_SA(1, 0), cA + kstep, voffA); PG8_STAGE(PG8_SB(1, 1), cB + hstep + kstep, voffB);
    PG8_WAIT_V(6); PG8_BAR;
    for (;;) {
        const bool has_next = S.next(ui + 1, nxt);
        const char* nA = has_next ? (const char*)g.A + (size_t)nxt.pm * tstep : cA; const char* nB = has_next ? (const char*)g.Bt + (size_t)nxt.pn * tstep : cB;
#pragma unroll 1
        for (int t = 0; t < nt; t += 2) {
            const bool last = (t == nt - 2);
            const char* a1 = cA + (size_t)(t + 1) * kstep;
            const char* a2 = last ? nA : cA + (size_t)(t + 2) * kstep; const char* b2 = last ? nB : cB + (size_t)(t + 2) * kstep;
            const char* a3 = a2 + kstep; const char* b3 = b2 + kstep;
            if constexpr (Epi::HAS_MID) { if (t == nt / 2) E.mid(acc, cur, wr, wc, fr, fq); }
            PG8_LDB(B0, 0, 0); PG8_LDB(B1, 0, 1); PG8_SCHED; PG8_LDA(At, 0, 0); PG8_STAGE(PG8_SA(1, 1), a1 + hstep, voffA);
            PG8_WAIT_V(8); PG8_WAIT_L(0); PG8_BAR; PG8_MMA(0, 0, At, B0); PG8_MMA(0, 1, At, B1); PG8_BAR; PG8_SCHED;
            PG8_LDA(At, 0, 1); PG8_STAGE(PG8_SB(0, 0), b2, voffB); PG8_STAGE(PG8_SB(0, 1), b2 + hstep, voffB); PG8_STAGE(PG8_SA(0, 0), a2, voffA);
            PG8_WAIT_V(8); PG8_WAIT_L(0); PG8_BAR; PG8_MMA(1, 0, At, B0); PG8_MMA(1, 1, At, B1); PG8_BAR; PG8_SCHED;
            PG8_LDB(B0, 1, 0); PG8_LDB(B1, 1, 1); PG8_SCHED; PG8_LDA(At, 1, 0); PG8_STAGE(PG8_SA(0, 1), a2 + hstep, voffA);
            PG8_WAIT_V(8); PG8_WAIT_L(0); PG8_BAR; PG8_MMA(0, 0, At, B0); PG8_MMA(0, 1, At, B1); PG8_BAR; PG8_SCHED;
            PG8_LDA(At, 1, 1); PG8_STAGE(PG8_SB(1, 0), b3, voffB); PG8_STAGE(PG8_SB(1, 1), b3 + hstep, voffB); PG8_STAGE(PG8_SA(1, 0), a3, voffA);
            PG8_WAIT_V(8); PG8_WAIT_L(0); PG8_BAR; PG8_MMA(1, 0, At, B0); PG8_MMA(1, 1, At, B1); PG8_BAR; PG8_SCHED;
        }
        if (wr == 0) PG8_BAR;
        E(acc, cur, wr, wc, fr, fq);
        if (!has_next) break;
#pragma unroll
        for (int a = 0; a < 2; ++a)
#pragma unroll
            for (int b = 0; b < 2; ++b)
#pragma unroll
                for (int m = 0; m < 4; ++m)
#pragma unroll
                    for (int n = 0; n < 2; ++n) acc[a][b][m][n] = (f32x4){0.f, 0.f, 0.f, 0.f};
        cur = nxt; cA = nA; cB = nB; ++ui;
        if (wr == 1) PG8_BAR;
    }
    PG8_WAIT_V(0);
    PG8_BAR;
#undef PG8_SA
#undef PG8_SB
#undef PG8_STAGE
#undef PG8_LDA
#undef PG8_LDB
#undef PG8_MMA
#undef PG8_WAIT_V
#undef PG8_WAIT_L
#undef PG8_BAR
#undef PG8_SCHED
}
}
typedef f32x4 AccT[2][2][4][2];

struct EpiProj {
    static constexpr bool PERM = true, HAS_MID = false, FP8 = true;
    const float* bias; bf16_t* PB; bf16_t* GB; const float* RS; const float* CS;
    __device__ __forceinline__ void operator()(const AccT& acc, const pg8::Unit& u, int wr, int wc, int fr, int fq) const {
        const int row0 = u.pm * 256 + wr * 64 + fr, lc0 = wc * 32 + 8 * fq;
        f32x4 bv[2][2], cv[2][2];
#pragma unroll
        for (int bj = 0; bj < 2; ++bj)
#pragma unroll
            for (int n = 0; n < 2; ++n) { bv[bj][n] = *(const f32x4*)(bias + u.pn * 256 + bj * 128 + lc0 + 4 * n); cv[bj][n] = *(const f32x4*)(CS + u.pn * 256 + bj * 128 + lc0 + 4 * n); }
        if (u.pn >= 2 && u.pn < 6) {
            const int t = u.pn - 2;
#pragma unroll
            for (int ai = 0; ai < 2; ++ai)
#pragma unroll
                for (int m = 0; m < 4; ++m) {
                    const int row = row0 + ai * 128 + m * 16; const float rs = RS[row];
                    float o[8];
#pragma unroll
                    for (int n = 0; n < 2; ++n) { const f32x4 v = acc[ai][0][m][n] * (cv[0][n] * rs) + bv[0][n], gt = acc[ai][1][m][n] * (cv[1][n] * rs) + bv[1][n];
#pragma unroll
                        for (int j = 0; j < 4; ++j) o[n * 4 + j] = v[j] * fast_sigmoid(gt[j]); }
                    u32x4 w; w.x = cvt_pk_bf16(o[0], o[1]); w.y = cvt_pk_bf16(o[2], o[3]); w.z = cvt_pk_bf16(o[4], o[5]); w.w = cvt_pk_bf16(o[6], o[7]);
                    *(u32x4*)(GB + (size_t)row * 512 + t * 128 + lc0) = w;
                }
        } else {
            const bool isp = true;
            bf16_t* base = PB; const int ldc = 512; const int colt = u.pn * 256;
#pragma unroll
            for (int ai = 0; ai < 2; ++ai)
#pragma unroll
                for (int m = 0; m < 4; ++m) {
                    const int row = row0 + ai * 128 + m * 16; const float rs = RS[row];
#pragma unroll
                    for (int bj = 0; bj < 2; ++bj) {
                        f32x4 v0 = acc[ai][bj][m][0] * (cv[bj][0] * rs) + bv[bj][0], v1 = acc[ai][bj][m][1] * (cv[bj][1] * rs) + bv[bj][1];
                        if (!isp) {
#pragma unroll
                            for (int j = 0; j < 4; ++j) { v0[j] = fast_sigmoid(v0[j]); v1[j] = fast_sigmoid(v1[j]); }
                        }
                        u32x4 w; w.x = cvt_pk_bf16(v0[0], v0[1]); w.y = cvt_pk_bf16(v0[2], v0[3]); w.z = cvt_pk_bf16(v1[0], v1[1]); w.w = cvt_pk_bf16(v1[2], v1[3]);
                        *(u32x4*)(base + (size_t)row * ldc + colt + bj * 128 + lc0) = w;
                    }
                }
        }
    }
};
struct EpiGate {
    static constexpr bool PERM = true, HAS_MID = false, FP8 = true;
    const float* bias; const float* RS; const float* CS; bf16_t* SG;
    __device__ __forceinline__ void operator()(const AccT& acc, const pg8::Unit& u, int wr, int wc, int fr, int fq) const {
        const int row0 = u.pm * 256 + wr * 64 + fr, lc0 = wc * 32 + 8 * fq, t = u.pn;
        float rs[2][4];
#pragma unroll
        for (int ai = 0; ai < 2; ++ai)
#pragma unroll
            for (int m = 0; m < 4; ++m) rs[ai][m] = RS[row0 + ai * 128 + m * 16];
#pragma unroll
        for (int n = 0; n < 2; ++n) {
            const f32x4 b1 = *(const f32x4*)(bias + 1536 + t * 256 + lc0 + 4 * n), b2 = *(const f32x4*)(bias + 1536 + t * 256 + 128 + lc0 + 4 * n);
            const f32x4 c1 = *(const f32x4*)(CS + t * 256 + lc0 + 4 * n), c2 = *(const f32x4*)(CS + t * 256 + 128 + lc0 + 4 * n);
#pragma unroll
            for (int ai = 0; ai < 2; ++ai)
#pragma unroll
                for (int m = 0; m < 4; ++m) {
                    const int row = row0 + ai * 128 + m * 16;
                    const f32x4 a1 = acc[ai][0][m][n] * (c1 * rs[ai][m]) + b1, a2 = acc[ai][1][m][n] * (c2 * rs[ai][m]) + b2;
                    float ra[4], s2[4];
#pragma unroll
                    for (int j = 0; j < 4; ++j) { const float e1 = __builtin_amdgcn_exp2f(-1.44269504089f * a1[j]), e2 = __builtin_amdgcn_exp2f(-1.44269504089f * a2[j]);
                        ra[j] = (1.0f + e2) * __builtin_amdgcn_rcpf(1.0f + e1); s2[j] = __builtin_amdgcn_rcpf(1.0f + e2); }
                    *(u32x2*)(SG + (size_t)row * 2048 + t * 128 + lc0 + 4 * n) = (u32x2){cvt_pk_bf16(ra[0], ra[1]), cvt_pk_bf16(ra[2], ra[3])};
                    *(u32x2*)(SG + (size_t)row * 2048 + 1024 + t * 128 + lc0 + 4 * n) = (u32x2){cvt_pk_bf16(s2[0], s2[1]), cvt_pk_bf16(s2[2], s2[3])};
                }
        }
    }
};
struct EpiIn {
    static constexpr bool PERM = true, HAS_MID = false, FP8 = true;
    EpiProj P; EpiGate G;
    __device__ __forceinline__ void operator()(const AccT& acc, const pg8::Unit& u, int wr, int wc, int fr, int fq) const {
        if (u.pn < 6) P(acc, u, wr, wc, fr, fq);
        else { pg8::Unit u2 = u; u2.pn = u.pn - 6; G(acc, u2, wr, wc, fr, fq); }
    }
};
struct EpiMerge {
    static constexpr bool PERM = true, HAS_MID = true, FP8 = false;
    const bf16_t* SG; bf16_t* MG;
    __device__ __forceinline__ void mid(AccT& acc, const pg8::Unit& u, int wr, int wc, int fr, int fq) const {
        const int row0 = u.pm * 256 + wr * 64 + fr, col0 = u.pn * 256 + wc * 32 + 8 * fq;
#pragma unroll
        for (int ai = 0; ai < 2; ++ai)
#pragma unroll
            for (int m = 0; m < 4; ++m) {
                const bf16_t* p = SG + (size_t)(row0 + ai * 128 + m * 16) * 2048 + col0;
                const u32x4 r0 = *(const u32x4*)p, r1 = *(const u32x4*)(p + 128);
#pragma unroll
                for (int bj = 0; bj < 2; ++bj) {
                    const unsigned a1[4] = {bj ? r1.x : r0.x, bj ? r1.y : r0.y, bj ? r1.z : r0.z, bj ? r1.w : r0.w};
#pragma unroll
                    for (int n = 0; n < 2; ++n)
#pragma unroll
                        for (int j = 0; j < 4; ++j) { const unsigned w1 = a1[n * 2 + (j >> 1)]; acc[ai][bj][m][n][j] *= (j & 1) ? bf_hi(w1) : bf_lo(w1); }
                }
                if (m & 1) asm volatile("" ::: "memory");
            }
    }
    __device__ __forceinline__ void operator()(const AccT& acc, const pg8::Unit& u, int wr, int wc, int fr, int fq) const {
        const int row0 = u.pm * 256 + wr * 64 + fr, col0 = u.pn * 256 + wc * 32 + 8 * fq;
#pragma unroll
        for (int ai = 0; ai < 2; ++ai)
#pragma unroll
            for (int m = 0; m < 4; ++m)
#pragma unroll
                for (int bj = 0; bj < 2; ++bj) {
                    const int row = row0 + ai * 128 + m * 16;
                    const u32x4 s2 = *(const u32x4*)(SG + (size_t)row * 2048 + 1024 + col0 + bj * 128);
                    const unsigned a2[4] = {s2.x, s2.y, s2.z, s2.w};
                    float o[8];
#pragma unroll
                    for (int n = 0; n < 2; ++n)
#pragma unroll
                        for (int j = 0; j < 4; ++j) {
                            const unsigned w2 = a2[n * 2 + (j >> 1)];
                            const float f2 = fmaxf((j & 1) ? bf_hi(w2) : bf_lo(w2), 1e-20f);
                            o[n * 4 + j] = acc[ai][bj][m][n][j] * f2;
                        }
                    u32x4 w; w.x = cvt_pk_bf16(o[0], o[1]); w.y = cvt_pk_bf16(o[2], o[3]); w.z = cvt_pk_bf16(o[4], o[5]); w.w = cvt_pk_bf16(o[6], o[7]);
                    *(u32x4*)(MG + (size_t)row * 1024 + col0 + bj * 128) = w;
                }
    }
};
struct EpiResid {
    static constexpr bool PERM = true, HAS_MID = false, FP8 = false;
    const float* X; const float* mod; bf16_t* X1B;
    const float* A2; bf16_t* XA; float* SSQ;
    __device__ __forceinline__ void operator()(const AccT& acc, const pg8::Unit& u, int wr, int wc, int fr, int fq) const {
        const int row0 = u.pm * 256 + wr * 64 + fr, col0 = u.pn * 256 + wc * 32 + 8 * fq;
        const int b = (u.pm * 256) / SEQ;
        const float* gt = mod + (size_t)b * NMOD; const float* a2 = A2 + b * 1024;
        f32x4 gv[2][2], av[2][2];
#pragma unroll
        for (int bj = 0; bj < 2; ++bj)
#pragma unroll
            for (int n = 0; n < 2; ++n) { gv[bj][n] = *(const f32x4*)(gt + col0 + bj * 128 + n * 4); av[bj][n] = *(const f32x4*)(a2 + col0 + bj * 128 + n * 4); }
#pragma unroll
        for (int ai = 0; ai < 2; ++ai)
#pragma unroll
            for (int m = 0; m < 4; ++m) {
                const int row = row0 + ai * 128 + m * 16;
                const size_t off = (size_t)row * 1024 + col0;
                float ss = 0.f;
#pragma unroll
                for (int bj = 0; bj < 2; ++bj) {
                    const f32x4 xv0 = *(const f32x4*)(X + off + bj * 128), xv1 = *(const f32x4*)(X + off + bj * 128 + 4);
                    const f32x4 x10 = xv0 + gv[bj][0] * acc[ai][bj][m][0], x11 = xv1 + gv[bj][1] * acc[ai][bj][m][1];
                    { u32x4 wx; wx.x = cvt_pk_bf16(x10[0], x10[1]); wx.y = cvt_pk_bf16(x10[2], x10[3]); wx.z = cvt_pk_bf16(x11[0], x11[1]); wx.w = cvt_pk_bf16(x11[2], x11[3]);
                      *(u32x4*)(X1B + off + bj * 128) = wx; }
                    ss += x10[0] * x10[0] + x10[1] * x10[1] + x10[2] * x10[2] + x10[3] * x10[3] + x11[0] * x11[0] + x11[1] * x11[1] + x11[2] * x11[2] + x11[3] * x11[3];
                    const f32x4 xa0 = x10 * av[bj][0], xa1 = x11 * av[bj][1];
                    u32x4 w; w.x = cvt_pk_bf16(xa0[0], xa0[1]); w.y = cvt_pk_bf16(xa0[2], xa0[3]); w.z = cvt_pk_bf16(xa1[0], xa1[1]); w.w = cvt_pk_bf16(xa1[2], xa1[3]);
                    *(u32x4*)(XA + off + bj * 128) = w;
                }
                ss += __shfl_xor(ss, 16); ss += __shfl_xor(ss, 32);
                if (fq == 0) __hip_atomic_fetch_add(SSQ + row, ss, __ATOMIC_RELAXED, __HIP_MEMORY_SCOPE_AGENT);
            }
    }
};
struct EpiBf16 {
    static constexpr bool PERM = true, HAS_MID = false, FP8 = false;
    bf16_t* O; int ldc;
    __device__ __forceinline__ void operator()(const AccT& acc, const pg8::Unit& u, int wr, int wc, int fr, int fq) const {
        const int row0 = u.pm * 256 + wr * 64 + fr, col0 = u.pn * 256 + wc * 32 + 8 * fq;
#pragma unroll
        for (int ai = 0; ai < 2; ++ai)
#pragma unroll
            for (int m = 0; m < 4; ++m)
#pragma unroll
                for (int bj = 0; bj < 2; ++bj) {
                    const f32x4 v0 = acc[ai][bj][m][0], v1 = acc[ai][bj][m][1];
                    u32x4 w; w.x = cvt_pk_bf16(v0[0], v0[1]); w.y = cvt_pk_bf16(v0[2], v0[3]); w.z = cvt_pk_bf16(v1[0], v1[1]); w.w = cvt_pk_bf16(v1[2], v1[3]);
                    *(u32x4*)(O + (size_t)(row0 + ai * 128 + m * 16) * ldc + col0 + bj * 128) = w;
                }
    }
};

struct EpiQ {
    static constexpr bool PERM = true, HAS_MID = false, FP8 = false;
    bf16_t* O; const float* SSQ; const float* BIAS2;
    __device__ __forceinline__ void operator()(const AccT& acc, const pg8::Unit& u, int wr, int wc, int fr, int fq) const {
        const int row0 = u.pm * 256 + wr * 64 + fr, col0 = u.pn * 256 + wc * 32 + 8 * fq;
        const float* bs = BIAS2 + ((u.pm * 256) / SEQ) * 2048 + col0;
        f32x4 bv[2][2];
#pragma unroll
        for (int bj = 0; bj < 2; ++bj)
#pragma unroll
            for (int n = 0; n < 2; ++n) bv[bj][n] = *(const f32x4*)(bs + bj * 128 + 4 * n);
#pragma unroll
        for (int ai = 0; ai < 2; ++ai)
#pragma unroll
            for (int m = 0; m < 4; ++m) {
                const int row = row0 + ai * 128 + m * 16;
                const float r = rsqrtf(SSQ[row] * (1.0f / D) + EPS);
#pragma unroll
                for (int bj = 0; bj < 2; ++bj) {
                    const f32x4 v0 = acc[ai][bj][m][0] * r + bv[bj][0], v1 = acc[ai][bj][m][1] * r + bv[bj][1];
                    u32x4 w; w.x = cvt_pk_bf16(v0[0], v0[1]); w.y = cvt_pk_bf16(v0[2], v0[3]); w.z = cvt_pk_bf16(v1[0], v1[1]); w.w = cvt_pk_bf16(v1[2], v1[3]);
                    { const int cw = wr * 2 + ai * 4 + (m >> 1), ks = 2 * wc + (fq >> 1), ln = (fq & 1) * 32 + (m & 1) * 16 + fr;
                      *(u32x4*)(O + ((size_t)(u.pm * 8 + u.pn) * 128 + (size_t)((cw * 2 + bj) * 8 + ks)) * 512 + ln * 8) = w; }
                }
            }
    }
};

#ifndef U_BITS
#define U_BITS 4
#endif
#ifndef V_BITS
#define V_BITS 4
#endif
template <int BITS> struct RowFmt;
template <> struct RowFmt<8> { typedef u32x4 row_t; static constexpr float QMAX = 224.0f; };
template <> struct RowFmt<4> { typedef u32x2 row_t; static constexpr float QMAX = 6.0f; };
template <int I> __device__ __forceinline__ f32x2 row_pair(const u32x4& r) {
    const unsigned w = (I >> 1) == 0 ? r.x : (I >> 1) == 1 ? r.y : (I >> 1) == 2 ? r.z : r.w;
    return __builtin_amdgcn_cvt_pk_f32_fp8((int)w, (I & 1) != 0);
}
template <int I> __device__ __forceinline__ f32x2 row_pair(const u32x2& r) {
    const unsigned w = (I >> 2) == 0 ? r.x : r.y;
    return __builtin_amdgcn_cvt_scalef32_pk_f32_fp4(w, 1.0f, I & 3);
}
template <class R> __device__ __forceinline__ float row_dot16(const R& r, const f32x2 (&hf)[8]) {
    f32x2 acc = {0.f, 0.f};
    acc = __builtin_elementwise_fma(row_pair<0>(r), hf[0], acc); acc = __builtin_elementwise_fma(row_pair<1>(r), hf[1], acc);
    acc = __builtin_elementwise_fma(row_pair<2>(r), hf[2], acc); acc = __builtin_elementwise_fma(row_pair<3>(r), hf[3], acc);
    acc = __builtin_elementwise_fma(row_pair<4>(r), hf[4], acc); acc = __builtin_elementwise_fma(row_pair<5>(r), hf[5], acc);
    acc = __builtin_elementwise_fma(row_pair<6>(r), hf[6], acc); acc = __builtin_elementwise_fma(row_pair<7>(r), hf[7], acc);
    return acc.x + acc.y;
}
template <class R> __device__ __forceinline__ void row_axpy16(const R& r, float c, f32x2 (&o)[8]) {
    const f32x2 c2 = {c, c};
    o[0] = __builtin_elementwise_fma(c2, row_pair<0>(r), o[0]); o[1] = __builtin_elementwise_fma(c2, row_pair<1>(r), o[1]);
    o[2] = __builtin_elementwise_fma(c2, row_pair<2>(r), o[2]); o[3] = __builtin_elementwise_fma(c2, row_pair<3>(r), o[3]);
    o[4] = __builtin_elementwise_fma(c2, row_pair<4>(r), o[4]); o[5] = __builtin_elementwise_fma(c2, row_pair<5>(r), o[5]);
    o[6] = __builtin_elementwise_fma(c2, row_pair<6>(r), o[6]); o[7] = __builtin_elementwise_fma(c2, row_pair<7>(r), o[7]);
}
template <int BITS> __device__ __forceinline__ void quant_row(const f32x4 (&v)[4], float qs, unsigned char* dst_row, int lane) {
    if constexpr (BITS == 8) {
#pragma unroll
        for (int q = 0; q < 4; ++q) { int p = 0; p = __builtin_amdgcn_cvt_pk_fp8_f32(v[q][0] * qs, v[q][1] * qs, p, false); p = __builtin_amdgcn_cvt_pk_fp8_f32(v[q][2] * qs, v[q][3] * qs, p, true);
            ((unsigned*)dst_row)[lane + 64 * q] = (unsigned)p; }
    } else {
#pragma unroll
        for (int q = 0; q < 4; ++q) { unsigned p = 0; p = __builtin_amdgcn_cvt_scalef32_pk_fp4_f32(p, v[q][0] * qs, v[q][1] * qs, 1.0f, 0); p = __builtin_amdgcn_cvt_scalef32_pk_fp4_f32(p, v[q][2] * qs, v[q][3] * qs, 1.0f, 1);
            ((unsigned short*)dst_row)[lane + 64 * q] = (unsigned short)(p & 0xffffu); }
    }
}
__device__ __forceinline__ void xpose_tile(const float* src, int ldsrc, int c0, int k0, bf16_t* dst, int lddst, int n0, int kd0, LAS float* tile, int tid) {
    { const int r = tid >> 4, c4 = tid & 15;
#pragma unroll
      for (int ps = 0; ps < 2; ++ps) { const f32x4 v = *(const f32x4*)(src + (size_t)(k0 + r + 32 * ps) * ldsrc + c0 + c4 * 4);
#pragma unroll
          for (int j = 0; j < 4; ++j) tile[(r + 32 * ps) * 65 + c4 * 4 + j] = v[j]; } }
    __syncthreads();
    { const int n = tid >> 3, kg = tid & 7; float f[8];
#pragma unroll
      for (int i = 0; i < 8; ++i) f[i] = tile[(kg * 8 + i) * 65 + n];
      u32x4 w; w.x = cvt_pk_bf16(f[0], f[1]); w.y = cvt_pk_bf16(f[2], f[3]); w.z = cvt_pk_bf16(f[4], f[5]); w.w = cvt_pk_bf16(f[6], f[7]);
      *(u32x4*)(dst + (size_t)(n0 + n) * lddst + kd0 + k0 + kg * 8) = w; }
    __syncthreads();
}
__device__ __forceinline__ void phase_prep(KP kp, LAS unsigned char* lds, int wave_s) {
    const int tid = wave_s * 64 + lane_id_asm(), G = gridDim.x;
    unsigned char* ws = kp->ws;
    const float* cvec = kp->in[1]; const float* ada_w = kp->in[2]; const float* ada_b = kp->in[3];
    float* mod = (float*)(ws + WS_MOD);
    LAS float* cact = (LAS float*)lds;
    LAS float* red = (LAS float*)(lds + 16384);
    LAS float* tile = (LAS float*)(lds + 49152);
    LAS float* pw = (LAS float*)(lds + 49152);
    if ((int)blockIdx.x < 192) {
        for (int i = tid; i < 4096; i += NTHREADS) { const float v = cvec[i]; cact[i] = v * fast_sigmoid(v); }
    }
    if (blockIdx.x == G - 1) {
        float* binp = (float*)(ws + WS_BINP); const float* b_in = kp->in[6];
        for (int i = tid; i < INW; i += NTHREADS) binp[i] = b_in[in_colmap(i)];
    }
    __syncthreads();
    constexpr int N_MOD = 192, N_WIN = 384, N_CO = 128, N_WO = 256, N_WQ = 512, N_WP = 128, N_WG = 512;
    constexpr int I1 = N_MOD, I2 = I1 + N_WIN, I3 = I2 + N_CO, I4 = I3 + N_WO, I5 = I4 + N_WQ, I6 = I5 + N_WP, I7 = I6 + N_WG;
    for (int it = blockIdx.x; it < I7; it += G) {
        if (it < I1) {
            const int n0 = it * 32, c4 = tid & 7, ks = tid >> 3;
            float a[4][4];
#pragma unroll
            for (int b = 0; b < 4; ++b)
#pragma unroll
                for (int j = 0; j < 4; ++j) a[b][j] = 0.f;
#pragma unroll 4
            for (int kk = 0; kk < 16; ++kk) { const int k = ks * 16 + kk; const f32x4 w = *(const f32x4*)(ada_w + (size_t)k * NMOD + n0 + c4 * 4);
#pragma unroll
                for (int b = 0; b < 4; ++b) { const float cv = cact[b * 1024 + k];
#pragma unroll
                    for (int j = 0; j < 4; ++j) a[b][j] += cv * w[j]; } }
#pragma unroll
            for (int b = 0; b < 4; ++b)
#pragma unroll
                for (int j = 0; j < 4; ++j) red[(ks * 4 + b) * 32 + c4 * 4 + j] = a[b][j];
            __syncthreads();
            if (tid < 128) { const int b = tid >> 5, col = tid & 31; float s = 0.f;
                for (int q = 0; q < 64; ++q) s += red[(q * 4 + b) * 32 + col];
                mod[b * NMOD + n0 + col] = s + ada_b[n0 + col]; }
            __syncthreads();
        } else if (it >= I6 || (it >= I1 && it < I2)) {
            const bool isp = it < I2;
            const int i = isp ? it - I1 : it - I6, kt = i & 15, n0 = (i >> 4) * 64 + (isp ? 0 : 1536), c0 = in_colmap(n0);
            const float* win = kp->in[5];
            LAS float* cmx = (LAS float*)(lds + 49152 + 17408);
            { const int r = tid >> 4, c4 = tid & 15;
              const f32x4 v0 = *(const f32x4*)(win + (size_t)(kt * 64 + r) * INW + c0 + c4 * 4), v1 = *(const f32x4*)(win + (size_t)(kt * 64 + r + 32) * INW + c0 + c4 * 4);
#pragma unroll
              for (int j = 0; j < 4; ++j) cmx[r * 64 + c4 * 4 + j] = fmaxf(fabsf(v0[j]), fabsf(v1[j])); }
            __syncthreads();
            if (tid < 64) { float mm = 0.f; for (int q = 0; q < 32; ++q) mm = fmaxf(mm, cmx[q * 64 + tid]); ((float*)(ws + WS_PMAX))[kt * 3584 + n0 + tid] = mm; }
            __syncthreads();
        } else if (it < I3) {
            const int i = it - I2, kt = i & 7, ntl = i >> 3;
            xpose_tile(kp->in[14], 1024, ntl * 64, kt * 64, (bf16_t*)(ws + WS_WPC), 1024, ntl * 64, 512, tile, tid);
        } else if (it < I4) {
            const int i = it - I3, kt = i & 15, ntl = i >> 4;
            xpose_tile(kp->in[15], 1024, ntl * 64, kt * 64, (bf16_t*)(ws + WS_WOUT), 1024, ntl * 64, 0, tile, tid);
        } else if (it < I5) {
            const int i = it - I4, kt = i & 15, ntl = i >> 4;
            xpose_tile(kp->in[17], 2048, ntl * 64, kt * 64, (bf16_t*)(ws + WS_WQ), 1024, ntl * 64, 0, tile, tid);
        } else {
            const int i = it - I5, nb = i & 1, cb = (i >> 1) & 15, g = i >> 5;
            const float* pool_w = kp->in[7]; const float* pool_scale = kp->in[8]; const float* pool_up = kp->in[9];
            for (int e = tid; e < 1024; e += NTHREADS) { const int ci = e >> 7, d = e & 127; pw[e] = pool_w[((size_t)g * 128 + cb * 8 + ci) * 128 + d] * pool_scale[g * 128 + d]; }
            __syncthreads();
            const int n = nb * 512 + tid; float a[8];
#pragma unroll
            for (int q = 0; q < 8; ++q) a[q] = 0.f;
#pragma unroll 4
            for (int d = 0; d < 128; ++d) { const float uv = pool_up[(size_t)(g * 128 + d) * 1024 + n];
#pragma unroll
                for (int q = 0; q < 8; ++q) a[q] += pw[q * 128 + d] * uv; }
            u32x4 w; w.x = cvt_pk_bf16(a[0], a[1]); w.y = cvt_pk_bf16(a[2], a[3]); w.z = cvt_pk_bf16(a[4], a[5]); w.w = cvt_pk_bf16(a[6], a[7]);
            *(u32x4*)((bf16_t*)(ws + WS_WPC) + (size_t)n * 1024 + g * 128 + cb * 8) = w;
            __syncthreads();
        }
    }
    {
        const int lane = tid & 63, wave = tid >> 6;
        f32x4 vn[4];
        { const int r0 = blockIdx.x * 8 + wave;
          if (r0 < 2 * NEXP) { const int tb0 = r0 >= NEXP ? 1 : 0; const f32x4* src = (const f32x4*)((tb0 ? kp->in[21] : kp->in[20]) + (size_t)(r0 - tb0 * NEXP) * D);
#pragma unroll
              for (int q = 0; q < 4; ++q) vn[q] = src[lane + 64 * q]; } }
        for (int r = blockIdx.x * 8 + wave; r < 2 * NEXP; r += G * 8) {
            const int tb = r >= NEXP ? 1 : 0, e = r - tb * NEXP;
            f32x4 v[4]; float m = 0.f;
#pragma unroll
            for (int q = 0; q < 4; ++q) v[q] = vn[q];
            { const int rn = r + G * 8;
              if (rn < 2 * NEXP) { const int tbn = rn >= NEXP ? 1 : 0; const f32x4* src = (const f32x4*)((tbn ? kp->in[21] : kp->in[20]) + (size_t)(rn - tbn * NEXP) * D);
#pragma unroll
                  for (int q = 0; q < 4; ++q) vn[q] = src[lane + 64 * q]; } }
#pragma unroll
            for (int q = 0; q < 4; ++q) m = fmaxf(m, fmaxf(fmaxf(fabsf(v[q][0]), fabsf(v[q][1])), fmaxf(fabsf(v[q][2]), fabsf(v[q][3]))));
            m = wave_max(m);
            const float qmax = tb ? RowFmt<V_BITS>::QMAX : RowFmt<U_BITS>::QMAX;
            const float qs = m > 0.f ? qmax / m : 0.f;
            if (tb) quant_row<V_BITS>(v, qs, ws + WS_EV + (size_t)e * (V_BITS * 128), lane);
            else quant_row<U_BITS>(v, qs, ws + WS_EU + (size_t)e * (U_BITS * 128), lane);
            if (lane == 0) ((float*)(ws + (tb ? WS_SV : WS_SU)))[e] = m / qmax;
        }
    }
}

__device__ __forceinline__ void phase_w8(KP kp, LAS unsigned char* lds, int wave_s) {
    const int tid = wave_s * 64 + lane_id_asm();
    unsigned char* ws = kp->ws;
    const float* win = kp->in[5]; const float* pmax = (const float*)(ws + WS_PMAX);
    LAS float* tile = (LAS float*)(lds + 49152);
    LAS float* csc = (LAS float*)(lds + 49152 + 17408);
    for (int it = blockIdx.x; it < 56 * 16; it += gridDim.x) {
        const int kt = it & 15, n0 = (it >> 4) * 64, c0 = in_colmap(n0);
        if (tid < 64) { float mm = 0.f;
#pragma unroll
            for (int q = 0; q < 16; ++q) mm = fmaxf(mm, pmax[q * 3584 + n0 + tid]);
            csc[tid] = mm > 0.f ? 224.0f / mm : 0.f; if (kt == 0) ((float*)(ws + WS_WP8S))[n0 + tid] = mm * (1.0f / 224.0f); }
        { const int r = tid >> 4, c4 = tid & 15;
#pragma unroll
          for (int ps = 0; ps < 2; ++ps) { const f32x4 v = *(const f32x4*)(win + (size_t)(kt * 64 + r + 32 * ps) * INW + c0 + c4 * 4);
#pragma unroll
              for (int j = 0; j < 4; ++j) tile[(r + 32 * ps) * 65 + c4 * 4 + j] = v[j]; } }
        __syncthreads();
        { const int n = tid >> 3, kg = tid & 7; const float qs = csc[n]; float f[8];
#pragma unroll
          for (int i = 0; i < 8; ++i) f[i] = tile[(kg * 8 + i) * 65 + n] * qs;
          int p0 = 0, p1 = 0;
          p0 = __builtin_amdgcn_cvt_pk_fp8_f32(f[0], f[1], p0, false); p0 = __builtin_amdgcn_cvt_pk_fp8_f32(f[2], f[3], p0, true);
          p1 = __builtin_amdgcn_cvt_pk_fp8_f32(f[4], f[5], p1, false); p1 = __builtin_amdgcn_cvt_pk_fp8_f32(f[6], f[7], p1, true);
          *(u32x2*)(ws + WS_WP8 + (size_t)(n0 + n) * 1024 + kt * 64 + kg * 8) = (u32x2){(unsigned)p0, (unsigned)p1}; }
        __syncthreads();
    }
}

template <bool WITH_FP8>
__device__ __forceinline__ void phase_norm_ada(const float* src, const float* gain, const float* mod, int shift_off, int scale_off, bf16_t* dst, unsigned char* dst8, float* dscale, int wave_s) {
    const int lane = lane_id_asm(), wave = wave_s;
    f32x4 vn[4];
    { const int row0 = blockIdx.x * 8 + wave;
      if (row0 < T) { const f32x4* xr = (const f32x4*)(src + (size_t)row0 * D);
#pragma unroll
          for (int j = 0; j < 4; ++j) vn[j] = xr[lane + 64 * j]; } }
    for (int row = blockIdx.x * 8 + wave; row < T; row += gridDim.x * 8) {
        const int b = row / SEQ;
        f32x4 v[4]; float ss = 0.f;
#pragma unroll
        for (int j = 0; j < 4; ++j) v[j] = vn[j];
        { const int rn = row + gridDim.x * 8;
          if (rn < T) { const f32x4* xr = (const f32x4*)(src + (size_t)rn * D);
#pragma unroll
              for (int j = 0; j < 4; ++j) vn[j] = xr[lane + 64 * j]; } }
#pragma unroll
        for (int j = 0; j < 4; ++j) ss += v[j][0] * v[j][0] + v[j][1] * v[j][1] + v[j][2] * v[j][2] + v[j][3] * v[j][3];
        ss = wave_sum(ss);
        const float r = rsqrtf(ss * (1.0f / D) + EPS);
        float am = 0.f;
#pragma unroll
        for (int j = 0; j < 4; ++j) {
            const int col = 4 * lane + 256 * j;
            const f32x4 g = *(const f32x4*)(gain + col), sc = *(const f32x4*)(mod + (size_t)b * NMOD + scale_off + col), sh = *(const f32x4*)(mod + (size_t)b * NMOD + shift_off + col);
            const f32x4 h = v[j] * r * g * (sc + 1.0f) + sh;
            u32x2 w; w.x = cvt_pk_bf16(h[0], h[1]); w.y = cvt_pk_bf16(h[2], h[3]);
            if (dst) *(u32x2*)(dst + (size_t)row * D + col) = w;
            if (WITH_FP8) { v[j] = h; am = fmaxf(am, fmaxf(fmaxf(fabsf(h[0]), fabsf(h[1])), fmaxf(fabsf(h[2]), fabsf(h[3])))); }
        }
        if (WITH_FP8) {
            am = wave_max(am);
            const float qs = am > 0.f ? 224.0f / am : 0.f;
#pragma unroll
            for (int j = 0; j < 4; ++j) { int p = 0; p = __builtin_amdgcn_cvt_pk_fp8_f32(v[j][0] * qs, v[j][1] * qs, p, false); p = __builtin_amdgcn_cvt_pk_fp8_f32(v[j][2] * qs, v[j][3] * qs, p, true);
                *(unsigned*)(dst8 + (size_t)row * D + 4 * lane + 256 * j) = (unsigned)p; }
            if (lane == 0) dscale[row] = am * (1.0f / 224.0f);
        }
    }
}

__device__ __forceinline__ void phase_aux(KP kp, LAS unsigned char* lds, int wave_s) {
    const int tid = wave_s * 64 + lane_id_asm();
    unsigned char* ws = kp->ws;
    const float* mod = (const float*)(ws + WS_MOD);
    const int bid = blockIdx.x;
    if (bid == 0) {
        float* A2 = (float*)(ws + WS_A2); const float* g2 = kp->in[16];
        for (int i = tid; i < 4096; i += NTHREADS) { const int b = i >> 10, k = i & 1023; A2[i] = g2[k] * (1.0f + mod[(size_t)b * NMOD + 4 * 1024 + k]); }
    } else if (bid <= 8) {
        float* SSQ = (float*)(ws + WS_SSQ) + (bid - 1) * 4096;
        for (int i = tid; i < 4096; i += NTHREADS) SSQ[i] = 0.f;
    } else if (bid <= 24) {
        const int n0 = (bid - 9) * 128, c4 = tid & 31, ks = tid >> 5;
        const float* wq = kp->in[17];
        LAS float* red = (LAS float*)lds;
        float a[4][4];
#pragma unroll
        for (int b = 0; b < 4; ++b)
#pragma unroll
            for (int j = 0; j < 4; ++j) a[b][j] = 0.f;
#pragma unroll 4
        for (int kk = 0; kk < 64; ++kk) { const int k = ks * 64 + kk; const f32x4 w = *(const f32x4*)(wq + (size_t)k * 2048 + n0 + c4 * 4);
#pragma unroll
            for (int b = 0; b < 4; ++b) { const float sv = mod[(size_t)b * NMOD + 3 * 1024 + k];
#pragma unroll
                for (int j = 0; j < 4; ++j) a[b][j] += sv * w[j]; } }
#pragma unroll
        for (int b = 0; b < 4; ++b)
#pragma unroll
            for (int j = 0; j < 4; ++j) red[(ks * 4 + b) * 128 + c4 * 4 + j] = a[b][j];
        __syncthreads();
        { const int b = tid >> 7, col = tid & 127; float sm = 0.f;
          for (int q = 0; q < 16; ++q) sm += red[(q * 4 + b) * 128 + col];
          ((float*)(ws + WS_BIAS2))[b * 2048 + n0 + col] = sm; }
        __syncthreads();
    }
}

template <int W>
__device__ __forceinline__ void pool_window(const float (&x0)[31], const float (&x1)[31], int spos0, bf16_t* dstp) {
#pragma unroll
    for (int i = 0; i < 16; ++i) {
        float s0 = 0.f, s1 = 0.f;
#pragma unroll
        for (int d = 0; d < W; ++d) { s0 += x0[i + 15 - d]; s1 += x1[i + 15 - d]; }
        const int sp = spos0 + i; const float inv = 1.0f / (float)(sp + 1 < W ? sp + 1 : W);
        const float m0 = s0 * inv - x0[i + 15], m1 = s1 * inv - x1[i + 15];
        *(unsigned*)(dstp + (size_t)i * 1024) = cvt_pk_bf16(m0, m1);
    }
}
__device__ __forceinline__ void phase_branches(KP kp, LAS unsigned char* lds, int wave_s) {
    const int lane = lane_id_asm(), wave = wave_s, tid = wave * 64 + lane;
    unsigned char* ws = kp->ws;
    const bf16_t* PB = (const bf16_t*)(ws + WS_PG); const bf16_t* GB = PB + (size_t)T * 512;
    bf16_t* MC = (bf16_t*)(ws + WS_MC);
    const float* dwk = kp->in[10]; const float* dwb = kp->in[11]; const float* lng = kp->in[12]; const float* lnb = kp->in[13];
    LAS unsigned* rows = (LAS unsigned*)lds;
    LAS float* ybuf = (LAS float*)(lds + 63488);
    const int cp = tid & 255, th = tid >> 8;
    float w0[31], w1[31];
#pragma unroll
    for (int j = 0; j < 31; ++j) { const f32x2 w = *(const f32x2*)(dwk + j * 512 + 2 * cp); w0[j] = w.x; w1[j] = w.y; }
    const f32x2 cb = *(const f32x2*)(dwb + 2 * cp);
    u32x4 gpre[8], ppre[6];
#define P3_LOAD_G(t0_, s0_) do { _Pragma("unroll") for (int i_ = 0; i_ < 8; ++i_) { const int e = tid + i_ * NTHREADS; const int r = e >> 6, c = e & 63; u32x4 v = {0u, 0u, 0u, 0u}; \
            if (e < 62 * 64 && (s0_) + r - 30 >= 0) v = *(const u32x4*)(GB + (size_t)((t0_) + r - 30) * 512 + c * 8); gpre[i_] = v; } } while (0)
#define P3_LOAD_P(t0_, s0_) do { _Pragma("unroll") for (int i_ = 0; i_ < 6; ++i_) { const int e = tid + i_ * NTHREADS; const int r = e >> 6, c = e & 63; u32x4 v = {0u, 0u, 0u, 0u}; \
            if (e < 47 * 64 && (s0_) + r - 15 >= 0) v = *(const u32x4*)(PB + (size_t)((t0_) + r - 15) * 512 + c * 8); ppre[i_] = v; } } while (0)
    if ((int)blockIdx.x < T / 32) { const int t0 = blockIdx.x * 32; P3_LOAD_G(t0, t0 % SEQ); }
    for (int tl = blockIdx.x; tl < T / 32; tl += gridDim.x) {
        const int t0 = tl * 32, s0 = t0 % SEQ;
#pragma unroll
        for (int i_ = 0; i_ < 8; ++i_) { const int e = tid + i_ * NTHREADS; if (e < 62 * 64) *(LAS u32x4*)(rows + (e >> 6) * 256 + (e & 63) * 4) = gpre[i_]; }
        __syncthreads();
        P3_LOAD_P(t0, s0);
        {
            float a0[16], a1[16];
#pragma unroll
            for (int i = 0; i < 16; ++i) { a0[i] = cb.x; a1[i] = cb.y; }
#pragma unroll
            for (int r = 0; r < 46; ++r) {
                const unsigned uu = rows[(th * 16 + r) * 256 + cp]; const float x0 = bf_lo(uu), x1 = bf_hi(uu);
#pragma unroll
                for (int i = 0; i < 16; ++i) { const int j = r - i; if (j >= 0 && j <= 30) { a0[i] += x0 * w0[j]; a1[i] += x1 * w1[j]; } }
            }
#pragma unroll
            for (int i = 0; i < 16; ++i) *(LAS f32x2*)(ybuf + (th * 16 + i) * 512 + 2 * cp) = (f32x2){a0[i], a1[i]};
        }
        __syncthreads();
        {
            const f32x4 g0 = *(const f32x4*)(lng + lane * 8), g1 = *(const f32x4*)(lng + lane * 8 + 4), b0 = *(const f32x4*)(lnb + lane * 8), b1 = *(const f32x4*)(lnb + lane * 8 + 4);
#pragma unroll
            for (int q = 0; q < 4; ++q) {
                const int tk = wave * 4 + q;
                const f32x4 y0 = *(const LAS f32x4*)(ybuf + tk * 512 + lane * 8), y1 = *(const LAS f32x4*)(ybuf + tk * 512 + lane * 8 + 4);
                float s = (y0[0] + y0[1]) + (y0[2] + y0[3]) + (y1[0] + y1[1]) + (y1[2] + y1[3]);
                s = wave_sum(s); const float mu = s * (1.0f / 512.0f);
                const f32x4 d0 = y0 - mu, d1 = y1 - mu;
                float qv = d0[0] * d0[0] + d0[1] * d0[1] + d0[2] * d0[2] + d0[3] * d0[3] + d1[0] * d1[0] + d1[1] * d1[1] + d1[2] * d1[2] + d1[3] * d1[3];
                qv = wave_sum(qv); const float rs = rsqrtf(qv * (1.0f / 512.0f) + EPS);
                f32x4 o0 = d0 * rs * g0 + b0, o1 = d1 * rs * g1 + b1;
#pragma unroll
                for (int j = 0; j < 4; ++j) { o0[j] = o0[j] * fast_sigmoid(o0[j]); o1[j] = o1[j] * fast_sigmoid(o1[j]); }
                u32x4 w; w.x = cvt_pk_bf16(o0[0], o0[1]); w.y = cvt_pk_bf16(o0[2], o0[3]); w.z = cvt_pk_bf16(o1[0], o1[1]); w.w = cvt_pk_bf16(o1[2], o1[3]);
                *(u32x4*)(MC + (size_t)(t0 + tk) * 1024 + 512 + lane * 8) = w;
            }
        }
        __syncthreads();
#pragma unroll
        for (int i_ = 0; i_ < 6; ++i_) { const int e = tid + i_ * NTHREADS; if (e < 47 * 64) *(LAS u32x4*)(rows + (e >> 6) * 256 + (e & 63) * 4) = ppre[i_]; }
        __syncthreads();
        { const int tn = tl + gridDim.x; if (tn < T / 32) { const int t0n = tn * 32; P3_LOAD_G(t0n, t0n % SEQ); } }
        {
            float x0[31], x1[31];
#pragma unroll
            for (int r = 0; r < 31; ++r) { const unsigned uu = rows[(th * 16 + r) * 256 + cp]; x0[r] = bf_lo(uu); x1[r] = bf_hi(uu); }
            bf16_t* dstp = MC + (size_t)(t0 + th * 16) * 1024 + 2 * cp;
            const int grp = __builtin_amdgcn_readfirstlane(cp >> 6), sp0 = s0 + th * 16;
            if (grp == 0) pool_window<2>(x0, x1, sp0, dstp);
            else if (grp == 1) pool_window<4>(x0, x1, sp0, dstp);
            else if (grp == 2) pool_window<8>(x0, x1, sp0, dstp);
            else pool_window<16>(x0, x1, sp0, dstp);
        }
        __syncthreads();
    }
}

#define CE_DESC(a, b) do { const int _hi = max(a, b), _lo = min(a, b); a = _hi; b = _lo; } while (0)
#define CE_ASC(a, b)  do { const int _hi = max(a, b), _lo = min(a, b); a = _lo; b = _hi; } while (0)
__device__ __forceinline__ void bitonic_sort16_desc(int (&v)[16]) {
#pragma unroll
    for (int k = 2; k <= 16; k <<= 1)
#pragma unroll
        for (int j = k >> 1; j > 0; j >>= 1)
#pragma unroll
            for (int i = 0; i < 16; ++i) { const int l = i ^ j; if (l > i) { if ((i & k) == 0) CE_DESC(v[i], v[l]); else CE_ASC(v[i], v[l]); } }
}
__device__ __forceinline__ void bitonic_merge16_desc(int (&v)[16]) {
#pragma unroll
    for (int j = 8; j > 0; j >>= 1)
#pragma unroll
        for (int i = 0; i < 16; ++i) { const int l = i ^ j; if (l > i) CE_DESC(v[i], v[l]); }
}
__device__ __forceinline__ void top16_merge(int (&a)[16], const int (&b)[16]) {
#pragma unroll
    for (int i = 0; i < 16; ++i) a[i] = max(a[i], b[15 - i]);
    bitonic_merge16_desc(a);
}
#define CEF_DESC(a, b) do { const float _hi = fmaxf(a, b), _lo = fminf(a, b); a = _hi; b = _lo; } while (0)
#define CEF_ASC(a, b)  do { const float _hi = fmaxf(a, b), _lo = fminf(a, b); a = _lo; b = _hi; } while (0)
__device__ __forceinline__ void fbitonic_sort16_desc(float (&v)[16]) {
#pragma unroll
    for (int k = 2; k <= 16; k <<= 1)
#pragma unroll
        for (int j = k >> 1; j > 0; j >>= 1)
#pragma unroll
            for (int i = 0; i < 16; ++i) { const int l = i ^ j; if (l > i) { if ((i & k) == 0) CEF_DESC(v[i], v[l]); else CEF_ASC(v[i], v[l]); } }
}
__device__ __forceinline__ void fsort16_desc(float (&v)[16]) {
    CEF_DESC(v[0], v[13]); CEF_DESC(v[1], v[12]); CEF_DESC(v[2], v[15]); CEF_DESC(v[3], v[14]); CEF_DESC(v[4], v[8]); CEF_DESC(v[5], v[6]); CEF_DESC(v[7], v[11]); CEF_DESC(v[9], v[10]); CEF_DESC(v[0], v[5]); CEF_DESC(v[1], v[7]); CEF_DESC(v[2], v[9]); CEF_DESC(v[3], v[4]); CEF_DESC(v[6], v[13]); CEF_DESC(v[8], v[14]); CEF_DESC(v[10], v[15]); CEF_DESC(v[11], v[12]); CEF_DESC(v[0], v[1]); CEF_DESC(v[2], v[3]); CEF_DESC(v[4], v[5]); CEF_DESC(v[6], v[8]); CEF_DESC(v[7], v[9]); CEF_DESC(v[10], v[11]); CEF_DESC(v[12], v[13]); CEF_DESC(v[14], v[15]); CEF_DESC(v[0], v[2]); CEF_DESC(v[1], v[3]); CEF_DESC(v[4], v[10]); CEF_DESC(v[5], v[11]); CEF_DESC(v[6], v[7]); CEF_DESC(v[8], v[9]); CEF_DESC(v[12], v[14]); CEF_DESC(v[13], v[15]); CEF_DESC(v[1], v[2]); CEF_DESC(v[3], v[12]); CEF_DESC(v[4], v[6]); CEF_DESC(v[5], v[7]); CEF_DESC(v[8], v[10]); CEF_DESC(v[9], v[11]); CEF_DESC(v[13], v[14]); CEF_DESC(v[1], v[4]); CEF_DESC(v[2], v[6]); CEF_DESC(v[5], v[8]); CEF_DESC(v[7], v[10]); CEF_DESC(v[9], v[13]); CEF_DESC(v[11], v[14]); CEF_DESC(v[2], v[4]); CEF_DESC(v[3], v[6]); CEF_DESC(v[9], v[12]); CEF_DESC(v[11], v[13]); CEF_DESC(v[3], v[5]); CEF_DESC(v[6], v[8]); CEF_DESC(v[7], v[9]); CEF_DESC(v[10], v[12]); CEF_DESC(v[3], v[4]); CEF_DESC(v[5], v[6]); CEF_DESC(v[7], v[8]); CEF_DESC(v[9], v[10]); CEF_DESC(v[11], v[12]); CEF_DESC(v[6], v[7]); CEF_DESC(v[8], v[9]);
}
__device__ __forceinline__ void fbitonic_merge16_desc(float (&v)[16]) {
#pragma unroll
    for (int j = 8; j > 0; j >>= 1)
#pragma unroll
        for (int i = 0; i < 16; ++i) { const int l = i ^ j; if (l > i) CEF_DESC(v[i], v[l]); }
}
__device__ __forceinline__ void ftop16_merge(float (&a)[16], const float (&b)[16]) {
#pragma unroll
    for (int i = 0; i < 16; ++i) a[i] = fmaxf(a[i], b[15 - i]);
    fbitonic_merge16_desc(a);
}
__device__ __forceinline__ int packkey(float v, int idx) { const int f = __float_as_int(v); const int s = f ^ ((f >> 31) & 0x7fffffff); return (s & ~127) | (127 - idx); }
__device__ __forceinline__ float keyval(int k) { const int s = k & ~127; return __int_as_float(s ^ ((s >> 31) & 0x7fffffff)); }
__device__ __forceinline__ void top16_of_scores(const f32x16 (&acc)[4], int hclr, float (&L)[16]) {
    float M[16];
#pragma unroll
    for (int kt = 0; kt < 4; ++kt) {
        float v[16];
#pragma unroll
        for (int r = 0; r < 16; ++r) v[r] = __int_as_float(((__float_as_int(acc[kt][r]) & ~127) | (127 - (kt * 32 + (r & 3) + 8 * (r >> 2)))) & hclr);
        fsort16_desc(v);
        if (kt == 0) {
#pragma unroll
            for (int i = 0; i < 16; ++i) L[i] = v[i];
        } else ftop16_merge(L, v);
    }
#pragma unroll
    for (int i = 0; i < 16; ++i) M[i] = __shfl_xor(L[i], 32);
    ftop16_merge(L, M);
}
__device__ __forceinline__ void phase_topk(KP kp, LAS unsigned char* lds, int wave_s) {
    const int lane = lane_id_asm(), wave = wave_s, tid = wave * 64 + lane;
    unsigned char* ws = kp->ws;
    const bf16_t* Q = (const bf16_t*)(ws + WS_SG);
    int* IDX = (int*)(ws + WS_IDX); float* GATE = (float*)(ws + WS_GATE);
    LAS unsigned* stg = (LAS unsigned*)(lds + 65536);
    for (int e = tid; e < 2 * 32 * 64; e += NTHREADS) {
        const int f = e >> 6, l = e & 63, set = f >> 5, kt = (f >> 3) & 3, ks = f & 7;
        const float* src = (set ? kp->in[19] : kp->in[18]) + (kt * 32 + (l & 31)) * 128 + ks * 16 + 8 * (l >> 5);
        const f32x4 a = *(const f32x4*)src, b = *(const f32x4*)(src + 4);
        u32x4 w; w.x = cvt_pk_bf16(a[0], a[1]); w.y = cvt_pk_bf16(a[2], a[3]); w.z = cvt_pk_bf16(b[0], b[1]); w.w = cvt_pk_bf16(b[2], b[3]);
        *(LAS u32x4*)(lds + (size_t)e * 16) = w;
    }
    __syncthreads();
    const int h = lane >> 5;
    pg8::StaticOrder SO; SO.init(T, 2048, gridDim.x, blockIdx.x);
    pg8::Unit uu;
    for (int ui = 0; SO.next(ui, uu); ++ui) {
        const int tile = uu.pm, head = uu.pn;
        const int tok = tile * 256 + wave * 32 + (lane & 31);
        const bf16_t* qfrag = Q + ((size_t)(tile * 8 + head) * 128 + (size_t)wave * 16) * 512 + lane * 8;
        float L1[16], L2[16];
#pragma unroll
        for (int set = 0; set < 2; ++set) {
            f32x16 acc[4];
#pragma unroll
            for (int kt = 0; kt < 4; ++kt)
#pragma unroll
                for (int r = 0; r < 16; ++r) acc[kt][r] = 0.f;
#pragma unroll
            for (int ks = 0; ks < 8; ++ks) {
                const bf16x8 bq = *(const bf16x8*)(qfrag + (set * 8 + ks) * 512);
#pragma unroll
                for (int kt = 0; kt < 4; ++kt) {
                    const bf16x8 ak = *(const LAS bf16x8*)(lds + (size_t)((((set * 4 + kt) * 8 + ks) * 64) + lane) * 16);
                    acc[kt] = __builtin_amdgcn_mfma_f32_32x32x16_bf16(ak, bq, acc[kt], 0, 0, 0);
                }
            }
#ifdef DBG_VALU_SCORES
            {   const float* keys = set ? kp->in[19] : kp->in[18];
                const bf16_t* qr = Q + (size_t)tok * 2048 + head * 256 + set * 128;
                for (int kt = 0; kt < 4; ++kt)
                    for (int r = 0; r < 16; ++r) {
                        const int idx = kt * 32 + (r & 3) + 8 * (r >> 2) + 4 * h; float sacc = 0.f;
                        for (int k = 0; k < 128; ++k) sacc += __uint_as_float(((unsigned)qr[k]) << 16) * keys[idx * 128 + k];
#pragma unroll
                        for (int kk = 0; kk < 4; ++kk)
#pragma unroll
                            for (int rr = 0; rr < 16; ++rr) if (kk == kt && rr == r) acc[kk][rr] = sacc;
                    }
            }
#endif
            if (set == 0) top16_of_scores(acc, ~(4 * h), L1); else top16_of_scores(acc, ~(4 * h), L2);
        }
        float v1[16], v2[16]; int i1[16], i2[16];
#pragma unroll
        for (int i = 0; i < 16; ++i) { const int k1 = __float_as_int(L1[i]), k2 = __float_as_int(L2[i]); v1[i] = __int_as_float(k1 & ~127); i1[i] = 127 - (k1 & 127); v2[i] = __int_as_float(k2 & ~127); i2[i] = 127 - (k2 & 127); }
        float thr, mx;
        {
            float A[16], B[16], C[16], Dd[16];
#pragma unroll
            for (int j = 0; j < 16; ++j) A[j] = v1[0] + v2[j];
#pragma unroll
            for (int j = 0; j < 8; ++j) { B[j] = v1[1] + v2[j]; B[8 + j] = v1[15 - j] + v2[0]; }
            fbitonic_merge16_desc(B);
            C[0] = v1[2] + v2[0]; C[1] = v1[2] + v2[1]; C[2] = v1[2] + v2[2]; C[3] = v1[2] + v2[3]; C[4] = v1[2] + v2[4];
            C[5] = v1[3] + v2[0]; C[6] = v1[3] + v2[1]; C[7] = v1[3] + v2[2]; C[8] = v1[3] + v2[3];
            C[9] = v1[4] + v2[0]; C[10] = v1[4] + v2[1]; C[11] = v1[4] + v2[2];
            C[12] = v1[5] + v2[0]; C[13] = v1[5] + v2[1]; C[14] = v1[6] + v2[0]; C[15] = v1[6] + v2[1];
            fsort16_desc(C);
            Dd[0] = v1[7] + v2[0]; Dd[1] = v1[7] + v2[1];
#pragma unroll
            for (int j = 2; j < 16; ++j) Dd[j] = -3.0e38f;
            ftop16_merge(A, B); ftop16_merge(C, Dd);
            mx = fmaxf(A[0], C[0]);
            float t = fmaxf(A[0], C[15]);
#pragma unroll
            for (int i = 1; i < 16; ++i) t = fminf(t, fmaxf(A[i], C[15 - i]));
            thr = t;
        }
        if (h == 0) {
            LAS unsigned* row = stg + (wave * 32 + (lane & 31)) * 44;
            int cnt = 0; float sum = 0.f;
#pragma unroll
            for (int i = 0; i < 16; ++i)
#pragma unroll
                for (int j = 0; j < 16; ++j) if ((i + 1) * (j + 1) <= 16) {
                    const float x = v1[i] + v2[j];
                    const bool pr = (x >= thr) && (cnt < 16);
                    const float ev = __expf(x - mx);
                    const int pos = pr ? cnt : 16;
                    row[pos] = (unsigned)(i1[i] * 128 + i2[j]); row[20 + pos] = __float_as_uint(ev);
                    sum += pr ? ev : 0.f; cnt += pr ? 1 : 0;
                }
            const float inv = 1.0f / sum;
            u32x4* ip = (u32x4*)(IDX + ((size_t)tok * 8 + head) * 16); f32x4* gp = (f32x4*)(GATE + ((size_t)tok * 8 + head) * 16);
#pragma unroll
            for (int q = 0; q < 4; ++q) {
                ip[q] = *(const LAS u32x4*)(row + 4 * q);
                const u32x4 gu = *(const LAS u32x4*)(row + 20 + 4 * q);
                gp[q] = (f32x4){__uint_as_float(gu.x) * inv, __uint_as_float(gu.y) * inv, __uint_as_float(gu.z) * inv, __uint_as_float(gu.w) * inv};
            }
        }
    }
}

__device__ __forceinline__ float gelu_tanh(float x) {
    const float y = 0.7978845608028654f * (x + 0.044715f * x * x * x);
    return x * fast_sigmoid(2.0f * y);
}
typedef int i32x8 __attribute__((ext_vector_type(8)));
#define DPPF(x, ctrl) __int_as_float(__builtin_amdgcn_update_dpp(0, __float_as_int(x), ctrl, 0xF, 0xF, true))
struct TokMeta { u32x4 hb; f32x2 hs; int e0, e1; float g0, g1, cu0, cu1, sv0, sv1; u32x4 x1[2]; f32x4 g2[4]; };
__device__ __forceinline__ void peer_load_meta(TokMeta& m, int tok, int lane, const unsigned char* HB, const f32x2* HS, const int* IDX, const float* GATE, const bf16_t* X1, const float* modp) {
    { const u32x4* xp = (const u32x4*)(X1 + (size_t)tok * D + 16 * lane); m.x1[0] = xp[0]; m.x1[1] = xp[1];
      const f32x4* gp = (const f32x4*)(modp + (size_t)(tok / SEQ) * NMOD + 5 * 1024 + 16 * lane); m.g2[0] = gp[0]; m.g2[1] = gp[1]; m.g2[2] = gp[2]; m.g2[3] = gp[3]; }
    m.hb = *(const u32x4*)(HB + (size_t)tok * 1024 + ((lane & 15) * 4 + (lane >> 4)) * 16);
    m.hs = HS[tok];
    m.e0 = IDX[(size_t)tok * 128 + lane]; m.e1 = IDX[(size_t)tok * 128 + 64 + lane];
    m.g0 = GATE[(size_t)tok * 128 + lane]; m.g1 = GATE[(size_t)tok * 128 + 64 + lane];
}
__device__ __forceinline__ void peer_load_scales(TokMeta& m, const float* SU, const float* SV) { m.cu0 = SU[m.e0]; m.cu1 = SU[m.e1]; m.sv0 = SV[m.e0]; m.sv1 = SV[m.e1]; }
typedef RowFmt<V_BITS>::row_t vrow_t;
#define PEER_LOAD(UQ, VQ, g) do { const int bb_ = (g) & 15; const bool nx_ = (g) >= 16; \
        const int src_ = bb_ < 8 ? (nx_ ? mn.e0 : m.e0) : (nx_ ? mn.e1 : m.e1); \
        _Pragma("unroll") for (int j_ = 0; j_ < 4; ++j_) { \
            const int ea_ = __builtin_amdgcn_readlane(src_, (8 * bb_ + 2 * j_) & 63), eb_ = __builtin_amdgcn_readlane(src_, (8 * bb_ + 2 * j_ + 1) & 63); \
            UQ[j_] = __builtin_bit_cast(u32x4, __builtin_amdgcn_raw_buffer_load_b128(rsU, ((mhi ? eb_ : ea_) << 9) + uoff, 0, 0)); \
            VQ[2 * j_] = __builtin_bit_cast(u32x2, __builtin_amdgcn_raw_buffer_load_b64(rsV, lane * 8, ea_ << 9, 0)); \
            VQ[2 * j_ + 1] = __builtin_bit_cast(u32x2, __builtin_amdgcn_raw_buffer_load_b64(rsV, lane * 8, eb_ << 9, 0)); } } while (0)
#define PEER_COMPUTE(UQ, VQ, bt) do { \
        float x_[4]; \
        _Pragma("unroll") for (int j_ = 0; j_ < 4; ++j_) { \
            const i32x8 a_ = {(int)UQ[j_].x, (int)UQ[j_].y, (int)UQ[j_].z, (int)UQ[j_].w, 0, 0, 0, 0}; \
            const f32x4 d_ = __builtin_amdgcn_mfma_scale_f32_16x16x128_f8f6f4(a_, hbv, (f32x4){0.f, 0.f, 0.f, 0.f}, 4, 4, 0, 0x7f7f7f7f, 0, 0x7f7f7f7f); \
            const float s_ = r0 ? d_[0] : r1 ? d_[1] : r2 ? d_[2] : d_[3]; \
            x_[j_] = s_ * st; } \
        float y2[2], q1; \
        _Pragma("unroll") for (int k_ = 0; k_ < 2; ++k_) { const float a_ = b4 ? x_[k_ + 2] : x_[k_], sd_ = b4 ? x_[k_] : x_[k_ + 2]; y2[k_] = a_ + __shfl_xor(sd_, 16); } \
        { const float a_ = b3 ? y2[1] : y2[0], sd_ = b3 ? y2[0] : y2[1]; q1 = a_ + DPPF(sd_, 0x128); }                  \
        q1 += DPPF(q1, 0xB1); q1 += DPPF(q1, 0x4E); q1 += DPPF(q1, 0x141);                                            \
        const int slot_ = (8 * (bt) + jj) & 63; \
        const float cu_ = __shfl((bt) < 8 ? m.cu0 : m.cu1, slot_), cv_ = __shfl((bt) < 8 ? m.g0 * m.sv0 : m.g1 * m.sv1, slot_); \
        const float c_ = gelu_tanh(q1 * cu_) * cv_; \
        _Pragma("unroll") for (int j_ = 0; j_ < 8; ++j_) { \
            const float cj_ = __int_as_float(__builtin_amdgcn_readlane(__float_as_int(c_), 32 * (j_ & 1) + 8 * ((j_ >> 1) & 1) + 16 * ((j_ >> 2) & 1))); \
            row_axpy16(VQ[j_], cj_, o); } } while (0)
__device__ __forceinline__ void phase_peer(KP kp, int wave_s) {
    const int lane = lane_id_asm(), wave = wave_s;
    unsigned char* ws = kp->ws;
    const __amdgpu_buffer_rsrc_t rsU = __builtin_amdgcn_make_buffer_rsrc((void*)(ws + WS_EU), 0, NEXP * U_BITS * 128, 0x00020000);
    const __amdgpu_buffer_rsrc_t rsV = __builtin_amdgcn_make_buffer_rsrc((void*)(ws + WS_EV), 0, NEXP * V_BITS * 128, 0x00020000);
    const unsigned char* HB = ws + WS_HB; const f32x2* HS = (const f32x2*)(ws + WS_HS);
    const int* IDX = (const int*)(ws + WS_IDX); const float* GATE = (const float*)(ws + WS_GATE);
    const float* SU = (const float*)(ws + WS_SU); const float* SV = (const float*)(ws + WS_SV);
    const float* mod = (const float*)(ws + WS_MOD); const float* fg = kp->in[22];
    const bf16_t* X1 = (const bf16_t*)(ws + WS_X1B); float* OUT = kp->out;
    const bool b5 = lane & 32, b4 = lane & 16, b3 = lane & 8;
    const int jj = 4 * (b4 ? 1 : 0) + 2 * (b3 ? 1 : 0) + (b5 ? 1 : 0);
    const int nn = lane & 15, qq = lane >> 4;
    const bool mhi = nn >= 8;
    const int uoff = 64 * (nn & 7) + 16 * qq;
    const bool useful = ((nn & 7) >> 2) == (qq & 1);
    const bool r0 = (nn & 3) == 0, r1 = (nn & 3) == 1, r2 = (nn & 3) == 2;
    const int tstride = gridDim.x * 8;
    int tok = blockIdx.x * 8 + wave;
    f32x4 fgv[4];
#pragma unroll
    for (int q = 0; q < 4; ++q) fgv[q] = *(const f32x4*)(fg + 16 * lane + 4 * q);
    TokMeta m, mn;
    u32x4 uqA[4], uqB[4]; vrow_t vqA[8], vqB[8];
    if (tok < T) { peer_load_meta(m, tok, lane, HB, HS, IDX, GATE, X1, mod); peer_load_scales(m, SU, SV); mn = m; PEER_LOAD(uqA, vqA, 0); }
    for (; tok < T; tok += tstride) {
        const int b = tok / SEQ;
        const bool has_next = tok + tstride < T;
        if (has_next) peer_load_meta(mn, tok + tstride, lane, HB, HS, IDX, GATE, X1, mod);
        const i32x8 hbv = {(int)m.hb.x, (int)m.hb.y, (int)m.hb.z, (int)m.hb.w, 0, 0, 0, 0};
        const float st = useful ? ((nn >> 3) ? m.hs.y : m.hs.x) : 0.f;
        f32x2 o[8];
#pragma unroll
        for (int i = 0; i < 8; ++i) o[i] = (f32x2){0.f, 0.f};
#pragma unroll 1
        for (int bt = 0; bt < 16; bt += 2) {
            PEER_LOAD(uqB, vqB, bt + 1);
            PEER_COMPUTE(uqA, vqA, bt);
            PEER_LOAD(uqA, vqA, bt + 2);
            PEER_COMPUTE(uqB, vqB, bt + 1);
        }
        if (has_next) peer_load_scales(mn, SU, SV);
        float* xr = OUT + (size_t)tok * D + 16 * lane;
        const unsigned xw[8] = {m.x1[0].x, m.x1[0].y, m.x1[0].z, m.x1[0].w, m.x1[1].x, m.x1[1].y, m.x1[1].z, m.x1[1].w};
        f32x4 xv[4]; float ss = 0.f;
#pragma unroll
        for (int q = 0; q < 4; ++q) {
            const f32x4 x1v = {bf_lo(xw[2 * q]), bf_hi(xw[2 * q]), bf_lo(xw[2 * q + 1]), bf_hi(xw[2 * q + 1])}, gv = m.g2[q];
            xv[q][0] = x1v[0] + gv[0] * o[2 * q].x; xv[q][1] = x1v[1] + gv[1] * o[2 * q].y; xv[q][2] = x1v[2] + gv[2] * o[2 * q + 1].x; xv[q][3] = x1v[3] + gv[3] * o[2 * q + 1].y;
            ss += xv[q][0] * xv[q][0] + xv[q][1] * xv[q][1] + xv[q][2] * xv[q][2] + xv[q][3] * xv[q][3];
        }
        ss = wave_sum(ss);
        const float r = rsqrtf(ss * (1.0f / D) + EPS);
#pragma unroll
        for (int q = 0; q < 4; ++q) *(f32x4*)(xr + 4 * q) = xv[q] * r * fgv[q];
        m = mn;
    }
}

__device__ __forceinline__ void quant_h2(const u32x4& xa0, const u32x4& xa1, float ssq, const LAS float* shrow, LAS unsigned char* hbuf, int lane, u32x4& hb, f32x2& hs) {
    const f32x4 s0v = *(const LAS f32x4*)(shrow + 16 * lane), s1v = *(const LAS f32x4*)(shrow + 16 * lane + 4), s2v = *(const LAS f32x4*)(shrow + 16 * lane + 8), s3v = *(const LAS f32x4*)(shrow + 16 * lane + 12);
    const float rr = rsqrtf(ssq * (1.0f / D) + EPS);
    const unsigned xw[8] = {xa0.x, xa0.y, xa0.z, xa0.w, xa1.x, xa1.y, xa1.z, xa1.w};
    const float sh[16] = {s0v[0], s0v[1], s0v[2], s0v[3], s1v[0], s1v[1], s1v[2], s1v[3], s2v[0], s2v[1], s2v[2], s2v[3], s3v[0], s3v[1], s3v[2], s3v[3]};
    float hv[16]; float am = 0.f;
#pragma unroll
    for (int i = 0; i < 8; ++i) { hv[2 * i] = bf_lo(xw[i]) * rr + sh[2 * i]; hv[2 * i + 1] = bf_hi(xw[i]) * rr + sh[2 * i + 1]; am = fmaxf(am, fmaxf(fabsf(hv[2 * i]), fabsf(hv[2 * i + 1]))); }
    am = wave_max(am);
    const float q0 = am > 0.f ? 6.0f / am : 0.f, d0 = am * (1.0f / 6.0f);
    unsigned w0[2] = {0u, 0u}, w1[2] = {0u, 0u}; float rv[16]; float am1 = 0.f;
#pragma unroll
    for (int i = 0; i < 8; ++i) {
        const int wi = i >> 2, bs = i & 3;
        if (bs == 0) w0[wi] = __builtin_amdgcn_cvt_scalef32_pk_fp4_f32(w0[wi], hv[2 * i] * q0, hv[2 * i + 1] * q0, 1.0f, 0);
        else if (bs == 1) w0[wi] = __builtin_amdgcn_cvt_scalef32_pk_fp4_f32(w0[wi], hv[2 * i] * q0, hv[2 * i + 1] * q0, 1.0f, 1);
        else if (bs == 2) w0[wi] = __builtin_amdgcn_cvt_scalef32_pk_fp4_f32(w0[wi], hv[2 * i] * q0, hv[2 * i + 1] * q0, 1.0f, 2);
        else w0[wi] = __builtin_amdgcn_cvt_scalef32_pk_fp4_f32(w0[wi], hv[2 * i] * q0, hv[2 * i + 1] * q0, 1.0f, 3);
    }
#pragma unroll
    for (int i = 0; i < 8; ++i) {
        const int wi = i >> 2, bs = i & 3;
        const f32x2 dq = bs == 0 ? __builtin_amdgcn_cvt_scalef32_pk_f32_fp4(w0[wi], 1.0f, 0) : bs == 1 ? __builtin_amdgcn_cvt_scalef32_pk_f32_fp4(w0[wi], 1.0f, 1) : bs == 2 ? __builtin_amdgcn_cvt_scalef32_pk_f32_fp4(w0[wi], 1.0f, 2) : __builtin_amdgcn_cvt_scalef32_pk_f32_fp4(w0[wi], 1.0f, 3);
        rv[2 * i] = hv[2 * i] - dq.x * d0; rv[2 * i + 1] = hv[2 * i + 1] - dq.y * d0;
        am1 = fmaxf(am1, fmaxf(fabsf(rv[2 * i]), fabsf(rv[2 * i + 1])));
    }
    am1 = wave_max(am1);
    const float q1 = am1 > 0.f ? 6.0f / am1 : 0.f, d1 = am1 * (1.0f / 6.0f);
#pragma unroll
    for (int i = 0; i < 8; ++i) {
        const int wi = i >> 2, bs = i & 3;
        if (bs == 0) w1[wi] = __builtin_amdgcn_cvt_scalef32_pk_fp4_f32(w1[wi], rv[2 * i] * q1, rv[2 * i + 1] * q1, 1.0f, 0);
        else if (bs == 1) w1[wi] = __builtin_amdgcn_cvt_scalef32_pk_fp4_f32(w1[wi], rv[2 * i] * q1, rv[2 * i + 1] * q1, 1.0f, 1);
        else if (bs == 2) w1[wi] = __builtin_amdgcn_cvt_scalef32_pk_fp4_f32(w1[wi], rv[2 * i] * q1, rv[2 * i + 1] * q1, 1.0f, 2);
        else w1[wi] = __builtin_amdgcn_cvt_scalef32_pk_fp4_f32(w1[wi], rv[2 * i] * q1, rv[2 * i + 1] * q1, 1.0f, 3);
    }
    *(LAS u32x2*)(hbuf + 8 * lane) = (u32x2){w0[0], w0[1]};
    *(LAS u32x2*)(hbuf + 512 + 8 * lane) = (u32x2){w1[0], w1[1]};
    asm volatile("" ::: "memory");
    hb = *(const LAS u32x4*)(hbuf + ((lane & 15) >> 3) * 512 + (lane & 7) * 16 + (lane >> 4) * 128);
    asm volatile("" ::: "memory");
    hs = (f32x2){d0, d1};
}
__device__ __forceinline__ void sort_words(unsigned& w0, unsigned& w1, int lane, LAS unsigned* scr) {
#pragma unroll
    for (int bit = 10; bit < 14; ++bit) {
        const bool z0 = ((w0 >> bit) & 1u) == 0u, z1 = ((w1 >> bit) & 1u) == 0u;
        const unsigned long long m0 = __ballot(z0), m1 = __ballot(z1);
        const int nz0 = __popcll(m0), nz = nz0 + __popcll(m1);
        const int r0 = __builtin_amdgcn_mbcnt_hi((unsigned)(m0 >> 32), __builtin_amdgcn_mbcnt_lo((unsigned)m0, 0u));
        const int r1 = __builtin_amdgcn_mbcnt_hi((unsigned)(m1 >> 32), __builtin_amdgcn_mbcnt_lo((unsigned)m1, 0u));
        const int p0 = z0 ? r0 : nz + lane - r0;
        const int p1 = z1 ? nz0 + r1 : nz + 64 - nz0 + lane - r1;
        scr[p0] = w0; scr[p1] = w1;
        asm volatile("" ::: "memory");
        w0 = scr[lane]; w1 = scr[64 + lane];
        asm volatile("" ::: "memory");
    }
}
struct UTok { u32x4 hb, xb; f32x2 hs; unsigned s0, s1; };
#define PU_LOAD(UQ, k, g) do { const int bb_ = (g) & 15; const bool nx_ = (g) >= 16; \
        const unsigned src_ = bb_ < 8 ? (nx_ ? nxt[k].s0 : cur[k].s0) : (nx_ ? nxt[k].s1 : cur[k].s1); \
        _Pragma("unroll") for (int j_ = 0; j_ < 4; ++j_) { \
            const int id_ = __builtin_amdgcn_ds_bpermute(4 * (((8 * bb_) & 63) + 2 * j_) + slotb, (int)src_) & 0x3fff; \
            UQ[j_] = __builtin_bit_cast(u32x4, __builtin_amdgcn_raw_buffer_load_b128(rsU, (id_ << 9) + uoff, 0, 0)); } } while (0)
#define PU_COMPUTE(UQ, k, bt) do { \
        const i32x8 hbv = {(int)cur[k].hb.x, (int)cur[k].hb.y, (int)cur[k].hb.z, (int)cur[k].hb.w, 0, 0, 0, 0}; const float st = cur[k].hs.x; \
        float x_[4]; \
        _Pragma("unroll") for (int j_ = 0; j_ < 4; ++j_) { \
            const i32x8 a_ = {(int)UQ[j_].x, (int)UQ[j_].y, (int)UQ[j_].z, (int)UQ[j_].w, 0, 0, 0, 0}; \
            const f32x4 d_ = __builtin_amdgcn_mfma_scale_f32_16x16x128_f8f6f4(a_, hbv, (f32x4){0.f, 0.f, 0.f, 0.f}, 4, 4, 0, 0x7f7f7f7f, 0, 0x7f7f7f7f); \
            x_[j_] = (d_[0] * lm0 + d_[1] * lm1 + d_[2] * lm2 + d_[3] * lm3) * st; } \
        float y2[2], q1; \
        _Pragma("unroll") for (int k_ = 0; k_ < 2; ++k_) { const float a_ = b4 ? x_[k_ + 2] : x_[k_], sd_ = b4 ? x_[k_] : x_[k_ + 2]; y2[k_] = a_ + __shfl_xor(sd_, 16); } \
        { const float a_ = b3 ? y2[1] : y2[0], sd_ = b3 ? y2[0] : y2[1]; q1 = a_ + DPPF(sd_, 0x128); } \
        q1 += DPPF(q1, 0xB1); q1 += DPPF(q1, 0x4E); q1 += DPPF(q1, 0x141); \
        const float qs_ = __shfl(q1, srcl);                                     \
        const bool mine_ = (lane >> 3) == ((bt) & 7); \
        if ((bt) < 8) qs0[k] = mine_ ? qs_ : qs0[k]; else qs1[k] = mine_ ? qs_ : qs1[k]; } while (0)
__device__ __forceinline__ void peer_u_raw(UTok& t, int tok, int lane, const bf16_t* XA, const float* SSQ, const int* IDX) {
    { const u32x4* xp = (const u32x4*)(XA + (size_t)tok * D + 16 * lane); t.hb = xp[0]; t.xb = xp[1]; }
    t.hs = (f32x2){SSQ[tok], 0.f};
    t.s0 = (unsigned)IDX[(size_t)tok * 128 + lane] | ((unsigned)lane << 14); t.s1 = (unsigned)IDX[(size_t)tok * 128 + 64 + lane] | ((unsigned)(64 + lane) << 14);
}
__device__ __forceinline__ void phase_peer_u(KP kp, LAS unsigned char* lds, int wave_s) {
    const int lane = lane_id_asm(), wave = wave_s;
    unsigned char* ws = kp->ws;
    const __amdgpu_buffer_rsrc_t rsU = __builtin_amdgcn_make_buffer_rsrc((void*)(ws + WS_EU), 0, NEXP * U_BITS * 128, 0x00020000);
    const bf16_t* XA = (const bf16_t*)(ws + WS_H); const float* SSQ = (const float*)(ws + WS_SSQ);
    const int* IDX = (const int*)(ws + WS_IDX); const float* GATE = (const float*)(ws + WS_GATE);
    const float* SU = (const float*)(ws + WS_SU); const float* SV = (const float*)(ws + WS_SV);
    LAS unsigned* scr = (LAS unsigned*)(lds + wave * 2048);
    LAS float* shl = (LAS float*)(lds + 32768);
    LAS unsigned char* hbuf = lds + 49152 + wave * 1024;
    { const float* modp = (const float*)(ws + WS_MOD); for (int i = wave * 64 + lane; i < 4096; i += NTHREADS) shl[i] = modp[(size_t)(i >> 10) * NMOD + 3 * 1024 + (i & 1023)]; }
    __syncthreads();
    const bool b4 = lane & 16, b3 = lane & 8;
    const int srcl = 32 * (lane & 1) + 16 * ((lane >> 2) & 1) + 8 * ((lane >> 1) & 1);
    const int nn = lane & 15, qq = lane >> 4;
    const int uoff = 16 * (nn & 7) + 128 * qq;
    const int slotb = 4 * (nn >> 3);
    const bool useful = ((nn & 7) >> 2) == (qq & 1);
    const float lm0 = (nn & 3) == 0 ? 1.f : 0.f, lm1 = (nn & 3) == 1 ? 1.f : 0.f, lm2 = (nn & 3) == 2 ? 1.f : 0.f, lm3 = (nn & 3) == 3 ? 1.f : 0.f;
    const int tstride = gridDim.x * 8;
    int tok0 = blockIdx.x * 8 + wave;
    if (tok0 < T) {
        UTok cur[4], nxt[4];
        u32x4 uq[4][4];
#pragma unroll
        for (int k = 0; k < 4; ++k) { const int tk = tok0 + k * tstride; peer_u_raw(cur[k], tk < T ? tk : tok0, lane, XA, SSQ, IDX); }
#pragma unroll
        for (int k = 0; k < 4; ++k) { const int tk = tok0 + k * tstride < T ? tok0 + k * tstride : tok0; sort_words(cur[k].s0, cur[k].s1, lane, scr + k * 128);
            { const u32x4 xa0 = cur[k].hb, xa1 = cur[k].xb; quant_h2(xa0, xa1, cur[k].hs.x, shl + (tk / SEQ) * 1024, hbuf, lane, cur[k].hb, cur[k].hs); }
            cur[k].hs.x = useful ? ((nn >> 3) ? cur[k].hs.y : cur[k].hs.x) : 0.f; nxt[k] = cur[k]; }
        PU_LOAD(uq[0], 0, 0); PU_LOAD(uq[1], 1, 0); PU_LOAD(uq[2], 2, 0);
        for (; tok0 < T; tok0 += 4 * tstride) {
            const bool has_next = tok0 + 4 * tstride < T;
            if (has_next) {
#pragma unroll
                for (int k = 0; k < 4; ++k) { const int tk = tok0 + (4 + k) * tstride; peer_u_raw(nxt[k], tk < T ? tk : tok0 + 4 * tstride, lane, XA, SSQ, IDX); }
            }
            float g0[4], g1[4], cu0[4], cu1[4], sv0[4], sv1[4];
#pragma unroll
            for (int k = 0; k < 4; ++k) { const int tk = tok0 + k * tstride < T ? tok0 + k * tstride : tok0;
                const int i0 = cur[k].s0 & 0x3fff, i1 = cur[k].s1 & 0x3fff;
                g0[k] = GATE[(size_t)tk * 128 + (cur[k].s0 >> 14)]; g1[k] = GATE[(size_t)tk * 128 + (cur[k].s1 >> 14)];
                cu0[k] = SU[i0]; cu1[k] = SU[i1]; sv0[k] = SV[i0]; sv1[k] = SV[i1]; }
            float qs0[4] = {0.f, 0.f, 0.f, 0.f}, qs1[4] = {0.f, 0.f, 0.f, 0.f};
#pragma unroll 1
            for (int bt = 0; bt < 16; ++bt) {
                if (bt == 8 && has_next) {
#pragma unroll
                    for (int k = 0; k < 4; ++k) { const int tk = tok0 + (4 + k) * tstride < T ? tok0 + (4 + k) * tstride : tok0 + 4 * tstride; sort_words(nxt[k].s0, nxt[k].s1, lane, scr + k * 128);
                        { const u32x4 xa0 = nxt[k].hb, xa1 = nxt[k].xb; quant_h2(xa0, xa1, nxt[k].hs.x, shl + (tk / SEQ) * 1024, hbuf, lane, nxt[k].hb, nxt[k].hs); }
                        nxt[k].hs.x = useful ? ((nn >> 3) ? nxt[k].hs.y : nxt[k].hs.x) : 0.f; }
                }
                PU_LOAD(uq[3], 3, bt);     PU_COMPUTE(uq[0], 0, bt);
                PU_LOAD(uq[0], 0, bt + 1); PU_COMPUTE(uq[1], 1, bt);
                PU_LOAD(uq[1], 1, bt + 1); PU_COMPUTE(uq[2], 2, bt);
                PU_LOAD(uq[2], 2, bt + 1); PU_COMPUTE(uq[3], 3, bt);
            }
#pragma unroll
            for (int k = 0; k < 4; ++k) { const int tok = tok0 + k * tstride;
                if (tok < T) {
                    const int e0 = (int)(cur[k].s0 & 0x3fff), e1 = (int)(cur[k].s1 & 0x3fff);
                    const float c0 = gelu_tanh(qs0[k] * cu0[k]) * (g0[k] * sv0[k]), c1 = gelu_tanh(qs1[k] * cu1[k]) * (g1[k] * sv1[k]);
                    float cm = fmaxf(fabsf(c0), fabsf(c1));
            cm = wave_max(cm);
                    const float f = cm > 0.f ? 256.0f / cm : 0.f;
                    const unsigned pk = (unsigned)__builtin_amdgcn_cvt_pk_fp8_f32(c0 * f, c1 * f, 0, false) & 0xffffu;
                    const unsigned nbe0 = (unsigned)__builtin_amdgcn_update_dpp(0, e0, 0xB1, 0xF, 0xF, true), nbe1 = (unsigned)__builtin_amdgcn_update_dpp(0, e1, 0xB1, 0xF, 0xF, true);
                    if (!(lane & 1)) {
                        const int p = lane >> 1, o0 = (p & 3) * 16 + (p >> 2), o1 = (p & 3) * 16 + 8 + (p >> 2);
                        unsigned* IDP = (unsigned*)(ws + WS_IDP) + (size_t)tok * 64;
                        IDP[o0] = (unsigned)e0 | (nbe0 << 16); IDP[o1] = (unsigned)e1 | (nbe1 << 16);
                    }
                    const unsigned nb4 = (unsigned)__shfl((int)pk, lane + 4);
                    if ((lane & 7) < 4) {
                        unsigned short* COP = (unsigned short*)(ws + WS_COP) + (size_t)tok * 64 + (lane & 3) * 16 + (lane >> 3);
                        COP[0] = (unsigned short)((pk & 0xffu) | ((nb4 & 0xffu) << 8)); COP[8] = (unsigned short)(((pk >> 8) & 0xffu) | (nb4 & 0xff00u));
                    }
                    if (lane == 0) ((float*)(ws + WS_CS))[tok] = cm * (1.0f / 256.0f);
                }
                cur[k] = nxt[k]; }
        }
    }
}
#define PV_LOADG(RB, k, g) do { const int gg_ = (g) & 15; \
        const unsigned pr_ = ((g) >= 16 ? mnx : mcu)[(k) * 96 + qq * 16 + gg_]; \
        cfr[k] = ((g) >= 16 ? mnx : mcu)[(k) * 96 + 64 + qq * 8 + (gg_ >> 1)]; \
        const int va_ = (int)((pr_ & 0xffffu) << 9) + lanebase, vb_ = (int)((pr_ >> 16) << 9) + lanebase; \
        _Pragma("unroll") for (int blk_ = 0; blk_ < 4; ++blk_) { \
            const u32x2 a_ = __builtin_bit_cast(u32x2, __builtin_amdgcn_raw_buffer_load_b64(rsV, va_ + 8 * (blk_ & 1) + 256 * (blk_ >> 1), 0, 0)); \
            const u32x2 b_ = __builtin_bit_cast(u32x2, __builtin_amdgcn_raw_buffer_load_b64(rsV, vb_ + 8 * (blk_ & 1) + 256 * (blk_ >> 1), 0, 0)); \
            RB[blk_] = (u32x4){a_.x, a_.y, b_.x, b_.y}; } } while (0)
#define PV_COMPG(RB, k, g, CW) do { const unsigned cw_ = (CW); \
        const unsigned ra_ = ((g) & 1) ? __builtin_amdgcn_perm(cw_, cw_, 0x02020202u) : __builtin_amdgcn_perm(cw_, cw_, 0x00000000u); \
        const unsigned rb_ = ((g) & 1) ? __builtin_amdgcn_perm(cw_, cw_, 0x03030303u) : __builtin_amdgcn_perm(cw_, cw_, 0x01010101u); \
        const i32x8 A_ = {(int)(ra_ & mk0), (int)(ra_ & mk1), (int)(ra_ & mk2), (int)(ra_ & mk3), (int)(rb_ & mk0), (int)(rb_ & mk1), (int)(rb_ & mk2), (int)(rb_ & mk3)}; \
        _Pragma("unroll") for (int blk_ = 0; blk_ < 4; ++blk_) { \
            const i32x8 B_ = {(int)RB[blk_].x, (int)RB[blk_].y, (int)RB[blk_].z, (int)RB[blk_].w, 0, 0, 0, 0}; \
            acc[k][blk_] = __builtin_amdgcn_mfma_scale_f32_16x16x128_f8f6f4(A_, B_, acc[k][blk_], 0, 4, 0, 0x7f7f7f7f, 0, 0x7f7f7f7f); } } while (0)
__device__ __forceinline__ void phase_peer_v(KP kp, LAS unsigned char* lds, int wave_s) {
    const int lane = lane_id_asm(), wave = wave_s;
    unsigned char* ws = kp->ws;
    const __amdgpu_buffer_rsrc_t rsV = __builtin_amdgcn_make_buffer_rsrc((void*)(ws + WS_EV), 0, NEXP * V_BITS * 128, 0x00020000);
    const float* mod = (const float*)(ws + WS_MOD); const float* fg = kp->in[22];
    const bf16_t* X1 = (const bf16_t*)(ws + WS_X1B); float* OUT = kp->out;
    const unsigned* IDP = (const unsigned*)(ws + WS_IDP); const unsigned* COP = (const unsigned*)(ws + WS_COP); const float* CS = (const float*)(ws + WS_CS);
    const int nn = lane & 15, qq = lane >> 4;
    const int lanebase = 16 * nn;
    const unsigned msel = 0xFFu << (8 * (nn & 3));
    const unsigned mk0 = (nn >> 2) == 0 ? msel : 0u, mk1 = (nn >> 2) == 1 ? msel : 0u, mk2 = (nn >> 2) == 2 ? msel : 0u, mk3 = (nn >> 2) == 3 ? msel : 0u;
    const int col0 = 32 * nn + 4 * qq;
    const int tstride = gridDim.x * 8;
    int tok0 = blockIdx.x * 8 + wave;
    LAS unsigned* mcu = (LAS unsigned*)(lds + wave * 3072);
    LAS unsigned* mnx = mcu + 384;
    if (tok0 < T) {
        unsigned idw[4], cfw[4]; float csc[4], csn[4];
#pragma unroll
        for (int k = 0; k < 4; ++k) { const int tk = tok0 + k * tstride < T ? tok0 + k * tstride : tok0;
            idw[k] = IDP[(size_t)tk * 64 + lane]; cfw[k] = COP[(size_t)tk * 32 + (lane & 31)]; csc[k] = CS[tk]; csn[k] = csc[k]; }
#pragma unroll
        for (int k = 0; k < 4; ++k) { mcu[k * 96 + lane] = idw[k]; if (lane < 32) mcu[k * 96 + 64 + lane] = cfw[k]; mnx[k * 96 + lane] = idw[k]; if (lane < 32) mnx[k * 96 + 64 + lane] = cfw[k]; }
        asm volatile("" ::: "memory");
        u32x4 rb0[4], rb1[4], rb2[4], rb3[4]; unsigned cfr[4];
        PV_LOADG(rb0, 0, 0); PV_LOADG(rb1, 1, 0); PV_LOADG(rb2, 2, 0);
        for (; tok0 < T; tok0 += 4 * tstride) {
            const bool has_next = tok0 + 4 * tstride < T;
            if (has_next) {
#pragma unroll
                for (int k = 0; k < 4; ++k) { const int tk = tok0 + (4 + k) * tstride < T ? tok0 + (4 + k) * tstride : tok0 + 4 * tstride;
                    idw[k] = IDP[(size_t)tk * 64 + lane]; cfw[k] = COP[(size_t)tk * 32 + (lane & 31)]; csn[k] = CS[tk]; }
            }
            f32x4 acc[4][4]; u32x2 xwa[4], xwb[4]; f32x4 gva[4], gvb[4];
#pragma unroll
            for (int k = 0; k < 4; ++k)
#pragma unroll
                for (int i = 0; i < 4; ++i) acc[k][i] = (f32x4){0.f, 0.f, 0.f, 0.f};
#pragma unroll 1
            for (int G = 0; G < 16; ++G) {
                if (G == 14) {
                    const bf16_t* xp = X1 + (size_t)tok0 * D + col0; const float* gp = mod + (size_t)(tok0 / SEQ) * NMOD + 5 * 1024 + col0;
#pragma unroll
                    for (int blk = 0; blk < 4; ++blk) { xwa[blk] = *(const u32x2*)(xp + 16 * (blk & 1) + 512 * (blk >> 1)); gva[blk] = *(const f32x4*)(gp + 16 * (blk & 1) + 512 * (blk >> 1)); }
                }
                if (G == 8) {
#pragma unroll
                    for (int k = 0; k < 4; ++k) { mnx[k * 96 + lane] = idw[k]; if (lane < 32) mnx[k * 96 + 64 + lane] = cfw[k]; }
                    asm volatile("" ::: "memory");
                }
                { const unsigned c_ = cfr[0]; PV_LOADG(rb3, 3, G);     PV_COMPG(rb0, 0, G, c_); }
                { const unsigned c_ = cfr[1]; PV_LOADG(rb0, 0, G + 1); PV_COMPG(rb1, 1, G, c_); }
                { const unsigned c_ = cfr[2]; PV_LOADG(rb1, 1, G + 1); PV_COMPG(rb2, 2, G, c_); }
                { const unsigned c_ = cfr[3]; PV_LOADG(rb2, 2, G + 1); PV_COMPG(rb3, 3, G, c_); }
            }
            f32x4 fgv[4];
#pragma unroll
            for (int blk = 0; blk < 4; ++blk) fgv[blk] = *(const f32x4*)(fg + col0 + 16 * (blk & 1) + 512 * (blk >> 1));
#pragma unroll
            for (int k = 0; k < 4; ++k) { const int tok = tok0 + k * tstride;
                if (k < 3) { const int tk = tok0 + (k + 1) * tstride < T ? tok0 + (k + 1) * tstride : tok0; const bf16_t* xp = X1 + (size_t)tk * D + col0; const float* gp = mod + (size_t)(tk / SEQ) * NMOD + 5 * 1024 + col0;
#pragma unroll
                    for (int blk = 0; blk < 4; ++blk) { xwb[blk] = *(const u32x2*)(xp + 16 * (blk & 1) + 512 * (blk >> 1)); gvb[blk] = *(const f32x4*)(gp + 16 * (blk & 1) + 512 * (blk >> 1)); } }
                if (tok < T) {
                    float* xr = OUT + (size_t)tok * D + col0;
                    f32x4 xv[4]; float ss = 0.f;
#pragma unroll
                    for (int blk = 0; blk < 4; ++blk) {
                        const f32x4 x1v = {bf_lo(xwa[blk].x), bf_hi(xwa[blk].x), bf_lo(xwa[blk].y), bf_hi(xwa[blk].y)};
                        xv[blk] = x1v + gva[blk] * (acc[k][blk] * csc[k]);
                        ss += xv[blk][0] * xv[blk][0] + xv[blk][1] * xv[blk][1] + xv[blk][2] * xv[blk][2] + xv[blk][3] * xv[blk][3]; }
                    ss = wave_sum(ss);
                    const float r = rsqrtf(ss * (1.0f / D) + EPS);
#pragma unroll
                    for (int blk = 0; blk < 4; ++blk) *(f32x4*)(xr + 16 * (blk & 1) + 512 * (blk >> 1)) = xv[blk] * r * fgv[blk];
                }
#pragma unroll
                for (int blk = 0; blk < 4; ++blk) { gva[blk] = gvb[blk]; xwa[blk] = xwb[blk]; }
                csc[k] = csn[k]; }
            { LAS unsigned* t_ = mcu; mcu = mnx; mnx = t_; }
        }
    }
}

__global__ void __launch_bounds__(NTHREADS, 2) fwd_megakernel(Params P_) {
    extern __shared__ __attribute__((aligned(16))) unsigned char lds_raw[];
    LAS unsigned char* lds = (LAS unsigned char*)lds_raw;
    KP kp = (KP)__builtin_amdgcn_kernarg_segment_ptr();
    volatile LAS unsigned* ctl = (volatile LAS unsigned*)(lds + LDS_CTL_OFF);
    const int wave_s = __builtin_amdgcn_readfirstlane(threadIdx.x >> 6);
    if (threadIdx.x < 4) ctl[threadIdx.x] = 0u;
    __syncthreads();
    { XcdBarrier b0 = xcd_barrier_post((unsigned*)(kp->ws + WS_CTL), ctl, wave_s); (void)b0; }
    const int lo = kp->ph_lo, hi = kp->ph_hi;
#define IN(k) (lo <= (k) && (k) < hi)
#define FRESH() asm volatile("" : "+s"(kp) :: "memory")
#define SEAM(k) do { if (IN(k) && IN((k) + 1)) { { XcdBarrier b_; b_.bar = (unsigned*)(kp->ws + WS_CTL); b_.x = xb_xcc_id(); b_.st = ctl; xcd_barrier(b_, wave_s); } } FRESH(); } while (0)

    if (IN(0)) phase_prep(kp, lds, wave_s);
#if DBG_REPEAT
    FRESH();
    if (IN(0)) phase_prep(kp, lds, wave_s);
#endif
    SEAM(0);
    if (IN(1)) { phase_aux(kp, lds, wave_s); phase_w8(kp, lds, wave_s); unsigned char* ws = kp->ws; phase_norm_ada<true>(kp->in[0], kp->in[4], (const float*)(ws + WS_MOD), 0, 1024, (bf16_t*)nullptr, ws + WS_X8, (float*)(ws + WS_X8S), wave_s); }
#if DBG_REPEAT
    FRESH();
    if (IN(1)) { unsigned char* ws = kp->ws; phase_norm_ada<true>(kp->in[0], kp->in[4], (const float*)(ws + WS_MOD), 0, 1024, (bf16_t*)nullptr, ws + WS_X8, (float*)(ws + WS_X8S), wave_s); }
#endif
    SEAM(1);
    if (IN(2)) {
        unsigned char* ws = kp->ws;
        { pg8::Gemm g{(const bf16_t*)(ws + WS_X8), (const bf16_t*)(ws + WS_WP8), T, 3584, D / 2}; pg8::StaticOrder S; S.init(T, 3584, gridDim.x, blockIdx.x);
          EpiIn E{EpiProj{(const float*)(ws + WS_BINP), (bf16_t*)(ws + WS_PG), (bf16_t*)(ws + WS_PG) + (size_t)T * 512, (const float*)(ws + WS_X8S), (const float*)(ws + WS_WP8S)},
                  EpiGate{(const float*)(ws + WS_BINP), (const float*)(ws + WS_X8S), (const float*)(ws + WS_WGS), (bf16_t*)(ws + WS_SG)}};
          pg8::gemm_phase<EpiIn>(lds, g, S, E, wave_s); }
    }
#if DBG_REPEAT
    FRESH();
    if (IN(2)) {
        unsigned char* ws = kp->ws;
        { pg8::Gemm g{(const bf16_t*)(ws + WS_X8), (const bf16_t*)(ws + WS_WP8), T, 3584, D / 2}; pg8::StaticOrder S; S.init(T, 3584, gridDim.x, blockIdx.x);
          EpiIn E{EpiProj{(const float*)(ws + WS_BINP), (bf16_t*)(ws + WS_PG), (bf16_t*)(ws + WS_PG) + (size_t)T * 512, (const float*)(ws + WS_X8S), (const float*)(ws + WS_WP8S)},
                  EpiGate{(const float*)(ws + WS_BINP), (const float*)(ws + WS_X8S), (const float*)(ws + WS_WGS), (bf16_t*)(ws + WS_SG)}};
          pg8::gemm_phase<EpiIn>(lds, g, S, E, wave_s); }
    }
#endif
    SEAM(2);
    if (IN(3)) phase_branches(kp, lds, wave_s);
#if DBG_REPEAT
    FRESH();
    if (IN(3)) phase_branches(kp, lds, wave_s);
#endif
    SEAM(3);
    if (IN(4)) {
        unsigned char* ws = kp->ws;
        pg8::Gemm g{(const bf16_t*)(ws + WS_MC), (const bf16_t*)(ws + WS_WPC), T, D, D}; pg8::StaticOrder S; S.init(T, D, gridDim.x, blockIdx.x);
        EpiMerge E{(const bf16_t*)(ws + WS_SG), (bf16_t*)(ws + WS_PG)};
        pg8::gemm_phase<EpiMerge>(lds, g, S, E, wave_s);
    }
#if DBG_REPEAT
    FRESH();
    if (IN(4)) {
        unsigned char* ws = kp->ws;
        pg8::Gemm g{(const bf16_t*)(ws + WS_MC), (const bf16_t*)(ws + WS_WPC), T, D, D}; pg8::StaticOrder S; S.init(T, D, gridDim.x, blockIdx.x);
        EpiMerge E{(const bf16_t*)(ws + WS_SG), (bf16_t*)(ws + WS_PG)};
        pg8::gemm_phase<EpiMerge>(lds, g, S, E, wave_s);
    }
#endif
    SEAM(4);
    if (IN(5)) {
        unsigned char* ws = kp->ws;
        pg8::Gemm g{(const bf16_t*)(ws + WS_PG), (const bf16_t*)(ws + WS_WOUT), T, D, D}; pg8::StaticOrder S; S.init(T, D, gridDim.x, blockIdx.x);
        EpiResid E{kp->in[0], (const float*)(ws + WS_MOD) + 2 * 1024, (bf16_t*)(ws + WS_X1B), (const float*)(ws + WS_A2), (bf16_t*)(ws + WS_H), (float*)(ws + WS_SSQ)};
        pg8::gemm_phase<EpiResid>(lds, g, S, E, wave_s);
    }
#if DBG_REPEAT
    FRESH();
    if (IN(5)) {
        unsigned char* ws = kp->ws;
        pg8::Gemm g{(const bf16_t*)(ws + WS_PG), (const bf16_t*)(ws + WS_WOUT), T, D, D}; pg8::StaticOrder S; S.init(T, D, gridDim.x, blockIdx.x);
        EpiResid E{kp->in[0], (const float*)(ws + WS_MOD) + 2 * 1024, (bf16_t*)(ws + WS_X1B), (const float*)(ws + WS_A2), (bf16_t*)(ws + WS_H), (float*)(ws + WS_SSQ)};
        pg8::gemm_phase<EpiResid>(lds, g, S, E, wave_s);
    }
#endif
    SEAM(5);
    if (IN(7)) {
        unsigned char* ws = kp->ws;
        pg8::Gemm g{(const bf16_t*)(ws + WS_H), (const bf16_t*)(ws + WS_WQ), T, 2048, D}; pg8::StaticOrder S; S.init(T, 2048, gridDim.x, blockIdx.x);
        EpiQ E{(bf16_t*)(ws + WS_SG), (const float*)(ws + WS_SSQ), (const float*)(ws + WS_BIAS2)};
        pg8::gemm_phase<EpiQ>(lds, g, S, E, wave_s);
    }
#if DBG_REPEAT
    FRESH();
    if (IN(7)) {
        unsigned char* ws = kp->ws;
        pg8::Gemm g{(const bf16_t*)(ws + WS_H), (const bf16_t*)(ws + WS_WQ), T, 2048, D}; pg8::StaticOrder S; S.init(T, 2048, gridDim.x, blockIdx.x);
        EpiQ E{(bf16_t*)(ws + WS_SG), (const float*)(ws + WS_SSQ), (const float*)(ws + WS_BIAS2)};
        pg8::gemm_phase<EpiQ>(lds, g, S, E, wave_s);
    }
#endif
    if (IN(7) && IN(8)) { asm volatile("s_waitcnt vmcnt(0)" ::: "memory"); __syncthreads();
        if (wave_s == 0 && lane_id_asm() == 0) { __builtin_amdgcn_fence(__ATOMIC_ACQUIRE, "agent"); asm volatile("s_waitcnt vmcnt(0)" ::: "memory"); }
        __syncthreads(); }
    FRESH();
    if (IN(8)) phase_topk(kp, lds, wave_s);
#if DBG_REPEAT
    FRESH();
    if (IN(8)) phase_topk(kp, lds, wave_s);
#endif
    SEAM(8);
    if (IN(9)) phase_peer_u(kp, lds, wave_s);
    SEAM(9);
    if (IN(10)) phase_peer_v(kp, lds, wave_s);
#undef IN
#undef SEAM
#undef FRESH
}

#define DBG_PHASE_SKIP(ph) (0)
#define DBG_LAST 9
#define DBG_DUMP_N ((size_t)3584 * 1024)
#define DBG_DUMP_BF16 1
#ifdef DBG_DUMP_OFF
__global__ void dbg_dump(const unsigned char* ws, float* out) {
    const size_t n = DBG_DUMP_N;
    for (size_t i = (size_t)blockIdx.x * blockDim.x + threadIdx.x; i < (size_t)T * D; i += (size_t)gridDim.x * blockDim.x) {
        const size_t j = (i * 7919ull) % n;
        float v;
        if (DBG_DUMP_BF16) v = __uint_as_float(((unsigned)((const bf16_t*)(ws + DBG_DUMP_OFF))[j]) << 16);
        else v = ((const float*)(ws + DBG_DUMP_OFF))[j];
        out[i] = v;
    }
}
#endif
#ifndef MK_N_LAUNCHES
#define MK_N_LAUNCHES 1
#endif
extern "C" void kernel_launch(void* const* d_in, const int* in_sizes, int n_in, void* d_out, int out_size, void* d_ws, size_t ws_size, hipStream_t stream) {
    static int grid = 0;
    if (grid == 0) {
        if (n_in != 23 || in_sizes[0] != T * D || out_size != T * D || ws_size < WS_END) {
            fprintf(stderr, "kernel_launch: unexpected shapes (n_in %d, in0 %d, out %d, ws %zu); nothing launched\n", n_in, n_in > 0 ? in_sizes[0] : -1, out_size, ws_size); grid = -1; return; }
        int dev = 0, cus = 0, per_cu = 0;
        if (hipGetDevice(&dev) != hipSuccess || hipDeviceGetAttribute(&cus, hipDeviceAttributeMultiprocessorCount, dev) != hipSuccess) { grid = -1; return; }
        if (hipFuncSetAttribute((const void*)fwd_megakernel, hipFuncAttributeMaxDynamicSharedMemorySize, LDS_BYTES) != hipSuccess) { fprintf(stderr, "kernel_launch: hipFuncSetAttribute failed\n"); grid = -1; return; }
        if (hipOccupancyMaxActiveBlocksPerMultiprocessor(&per_cu, (const void*)fwd_megakernel, NTHREADS, LDS_BYTES) != hipSuccess || per_cu < 1) {
            fprintf(stderr, "kernel_launch: occupancy query says %d blocks per CU; nothing launched\n", per_cu); grid = -1; return; }
        grid = cus;
    }
    if (grid < 0) return;
    (void)hipMemsetAsync((char*)d_ws + WS_CTL, 0, 16384, stream);
    Params p{};
    for (int i = 0; i < 23; ++i) p.in[i] = (const float*)d_in[i];
    p.out = (float*)d_out; p.ws = (unsigned char*)d_ws;
#if MK_N_LAUNCHES == 1
    p.ph_lo = 0; p.ph_hi = 11;
    void* args[] = {&p};
    hipError_t e = hipLaunchCooperativeKernel((const void*)fwd_megakernel, dim3(grid), dim3(NTHREADS), args, LDS_BYTES, stream);
    if (e != hipSuccess) fprintf(stderr, "kernel_launch: cooperative launch failed: %s (grid %d)\n", hipGetErrorString(e), grid);
#else
    for (int ph = 0; ph < 11; ++ph) { if (DBG_PHASE_SKIP(ph)) continue; p.ph_lo = ph; p.ph_hi = ph + 1; hipLaunchKernelGGL(fwd_megakernel, dim3(grid), dim3(NTHREADS), LDS_BYTES, stream, p); }
#ifdef DBG_DUMP_OFF
    hipLaunchKernelGGL(dbg_dump, dim3(1024), dim3(256), 0, stream, (const unsigned char*)d_ws, (float*)d_out);
#endif
#endif
}
```

```cpp
#include <hip/hip_runtime.h>
#include <hip/hip_cooperative_groups.h>
#include <cstdio>
#include <cstdint>
namespace cg = cooperative_groups;
#define DBG_NO_DOT2 1
#define DBG_REPEAT 0

#define LAS __attribute__((address_space(3)))
typedef unsigned short bf16_t;
typedef short bf16x8 __attribute__((ext_vector_type(8)));
typedef float f32x4 __attribute__((ext_vector_type(4)));
typedef float f32x2 __attribute__((ext_vector_type(2)));
typedef float f32x16 __attribute__((ext_vector_type(16)));
typedef unsigned u32x4 __attribute__((ext_vector_type(4)));
typedef unsigned u32x2 __attribute__((ext_vector_type(2)));
typedef __bf16 bf16x2_t __attribute__((ext_vector_type(2)));

constexpr int T = 32768, D = 1024, SEQ = 8192, NBATCH = 4, INW = 3584, NMOD = 6 * 1024;
constexpr int NEXP = 16384;
constexpr float EPS = 1e-6f;
constexpr int NTHREADS = 512;
constexpr int LDS_BYTES = 131072 + 1024;
constexpr int LDS_CTL_OFF = 131072;

constexpr size_t MiB = 1024ull * 1024ull;
constexpr size_t WS_CTL = 0;
constexpr size_t WS_MOD = 16384;
constexpr size_t WS_BINP = 114688;
constexpr size_t WS_WIN = 131072;
constexpr size_t WS_WPC = WS_WIN + 7340032;
constexpr size_t WS_WOUT = WS_WPC + 2 * MiB;
constexpr size_t WS_WQ = WS_WOUT + 2 * MiB;
constexpr size_t WS_EU = 16 * MiB;
constexpr size_t WS_EV = 32 * MiB;
constexpr size_t WS_SU = 48 * MiB;
constexpr size_t WS_SV = 48 * MiB + 65536;
constexpr size_t WS_H = 80 * MiB;
constexpr size_t WS_PG = 144 * MiB;
constexpr size_t WS_SG = 208 * MiB;
constexpr size_t WS_MC = 336 * MiB;
constexpr size_t WS_IDX = 400 * MiB;
constexpr size_t WS_GATE = 416 * MiB;
constexpr size_t WS_HB = WS_PG;
constexpr size_t WS_HS = WS_PG + 32 * MiB;
constexpr size_t WS_WG8 = WS_WIN + 1536 * 1024;
constexpr size_t WS_WGS = WS_WIN + 4 * MiB + 1536 * 4;
constexpr size_t WS_X8 = 436 * MiB;
constexpr size_t WS_X8S = 468 * MiB;
constexpr size_t WS_X1B = WS_MC;
constexpr size_t WS_A2 = 432 * MiB;
constexpr size_t WS_BIAS2 = WS_A2 + 16384;
constexpr size_t WS_SSQ = WS_A2 + 65536;
constexpr size_t WS_CO = WS_SG;
constexpr size_t WS_IDP = WS_SG + 16 * MiB;
constexpr size_t WS_COP = WS_SG + 32 * MiB;
constexpr size_t WS_CS = WS_SG + 48 * MiB;
constexpr size_t WS_WP8 = WS_WIN;
constexpr size_t WS_WP8S = WS_WIN + 4 * MiB;
constexpr size_t WS_PMAX = WS_WIN + 5 * MiB;
constexpr size_t WS_END = 469 * MiB;
static_assert(WS_WQ + 4 * MiB <= WS_EU, "weight region overflow");

struct Params;
typedef const __attribute__((address_space(4))) Params* KP;
struct Params {
    const float* in[23];
    float* out;
    unsigned char* ws;
    int ph_lo, ph_hi;
};

typedef __bf16 bf16x2v_t __attribute__((ext_vector_type(2)));
__device__ __forceinline__ unsigned cvt_pk_bf16(float lo, float hi) { return __builtin_bit_cast(unsigned, __builtin_convertvector((f32x2){lo, hi}, bf16x2v_t)); }
__device__ __forceinline__ float bf_lo(unsigned u) { return __uint_as_float(u << 16); }
__device__ __forceinline__ float bf_hi(unsigned u) { return __uint_as_float(u & 0xffff0000u); }
__device__ __forceinline__ float fast_sigmoid(float x) { return __builtin_amdgcn_rcpf(1.0f + __builtin_amdgcn_exp2f(-1.44269504089f * x)); }
__device__ __forceinline__ int lane_id_asm() { int l; asm volatile("v_mbcnt_lo_u32_b32 %0, -1, 0\n\tv_mbcnt_hi_u32_b32 %0, -1, %0" : "=v"(l)); return l; }
#define DPPI(old, x, ctrl, rmask, bc) __builtin_amdgcn_update_dpp((old), (x), (ctrl), (rmask), 0xF, (bc))
__device__ __forceinline__ float wave_sum(float v) {
    v += __int_as_float(DPPI(0, __float_as_int(v), 0xB1, 0xF, true)); v += __int_as_float(DPPI(0, __float_as_int(v), 0x4E, 0xF, true));
    v += __int_as_float(DPPI(0, __float_as_int(v), 0x141, 0xF, true)); v += __int_as_float(DPPI(0, __float_as_int(v), 0x140, 0xF, true));
    v += __int_as_float(DPPI(0, __float_as_int(v), 0x142, 0xA, false)); v += __int_as_float(DPPI(0, __float_as_int(v), 0x143, 0xC, false));
    return __int_as_float(__builtin_amdgcn_readlane(__float_as_int(v), 63));
}
__device__ __forceinline__ float wave_max(float v) {
    v = fmaxf(v, __int_as_float(DPPI(0, __float_as_int(v), 0xB1, 0xF, true))); v = fmaxf(v, __int_as_float(DPPI(0, __float_as_int(v), 0x4E, 0xF, true)));
    v = fmaxf(v, __int_as_float(DPPI(0, __float_as_int(v), 0x141, 0xF, true))); v = fmaxf(v, __int_as_float(DPPI(0, __float_as_int(v), 0x140, 0xF, true)));
    v = fmaxf(v, __int_as_float(DPPI(0, __float_as_int(v), 0x142, 0xA, false))); v = fmaxf(v, __int_as_float(DPPI(0, __float_as_int(v), 0x143, 0xC, false)));
    return __int_as_float(__builtin_amdgcn_readlane(__float_as_int(v), 63));
}
__device__ __forceinline__ int in_colmap(int n) {
    if (n < 512) return n;
    if (n < 1536) { const int t = (n - 512) >> 8, r = (n - 512) & 255; return r < 128 ? 512 + 128 * t + r : 1024 + 128 * t + (r - 128); }
    const int t = (n - 1536) >> 8, r = (n - 1536) & 255;
    return r < 128 ? 1536 + 128 * t + r : 2560 + 128 * t + (r - 128);
}

#define XB_TMO      128
#define XB_XCNT(j)  (256  + 64 * (j))
#define XB_XSUB(j)  (1280 + 64 * (j))
#define XB_XGEN(j)  (2304 + 64 * (j))
#define XB_TOP      3328
#define XB_TOPGEN   3392
#define XCD_BAR_WORDS 3456
#define XB_SPIN_CAP (1u << 22)
__device__ __forceinline__ unsigned xb_ld(unsigned* p)              { return __hip_atomic_load(p, __ATOMIC_RELAXED, __HIP_MEMORY_SCOPE_AGENT); }
__device__ __forceinline__ unsigned xb_add(unsigned* p, unsigned v) { return __hip_atomic_fetch_add(p, v, __ATOMIC_RELAXED, __HIP_MEMORY_SCOPE_AGENT); }
__device__ __forceinline__ unsigned xb_xcc_id() { return (unsigned)__builtin_amdgcn_s_getreg((3 << 11) | 20) & 0xFu; }
#define XB_SPIN(cond, bar) do { unsigned _sp = 0; while (cond) { __builtin_amdgcn_s_sleep(1); \
    if ((++_sp & 255u) == 0u) { if (xb_ld(&(bar)[XB_TMO])) break; if (_sp > XB_SPIN_CAP) { atomicAdd(&(bar)[XB_TMO], 1u); break; } } } } while (0)
struct XcdBarrier { unsigned* bar; unsigned x; volatile LAS unsigned* st; };
__device__ __forceinline__ XcdBarrier xcd_barrier_post(unsigned* bar, volatile LAS unsigned* st, int wave_s) {
    XcdBarrier b; b.bar = bar; b.x = xb_xcc_id(); b.st = st;
    if (wave_s == 0 && lane_id_asm() == 0) (void)xb_add(&bar[XB_XCNT(b.x)], 1u);
    return b;
}
__device__ __forceinline__ void xcd_barrier_complete(unsigned* bar, unsigned x, unsigned& nloc, unsigned& nx) {
    const unsigned G = gridDim.x * gridDim.y * gridDim.z;
    unsigned sum, cnt, mine, sp = 0u;
    for (;;) {
        sum = 0u; cnt = 0u; mine = 0u;
#pragma unroll
        for (unsigned j = 0; j < 16; ++j) { const unsigned c = xb_ld(&bar[XB_XCNT(j)]); sum += c; cnt += (c > 0u) ? 1u : 0u; mine = (j == x) ? c : mine; }
        if (sum == G) break;
        __builtin_amdgcn_s_sleep(1);
        if ((++sp & 255u) == 0u) { if (xb_ld(&bar[XB_TMO])) break; if (sp > XB_SPIN_CAP) { atomicAdd(&bar[XB_TMO], 1u); break; } }
    }
    nloc = mine > 0u ? mine : 1u; nx = cnt > 0u ? cnt : 1u;
}
__device__ __forceinline__ void xcd_barrier(const XcdBarrier& b, int wave_s) {
    asm volatile("s_waitcnt vmcnt(0)" ::: "memory");
    __syncthreads();
    if (wave_s == 0 && lane_id_asm() == 0) {
        unsigned* bar = b.bar;
        __builtin_amdgcn_s_waitcnt(0);
        unsigned nloc = b.st[0], nx = b.st[1];
        if (nloc == 0u) { xcd_barrier_complete(bar, b.x, nloc, nx); b.st[0] = nloc; b.st[1] = nx; }
        const unsigned old = xb_add(&bar[XB_XSUB(b.x)], 1u);
        const unsigned gen = old / nloc;
        if (old + 1u == (gen + 1u) * nloc) {
            __builtin_amdgcn_fence(__ATOMIC_RELEASE, "agent");
            asm volatile("s_waitcnt vmcnt(0)" ::: "memory");
            const unsigned og = xb_add(&bar[XB_TOP], 1u);
            const unsigned tg = og / nx;
            if (og + 1u == (tg + 1u) * nx) xb_add(&bar[XB_TOPGEN], 1u);
            else XB_SPIN(xb_ld(&bar[XB_TOPGEN]) == tg, bar);
            __builtin_amdgcn_fence(__ATOMIC_ACQUIRE, "agent");
            xb_add(&bar[XB_XGEN(b.x)], 1u);
            asm volatile("s_waitcnt vmcnt(0)" ::: "memory");
        } else {
            XB_SPIN(xb_ld(&bar[XB_XGEN(b.x)]) == gen, bar);
            __builtin_amdgcn_fence(__ATOMIC_ACQUIRE, "agent");
            asm volatile("s_waitcnt vmcnt(0)" ::: "memory");
        }
    }
    __syncthreads();
}

namespace pg8 {
constexpr int BM = 256, BK = 64, HALF = 128, HTB = HALF * BK * 2, STAGE_BYTES = 8 * HTB, NXCD = 8, WGM = 4;
__host__ __device__ __forceinline__ int lds_byte(int r, int c) { const int st = (r >> 4) * 2 + (c >> 5), rr = r & 15, cc = c & 31, ob = rr * 64 + cc * 2; return st * 1024 + (ob ^ (((ob >> 9) & 1) << 5)); }
__host__ __device__ __forceinline__ void stage_rc(int b, int& R, int& C) { const int st = b / 1024, sb = b % 1024, swz = sb ^ (((sb >> 9) & 1) << 5); R = (st >> 1) * 16 + swz / 64; C = (st & 1) * 32 + (swz % 64) / 2; }
__host__ __device__ __forceinline__ int perm32(int rho) { const int n = rho >> 4, i = rho & 15; return 8 * (i >> 2) + 4 * n + (i & 3); }
struct Unit { int pm, pn; };
struct Gemm { const bf16_t* A; const bf16_t* Bt; int M, N, K; };
struct StaticOrder {
    int nM, nN, nwg, G, c;
    __host__ __device__ void init(int M, int N, int G_, int c_) { nM = M / BM; nN = N / BM; nwg = nM * nN; G = G_; c = c_; }
    __host__ __device__ bool next(int i, Unit& u) const {
        const long L = (long)i * G + c; if (L >= nwg) return false;
        int wgid = (int)L; { const int q = nwg / NXCD, r = nwg % NXCD, xcd = wgid % NXCD, off = wgid / NXCD; wgid = (xcd < r ? xcd * (q + 1) : r * (q + 1) + (xcd - r) * q) + off; }
        const int nig = WGM * nN, gid = wgid / nig, fm = gid * WGM, gsz = (nM - fm) < WGM ? (nM - fm) : WGM;
        u.pm = fm + ((wgid % nig) % gsz); u.pn = (wgid % nig) / gsz; return true;
    }
};
typedef int i32x8_t __attribute__((ext_vector_type(8)));
typedef int i32x4_t __attribute__((ext_vector_type(4)));
template <bool FP8> struct FragT { typedef bf16x8 type[2]; };
template <> struct FragT<true> { typedef i32x8_t type; };
__device__ __forceinline__ void ldfrag(bf16x8 (&d)[2], const LAS unsigned char* p) { d[0] = *(const LAS bf16x8*)p; d[1] = *(const LAS bf16x8*)(p + 1024); }
__device__ __forceinline__ void ldfrag(i32x8_t& d, const LAS unsigned char* p) { const i32x4_t lo = *(const LAS i32x4_t*)p, hi = *(const LAS i32x4_t*)(p + 1024); d = (i32x8_t){lo[0], lo[1], lo[2], lo[3], hi[0], hi[1], hi[2], hi[3]}; }
__device__ __forceinline__ void mma1(f32x4& acc, const bf16x8 (&b)[2], const bf16x8 (&a)[2]) {
    acc = __builtin_amdgcn_mfma_f32_16x16x32_bf16(b[0], a[0], acc, 0, 0, 0); acc = __builtin_amdgcn_mfma_f32_16x16x32_bf16(b[1], a[1], acc, 0, 0, 0); }
__device__ __forceinline__ void mma1(f32x4& acc, const i32x8_t& b, const i32x8_t& a) {
    asm volatile("v_mfma_scale_f32_16x16x128_f8f6f4 %0, %1, %2, %0, %3, %3 op_sel_hi:[0,0,0]" : "+v"(acc) : "v"(b), "v"(a), "v"(0x7f7f7f7f)); }
template <class Epi>
__device__ __forceinline__ void gemm_phase(LAS unsigned char* lds, const Gemm g, const StaticOrder& S, const Epi& E, int wave_s) {
    const int lane = lane_id_asm(), wid = wave_s, tid = wid * 64 + lane, wr = wid >> 2, wc = wid & 3, fr = lane & 15, fq = lane >> 4;
    const int K = g.K, nt = K / BK;
    unsigned voffA[2], voffB[2];
#pragma unroll
    for (int i = 0; i < 2; ++i) { int R, C; stage_rc(tid * 16 + i * 8192, R, C); const int Rb = Epi::PERM ? ((R & ~31) + perm32(R & 31)) : R;
        voffA[i] = (unsigned)(R * K + C) * 2u; voffB[i] = (unsigned)(Rb * K + C) * 2u; }
    const size_t kstep = (size_t)(BK * 2);
    const size_t hstep = (size_t)HALF * K * 2;
    const size_t tstep = 2 * hstep;
    const unsigned ldsw = (unsigned)wid * 1024u;
    const int aoff = lds_byte(wr * 64 + fr, fq * 8), boff = lds_byte(wc * 32 + fr, fq * 8);
#define PG8_SA(b, h) (((b) * 2 + (h)) * HTB)
#define PG8_SB(b, h) ((4 + (b) * 2 + (h)) * HTB)
#define PG8_STAGE(bufoff, gbase, voff) do { _Pragma("unroll") for (int _i = 0; _i < 2; ++_i) \
        __builtin_amdgcn_global_load_lds((const unsigned*)((const char*)(gbase) + (voff)[_i]), (LAS unsigned*)(lds + (bufoff) + ldsw + _i * 8192), 16, 0, 0); } while (0)
#define PG8_LDA(dst, b, h) do { _Pragma("unroll") for (int m = 0; m < 4; ++m) ldfrag(dst[m], lds + PG8_SA(b, h) + aoff + m * 2048); } while (0)
#define PG8_LDB(dst, b, h) do { _Pragma("unroll") for (int n = 0; n < 2; ++n) ldfrag(dst[n], lds + PG8_SB(b, h) + boff + n * 2048); } while (0)
#define PG8_MMA(ai, bj, At, Bt) do { __builtin_amdgcn_s_setprio(1); _Pragma("unroll") for (int m = 0; m < 4; ++m) _Pragma("unroll") for (int n = 0; n < 2; ++n) mma1(acc[ai][bj][m][n], Bt[n], At[m]); __builtin_amdgcn_s_setprio(0); } while (0)
#define PG8_WAIT_V(n) asm volatile("s_waitcnt vmcnt(" #n ")" ::: "memory")
#define PG8_WAIT_L(n) asm volatile("s_waitcnt lgkmcnt(" #n ")" ::: "memory")
#define PG8_BAR __builtin_amdgcn_s_barrier()
#define PG8_SCHED __builtin_amdgcn_sched_barrier(0)
    Unit cur, nxt; int ui = 0;
    if (!S.next(0, cur)) return;
    f32x4 acc[2][2][4][2];
#pragma unroll
    for (int a = 0; a < 2; ++a)
#pragma unroll
        for (int b = 0; b < 2; ++b)
#pragma unroll
            for (int m = 0; m < 4; ++m)
#pragma unroll
                for (int n = 0; n < 2; ++n) acc[a][b][m][n] = (f32x4){0.f, 0.f, 0.f, 0.f};
    typename FragT<Epi::FP8>::type At[4], B0[2], B1[2];
    const char* cA = (const char*)g.A + (size_t)cur.pm * tstep; const char* cB = (const char*)g.Bt + (size_t)cur.pn * tstep;
    PG8_STAGE(PG8_SB(0, 0), cB, voffB); PG8_STAGE(PG8_SB(0, 1), cB + hstep, voffB); PG8_STAGE(PG8_SA(0, 0), cA, voffA); PG8_STAGE(PG8_SA(0, 1), cA + hstep, voffA);
    if (wr == 1) PG8_BAR;
    PG8_WAIT_V(2); PG8_BAR;
    PG8_STAGE(PG8_SB(1, 0), cB + kstep, voffB); PG8_STAGE(PG8_SA(1, 0), cA + kstep, voffA); PG8_STAGE(PG8_SB(1, 1), cB + hstep + kstep, voffB);
    PG8_WAIT_V(6); PG8_BAR;
    for (;;) {
        const bool has_next = S.next(ui + 1, nxt);
        const char* nA = has_next ? (const char*)g.A + (size_t)nxt.pm * tstep : cA; const char* nB = has_next ? (const char*)g.Bt + (size_t)nxt.pn * tstep : cB;
#pragma unroll 1
        for (int t = 0; t < nt; t += 2) {
            const bool last = (t == nt - 2);
            const char* a1 = cA + (size_t)(t + 1) * kstep;
            const char* a2 = last ? nA : cA + (size_t)(t + 2) * kstep; const char* b2 = last ? nB : cB + (size_t)(t + 2) * kstep;
            const char* a3 = a2 + kstep; const char* b3 = b2 + kstep;
            if constexpr (Epi::HAS_MID) { if (t == nt / 2) E.mid(acc, cur, wr, wc, fr, fq); }
            PG8_LDB(B0, 0, 0); PG8_LDB(B1, 0, 1); PG8_SCHED; PG8_LDA(At, 0, 0); PG8_STAGE(PG8_SA(1, 1), a1 + hstep, voffA);
            PG8_WAIT_V(8); PG8_WAIT_L(0); PG8_BAR; PG8_MMA(0, 0, At, B0); PG8_MMA(0, 1, At, B1); PG8_BAR; PG8_SCHED;
            PG8_LDA(At, 0, 1); PG8_STAGE(PG8_SB(0, 0), b2, voffB); PG8_STAGE(PG8_SB(0, 1), b2 + hstep, voffB); PG8_STAGE(PG8_SA(0, 0), a2, voffA);
            PG8_WAIT_V(8); PG8_WAIT_L(0); PG8_BAR; PG8_MMA(1, 0, At, B0); PG8_MMA(1, 1, At, B1); PG8_BAR; PG8_SCHED;
            PG8_LDB(B0, 1, 0); PG8_LDB(B1, 1, 1); PG8_SCHED; PG8_LDA(At, 1, 0); PG8_STAGE(PG8_SA(0, 1), a2 + hstep, voffA);
            PG8_WAIT_V(8); PG8_WAIT_L(0); PG8_BAR; PG8_MMA(0, 0, At, B0); PG8_MMA(0, 1, At, B1); PG8_BAR; PG8_SCHED;
            PG8_LDA(At, 1, 1); PG8_STAGE(PG8_SB(1, 0), b3, voffB); PG8_STAGE(PG8_SB(1, 1), b3 + hstep, voffB); PG8_STAGE(PG8_SA(1, 0), a3, voffA);
            PG8_WAIT_V(8); PG8_WAIT_L(0); PG8_BAR; PG8_MMA(1, 0, At, B0); PG8_MMA(1, 1, At, B1); PG8_BAR; PG8_SCHED;
        }
        if (wr == 0) PG8_BAR;
        E(acc, cur, wr, wc, fr, fq);
        if (!has_next) break;
#pragma unroll
        for (int a = 0; a < 2; ++a)
#pragma unroll
            for (int b = 0; b < 2; ++b)
#pragma unroll
                for (int m = 0; m < 4; ++m)
#pragma unroll
                    for (int n = 0; n < 2; ++n) acc[a][b][m][n] = (f32x4){0.f, 0.f, 0.f, 0.f};
        cur = nxt; cA = nA; cB = nB; ++ui;
        if (wr == 1) PG8_BAR;
    }
    PG8_WAIT_V(0);
    PG8_BAR;
#undef PG8_SA
#undef PG8_SB
#undef PG8_STAGE
#undef PG8_LDA
#undef PG8_LDB
#undef PG8_MMA
#undef PG8_WAIT_V
#undef PG8_WAIT_L
#undef PG8_BAR
#undef PG8_SCHED
}
}
typedef f32x4 AccT[2][2][4][2];

struct EpiProj {
    static constexpr bool PERM = true, HAS_MID = false, FP8 = true;
    const float* bias; bf16_t* PB; bf16_t* GB; const float* RS; const float* CS;
    __device__ __forceinline__ void operator()(const AccT& acc, const pg8::Unit& u, int wr, int wc, int fr, int fq) const {
        const int row0 = u.pm * 256 + wr * 64 + fr, lc0 = wc * 32 + 8 * fq;
        f32x4 bv[2][2], cv[2][2];
#pragma unroll
        for (int bj = 0; bj < 2; ++bj)
#pragma unroll
            for (int n = 0; n < 2; ++n) { bv[bj][n] = *(const f32x4*)(bias + u.pn * 256 + bj * 128 + lc0 + 4 * n); cv[bj][n] = *(const f32x4*)(CS + u.pn * 256 + bj * 128 + lc0 + 4 * n); }
        if (u.pn >= 2 && u.pn < 6) {
            const int t = u.pn - 2;
#pragma unroll
            for (int ai = 0; ai < 2; ++ai)
#pragma unroll
                for (int m = 0; m < 4; ++m) {
                    const int row = row0 + ai * 128 + m * 16; const float rs = RS[row];
                    float o[8];
#pragma unroll
                    for (int n = 0; n < 2; ++n) { const f32x4 v = acc[ai][0][m][n] * (cv[0][n] * rs) + bv[0][n], gt = acc[ai][1][m][n] * (cv[1][n] * rs) + bv[1][n];
#pragma unroll
                        for (int j = 0; j < 4; ++j) o[n * 4 + j] = v[j] * fast_sigmoid(gt[j]); }
                    u32x4 w; w.x = cvt_pk_bf16(o[0], o[1]); w.y = cvt_pk_bf16(o[2], o[3]); w.z = cvt_pk_bf16(o[4], o[5]); w.w = cvt_pk_bf16(o[6], o[7]);
                    *(u32x4*)(GB + (size_t)row * 512 + t * 128 + lc0) = w;
                }
        } else {
            const bool isp = true;
            bf16_t* base = PB; const int ldc = 512; const int colt = u.pn * 256;
#pragma unroll
            for (int ai = 0; ai < 2; ++ai)
#pragma unroll
                for (int m = 0; m < 4; ++m) {
                    const int row = row0 + ai * 128 + m * 16; const float rs = RS[row];
#pragma unroll
                    for (int bj = 0; bj < 2; ++bj) {
                        f32x4 v0 = acc[ai][bj][m][0] * (cv[bj][0] * rs) + bv[bj][0], v1 = acc[ai][bj][m][1] * (cv[bj][1] * rs) + bv[bj][1];
                        if (!isp) {
#pragma unroll
                            for (int j = 0; j < 4; ++j) { v0[j] = fast_sigmoid(v0[j]); v1[j] = fast_sigmoid(v1[j]); }
                        }
                        u32x4 w; w.x = cvt_pk_bf16(v0[0], v0[1]); w.y = cvt_pk_bf16(v0[2], v0[3]); w.z = cvt_pk_bf16(v1[0], v1[1]); w.w = cvt_pk_bf16(v1[2], v1[3]);
                        *(u32x4*)(base + (size_t)row * ldc + colt + bj * 128 + lc0) = w;
                    }
                }
        }
    }
};
struct EpiGate {
    static constexpr bool PERM = true, HAS_MID = false, FP8 = true;
    const float* bias; const float* RS; const float* CS; bf16_t* SG;
    __device__ __forceinline__ void operator()(const AccT& acc, const pg8::Unit& u, int wr, int wc, int fr, int fq) const {
        const int row0 = u.pm * 256 + wr * 64 + fr, lc0 = wc * 32 + 8 * fq, t = u.pn;
        float rs[2][4];
#pragma unroll
        for (int ai = 0; ai < 2; ++ai)
#pragma unroll
            for (int m = 0; m < 4; ++m) rs[ai][m] = RS[row0 + ai * 128 + m * 16];
#pragma unroll
        for (int n = 0; n < 2; ++n) {
            const f32x4 b1 = *(const f32x4*)(bias + 1536 + t * 256 + lc0 + 4 * n), b2 = *(const f32x4*)(bias + 1536 + t * 256 + 128 + lc0 + 4 * n);
            const f32x4 c1 = *(const f32x4*)(CS + t * 256 + lc0 + 4 * n), c2 = *(const f32x4*)(CS + t * 256 + 128 + lc0 + 4 * n);
#pragma unroll
            for (int ai = 0; ai < 2; ++ai)
#pragma unroll
                for (int m = 0; m < 4; ++m) {
                    const int row = row0 + ai * 128 + m * 16;
                    const f32x4 a1 = acc[ai][0][m][n] * (c1 * rs[ai][m]) + b1, a2 = acc[ai][1][m][n] * (c2 * rs[ai][m]) + b2;
                    float ra[4], s2[4];
#pragma unroll
                    for (int j = 0; j < 4; ++j) { const float e1 = __builtin_amdgcn_exp2f(-1.44269504089f * a1[j]), e2 = __builtin_amdgcn_exp2f(-1.44269504089f * a2[j]);
                        ra[j] = (1.0f + e2) * __builtin_amdgcn_rcpf(1.0f + e1); s2[j] = __builtin_amdgcn_rcpf(1.0f + e2); }
                    *(u32x2*)(SG + (size_t)row * 2048 + t * 128 + lc0 + 4 * n) = (u32x2){cvt_pk_bf16(ra[0], ra[1]), cvt_pk_bf16(ra[2], ra[3])};
                    *(u32x2*)(SG + (size_t)row * 2048 + 1024 + t * 128 + lc0 + 4 * n) = (u32x2){cvt_pk_bf16(s2[0], s2[1]), cvt_pk_bf16(s2[2], s2[3])};
                }
        }
    }
};
struct EpiIn {
    static constexpr bool PERM = true, HAS_MID = false, FP8 = true;
    EpiProj P; EpiGate G;
    __device__ __forceinline__ void operator()(const AccT& acc, const pg8::Unit& u, int wr, int wc, int fr, int fq) const {
        if (u.pn < 6) P(acc, u, wr, wc, fr, fq);
        else { pg8::Unit u2 = u; u2.pn = u.pn - 6; G(acc, u2, wr, wc, fr, fq); }
    }
};
struct EpiMerge {
    static constexpr bool PERM = true, HAS_MID = true, FP8 = false;
    const bf16_t* SG; bf16_t* MG;
    __device__ __forceinline__ void mid(AccT& acc, const pg8::Unit& u, int wr, int wc, int fr, int fq) const {
        const int row0 = u.pm * 256 + wr * 64 + fr, col0 = u.pn * 256 + wc * 32 + 8 * fq;
#pragma unroll
        for (int ai = 0; ai < 2; ++ai)
#pragma unroll
            for (int m = 0; m < 4; ++m) {
                const bf16_t* p = SG + (size_t)(row0 + ai * 128 + m * 16) * 2048 + col0;
                const u32x4 r0 = *(const u32x4*)p, r1 = *(const u32x4*)(p + 128);
#pragma unroll
                for (int bj = 0; bj < 2; ++bj) {
                    const unsigned a1[4] = {bj ? r1.x : r0.x, bj ? r1.y : r0.y, bj ? r1.z : r0.z, bj ? r1.w : r0.w};
#pragma unroll
                    for (int n = 0; n < 2; ++n)
#pragma unroll
                        for (int j = 0; j < 4; ++j) { const unsigned w1 = a1[n * 2 + (j >> 1)]; acc[ai][bj][m][n][j] *= (j & 1) ? bf_hi(w1) : bf_lo(w1); }
                }
                if (m & 1) asm volatile("" ::: "memory");
            }
    }
    __device__ __forceinline__ void operator()(const AccT& acc, const pg8::Unit& u, int wr, int wc, int fr, int fq) const {
        const int row0 = u.pm * 256 + wr * 64 + fr, col0 = u.pn * 256 + wc * 32 + 8 * fq;
#pragma unroll
        for (int ai = 0; ai < 2; ++ai)
#pragma unroll
            for (int m = 0; m < 4; ++m)
#pragma unroll
                for (int bj = 0; bj < 2; ++bj) {
                    const int row = row0 + ai * 128 + m * 16;
                    const u32x4 s2 = *(const u32x4*)(SG + (size_t)row * 2048 + 1024 + col0 + bj * 128);
                    const unsigned a2[4] = {s2.x, s2.y, s2.z, s2.w};
                    float o[8];
#pragma unroll
                    for (int n = 0; n < 2; ++n)
#pragma unroll
                        for (int j = 0; j < 4; ++j) {
                            const unsigned w2 = a2[n * 2 + (j >> 1)];
                            const float f2 = fmaxf((j & 1) ? bf_hi(w2) : bf_lo(w2), 1e-20f);
                            o[n * 4 + j] = acc[ai][bj][m][n][j] * f2;
                        }
                    u32x4 w; w.x = cvt_pk_bf16(o[0], o[1]); w.y = cvt_pk_bf16(o[2], o[3]); w.z = cvt_pk_bf16(o[4], o[5]); w.w = cvt_pk_bf16(o[6], o[7]);
                    *(u32x4*)(MG + (size_t)row * 1024 + col0 + bj * 128) = w;
                }
    }
};
struct EpiResid {
    static constexpr bool PERM = true, HAS_MID = false, FP8 = false;
    const float* X; const float* mod; bf16_t* X1B;
    const float* A2; bf16_t* XA; float* SSQ;
    __device__ __forceinline__ void operator()(const AccT& acc, const pg8::Unit& u, int wr, int wc, int fr, int fq) const {
        const int row0 = u.pm * 256 + wr * 64 + fr, col0 = u.pn * 256 + wc * 32 + 8 * fq;
        const int b = (u.pm * 256) / SEQ;
        const float* gt = mod + (size_t)b * NMOD; const float* a2 = A2 + b * 1024;
        f32x4 gv[2][2], av[2][2];
#pragma unroll
        for (int bj = 0; bj < 2; ++bj)
#pragma unroll
            for (int n = 0; n < 2; ++n) { gv[bj][n] = *(const f32x4*)(gt + col0 + bj * 128 + n * 4); av[bj][n] = *(const f32x4*)(a2 + col0 + bj * 128 + n * 4); }
#pragma unroll
        for (int ai = 0; ai < 2; ++ai)
#pragma unroll
            for (int m = 0; m < 4; ++m) {
                const int row = row0 + ai * 128 + m * 16;
                const size_t off = (size_t)row * 1024 + col0;
                float ss = 0.f;
#pragma unroll
                for (int bj = 0; bj < 2; ++bj) {
                    const f32x4 xv0 = *(const f32x4*)(X + off + bj * 128), xv1 = *(const f32x4*)(X + off + bj * 128 + 4);
                    const f32x4 x10 = xv0 + gv[bj][0] * acc[ai][bj][m][0], x11 = xv1 + gv[bj][1] * acc[ai][bj][m][1];
                    { u32x4 wx; wx.x = cvt_pk_bf16(x10[0], x10[1]); wx.y = cvt_pk_bf16(x10[2], x10[3]); wx.z = cvt_pk_bf16(x11[0], x11[1]); wx.w = cvt_pk_bf16(x11[2], x11[3]);
                      *(u32x4*)(X1B + off + bj * 128) = wx; }
                    ss += x10[0] * x10[0] + x10[1] * x10[1] + x10[2] * x10[2] + x10[3] * x10[3] + x11[0] * x11[0] + x11[1] * x11[1] + x11[2] * x11[2] + x11[3] * x11[3];
                    const f32x4 xa0 = x10 * av[bj][0], xa1 = x11 * av[bj][1];
                    u32x4 w; w.x = cvt_pk_bf16(xa0[0], xa0[1]); w.y = cvt_pk_bf16(xa0[2], xa0[3]); w.z = cvt_pk_bf16(xa1[0], xa1[1]); w.w = cvt_pk_bf16(xa1[2], xa1[3]);
                    *(u32x4*)(XA + off + bj * 128) = w;
                }
                ss += __shfl_xor(ss, 16); ss += __shfl_xor(ss, 32);
                if (fq == 0) __hip_atomic_fetch_add(SSQ + row, ss, __ATOMIC_RELAXED, __HIP_MEMORY_SCOPE_AGENT);
            }
    }
};
struct EpiBf16 {
    static constexpr bool PERM = true, HAS_MID = false, FP8 = false;
    bf16_t* O; int ldc;
    __device__ __forceinline__ void operator()(const AccT& acc, const pg8::Unit& u, int wr, int wc, int fr, int fq) const {
        const int row0 = u.pm * 256 + wr * 64 + fr, col0 = u.pn * 256 + wc * 32 + 8 * fq;
#pragma unroll
        for (int ai = 0; ai < 2; ++ai)
#pragma unroll
            for (int m = 0; m < 4; ++m)
#pragma unroll
                for (int bj = 0; bj < 2; ++bj) {
                    const f32x4 v0 = acc[ai][bj][m][0], v1 = acc[ai][bj][m][1];
                    u32x4 w; w.x = cvt_pk_bf16(v0[0], v0[1]); w.y = cvt_pk_bf16(v0[2], v0[3]); w.z = cvt_pk_bf16(v1[0], v1[1]); w.w = cvt_pk_bf16(v1[2], v1[3]);
                    *(u32x4*)(O + (size_t)(row0 + ai * 128 + m * 16) * ldc + col0 + bj * 128) = w;
                }
    }
};

struct EpiQ {
    static constexpr bool PERM = true, HAS_MID = false, FP8 = false;
    bf16_t* O; const float* SSQ; const float* BIAS2;
    __device__ __forceinline__ void operator()(const AccT& acc, const pg8::Unit& u, int wr, int wc, int fr, int fq) const {
        const int row0 = u.pm * 256 + wr * 64 + fr, col0 = u.pn * 256 + wc * 32 + 8 * fq;
        const float* bs = BIAS2 + ((u.pm * 256) / SEQ) * 2048 + col0;
        f32x4 bv[2][2];
#pragma unroll
        for (int bj = 0; bj < 2; ++bj)
#pragma unroll
            for (int n = 0; n < 2; ++n) bv[bj][n] = *(const f32x4*)(bs + bj * 128 + 4 * n);
#pragma unroll
        for (int ai = 0; ai < 2; ++ai)
#pragma unroll
            for (int m = 0; m < 4; ++m) {
                const int row = row0 + ai * 128 + m * 16;
                const float r = rsqrtf(SSQ[row] * (1.0f / D) + EPS);
#pragma unroll
                for (int bj = 0; bj < 2; ++bj) {
                    const f32x4 v0 = acc[ai][bj][m][0] * r + bv[bj][0], v1 = acc[ai][bj][m][1] * r + bv[bj][1];
                    u32x4 w; w.x = cvt_pk_bf16(v0[0], v0[1]); w.y = cvt_pk_bf16(v0[2], v0[3]); w.z = cvt_pk_bf16(v1[0], v1[1]); w.w = cvt_pk_bf16(v1[2], v1[3]);
                    { const int cw = wr * 2 + ai * 4 + (m >> 1), ks = 2 * wc + (fq >> 1), ln = (fq & 1) * 32 + (m & 1) * 16 + fr;
                      *(u32x4*)(O + ((size_t)(u.pm * 8 + u.pn) * 128 + (size_t)((cw * 2 + bj) * 8 + ks)) * 512 + ln * 8) = w; }
                }
            }
    }
};

#ifndef U_BITS
#define U_BITS 4
#endif
#ifndef V_BITS
#define V_BITS 4
#endif
template <int BITS> struct RowFmt;
template <> struct RowFmt<8> { typedef u32x4 row_t; static constexpr float QMAX = 224.0f; };
template <> struct RowFmt<4> { typedef u32x2 row_t; static constexpr float QMAX = 6.0f; };
template <int I> __device__ __forceinline__ f32x2 row_pair(const u32x4& r) {
    const unsigned w = (I >> 1) == 0 ? r.x : (I >> 1) == 1 ? r.y : (I >> 1) == 2 ? r.z : r.w;
    return __builtin_amdgcn_cvt_pk_f32_fp8((int)w, (I & 1) != 0);
}
template <int I> __device__ __forceinline__ f32x2 row_pair(const u32x2& r) {
    const unsigned w = (I >> 2) == 0 ? r.x : r.y;
    return __builtin_amdgcn_cvt_scalef32_pk_f32_fp4(w, 1.0f, I & 3);
}
template <class R> __device__ __forceinline__ float row_dot16(const R& r, const f32x2 (&hf)[8]) {
    f32x2 acc = {0.f, 0.f};
    acc = __builtin_elementwise_fma(row_pair<0>(r), hf[0], acc); acc = __builtin_elementwise_fma(row_pair<1>(r), hf[1], acc);
    acc = __builtin_elementwise_fma(row_pair<2>(r), hf[2], acc); acc = __builtin_elementwise_fma(row_pair<3>(r), hf[3], acc);
    acc = __builtin_elementwise_fma(row_pair<4>(r), hf[4], acc); acc = __builtin_elementwise_fma(row_pair<5>(r), hf[5], acc);
    acc = __builtin_elementwise_fma(row_pair<6>(r), hf[6], acc); acc = __builtin_elementwise_fma(row_pair<7>(r), hf[7], acc);
    return acc.x + acc.y;
}
template <class R> __device__ __forceinline__ void row_axpy16(const R& r, float c, f32x2 (&o)[8]) {
    const f32x2 c2 = {c, c};
    o[0] = __builtin_elementwise_fma(c2, row_pair<0>(r), o[0]); o[1] = __builtin_elementwise_fma(c2, row_pair<1>(r), o[1]);
    o[2] = __builtin_elementwise_fma(c2, row_pair<2>(r), o[2]); o[3] = __builtin_elementwise_fma(c2, row_pair<3>(r), o[3]);
    o[4] = __builtin_elementwise_fma(c2, row_pair<4>(r), o[4]); o[5] = __builtin_elementwise_fma(c2, row_pair<5>(r), o[5]);
    o[6] = __builtin_elementwise_fma(c2, row_pair<6>(r), o[6]); o[7] = __builtin_elementwise_fma(c2, row_pair<7>(r), o[7]);
}
template <int BITS> __device__ __forceinline__ void quant_row(const f32x4 (&v)[4], float qs, unsigned char* dst_row, int lane) {
    if constexpr (BITS == 8) {
#pragma unroll
        for (int q = 0; q < 4; ++q) { int p = 0; p = __builtin_amdgcn_cvt_pk_fp8_f32(v[q][0] * qs, v[q][1] * qs, p, false); p = __builtin_amdgcn_cvt_pk_fp8_f32(v[q][2] * qs, v[q][3] * qs, p, true);
            ((unsigned*)dst_row)[lane + 64 * q] = (unsigned)p; }
    } else {
#pragma unroll
        for (int q = 0; q < 4; ++q) { unsigned p = 0; p = __builtin_amdgcn_cvt_scalef32_pk_fp4_f32(p, v[q][0] * qs, v[q][1] * qs, 1.0f, 0); p = __builtin_amdgcn_cvt_scalef32_pk_fp4_f32(p, v[q][2] * qs, v[q][3] * qs, 1.0f, 1);
            ((unsigned short*)dst_row)[lane + 64 * q] = (unsigned short)(p & 0xffffu); }
    }
}
__device__ __forceinline__ void xpose_tile(const float* src, int ldsrc, int c0, int k0, bf16_t* dst, int lddst, int n0, int kd0, LAS float* tile, int tid) {
    { const int r = tid >> 4, c4 = tid & 15;
#pragma unroll
      for (int ps = 0; ps < 2; ++ps) { const f32x4 v = *(const f32x4*)(src + (size_t)(k0 + r + 32 * ps) * ldsrc + c0 + c4 * 4);
#pragma unroll
          for (int j = 0; j < 4; ++j) tile[(r + 32 * ps) * 65 + c4 * 4 + j] = v[j]; } }
    __syncthreads();
    { const int n = tid >> 3, kg = tid & 7; float f[8];
#pragma unroll
      for (int i = 0; i < 8; ++i) f[i] = tile[(kg * 8 + i) * 65 + n];
      u32x4 w; w.x = cvt_pk_bf16(f[0], f[1]); w.y = cvt_pk_bf16(f[2], f[3]); w.z = cvt_pk_bf16(f[4], f[5]); w.w = cvt_pk_bf16(f[6], f[7]);
      *(u32x4*)(dst + (size_t)(n0 + n) * lddst + kd0 + k0 + kg * 8) = w; }
    __syncthreads();
}
__device__ __forceinline__ void phase_prep(KP kp, LAS unsigned char* lds, int wave_s) {
    const int tid = wave_s * 64 + lane_id_asm(), G = gridDim.x;
    unsigned char* ws = kp->ws;
    const float* cvec = kp->in[1]; const float* ada_w = kp->in[2]; const float* ada_b = kp->in[3];
    float* mod = (float*)(ws + WS_MOD);
    LAS float* cact = (LAS float*)lds;
    LAS float* red = (LAS float*)(lds + 16384);
    LAS float* tile = (LAS float*)(lds + 49152);
    LAS float* pw = (LAS float*)(lds + 49152);
    if ((int)blockIdx.x < 192) {
        for (int i = tid; i < 4096; i += NTHREADS) { const float v = cvec[i]; cact[i] = v * fast_sigmoid(v); }
    }
    if (blockIdx.x == G - 1) {
        float* binp = (float*)(ws + WS_BINP); const float* b_in = kp->in[6];
        for (int i = tid; i < INW; i += NTHREADS) binp[i] = b_in[in_colmap(i)];
    }
    __syncthreads();
    constexpr int N_MOD = 192, N_WIN = 384, N_CO = 128, N_WO = 256, N_WQ = 512, N_WP = 128, N_WG = 512;
    constexpr int I1 = N_MOD, I2 = I1 + N_WIN, I3 = I2 + N_CO, I4 = I3 + N_WO, I5 = I4 + N_WQ, I6 = I5 + N_WP, I7 = I6 + N_WG;
    for (int it = blockIdx.x; it < I7; it += G) {
        if (it < I1) {
            const int n0 = it * 32, c4 = tid & 7, ks = tid >> 3;
            float a[4][4];
#pragma unroll
            for (int b = 0; b < 4; ++b)
#pragma unroll
                for (int j = 0; j < 4; ++j) a[b][j] = 0.f;
#pragma unroll 4
            for (int kk = 0; kk < 16; ++kk) { const int k = ks * 16 + kk; const f32x4 w = *(const f32x4*)(ada_w + (size_t)k * NMOD + n0 + c4 * 4);
#pragma unroll
                for (int b = 0; b < 4; ++b) { const float cv = cact[b * 1024 + k];
#pragma unroll
                    for (int j = 0; j < 4; ++j) a[b][j] += cv * w[j]; } }
#pragma unroll
            for (int b = 0; b < 4; ++b)
#pragma unroll
                for (int j = 0; j < 4; ++j) red[(ks * 4 + b) * 32 + c4 * 4 + j] = a[b][j];
            __syncthreads();
            if (tid < 128) { const int b = tid >> 5, col = tid & 31; float s = 0.f;
                for (int q = 0; q < 64; ++q) s += red[(q * 4 + b) * 32 + col];
                mod[b * NMOD + n0 + col] = s + ada_b[n0 + col]; }
            __syncthreads();
        } else if (it >= I6 || (it >= I1 && it < I2)) {
            const bool isp = it < I2;
            const int i = isp ? it - I1 : it - I6, kt = i & 15, n0 = (i >> 4) * 64 + (isp ? 0 : 1536), c0 = in_colmap(n0);
            const float* win = kp->in[5];
            LAS float* cmx = (LAS float*)(lds + 49152 + 17408);
            { const int r = tid >> 4, c4 = tid & 15;
              const f32x4 v0 = *(const f32x4*)(win + (size_t)(kt * 64 + r) * INW + c0 + c4 * 4), v1 = *(const f32x4*)(win + (size_t)(kt * 64 + r + 32) * INW + c0 + c4 * 4);
#pragma unroll
              for (int j = 0; j < 4; ++j) cmx[r * 64 + c4 * 4 + j] = fmaxf(fabsf(v0[j]), fabsf(v1[j])); }
            __syncthreads();
            if (tid < 64) { float mm = 0.f; for (int q = 0; q < 32; ++q) mm = fmaxf(mm, cmx[q * 64 + tid]); ((float*)(ws + WS_PMAX))[kt * 3584 + n0 + tid] = mm; }
            __syncthreads();
        } else if (it < I3) {
            const int i = it - I2, kt = i & 7, ntl = i >> 3;
            xpose_tile(kp->in[14], 1024, ntl * 64, kt * 64, (bf16_t*)(ws + WS_WPC), 1024, ntl * 64, 512, tile, tid);
        } else if (it < I4) {
            const int i = it - I3, kt = i & 15, ntl = i >> 4;
            xpose_tile(kp->in[15], 1024, ntl * 64, kt * 64, (bf16_t*)(ws + WS_WOUT), 1024, ntl * 64, 0, tile, tid);
        } else if (it < I5) {
            const int i = it - I4, kt = i & 15, ntl = i >> 4;
            xpose_tile(kp->in[17], 2048, ntl * 64, kt * 64, (bf16_t*)(ws + WS_WQ), 1024, ntl * 64, 0, tile, tid);
        } else {
            const int i = it - I5, nb = i & 1, cb = (i >> 1) & 15, g = i >> 5;
            const float* pool_w = kp->in[7]; const float* pool_scale = kp->in[8]; const float* pool_up = kp->in[9];
            for (int e = tid; e < 1024; e += NTHREADS) { const int ci = e >> 7, d = e & 127; pw[e] = pool_w[((size_t)g * 128 + cb * 8 + ci) * 128 + d] * pool_scale[g * 128 + d]; }
            __syncthreads();
            const int n = nb * 512 + tid; float a[8];
#pragma unroll
            for (int q = 0; q < 8; ++q) a[q] = 0.f;
#pragma unroll 4
            for (int d = 0; d < 128; ++d) { const float uv = pool_up[(size_t)(g * 128 + d) * 1024 + n];
#pragma unroll
                for (int q = 0; q < 8; ++q) a[q] += pw[q * 128 + d] * uv; }
            u32x4 w; w.x = cvt_pk_bf16(a[0], a[1]); w.y = cvt_pk_bf16(a[2], a[3]); w.z = cvt_pk_bf16(a[4], a[5]); w.w = cvt_pk_bf16(a[6], a[7]);
            *(u32x4*)((bf16_t*)(ws + WS_WPC) + (size_t)n * 1024 + g * 128 + cb * 8) = w;
            __syncthreads();
        }
    }
    {
        const int lane = tid & 63, wave = tid >> 6;
        f32x4 vn[4];
        { const int r0 = blockIdx.x * 8 + wave;
          if (r0 < 2 * NEXP) { const int tb0 = r0 >= NEXP ? 1 : 0; const f32x4* src = (const f32x4*)((tb0 ? kp->in[21] : kp->in[20]) + (size_t)(r0 - tb0 * NEXP) * D);
#pragma unroll
              for (int q = 0; q < 4; ++q) vn[q] = src[lane + 64 * q]; } }
        for (int r = blockIdx.x * 8 + wave; r < 2 * NEXP; r += G * 8) {
            const int tb = r >= NEXP ? 1 : 0, e = r - tb * NEXP;
            f32x4 v[4]; float m = 0.f;
#pragma unroll
            for (int q = 0; q < 4; ++q) v[q] = vn[q];
            { const int rn = r + G * 8;
              if (rn < 2 * NEXP) { const int tbn = rn >= NEXP ? 1 : 0; const f32x4* src = (const f32x4*)((tbn ? kp->in[21] : kp->in[20]) + (size_t)(rn - tbn * NEXP) * D);
#pragma unroll
                  for (int q = 0; q < 4; ++q) vn[q] = src[lane + 64 * q]; } }
#pragma unroll
            for (int q = 0; q < 4; ++q) m = fmaxf(m, fmaxf(fmaxf(fabsf(v[q][0]), fabsf(v[q][1])), fmaxf(fabsf(v[q][2]), fabsf(v[q][3]))));
            m = wave_max(m);
            const float qmax = tb ? RowFmt<V_BITS>::QMAX : RowFmt<U_BITS>::QMAX;
            const float qs = m > 0.f ? qmax / m : 0.f;
            if (tb) quant_row<V_BITS>(v, qs, ws + WS_EV + (size_t)e * (V_BITS * 128), lane);
            else quant_row<U_BITS>(v, qs, ws + WS_EU + (size_t)e * (U_BITS * 128), lane);
            if (lane == 0) ((float*)(ws + (tb ? WS_SV : WS_SU)))[e] = m / qmax;
        }
    }
}

__device__ __forceinline__ void phase_w8(KP kp, LAS unsigned char* lds, int wave_s) {
    const int tid = wave_s * 64 + lane_id_asm();
    unsigned char* ws = kp->ws;
    const float* win = kp->in[5]; const float* pmax = (const float*)(ws + WS_PMAX);
    LAS float* tile = (LAS float*)(lds + 49152);
    LAS float* csc = (LAS float*)(lds + 49152 + 17408);
    for (int it = blockIdx.x; it < 56 * 16; it += gridDim.x) {
        const int kt = it & 15, n0 = (it >> 4) * 64, c0 = in_colmap(n0);
        if (tid < 64) { float mm = 0.f;
#pragma unroll
            for (int q = 0; q < 16; ++q) mm = fmaxf(mm, pmax[q * 3584 + n0 + tid]);
            csc[tid] = mm > 0.f ? 224.0f / mm : 0.f; if (kt == 0) ((float*)(ws + WS_WP8S))[n0 + tid] = mm * (1.0f / 224.0f); }
        { const int r = tid >> 4, c4 = tid & 15;
#pragma unroll
          for (int ps = 0; ps < 2; ++ps) { const f32x4 v = *(const f32x4*)(win + (size_t)(kt * 64 + r + 32 * ps) * INW + c0 + c4 * 4);
#pragma unroll
              for (int j = 0; j < 4; ++j) tile[(r + 32 * ps) * 65 + c4 * 4 + j] = v[j]; } }
        __syncthreads();
        { const int n = tid >> 3, kg = tid & 7; const float qs = csc[n]; float f[8];
#pragma unroll
          for (int i = 0; i < 8; ++i) f[i] = tile[(kg * 8 + i) * 65 + n] * qs;
          int p0 = 0, p1 = 0;
          p0 = __builtin_amdgcn_cvt_pk_fp8_f32(f[0], f[1], p0, false); p0 = __builtin_amdgcn_cvt_pk_fp8_f32(f[2], f[3], p0, true);
          p1 = __builtin_amdgcn_cvt_pk_fp8_f32(f[4], f[5], p1, false); p1 = __builtin_amdgcn_cvt_pk_fp8_f32(f[6], f[7], p1, true);
          *(u32x2*)(ws + WS_WP8 + (size_t)(n0 + n) * 1024 + kt * 64 + kg * 8) = (u32x2){(unsigned)p0, (unsigned)p1}; }
        __syncthreads();
    }
}

template <bool WITH_FP8>
__device__ __forceinline__ void phase_norm_ada(const float* src, const float* gain, const float* mod, int shift_off, int scale_off, bf16_t* dst, unsigned char* dst8, float* dscale, int wave_s) {
    const int lane = lane_id_asm(), wave = wave_s;
    f32x4 vn[4];
    { const int row0 = blockIdx.x * 8 + wave;
      if (row0 < T) { const f32x4* xr = (const f32x4*)(src + (size_t)row0 * D);
#pragma unroll
          for (int j = 0; j < 4; ++j) vn[j] = xr[lane + 64 * j]; } }
    for (int row = blockIdx.x * 8 + wave; row < T; row += gridDim.x * 8) {
        const int b = row / SEQ;
        f32x4 v[4]; float ss = 0.f;
#pragma unroll
        for (int j = 0; j < 4; ++j) v[j] = vn[j];
        { const int rn = row + gridDim.x * 8;
          if (rn < T) { const f32x4* xr = (const f32x4*)(src + (size_t)rn * D);
#pragma unroll
              for (int j = 0; j < 4; ++j) vn[j] = xr[lane + 64 * j]; } }
#pragma unroll
        for (int j = 0; j < 4; ++j) ss += v[j][0] * v[j][0] + v[j][1] * v[j][1] + v[j][2] * v[j][2] + v[j][3] * v[j][3];
        ss = wave_sum(ss);
        const float r = rsqrtf(ss * (1.0f / D) + EPS);
        float am = 0.f;
#pragma unroll
        for (int j = 0; j < 4; ++j) {
            const int col = 4 * lane + 256 * j;
            const f32x4 g = *(const f32x4*)(gain + col), sc = *(const f32x4*)(mod + (size_t)b * NMOD + scale_off + col), sh = *(const f32x4*)(mod + (size_t)b * NMOD + shift_off + col);
            const f32x4 h = v[j] * r * g * (sc + 1.0f) + sh;
            u32x2 w; w.x = cvt_pk_bf16(h[0], h[1]); w.y = cvt_pk_bf16(h[2], h[3]);
            if (dst) *(u32x2*)(dst + (size_t)row * D + col) = w;
            if (WITH_FP8) { v[j] = h; am = fmaxf(am, fmaxf(fmaxf(fabsf(h[0]), fabsf(h[1])), fmaxf(fabsf(h[2]), fabsf(h[3])))); }
        }
        if (WITH_FP8) {
            am = wave_max(am);
            const float qs = am > 0.f ? 224.0f / am : 0.f;
#pragma unroll
            for (int j = 0; j < 4; ++j) { int p = 0; p = __builtin_amdgcn_cvt_pk_fp8_f32(v[j][0] * qs, v[j][1] * qs, p, false); p = __builtin_amdgcn_cvt_pk_fp8_f32(v[j][2] * qs, v[j][3] * qs, p, true);
                *(unsigned*)(dst8 + (size_t)row * D + 4 * lane + 256 * j) = (unsigned)p; }
            if (lane == 0) dscale[row] = am * (1.0f / 224.0f);
        }
    }
}

__device__ __forceinline__ void phase_aux(KP kp, LAS unsigned char* lds, int wave_s) {
    const int tid = wave_s * 64 + lane_id_asm();
    unsigned char* ws = kp->ws;
    const float* mod = (const float*)(ws + WS_MOD);
    const int bid = blockIdx.x;
    if (bid == 0) {
        float* A2 = (float*)(ws + WS_A2); const float* g2 = kp->in[16];
        for (int i = tid; i < 4096; i += NTHREADS) { const int b = i >> 10, k = i & 1023; A2[i] = g2[k] * (1.0f + mod[(size_t)b * NMOD + 4 * 1024 + k]); }
    } else if (bid <= 8) {
        float* SSQ = (float*)(ws + WS_SSQ) + (bid - 1) * 4096;
        for (int i = tid; i < 4096; i += NTHREADS) SSQ[i] = 0.f;
    } else if (bid <= 24) {
        const int n0 = (bid - 9) * 128, c4 = tid & 31, ks = tid >> 5;
        const float* wq = kp->in[17];
        LAS float* red = (LAS float*)lds;
        float a[4][4];
#pragma unroll
        for (int b = 0; b < 4; ++b)
#pragma unroll
            for (int j = 0; j < 4; ++j) a[b][j] = 0.f;
#pragma unroll 4
        for (int kk = 0; kk < 64; ++kk) { const int k = ks * 64 + kk; const f32x4 w = *(const f32x4*)(wq + (size_t)k * 2048 + n0 + c4 * 4);
#pragma unroll
            for (int b = 0; b < 4; ++b) { const float sv = mod[(size_t)b * NMOD + 3 * 1024 + k];
#pragma unroll
                for (int j = 0; j < 4; ++j) a[b][j] += sv * w[j]; } }
#pragma unroll
        for (int b = 0; b < 4; ++b)
#pragma unroll
            for (int j = 0; j < 4; ++j) red[(ks * 4 + b) * 128 + c4 * 4 + j] = a[b][j];
        __syncthreads();
        { const int b = tid >> 7, col = tid & 127; float sm = 0.f;
          for (int q = 0; q < 16; ++q) sm += red[(q * 4 + b) * 128 + col];
          ((float*)(ws + WS_BIAS2))[b * 2048 + n0 + col] = sm; }
        __syncthreads();
    }
}

template <int W>
__device__ __forceinline__ void pool_window(const float (&x0)[31], const float (&x1)[31], int spos0, bf16_t* dstp) {
#pragma unroll
    for (int i = 0; i < 16; ++i) {
        float s0 = 0.f, s1 = 0.f;
#pragma unroll
        for (int d = 0; d < W; ++d) { s0 += x0[i + 15 - d]; s1 += x1[i + 15 - d]; }
        const int sp = spos0 + i; const float inv = 1.0f / (float)(sp + 1 < W ? sp + 1 : W);
        const float m0 = s0 * inv - x0[i + 15], m1 = s1 * inv - x1[i + 15];
        *(unsigned*)(dstp + (size_t)i * 1024) = cvt_pk_bf16(m0, m1);
    }
}
__device__ __forceinline__ void phase_branches(KP kp, LAS unsigned char* lds, int wave_s) {
    const int lane = lane_id_asm(), wave = wave_s, tid = wave * 64 + lane;
    unsigned char* ws = kp->ws;
    const bf16_t* PB = (const bf16_t*)(ws + WS_PG); const bf16_t* GB = PB + (size_t)T * 512;
    bf16_t* MC = (bf16_t*)(ws + WS_MC);
    const float* dwk = kp->in[10]; const float* dwb = kp->in[11]; const float* lng = kp->in[12]; const float* lnb = kp->in[13];
    LAS unsigned* rows = (LAS unsigned*)lds;
    LAS float* ybuf = (LAS float*)(lds + 63488);
    const int cp = tid & 255, th = tid >> 8;
    float w0[31], w1[31];
#pragma unroll
    for (int j = 0; j < 31; ++j) { const f32x2 w = *(const f32x2*)(dwk + j * 512 + 2 * cp); w0[j] = w.x; w1[j] = w.y; }
    const f32x2 cb = *(const f32x2*)(dwb + 2 * cp);
    u32x4 gpre[8], ppre[6];
#define P3_LOAD_G(t0_, s0_) do { _Pragma("unroll") for (int i_ = 0; i_ < 8; ++i_) { const int e = tid + i_ * NTHREADS; const int r = e >> 6, c = e & 63; u32x4 v = {0u, 0u, 0u, 0u}; \
            if (e < 62 * 64 && (s0_) + r - 30 >= 0) v = *(const u32x4*)(GB + (size_t)((t0_) + r - 30) * 512 + c * 8); gpre[i_] = v; } } while (0)
#define P3_LOAD_P(t0_, s0_) do { _Pragma("unroll") for (int i_ = 0; i_ < 6; ++i_) { const int e = tid + i_ * NTHREADS; const int r = e >> 6, c = e & 63; u32x4 v = {0u, 0u, 0u, 0u}; \
            if (e < 47 * 64 && (s0_) + r - 15 >= 0) v = *(const u32x4*)(PB + (size_t)((t0_) + r - 15) * 512 + c * 8); ppre[i_] = v; } } while (0)
    if ((int)blockIdx.x < T / 32) { const int t0 = blockIdx.x * 32; P3_LOAD_G(t0, t0 % SEQ); }
    for (int tl = blockIdx.x; tl < T / 32; tl += gridDim.x) {
        const int t0 = tl * 32, s0 = t0 % SEQ;
#pragma unroll
        for (int i_ = 0; i_ < 8; ++i_) { const int e = tid + i_ * NTHREADS; if (e < 62 * 64) *(LAS u32x4*)(rows + (e >> 6) * 256 + (e & 63) * 4) = gpre[i_]; }
        __syncthreads();
        P3_LOAD_P(t0, s0);
        {
            float a0[16], a1[16];
#pragma unroll
            for (int i = 0; i < 16; ++i) { a0[i] = cb.x; a1[i] = cb.y; }
#pragma unroll
            for (int r = 0; r < 46; ++r) {
                const unsigned uu = rows[(th * 16 + r) * 256 + cp]; const float x0 = bf_lo(uu), x1 = bf_hi(uu);
#pragma unroll
                for (int i = 0; i < 16; ++i) { const int j = r - i; if (j >= 0 && j <= 30) { a0[i] += x0 * w0[j]; a1[i] += x1 * w1[j]; } }
            }
#pragma unroll
            for (int i = 0; i < 16; ++i) *(LAS f32x2*)(ybuf + (th * 16 + i) * 512 + 2 * cp) = (f32x2){a0[i], a1[i]};
        }
        __syncthreads();
        {
            const f32x4 g0 = *(const f32x4*)(lng + lane * 8), g1 = *(const f32x4*)(lng + lane * 8 + 4), b0 = *(const f32x4*)(lnb + lane * 8), b1 = *(const f32x4*)(lnb + lane * 8 + 4);
#pragma unroll
            for (int q = 0; q < 4; ++q) {
                const int tk = wave * 4 + q;
                const f32x4 y0 = *(const LAS f32x4*)(ybuf + tk * 512 + lane * 8), y1 = *(const LAS f32x4*)(ybuf + tk * 512 + lane * 8 + 4);
                float s = (y0[0] + y0[1]) + (y0[2] + y0[3]) + (y1[0] + y1[1]) + (y1[2] + y1[3]);
                s = wave_sum(s); const float mu = s * (1.0f / 512.0f);
                const f32x4 d0 = y0 - mu, d1 = y1 - mu;
                float qv = d0[0] * d0[0] + d0[1] * d0[1] + d0[2] * d0[2] + d0[3] * d0[3] + d1[0] * d1[0] + d1[1] * d1[1] + d1[2] * d1[2] + d1[3] * d1[3];
                qv = wave_sum(qv); const float rs = rsqrtf(qv * (1.0f / 512.0f) + EPS);
                f32x4 o0 = d0 * rs * g0 + b0, o1 = d1 * rs * g1 + b1;
#pragma unroll
                for (int j = 0; j < 4; ++j) { o0[j] = o0[j] * fast_sigmoid(o0[j]); o1[j] = o1[j] * fast_sigmoid(o1[j]); }
                u32x4 w; w.x = cvt_pk_bf16(o0[0], o0[1]); w.y = cvt_pk_bf16(o0[2], o0[3]); w.z = cvt_pk_bf16(o1[0], o1[1]); w.w = cvt_pk_bf16(o1[2], o1[3]);
                *(u32x4*)(MC + (size_t)(t0 + tk) * 1024 + 512 + lane * 8) = w;
            }
        }
        __syncthreads();
#pragma unroll
        for (int i_ = 0; i_ < 6; ++i_) { const int e = tid + i_ * NTHREADS; if (e < 47 * 64) *(LAS u32x4*)(rows + (e >> 6) * 256 + (e & 63) * 4) = ppre[i_]; }
        __syncthreads();
        { const int tn = tl + gridDim.x; if (tn < T / 32) { const int t0n = tn * 32; P3_LOAD_G(t0n, t0n % SEQ); } }
        {
            float x0[31], x1[31];
#pragma unroll
            for (int r = 0; r < 31; ++r) { const unsigned uu = rows[(th * 16 + r) * 256 + cp]; x0[r] = bf_lo(uu); x1[r] = bf_hi(uu); }
            bf16_t* dstp = MC + (size_t)(t0 + th * 16) * 1024 + 2 * cp;
            const int grp = __builtin_amdgcn_readfirstlane(cp >> 6), sp0 = s0 + th * 16;
            if (grp == 0) pool_window<2>(x0, x1, sp0, dstp);
            else if (grp == 1) pool_window<4>(x0, x1, sp0, dstp);
            else if (grp == 2) pool_window<8>(x0, x1, sp0, dstp);
            else pool_window<16>(x0, x1, sp0, dstp);
        }
        __syncthreads();
    }
}

#define CE_DESC(a, b) do { const int _hi = max(a, b), _lo = min(a, b); a = _hi; b = _lo; } while (0)
#define CE_ASC(a, b)  do { const int _hi = max(a, b), _lo = min(a, b); a = _lo; b = _hi; } while (0)
__device__ __forceinline__ void bitonic_sort16_desc(int (&v)[16]) {
#pragma unroll
    for (int k = 2; k <= 16; k <<= 1)
#pragma unroll
        for (int j = k >> 1; j > 0; j >>= 1)
#pragma unroll
            for (int i = 0; i < 16; ++i) { const int l = i ^ j; if (l > i) { if ((i & k) == 0) CE_DESC(v[i], v[l]); else CE_ASC(v[i], v[l]); } }
}
__device__ __forceinline__ void bitonic_merge16_desc(int (&v)[16]) {
#pragma unroll
    for (int j = 8; j > 0; j >>= 1)
#pragma unroll
        for (int i = 0; i < 16; ++i) { const int l = i ^ j; if (l > i) CE_DESC(v[i], v[l]); }
}
__device__ __forceinline__ void top16_merge(int (&a)[16], const int (&b)[16]) {
#pragma unroll
    for (int i = 0; i < 16; ++i) a[i] = max(a[i], b[15 - i]);
    bitonic_merge16_desc(a);
}
#define CEF_DESC(a, b) do { const float _hi = fmaxf(a, b), _lo = fminf(a, b); a = _hi; b = _lo; } while (0)
#define CEF_ASC(a, b)  do { const float _hi = fmaxf(a, b), _lo = fminf(a, b); a = _lo; b = _hi; } while (0)
__device__ __forceinline__ void fbitonic_sort16_desc(float (&v)[16]) {
#pragma unroll
    for (int k = 2; k <= 16; k <<= 1)
#pragma unroll
        for (int j = k >> 1; j > 0; j >>= 1)
#pragma unroll
            for (int i = 0; i < 16; ++i) { const int l = i ^ j; if (l > i) { if ((i & k) == 0) CEF_DESC(v[i], v[l]); else CEF_ASC(v[i], v[l]); } }
}
__device__ __forceinline__ void fsort16_desc(float (&v)[16]) {
    CEF_DESC(v[0], v[13]); CEF_DESC(v[1], v[12]); CEF_DESC(v[2], v[15]); CEF_DESC(v[3], v[14]); CEF_DESC(v[4], v[8]); CEF_DESC(v[5], v[6]); CEF_DESC(v[7], v[11]); CEF_DESC(v[9], v[10]); CEF_DESC(v[0], v[5]); CEF_DESC(v[1], v[7]); CEF_DESC(v[2], v[9]); CEF_DESC(v[3], v[4]); CEF_DESC(v[6], v[13]); CEF_DESC(v[8], v[14]); CEF_DESC(v[10], v[15]); CEF_DESC(v[11], v[12]); CEF_DESC(v[0], v[1]); CEF_DESC(v[2], v[3]); CEF_DESC(v[4], v[5]); CEF_DESC(v[6], v[8]); CEF_DESC(v[7], v[9]); CEF_DESC(v[10], v[11]); CEF_DESC(v[12], v[13]); CEF_DESC(v[14], v[15]); CEF_DESC(v[0], v[2]); CEF_DESC(v[1], v[3]); CEF_DESC(v[4], v[10]); CEF_DESC(v[5], v[11]); CEF_DESC(v[6], v[7]); CEF_DESC(v[8], v[9]); CEF_DESC(v[12], v[14]); CEF_DESC(v[13], v[15]); CEF_DESC(v[1], v[2]); CEF_DESC(v[3], v[12]); CEF_DESC(v[4], v[6]); CEF_DESC(v[5], v[7]); CEF_DESC(v[8], v[10]); CEF_DESC(v[9], v[11]); CEF_DESC(v[13], v[14]); CEF_DESC(v[1], v[4]); CEF_DESC(v[2], v[6]); CEF_DESC(v[5], v[8]); CEF_DESC(v[7], v[10]); CEF_DESC(v[9], v[13]); CEF_DESC(v[11], v[14]); CEF_DESC(v[2], v[4]); CEF_DESC(v[3], v[6]); CEF_DESC(v[9], v[12]); CEF_DESC(v[11], v[13]); CEF_DESC(v[3], v[5]); CEF_DESC(v[6], v[8]); CEF_DESC(v[7], v[9]); CEF_DESC(v[10], v[12]); CEF_DESC(v[3], v[4]); CEF_DESC(v[5], v[6]); CEF_DESC(v[7], v[8]); CEF_DESC(v[9], v[10]); CEF_DESC(v[11], v[12]); CEF_DESC(v[6], v[7]); CEF_DESC(v[8], v[9]);
}
__device__ __forceinline__ void fbitonic_merge16_desc(float (&v)[16]) {
#pragma unroll
    for (int j = 8; j > 0; j >>= 1)
#pragma unroll
        for (int i = 0; i < 16; ++i) { const int l = i ^ j; if (l > i) CEF_DESC(v[i], v[l]); }
}
__device__ __forceinline__ void ftop16_merge(float (&a)[16], const float (&b)[16]) {
#pragma unroll
    for (int i = 0; i < 16; ++i) a[i] = fmaxf(a[i], b[15 - i]);
    fbitonic_merge16_desc(a);
}
__device__ __forceinline__ int packkey(float v, int idx) { const int f = __float_as_int(v); const int s = f ^ ((f >> 31) & 0x7fffffff); return (s & ~127) | (127 - idx); }
__device__ __forceinline__ float keyval(int k) { const int s = k & ~127; return __int_as_float(s ^ ((s >> 31) & 0x7fffffff)); }
__device__ __forceinline__ void top16_of_scores(const f32x16 (&acc)[4], int hclr, float (&L)[16]) {
    float M[16];
#pragma unroll
    for (int kt = 0; kt < 4; ++kt) {
        float v[16];
#pragma unroll
        for (int r = 0; r < 16; ++r) v[r] = __int_as_float(((__float_as_int(acc[kt][r]) & ~127) | (127 - (kt * 32 + (r & 3) + 8 * (r >> 2)))) & hclr);
        fsort16_desc(v);
        if (kt == 0) {
#pragma unroll
            for (int i = 0; i < 16; ++i) L[i] = v[i];
        } else ftop16_merge(L, v);
    }
#pragma unroll
    for (int i = 0; i < 16; ++i) M[i] = __shfl_xor(L[i], 32);
    ftop16_merge(L, M);
}
__device__ __forceinline__ void phase_topk(KP kp, LAS unsigned char* lds, int wave_s) {
    const int lane = lane_id_asm(), wave = wave_s, tid = wave * 64 + lane;
    unsigned char* ws = kp->ws;
    const bf16_t* Q = (const bf16_t*)(ws + WS_SG);
    int* IDX = (int*)(ws + WS_IDX); float* GATE = (float*)(ws + WS_GATE);
    LAS unsigned* stg = (LAS unsigned*)(lds + 65536);
    for (int e = tid; e < 2 * 32 * 64; e += NTHREADS) {
        const int f = e >> 6, l = e & 63, set = f >> 5, kt = (f >> 3) & 3, ks = f & 7;
        const float* src = (set ? kp->in[19] : kp->in[18]) + (kt * 32 + (l & 31)) * 128 + ks * 16 + 8 * (l >> 5);
        const f32x4 a = *(const f32x4*)src, b = *(const f32x4*)(src + 4);
        u32x4 w; w.x = cvt_pk_bf16(a[0], a[1]); w.y = cvt_pk_bf16(a[2], a[3]); w.z = cvt_pk_bf16(b[0], b[1]); w.w = cvt_pk_bf16(b[2], b[3]);
        *(LAS u32x4*)(lds + (size_t)e * 16) = w;
    }
    __syncthreads();
    const int h = lane >> 5;
    pg8::StaticOrder SO; SO.init(T, 2048, gridDim.x, blockIdx.x);
    pg8::Unit uu;
    for (int ui = 0; SO.next(ui, uu); ++ui) {
        const int tile = uu.pm, head = uu.pn;
        const int tok = tile * 256 + wave * 32 + (lane & 31);
        const bf16_t* qfrag = Q + ((size_t)(tile * 8 + head) * 128 + (size_t)wave * 16) * 512 + lane * 8;
        float L1[16], L2[16];
#pragma unroll
        for (int set = 0; set < 2; ++set) {
            f32x16 acc[4];
#pragma unroll
            for (int kt = 0; kt < 4; ++kt)
#pragma unroll
                for (int r = 0; r < 16; ++r) acc[kt][r] = 0.f;
#pragma unroll
            for (int ks = 0; ks < 8; ++ks) {
                const bf16x8 bq = *(const bf16x8*)(qfrag + (set * 8 + ks) * 512);
#pragma unroll
                for (int kt = 0; kt < 4; ++kt) {
                    const bf16x8 ak = *(const LAS bf16x8*)(lds + (size_t)((((set * 4 + kt) * 8 + ks) * 64) + lane) * 16);
                    acc[kt] = __builtin_amdgcn_mfma_f32_32x32x16_bf16(ak, bq, acc[kt], 0, 0, 0);
                }
            }
#ifdef DBG_VALU_SCORES
            {   const float* keys = set ? kp->in[19] : kp->in[18];
                const bf16_t* qr = Q + (size_t)tok * 2048 + head * 256 + set * 128;
                for (int kt = 0; kt < 4; ++kt)
                    for (int r = 0; r < 16; ++r) {
                        const int idx = kt * 32 + (r & 3) + 8 * (r >> 2) + 4 * h; float sacc = 0.f;
                        for (int k = 0; k < 128; ++k) sacc += __uint_as_float(((unsigned)qr[k]) << 16) * keys[idx * 128 + k];
#pragma unroll
                        for (int kk = 0; kk < 4; ++kk)
#pragma unroll
                            for (int rr = 0; rr < 16; ++rr) if (kk == kt && rr == r) acc[kk][rr] = sacc;
                    }
            }
#endif
            if (set == 0) top16_of_scores(acc, ~(4 * h), L1); else top16_of_scores(acc, ~(4 * h), L2);
        }
        float v1[16], v2[16]; int i1[16], i2[16];
#pragma unroll
        for (int i = 0; i < 16; ++i) { const int k1 = __float_as_int(L1[i]), k2 = __float_as_int(L2[i]); v1[i] = __int_as_float(k1 & ~127); i1[i] = 127 - (k1 & 127); v2[i] = __int_as_float(k2 & ~127); i2[i] = 127 - (k2 & 127); }
        float thr, mx;
        {
            float A[16], B[16], C[16], Dd[16];
#pragma unroll
            for (int j = 0; j < 16; ++j) A[j] = v1[0] + v2[j];
#pragma unroll
            for (int j = 0; j < 8; ++j) { B[j] = v1[1] + v2[j]; B[8 + j] = v1[15 - j] + v2[0]; }
            fbitonic_merge16_desc(B);
            C[0] = v1[2] + v2[0]; C[1] = v1[2] + v2[1]; C[2] = v1[2] + v2[2]; C[3] = v1[2] + v2[3]; C[4] = v1[2] + v2[4];
            C[5] = v1[3] + v2[0]; C[6] = v1[3] + v2[1]; C[7] = v1[3] + v2[2]; C[8] = v1[3] + v2[3];
            C[9] = v1[4] + v2[0]; C[10] = v1[4] + v2[1]; C[11] = v1[4] + v2[2];
            C[12] = v1[5] + v2[0]; C[13] = v1[5] + v2[1]; C[14] = v1[6] + v2[0]; C[15] = v1[6] + v2[1];
            fsort16_desc(C);
            Dd[0] = v1[7] + v2[0]; Dd[1] = v1[7] + v2[1];
#pragma unroll
            for (int j = 2; j < 16; ++j) Dd[j] = -3.0e38f;
            ftop16_merge(A, B); ftop16_merge(C, Dd);
            mx = fmaxf(A[0], C[0]);
            float t = fmaxf(A[0], C[15]);
#pragma unroll
            for (int i = 1; i < 16; ++i) t = fminf(t, fmaxf(A[i], C[15 - i]));
            thr = t;
        }
        if (h == 0) {
            LAS unsigned* row = stg + (wave * 32 + (lane & 31)) * 44;
            int cnt = 0; float sum = 0.f;
#pragma unroll
            for (int i = 0; i < 16; ++i)
#pragma unroll
                for (int j = 0; j < 16; ++j) if ((i + 1) * (j + 1) <= 16) {
                    const float x = v1[i] + v2[j];
                    const bool pr = (x >= thr) && (cnt < 16);
                    const float ev = __expf(x - mx);
                    const int pos = pr ? cnt : 16;
                    row[pos] = (unsigned)(i1[i] * 128 + i2[j]); row[20 + pos] = __float_as_uint(ev);
                    sum += pr ? ev : 0.f; cnt += pr ? 1 : 0;
                }
            const float inv = 1.0f / sum;
            u32x4* ip = (u32x4*)(IDX + ((size_t)tok * 8 + head) * 16); f32x4* gp = (f32x4*)(GATE + ((size_t)tok * 8 + head) * 16);
#pragma unroll
            for (int q = 0; q < 4; ++q) {
                ip[q] = *(const LAS u32x4*)(row + 4 * q);
                const u32x4 gu = *(const LAS u32x4*)(row + 20 + 4 * q);
                gp[q] = (f32x4){__uint_as_float(gu.x) * inv, __uint_as_float(gu.y) * inv, __uint_as_float(gu.z) * inv, __uint_as_float(gu.w) * inv};
            }
        }
    }
}

__device__ __forceinline__ float gelu_tanh(float x) {
    const float y = 0.7978845608028654f * (x + 0.044715f * x * x * x);
    return x * fast_sigmoid(2.0f * y);
}
typedef int i32x8 __attribute__((ext_vector_type(8)));
#define DPPF(x, ctrl) __int_as_float(__builtin_amdgcn_update_dpp(0, __float_as_int(x), ctrl, 0xF, 0xF, true))
struct TokMeta { u32x4 hb; f32x2 hs; int e0, e1; float g0, g1, cu0, cu1, sv0, sv1; u32x4 x1[2]; f32x4 g2[4]; };
__device__ __forceinline__ void peer_load_meta(TokMeta& m, int tok, int lane, const unsigned char* HB, const f32x2* HS, const int* IDX, const float* GATE, const bf16_t* X1, const float* modp) {
    { const u32x4* xp = (const u32x4*)(X1 + (size_t)tok * D + 16 * lane); m.x1[0] = xp[0]; m.x1[1] = xp[1];
      const f32x4* gp = (const f32x4*)(modp + (size_t)(tok / SEQ) * NMOD + 5 * 1024 + 16 * lane); m.g2[0] = gp[0]; m.g2[1] = gp[1]; m.g2[2] = gp[2]; m.g2[3] = gp[3]; }
    m.hb = *(const u32x4*)(HB + (size_t)tok * 1024 + ((lane & 15) * 4 + (lane >> 4)) * 16);
    m.hs = HS[tok];
    m.e0 = IDX[(size_t)tok * 128 + lane]; m.e1 = IDX[(size_t)tok * 128 + 64 + lane];
    m.g0 = GATE[(size_t)tok * 128 + lane]; m.g1 = GATE[(size_t)tok * 128 + 64 + lane];
}
__device__ __forceinline__ void peer_load_scales(TokMeta& m, const float* SU, const float* SV) { m.cu0 = SU[m.e0]; m.cu1 = SU[m.e1]; m.sv0 = SV[m.e0]; m.sv1 = SV[m.e1]; }
typedef RowFmt<V_BITS>::row_t vrow_t;
#define PEER_LOAD(UQ, VQ, g) do { const int bb_ = (g) & 15; const bool nx_ = (g) >= 16; \
        const int src_ = bb_ < 8 ? (nx_ ? mn.e0 : m.e0) : (nx_ ? mn.e1 : m.e1); \
        _Pragma("unroll") for (int j_ = 0; j_ < 4; ++j_) { \
            const int ea_ = __builtin_amdgcn_readlane(src_, (8 * bb_ + 2 * j_) & 63), eb_ = __builtin_amdgcn_readlane(src_, (8 * bb_ + 2 * j_ + 1) & 63); \
            UQ[j_] = __builtin_bit_cast(u32x4, __builtin_amdgcn_raw_buffer_load_b128(rsU, ((mhi ? eb_ : ea_) << 9) + uoff, 0, 0)); \
            VQ[2 * j_] = __builtin_bit_cast(u32x2, __builtin_amdgcn_raw_buffer_load_b64(rsV, lane * 8, ea_ << 9, 0)); \
            VQ[2 * j_ + 1] = __builtin_bit_cast(u32x2, __builtin_amdgcn_raw_buffer_load_b64(rsV, lane * 8, eb_ << 9, 0)); } } while (0)
#define PEER_COMPUTE(UQ, VQ, bt) do { \
        float x_[4]; \
        _Pragma("unroll") for (int j_ = 0; j_ < 4; ++j_) { \
            const i32x8 a_ = {(int)UQ[j_].x, (int)UQ[j_].y, (int)UQ[j_].z, (int)UQ[j_].w, 0, 0, 0, 0}; \
            const f32x4 d_ = __builtin_amdgcn_mfma_scale_f32_16x16x128_f8f6f4(a_, hbv, (f32x4){0.f, 0.f, 0.f, 0.f}, 4, 4, 0, 0x7f7f7f7f, 0, 0x7f7f7f7f); \
            const float s_ = r0 ? d_[0] : r1 ? d_[1] : r2 ? d_[2] : d_[3]; \
            x_[j_] = s_ * st; } \
        float y2[2], q1; \
        _Pragma("unroll") for (int k_ = 0; k_ < 2; ++k_) { const float a_ = b4 ? x_[k_ + 2] : x_[k_], sd_ = b4 ? x_[k_] : x_[k_ + 2]; y2[k_] = a_ + __shfl_xor(sd_, 16); } \
        { const float a_ = b3 ? y2[1] : y2[0], sd_ = b3 ? y2[0] : y2[1]; q1 = a_ + DPPF(sd_, 0x128); }                  \
        q1 += DPPF(q1, 0xB1); q1 += DPPF(q1, 0x4E); q1 += DPPF(q1, 0x141);                                            \
        const int slot_ = (8 * (bt) + jj) & 63; \
        const float cu_ = __shfl((bt) < 8 ? m.cu0 : m.cu1, slot_), cv_ = __shfl((bt) < 8 ? m.g0 * m.sv0 : m.g1 * m.sv1, slot_); \
        const float c_ = gelu_tanh(q1 * cu_) * cv_; \
        _Pragma("unroll") for (int j_ = 0; j_ < 8; ++j_) { \
            const float cj_ = __int_as_float(__builtin_amdgcn_readlane(__float_as_int(c_), 32 * (j_ & 1) + 8 * ((j_ >> 1) & 1) + 16 * ((j_ >> 2) & 1))); \
            row_axpy16(VQ[j_], cj_, o); } } while (0)
__device__ __forceinline__ void phase_peer(KP kp, int wave_s) {
    const int lane = lane_id_asm(), wave = wave_s;
    unsigned char* ws = kp->ws;
    const __amdgpu_buffer_rsrc_t rsU = __builtin_amdgcn_make_buffer_rsrc((void*)(ws + WS_EU), 0, NEXP * U_BITS * 128, 0x00020000);
    const __amdgpu_buffer_rsrc_t rsV = __builtin_amdgcn_make_buffer_rsrc((void*)(ws + WS_EV), 0, NEXP * V_BITS * 128, 0x00020000);
    const unsigned char* HB = ws + WS_HB; const f32x2* HS = (const f32x2*)(ws + WS_HS);
    const int* IDX = (const int*)(ws + WS_IDX); const float* GATE = (const float*)(ws + WS_GATE);
    const float* SU = (const float*)(ws + WS_SU); const float* SV = (const float*)(ws + WS_SV);
    const float* mod = (const float*)(ws + WS_MOD); const float* fg = kp->in[22];
    const bf16_t* X1 = (const bf16_t*)(ws + WS_X1B); float* OUT = kp->out;
    const bool b5 = lane & 32, b4 = lane & 16, b3 = lane & 8;
    const int jj = 4 * (b4 ? 1 : 0) + 2 * (b3 ? 1 : 0) + (b5 ? 1 : 0);
    const int nn = lane & 15, qq = lane >> 4;
    const bool mhi = nn >= 8;
    const int uoff = 64 * (nn & 7) + 16 * qq;
    const bool useful = ((nn & 7) >> 2) == (qq & 1);
    const bool r0 = (nn & 3) == 0, r1 = (nn & 3) == 1, r2 = (nn & 3) == 2;
    const int tstride = gridDim.x * 8;
    int tok = blockIdx.x * 8 + wave;
    f32x4 fgv[4];
#pragma unroll
    for (int q = 0; q < 4; ++q) fgv[q] = *(const f32x4*)(fg + 16 * lane + 4 * q);
    TokMeta m, mn;
    u32x4 uqA[4], uqB[4]; vrow_t vqA[8], vqB[8];
    if (tok < T) { peer_load_meta(m, tok, lane, HB, HS, IDX, GATE, X1, mod); peer_load_scales(m, SU, SV); mn = m; PEER_LOAD(uqA, vqA, 0); }
    for (; tok < T; tok += tstride) {
        const int b = tok / SEQ;
        const bool has_next = tok + tstride < T;
        if (has_next) peer_load_meta(mn, tok + tstride, lane, HB, HS, IDX, GATE, X1, mod);
        const i32x8 hbv = {(int)m.hb.x, (int)m.hb.y, (int)m.hb.z, (int)m.hb.w, 0, 0, 0, 0};
        const float st = useful ? ((nn >> 3) ? m.hs.y : m.hs.x) : 0.f;
        f32x2 o[8];
#pragma unroll
        for (int i = 0; i < 8; ++i) o[i] = (f32x2){0.f, 0.f};
#pragma unroll 1
        for (int bt = 0; bt < 16; bt += 2) {
            PEER_LOAD(uqB, vqB, bt + 1);
            PEER_COMPUTE(uqA, vqA, bt);
            PEER_LOAD(uqA, vqA, bt + 2);
            PEER_COMPUTE(uqB, vqB, bt + 1);
        }
        if (has_next) peer_load_scales(mn, SU, SV);
        float* xr = OUT + (size_t)tok * D + 16 * lane;
        const unsigned xw[8] = {m.x1[0].x, m.x1[0].y, m.x1[0].z, m.x1[0].w, m.x1[1].x, m.x1[1].y, m.x1[1].z, m.x1[1].w};
        f32x4 xv[4]; float ss = 0.f;
#pragma unroll
        for (int q = 0; q < 4; ++q) {
            const f32x4 x1v = {bf_lo(xw[2 * q]), bf_hi(xw[2 * q]), bf_lo(xw[2 * q + 1]), bf_hi(xw[2 * q + 1])}, gv = m.g2[q];
            xv[q][0] = x1v[0] + gv[0] * o[2 * q].x; xv[q][1] = x1v[1] + gv[1] * o[2 * q].y; xv[q][2] = x1v[2] + gv[2] * o[2 * q + 1].x; xv[q][3] = x1v[3] + gv[3] * o[2 * q + 1].y;
            ss += xv[q][0] * xv[q][0] + xv[q][1] * xv[q][1] + xv[q][2] * xv[q][2] + xv[q][3] * xv[q][3];
        }
        ss = wave_sum(ss);
        const float r = rsqrtf(ss * (1.0f / D) + EPS);
#pragma unroll
        for (int q = 0; q < 4; ++q) *(f32x4*)(xr + 4 * q) = xv[q] * r * fgv[q];
        m = mn;
    }
}

__device__ __forceinline__ void quant_h2(const u32x4& xa0, const u32x4& xa1, float ssq, const LAS float* shrow, LAS unsigned char* hbuf, int lane, u32x4& hb, f32x2& hs) {
    const f32x4 s0v = *(const LAS f32x4*)(shrow + 16 * lane), s1v = *(const LAS f32x4*)(shrow + 16 * lane + 4), s2v = *(const LAS f32x4*)(shrow + 16 * lane + 8), s3v = *(const LAS f32x4*)(shrow + 16 * lane + 12);
    const float rr = rsqrtf(ssq * (1.0f / D) + EPS);
    const unsigned xw[8] = {xa0.x, xa0.y, xa0.z, xa0.w, xa1.x, xa1.y, xa1.z, xa1.w};
    const float sh[16] = {s0v[0], s0v[1], s0v[2], s0v[3], s1v[0], s1v[1], s1v[2], s1v[3], s2v[0], s2v[1], s2v[2], s2v[3], s3v[0], s3v[1], s3v[2], s3v[3]};
    float hv[16]; float am = 0.f;
#pragma unroll
    for (int i = 0; i < 8; ++i) { hv[2 * i] = bf_lo(xw[i]) * rr + sh[2 * i]; hv[2 * i + 1] = bf_hi(xw[i]) * rr + sh[2 * i + 1]; am = fmaxf(am, fmaxf(fabsf(hv[2 * i]), fabsf(hv[2 * i + 1]))); }
    am = wave_max(am);
    const float q0 = am > 0.f ? 6.0f / am : 0.f, d0 = am * (1.0f / 6.0f);
    unsigned w0[2] = {0u, 0u}, w1[2] = {0u, 0u}; float rv[16]; float am1 = 0.f;
#pragma unroll
    for (int i = 0; i < 8; ++i) {
        const int wi = i >> 2, bs = i & 3;
        if (bs == 0) w0[wi] = __builtin_amdgcn_cvt_scalef32_pk_fp4_f32(w0[wi], hv[2 * i] * q0, hv[2 * i + 1] * q0, 1.0f, 0);
        else if (bs == 1) w0[wi] = __builtin_amdgcn_cvt_scalef32_pk_fp4_f32(w0[wi], hv[2 * i] * q0, hv[2 * i + 1] * q0, 1.0f, 1);
        else if (bs == 2) w0[wi] = __builtin_amdgcn_cvt_scalef32_pk_fp4_f32(w0[wi], hv[2 * i] * q0, hv[2 * i + 1] * q0, 1.0f, 2);
        else w0[wi] = __builtin_amdgcn_cvt_scalef32_pk_fp4_f32(w0[wi], hv[2 * i] * q0, hv[2 * i + 1] * q0, 1.0f, 3);
    }
#pragma unroll
    for (int i = 0; i < 8; ++i) {
        const int wi = i >> 2, bs = i & 3;
        const f32x2 dq = bs == 0 ? __builtin_amdgcn_cvt_scalef32_pk_f32_fp4(w0[wi], 1.0f, 0) : bs == 1 ? __builtin_amdgcn_cvt_scalef32_pk_f32_fp4(w0[wi], 1.0f, 1) : bs == 2 ? __builtin_amdgcn_cvt_scalef32_pk_f32_fp4(w0[wi], 1.0f, 2) : __builtin_amdgcn_cvt_scalef32_pk_f32_fp4(w0[wi], 1.0f, 3);
        rv[2 * i] = hv[2 * i] - dq.x * d0; rv[2 * i + 1] = hv[2 * i + 1] - dq.y * d0;
        am1 = fmaxf(am1, fmaxf(fabsf(rv[2 * i]), fabsf(rv[2 * i + 1])));
    }
    am1 = wave_max(am1);
    const float q1 = am1 > 0.f ? 6.0f / am1 : 0.f, d1 = am1 * (1.0f / 6.0f);
#pragma unroll
    for (int i = 0; i < 8; ++i) {
        const int wi = i >> 2, bs = i & 3;
        if (bs == 0) w1[wi] = __builtin_amdgcn_cvt_scalef32_pk_fp4_f32(w1[wi], rv[2 * i] * q1, rv[2 * i + 1] * q1, 1.0f, 0);
        else if (bs == 1) w1[wi] = __builtin_amdgcn_cvt_scalef32_pk_fp4_f32(w1[wi], rv[2 * i] * q1, rv[2 * i + 1] * q1, 1.0f, 1);
        else if (bs == 2) w1[wi] = __builtin_amdgcn_cvt_scalef32_pk_fp4_f32(w1[wi], rv[2 * i] * q1, rv[2 * i + 1] * q1, 1.0f, 2);
        else w1[wi] = __builtin_amdgcn_cvt_scalef32_pk_fp4_f32(w1[wi], rv[2 * i] * q1, rv[2 * i + 1] * q1, 1.0f, 3);
    }
    *(LAS u32x2*)(hbuf + 8 * lane) = (u32x2){w0[0], w0[1]};
    *(LAS u32x2*)(hbuf + 512 + 8 * lane) = (u32x2){w1[0], w1[1]};
    asm volatile("" ::: "memory");
    hb = *(const LAS u32x4*)(hbuf + ((lane & 15) >> 3) * 512 + (lane & 7) * 16 + (lane >> 4) * 128);
    asm volatile("" ::: "memory");
    hs = (f32x2){d0, d1};
}
__device__ __forceinline__ void sort_words(unsigned& w0, unsigned& w1, int lane, LAS unsigned* scr) {
#pragma unroll
    for (int bit = 10; bit < 14; ++bit) {
        const bool z0 = ((w0 >> bit) & 1u) == 0u, z1 = ((w1 >> bit) & 1u) == 0u;
        const unsigned long long m0 = __ballot(z0), m1 = __ballot(z1);
        const int nz0 = __popcll(m0), nz = nz0 + __popcll(m1);
        const int r0 = __builtin_amdgcn_mbcnt_hi((unsigned)(m0 >> 32), __builtin_amdgcn_mbcnt_lo((unsigned)m0, 0u));
        const int r1 = __builtin_amdgcn_mbcnt_hi((unsigned)(m1 >> 32), __builtin_amdgcn_mbcnt_lo((unsigned)m1, 0u));
        const int p0 = z0 ? r0 : nz + lane - r0;
        const int p1 = z1 ? nz0 + r1 : nz + 64 - nz0 + lane - r1;
        scr[p0] = w0; scr[p1] = w1;
        asm volatile("" ::: "memory");
        w0 = scr[lane]; w1 = scr[64 + lane];
        asm volatile("" ::: "memory");
    }
}
struct UTok { u32x4 hb, xb; f32x2 hs; unsigned s0, s1; };
#define PU_LOAD(UQ, k, g) do { const int bb_ = (g) & 15; const bool nx_ = (g) >= 16; \
        const unsigned src_ = bb_ < 8 ? (nx_ ? nxt[k].s0 : cur[k].s0) : (nx_ ? nxt[k].s1 : cur[k].s1); \
        _Pragma("unroll") for (int j_ = 0; j_ < 4; ++j_) { \
            const int id_ = __builtin_amdgcn_ds_bpermute(4 * (((8 * bb_) & 63) + 2 * j_) + slotb, (int)src_) & 0x3fff; \
            UQ[j_] = __builtin_bit_cast(u32x4, __builtin_amdgcn_raw_buffer_load_b128(rsU, (id_ << 9) + uoff, 0, 0)); } } while (0)
#define PU_COMPUTE(UQ, k, bt) do { \
        const i32x8 hbv = {(int)cur[k].hb.x, (int)cur[k].hb.y, (int)cur[k].hb.z, (int)cur[k].hb.w, 0, 0, 0, 0}; const float st = cur[k].hs.x; \
        float x_[4]; \
        _Pragma("unroll") for (int j_ = 0; j_ < 4; ++j_) { \
            const i32x8 a_ = {(int)UQ[j_].x, (int)UQ[j_].y, (int)UQ[j_].z, (int)UQ[j_].w, 0, 0, 0, 0}; \
            const f32x4 d_ = __builtin_amdgcn_mfma_scale_f32_16x16x128_f8f6f4(a_, hbv, (f32x4){0.f, 0.f, 0.f, 0.f}, 4, 4, 0, 0x7f7f7f7f, 0, 0x7f7f7f7f); \
            x_[j_] = (d_[0] * lm0 + d_[1] * lm1 + d_[2] * lm2 + d_[3] * lm3) * st; } \
        float y2[2], q1; \
        _Pragma("unroll") for (int k_ = 0; k_ < 2; ++k_) { const float a_ = b4 ? x_[k_ + 2] : x_[k_], sd_ = b4 ? x_[k_] : x_[k_ + 2]; y2[k_] = a_ + __shfl_xor(sd_, 16); } \
        { const float a_ = b3 ? y2[1] : y2[0], sd_ = b3 ? y2[0] : y2[1]; q1 = a_ + DPPF(sd_, 0x128); } \
        q1 += DPPF(q1, 0xB1); q1 += DPPF(q1, 0x4E); q1 += DPPF(q1, 0x141); \
        const float qs_ = __shfl(q1, srcl);                                     \
        const bool mine_ = (lane >> 3) == ((bt) & 7); \
        if ((bt) < 8) qs0[k] = mine_ ? qs_ : qs0[k]; else qs1[k] = mine_ ? qs_ : qs1[k]; } while (0)
__device__ __forceinline__ void peer_u_raw(UTok& t, int tok, int lane, const bf16_t* XA, const float* SSQ, const int* IDX) {
    { const u32x4* xp = (const u32x4*)(XA + (size_t)tok * D + 16 * lane); t.hb = xp[0]; t.xb = xp[1]; }
    t.hs = (f32x2){SSQ[tok], 0.f};
    t.s0 = (unsigned)IDX[(size_t)tok * 128 + lane] | ((unsigned)lane << 14); t.s1 = (unsigned)IDX[(size_t)tok * 128 + 64 + lane] | ((unsigned)(64 + lane) << 14);
}
__device__ __forceinline__ void phase_peer_u(KP kp, LAS unsigned char* lds, int wave_s) {
    const int lane = lane_id_asm(), wave = wave_s;
    unsigned char* ws = kp->ws;
    const __amdgpu_buffer_rsrc_t rsU = __builtin_amdgcn_make_buffer_rsrc((void*)(ws + WS_EU), 0, NEXP * U_BITS * 128, 0x00020000);
    const bf16_t* XA = (const bf16_t*)(ws + WS_H); const float* SSQ = (const float*)(ws + WS_SSQ);
    const int* IDX = (const int*)(ws + WS_IDX); const float* GATE = (const float*)(ws + WS_GATE);
    const float* SU = (const float*)(ws + WS_SU); const float* SV = (const float*)(ws + WS_SV);
    LAS unsigned* scr = (LAS unsigned*)(lds + wave * 2048);
    LAS float* shl = (LAS float*)(lds + 32768);
    LAS unsigned char* hbuf = lds + 49152 + wave * 1024;
    { const float* modp = (const float*)(ws + WS_MOD); for (int i = wave * 64 + lane; i < 4096; i += NTHREADS) shl[i] = modp[(size_t)(i >> 10) * NMOD + 3 * 1024 + (i & 1023)]; }
    __syncthreads();
    const bool b4 = lane & 16, b3 = lane & 8;
    const int srcl = 32 * (lane & 1) + 16 * ((lane >> 2) & 1) + 8 * ((lane >> 1) & 1);
    const int nn = lane & 15, qq = lane >> 4;
    const int uoff = 16 * (nn & 7) + 128 * qq;
    const int slotb = 4 * (nn >> 3);
    const bool useful = ((nn & 7) >> 2) == (qq & 1);
    const float lm0 = (nn & 3) == 0 ? 1.f : 0.f, lm1 = (nn & 3) == 1 ? 1.f : 0.f, lm2 = (nn & 3) == 2 ? 1.f : 0.f, lm3 = (nn & 3) == 3 ? 1.f : 0.f;
    const int tstride = gridDim.x * 8;
    int tok0 = blockIdx.x * 8 + wave;
    if (tok0 < T) {
        UTok cur[4], nxt[4];
        u32x4 uq[4][4];
#pragma unroll
        for (int k = 0; k < 4; ++k) { const int tk = tok0 + k * tstride; peer_u_raw(cur[k], tk < T ? tk : tok0, lane, XA, SSQ, IDX); }
#pragma unroll
        for (int k = 0; k < 4; ++k) { const int tk = tok0 + k * tstride < T ? tok0 + k * tstride : tok0; sort_words(cur[k].s0, cur[k].s1, lane, scr + k * 128);
            { const u32x4 xa0 = cur[k].hb, xa1 = cur[k].xb; quant_h2(xa0, xa1, cur[k].hs.x, shl + (tk / SEQ) * 1024, hbuf, lane, cur[k].hb, cur[k].hs); }
            cur[k].hs.x = useful ? ((nn >> 3) ? cur[k].hs.y : cur[k].hs.x) : 0.f; nxt[k] = cur[k]; }
        PU_LOAD(uq[0], 0, 0); PU_LOAD(uq[1], 1, 0); PU_LOAD(uq[2], 2, 0);
        for (; tok0 < T; tok0 += 4 * tstride) {
            const bool has_next = tok0 + 4 * tstride < T;
            if (has_next) {
#pragma unroll
                for (int k = 0; k < 4; ++k) { const int tk = tok0 + (4 + k) * tstride; peer_u_raw(nxt[k], tk < T ? tk : tok0 + 4 * tstride, lane, XA, SSQ, IDX); }
            }
            float g0[4], g1[4], cu0[4], cu1[4], sv0[4], sv1[4];
#pragma unroll
            for (int k = 0; k < 4; ++k) { const int tk = tok0 + k * tstride < T ? tok0 + k * tstride : tok0;
                const int i0 = cur[k].s0 & 0x3fff, i1 = cur[k].s1 & 0x3fff;
                g0[k] = GATE[(size_t)tk * 128 + (cur[k].s0 >> 14)]; g1[k] = GATE[(size_t)tk * 128 + (cur[k].s1 >> 14)];
                cu0[k] = SU[i0]; cu1[k] = SU[i1]; sv0[k] = SV[i0]; sv1[k] = SV[i1]; }
            float qs0[4] = {0.f, 0.f, 0.f, 0.f}, qs1[4] = {0.f, 0.f, 0.f, 0.f};
#pragma unroll 1
            for (int bt = 0; bt < 16; ++bt) {
                if (bt == 8 && has_next) {
#pragma unroll
                    for (int k = 0; k < 4; ++k) { const int tk = tok0 + (4 + k) * tstride < T ? tok0 + (4 + k) * tstride : tok0 + 4 * tstride; sort_words(nxt[k].s0, nxt[k].s1, lane, scr + k * 128);
                        { const u32x4 xa0 = nxt[k].hb, xa1 = nxt[k].xb; quant_h2(xa0, xa1, nxt[k].hs.x, shl + (tk / SEQ) * 1024, hbuf, lane, nxt[k].hb, nxt[k].hs); }
                        nxt[k].hs.x = useful ? ((nn >> 3) ? nxt[k].hs.y : nxt[k].hs.x) : 0.f; }
                }
                PU_LOAD(uq[3], 3, bt);     PU_COMPUTE(uq[0], 0, bt);
                PU_LOAD(uq[0], 0, bt + 1); PU_COMPUTE(uq[1], 1, bt);
                PU_LOAD(uq[1], 1, bt + 1); PU_COMPUTE(uq[2], 2, bt);
                PU_LOAD(uq[2], 2, bt + 1); PU_COMPUTE(uq[3], 3, bt);
            }
#pragma unroll
            for (int k = 0; k < 4; ++k) { const int tok = tok0 + k * tstride;
                if (tok < T) {
                    const int e0 = (int)(cur[k].s0 & 0x3fff), e1 = (int)(cur[k].s1 & 0x3fff);
                    const float c0 = gelu_tanh(qs0[k] * cu0[k]) * (g0[k] * sv0[k]), c1 = gelu_tanh(qs1[k] * cu1[k]) * (g1[k] * sv1[k]);
                    float cm = fmaxf(fabsf(c0), fabsf(c1));
            cm = wave_max(cm);
                    const float f = cm > 0.f ? 256.0f / cm : 0.f;
                    const unsigned pk = (unsigned)__builtin_amdgcn_cvt_pk_fp8_f32(c0 * f, c1 * f, 0, false) & 0xffffu;
                    const unsigned nbe0 = (unsigned)__builtin_amdgcn_update_dpp(0, e0, 0xB1, 0xF, 0xF, true), nbe1 = (unsigned)__builtin_amdgcn_update_dpp(0, e1, 0xB1, 0xF, 0xF, true);
                    if (!(lane & 1)) {
                        const int p = lane >> 1, o0 = (p & 3) * 16 + (p >> 2), o1 = (p & 3) * 16 + 8 + (p >> 2);
                        unsigned* IDP = (unsigned*)(ws + WS_IDP) + (size_t)tok * 64;
                        IDP[o0] = (unsigned)e0 | (nbe0 << 16); IDP[o1] = (unsigned)e1 | (nbe1 << 16);
                    }
                    const unsigned nb4 = (unsigned)__shfl((int)pk, lane + 4);
                    if ((lane & 7) < 4) {
                        unsigned short* COP = (unsigned short*)(ws + WS_COP) + (size_t)tok * 64 + (lane & 3) * 16 + (lane >> 3);
                        COP[0] = (unsigned short)((pk & 0xffu) | ((nb4 & 0xffu) << 8)); COP[8] = (unsigned short)(((pk >> 8) & 0xffu) | (nb4 & 0xff00u));
                    }
                    if (lane == 0) ((float*)(ws + WS_CS))[tok] = cm * (1.0f / 256.0f);
                }
                cur[k] = nxt[k]; }
        }
    }
}
#define PV_LOADG(RB, k, g) do { const int gg_ = (g) & 15; \
        const unsigned pr_ = ((g) >= 16 ? mnx : mcu)[(k) * 96 + qq * 16 + gg_]; \
        cfr[k] = ((g) >= 16 ? mnx : mcu)[(k) * 96 + 64 + qq * 8 + (gg_ >> 1)]; \
        const int va_ = (int)((pr_ & 0xffffu) << 9) + lanebase, vb_ = (int)((pr_ >> 16) << 9) + lanebase; \
        _Pragma("unroll") for (int blk_ = 0; blk_ < 4; ++blk_) { \
            const u32x2 a_ = __builtin_bit_cast(u32x2, __builtin_amdgcn_raw_buffer_load_b64(rsV, va_ + 8 * (blk_ & 1) + 256 * (blk_ >> 1), 0, 0)); \
            const u32x2 b_ = __builtin_bit_cast(u32x2, __builtin_amdgcn_raw_buffer_load_b64(rsV, vb_ + 8 * (blk_ & 1) + 256 * (blk_ >> 1), 0, 0)); \
            RB[blk_] = (u32x4){a_.x, a_.y, b_.x, b_.y}; } } while (0)
#define PV_COMPG(RB, k, g, CW) do { const unsigned cw_ = (CW); \
        const unsigned ra_ = ((g) & 1) ? __builtin_amdgcn_perm(cw_, cw_, 0x02020202u) : __builtin_amdgcn_perm(cw_, cw_, 0x00000000u); \
        const unsigned rb_ = ((g) & 1) ? __builtin_amdgcn_perm(cw_, cw_, 0x03030303u) : __builtin_amdgcn_perm(cw_, cw_, 0x01010101u); \
        const i32x8 A_ = {(int)(ra_ & mk0), (int)(ra_ & mk1), (int)(ra_ & mk2), (int)(ra_ & mk3), (int)(rb_ & mk0), (int)(rb_ & mk1), (int)(rb_ & mk2), (int)(rb_ & mk3)}; \
        _Pragma("unroll") for (int blk_ = 0; blk_ < 4; ++blk_) { \
            const i32x8 B_ = {(int)RB[blk_].x, (int)RB[blk_].y, (int)RB[blk_].z, (int)RB[blk_].w, 0, 0, 0, 0}; \
            acc[k][blk_] = __builtin_amdgcn_mfma_scale_f32_16x16x128_f8f6f4(A_, B_, acc[k][blk_], 0, 4, 0, 0x7f7f7f7f, 0, 0x7f7f7f7f); } } while (0)
__device__ __forceinline__ void phase_peer_v(KP kp, LAS unsigned char* lds, int wave_s) {
    const int lane = lane_id_asm(), wave = wave_s;
    unsigned char* ws = kp->ws;
    const __amdgpu_buffer_rsrc_t rsV = __builtin_amdgcn_make_buffer_rsrc((void*)(ws + WS_EV), 0, NEXP * V_BITS * 128, 0x00020000);
    const float* mod = (const float*)(ws + WS_MOD); const float* fg = kp->in[22];
    const bf16_t* X1 = (const bf16_t*)(ws + WS_X1B); float* OUT = kp->out;
    const unsigned* IDP = (const unsigned*)(ws + WS_IDP); const unsigned* COP = (const unsigned*)(ws + WS_COP); const float* CS = (const float*)(ws + WS_CS);
    const int nn = lane & 15, qq = lane >> 4;
    const int lanebase = 16 * nn;
    const unsigned msel = 0xFFu << (8 * (nn & 3));
    const unsigned mk0 = (nn >> 2) == 0 ? msel : 0u, mk1 = (nn >> 2) == 1 ? msel : 0u, mk2 = (nn >> 2) == 2 ? msel : 0u, mk3 = (nn >> 2) == 3 ? msel : 0u;
    const int col0 = 32 * nn + 4 * qq;
    const int tstride = gridDim.x * 8;
    int tok0 = blockIdx.x * 8 + wave;
    LAS unsigned* mcu = (LAS unsigned*)(lds + wave * 3072);
    LAS unsigned* mnx = mcu + 384;
    if (tok0 < T) {
        unsigned idw[4], cfw[4]; float csc[4], csn[4];
#pragma unroll
        for (int k = 0; k < 4; ++k) { const int tk = tok0 + k * tstride < T ? tok0 + k * tstride : tok0;
            idw[k] = IDP[(size_t)tk * 64 + lane]; cfw[k] = COP[(size_t)tk * 32 + (lane & 31)]; csc[k] = CS[tk]; csn[k] = csc[k]; }
#pragma unroll
        for (int k = 0; k < 4; ++k) { mcu[k * 96 + lane] = idw[k]; if (lane < 32) mcu[k * 96 + 64 + lane] = cfw[k]; mnx[k * 96 + lane] = idw[k]; if (lane < 32) mnx[k * 96 + 64 + lane] = cfw[k]; }
        asm volatile("" ::: "memory");
        u32x4 rb0[4], rb1[4], rb2[4], rb3[4]; unsigned cfr[4];
        PV_LOADG(rb0, 0, 0); PV_LOADG(rb1, 1, 0); PV_LOADG(rb2, 2, 0);
        for (; tok0 < T; tok0 += 4 * tstride) {
            const bool has_next = tok0 + 4 * tstride < T;
            if (has_next) {
#pragma unroll
                for (int k = 0; k < 4; ++k) { const int tk = tok0 + (4 + k) * tstride < T ? tok0 + (4 + k) * tstride : tok0 + 4 * tstride;
                    idw[k] = IDP[(size_t)tk * 64 + lane]; cfw[k] = COP[(size_t)tk * 32 + (lane & 31)]; csn[k] = CS[tk]; }
            }
            f32x4 acc[4][4]; u32x2 xwa[4], xwb[4]; f32x4 gva[4], gvb[4];
#pragma unroll
            for (int k = 0; k < 4; ++k)
#pragma unroll
                for (int i = 0; i < 4; ++i) acc[k][i] = (f32x4){0.f, 0.f, 0.f, 0.f};
#pragma unroll 1
            for (int G = 0; G < 16; ++G) {
                if (G == 14) {
                    const bf16_t* xp = X1 + (size_t)tok0 * D + col0; const float* gp = mod + (size_t)(tok0 / SEQ) * NMOD + 5 * 1024 + col0;
#pragma unroll
                    for (int blk = 0; blk < 4; ++blk) { xwa[blk] = *(const u32x2*)(xp + 16 * (blk & 1) + 512 * (blk >> 1)); gva[blk] = *(const f32x4*)(gp + 16 * (blk & 1) + 512 * (blk >> 1)); }
                }
                if (G == 8) {
#pragma unroll
                    for (int k = 0; k < 4; ++k) { mnx[k * 96 + lane] = idw[k]; if (lane < 32) mnx[k * 96 + 64 + lane] = cfw[k]; }
                    asm volatile("" ::: "memory");
                }
                { const unsigned c_ = cfr[0]; PV_LOADG(rb3, 3, G);     PV_COMPG(rb0, 0, G, c_); }
                { const unsigned c_ = cfr[1]; PV_LOADG(rb0, 0, G + 1); PV_COMPG(rb1, 1, G, c_); }
                { const unsigned c_ = cfr[2]; PV_LOADG(rb1, 1, G + 1); PV_COMPG(rb2, 2, G, c_); }
                { const unsigned c_ = cfr[3]; PV_LOADG(rb2, 2, G + 1); PV_COMPG(rb3, 3, G, c_); }
            }
            f32x4 fgv[4];
#pragma unroll
            for (int blk = 0; blk < 4; ++blk) fgv[blk] = *(const f32x4*)(fg + col0 + 16 * (blk & 1) + 512 * (blk >> 1));
#pragma unroll
            for (int k = 0; k < 4; ++k) { const int tok = tok0 + k * tstride;
                if (k < 3) { const int tk = tok0 + (k + 1) * tstride < T ? tok0 + (k + 1) * tstride : tok0; const bf16_t* xp = X1 + (size_t)tk * D + col0; const float* gp = mod + (size_t)(tk / SEQ) * NMOD + 5 * 1024 + col0;
#pragma unroll
                    for (int blk = 0; blk < 4; ++blk) { xwb[blk] = *(const u32x2*)(xp + 16 * (blk & 1) + 512 * (blk >> 1)); gvb[blk] = *(const f32x4*)(gp + 16 * (blk & 1) + 512 * (blk >> 1)); } }
                if (tok < T) {
                    float* xr = OUT + (size_t)tok * D + col0;
                    f32x4 xv[4]; float ss = 0.f;
#pragma unroll
                    for (int blk = 0; blk < 4; ++blk) {
                        const f32x4 x1v = {bf_lo(xwa[blk].x), bf_hi(xwa[blk].x), bf_lo(xwa[blk].y), bf_hi(xwa[blk].y)};
                        xv[blk] = x1v + gva[blk] * (acc[k][blk] * csc[k]);
                        ss += xv[blk][0] * xv[blk][0] + xv[blk][1] * xv[blk][1] + xv[blk][2] * xv[blk][2] + xv[blk][3] * xv[blk][3]; }
                    ss = wave_sum(ss);
                    const float r = rsqrtf(ss * (1.0f / D) + EPS);
#pragma unroll
                    for (int blk = 0; blk < 4; ++blk) *(f32x4*)(xr + 16 * (blk & 1) + 512 * (blk >> 1)) = xv[blk] * r * fgv[blk];
                }
#pragma unroll
                for (int blk = 0; blk < 4; ++blk) { gva[blk] = gvb[blk]; xwa[blk] = xwb[blk]; }
                csc[k] = csn[k]; }
            { LAS unsigned* t_ = mcu; mcu = mnx; mnx = t_; }
        }
    }
}

__global__ void __launch_bounds__(NTHREADS, 2) fwd_megakernel(Params P_) {
    extern __shared__ __attribute__((aligned(16))) unsigned char lds_raw[];
    LAS unsigned char* lds = (LAS unsigned char*)lds_raw;
    KP kp = (KP)__builtin_amdgcn_kernarg_segment_ptr();
    volatile LAS unsigned* ctl = (volatile LAS unsigned*)(lds + LDS_CTL_OFF);
    const int wave_s = __builtin_amdgcn_readfirstlane(threadIdx.x >> 6);
    if (threadIdx.x < 4) ctl[threadIdx.x] = 0u;
    __syncthreads();
    { XcdBarrier b0 = xcd_barrier_post((unsigned*)(kp->ws + WS_CTL), ctl, wave_s); (void)b0; }
    const int lo = kp->ph_lo, hi = kp->ph_hi;
#define IN(k) (lo <= (k) && (k) < hi)
#define FRESH() asm volatile("" : "+s"(kp) :: "memory")
#define SEAM(k) do { if (IN(k) && IN((k) + 1)) { { XcdBarrier b_; b_.bar = (unsigned*)(kp->ws + WS_CTL); b_.x = xb_xcc_id(); b_.st = ctl; xcd_barrier(b_, wave_s); } } FRESH(); } while (0)

    if (IN(0)) phase_prep(kp, lds, wave_s);
#if DBG_REPEAT
    FRESH();
    if (IN(0)) phase_prep(kp, lds, wave_s);
#endif
    SEAM(0);
    if (IN(1)) { phase_aux(kp, lds, wave_s); phase_w8(kp, lds, wave_s); unsigned char* ws = kp->ws; phase_norm_ada<true>(kp->in[0], kp->in[4], (const float*)(ws + WS_MOD), 0, 1024, (bf16_t*)nullptr, ws + WS_X8, (float*)(ws + WS_X8S), wave_s); }
#if DBG_REPEAT
    FRESH();
    if (IN(1)) { unsigned char* ws = kp->ws; phase_norm_ada<true>(kp->in[0], kp->in[4], (const float*)(ws + WS_MOD), 0, 1024, (bf16_t*)nullptr, ws + WS_X8, (float*)(ws + WS_X8S), wave_s); }
#endif
    SEAM(1);
    if (IN(2)) {
        unsigned char* ws = kp->ws;
        { pg8::Gemm g{(const bf16_t*)(ws + WS_X8), (const bf16_t*)(ws + WS_WP8), T, 3584, D / 2}; pg8::StaticOrder S; S.init(T, 3584, gridDim.x, blockIdx.x);
          EpiIn E{EpiProj{(const float*)(ws + WS_BINP), (bf16_t*)(ws + WS_PG), (bf16_t*)(ws + WS_PG) + (size_t)T * 512, (const float*)(ws + WS_X8S), (const float*)(ws + WS_WP8S)},
                  EpiGate{(const float*)(ws + WS_BINP), (const float*)(ws + WS_X8S), (const float*)(ws + WS_WGS), (bf16_t*)(ws + WS_SG)}};
          pg8::gemm_phase<EpiIn>(lds, g, S, E, wave_s); }
    }
#if DBG_REPEAT
    FRESH();
    if (IN(2)) {
        unsigned char* ws = kp->ws;
        { pg8::Gemm g{(const bf16_t*)(ws + WS_X8), (const bf16_t*)(ws + WS_WP8), T, 3584, D / 2}; pg8::StaticOrder S; S.init(T, 3584, gridDim.x, blockIdx.x);
          EpiIn E{EpiProj{(const float*)(ws + WS_BINP), (bf16_t*)(ws + WS_PG), (bf16_t*)(ws + WS_PG) + (size_t)T * 512, (const float*)(ws + WS_X8S), (const float*)(ws + WS_WP8S)},
                  EpiGate{(const float*)(ws + WS_BINP), (const float*)(ws + WS_X8S), (const float*)(ws + WS_WGS), (bf16_t*)(ws + WS_SG)}};
          pg8::gemm_phase<EpiIn>(lds, g, S, E, wave_s); }
    }
#endif
    SEAM(2);
    if (IN(3)) phase_branches(kp, lds, wave_s);
#if DBG_REPEAT
    FRESH();
    if (IN(3)) phase_branches(kp, lds, wave_s);
#endif
    SEAM(3);
    if (IN(4)) {
        unsigned char* ws = kp->ws;
        pg8::Gemm g{(const bf16_t*)(ws + WS_MC), (const bf16_t*)(ws + WS_WPC), T, D, D}; pg8::StaticOrder S; S.init(T, D, gridDim.x, blockIdx.x);
        EpiMerge E{(const bf16_t*)(ws + WS_SG), (bf16_t*)(ws + WS_PG)};
        pg8::gemm_phase<EpiMerge>(lds, g, S, E, wave_s);
    }
#if DBG_REPEAT
    FRESH();
    if (IN(4)) {
        unsigned char* ws = kp->ws;
        pg8::Gemm g{(const bf16_t*)(ws + WS_MC), (const bf16_t*)(ws + WS_WPC), T, D, D}; pg8::StaticOrder S; S.init(T, D, gridDim.x, blockIdx.x);
        EpiMerge E{(const bf16_t*)(ws + WS_SG), (bf16_t*)(ws + WS_PG)};
        pg8::gemm_phase<EpiMerge>(lds, g, S, E, wave_s);
    }
#endif
    SEAM(4);
    if (IN(5)) {
        unsigned char* ws = kp->ws;
        pg8::Gemm g{(const bf16_t*)(ws + WS_PG), (const bf16_t*)(ws + WS_WOUT), T, D, D}; pg8::StaticOrder S; S.init(T, D, gridDim.x, blockIdx.x);
        EpiResid E{kp->in[0], (const float*)(ws + WS_MOD) + 2 * 1024, (bf16_t*)(ws + WS_X1B), (const float*)(ws + WS_A2), (bf16_t*)(ws + WS_H), (float*)(ws + WS_SSQ)};
        pg8::gemm_phase<EpiResid>(lds, g, S, E, wave_s);
    }
#if DBG_REPEAT
    FRESH();
    if (IN(5)) {
        unsigned char* ws = kp->ws;
        pg8::Gemm g{(const bf16_t*)(ws + WS_PG), (const bf16_t*)(ws + WS_WOUT), T, D, D}; pg8::StaticOrder S; S.init(T, D, gridDim.x, blockIdx.x);
        EpiResid E{kp->in[0], (const float*)(ws + WS_MOD) + 2 * 1024, (bf16_t*)(ws + WS_X1B), (const float*)(ws + WS_A2), (bf16_t*)(ws + WS_H), (float*)(ws + WS_SSQ)};
        pg8::gemm_phase<EpiResid>(lds, g, S, E, wave_s);
    }
#endif
    SEAM(5);
    if (IN(7)) {
        unsigned char* ws = kp->ws;
        pg8::Gemm g{(const bf16_t*)(ws + WS_H), (const bf16_t*)(ws + WS_WQ), T, 2048, D}; pg8::StaticOrder S; S.init(T, 2048, gridDim.x, blockIdx.x);
        EpiQ E{(bf16_t*)(ws + WS_SG), (const float*)(ws + WS_SSQ), (const float*)(ws + WS_BIAS2)};
        pg8::gemm_phase<EpiQ>(lds, g, S, E, wave_s);
    }
#if DBG_REPEAT
    FRESH();
    if (IN(7)) {
        unsigned char* ws = kp->ws;
        pg8::Gemm g{(const bf16_t*)(ws + WS_H), (const bf16_t*)(ws + WS_WQ), T, 2048, D}; pg8::StaticOrder S; S.init(T, 2048, gridDim.x, blockIdx.x);
        EpiQ E{(bf16_t*)(ws + WS_SG), (const float*)(ws + WS_SSQ), (const float*)(ws + WS_BIAS2)};
        pg8::gemm_phase<EpiQ>(lds, g, S, E, wave_s);
    }
#endif
    if (IN(7) && IN(8)) { asm volatile("s_waitcnt vmcnt(0)" ::: "memory"); __syncthreads();
        if (wave_s == 0 && lane_id_asm() == 0) { __builtin_amdgcn_fence(__ATOMIC_ACQUIRE, "agent"); asm volatile("s_waitcnt vmcnt(0)" ::: "memory"); }
        __syncthreads(); }
    FRESH();
    if (IN(8)) phase_topk(kp, lds, wave_s);
#if DBG_REPEAT
    FRESH();
    if (IN(8)) phase_topk(kp, lds, wave_s);
#endif
    SEAM(8);
    if (IN(9)) phase_peer_u(kp, lds, wave_s);
    SEAM(9);
    if (IN(10)) phase_peer_v(kp, lds, wave_s);
#undef IN
#undef SEAM
#undef FRESH
}

#define DBG_PHASE_SKIP(ph) (0)
#define DBG_LAST 9
#define DBG_DUMP_N ((size_t)3584 * 1024)
#define DBG_DUMP_BF16 1
#ifdef DBG_DUMP_OFF
__global__ void dbg_dump(const unsigned char* ws, float* out) {
    const size_t n = DBG_DUMP_N;
    for (size_t i = (size_t)blockIdx.x * blockDim.x + threadIdx.x; i < (size_t)T * D; i += (size_t)gridDim.x * blockDim.x) {
        const size_t j = (i * 7919ull) % n;
        float v;
        if (DBG_DUMP_BF16) v = __uint_as_float(((unsigned)((const bf16_t*)(ws + DBG_DUMP_OFF))[j]) << 16);
        else v = ((const float*)(ws + DBG_DUMP_OFF))[j];
        out[i] = v;
    }
}
#endif
#ifndef MK_N_LAUNCHES
#define MK_N_LAUNCHES 1
#endif
extern "C" void kernel_launch(void* const* d_in, const int* in_sizes, int n_in, void* d_out, int out_size, void* d_ws, size_t ws_size, hipStream_t stream) {
    static int grid = 0;
    if (grid == 0) {
        if (n_in != 23 || in_sizes[0] != T * D || out_size != T * D || ws_size < WS_END) {
            fprintf(stderr, "kernel_launch: unexpected shapes (n_in %d, in0 %d, out %d, ws %zu); nothing launched\n", n_in, n_in > 0 ? in_sizes[0] : -1, out_size, ws_size); grid = -1; return; }
        int dev = 0, cus = 0, per_cu = 0;
        if (hipGetDevice(&dev) != hipSuccess || hipDeviceGetAttribute(&cus, hipDeviceAttributeMultiprocessorCount, dev) != hipSuccess) { grid = -1; return; }
        if (hipFuncSetAttribute((const void*)fwd_megakernel, hipFuncAttributeMaxDynamicSharedMemorySize, LDS_BYTES) != hipSuccess) { fprintf(stderr, "kernel_launch: hipFuncSetAttribute failed\n"); grid = -1; return; }
        if (hipOccupancyMaxActiveBlocksPerMultiprocessor(&per_cu, (const void*)fwd_megakernel, NTHREADS, LDS_BYTES) != hipSuccess || per_cu < 1) {
            fprintf(stderr, "kernel_launch: occupancy query says %d blocks per CU; nothing launched\n", per_cu); grid = -1; return; }
        grid = cus;
    }
    if (grid < 0) return;
    (void)hipMemsetAsync((char*)d_ws + WS_CTL, 0, 16384, stream);
    Params p{};
    for (int i = 0; i < 23; ++i) p.in[i] = (const float*)d_in[i];
    p.out = (float*)d_out; p.ws = (unsigned char*)d_ws;
#if MK_N_LAUNCHES == 1
    p.ph_lo = 0; p.ph_hi = 11;
    void* args[] = {&p};
    hipError_t e = hipLaunchCooperativeKernel((const void*)fwd_megakernel, dim3(grid), dim3(NTHREADS), args, LDS_BYTES, stream);
    if (e != hipSuccess) fprintf(stderr, "kernel_launch: cooperative launch failed: %s (grid %d)\n", hipGetErrorString(e), grid);
#else
    for (int ph = 0; ph < 11; ++ph) { if (DBG_PHASE_SKIP(ph)) continue; p.ph_lo = ph; p.ph_hi = ph + 1; hipLaunchKernelGGL(fwd_megakernel, dim3(grid), dim3(NTHREADS), LDS_BYTES, stream, p); }
#ifdef DBG_DUMP_OFF
    hipLaunchKernelGGL(dbg_dump, dim3(1024), dim3(256), 0, stream, (const unsigned char*)d_ws, (float*)d_out);
#endif
#endif
}
```

```cpp
#include <hip/hip_runtime.h>
#include <hip/hip_cooperative_groups.h>
#include <cstdio>
#include <cstdint>
namespace cg = cooperative_groups;
#define DBG_NO_DOT2 1
#define DBG_REPEAT 0

#define LAS __attribute__((address_space(3)))
typedef unsigned short bf16_t;
typedef short bf16x8 __attribute__((ext_vector_type(8)));
typedef float f32x4 __attribute__((ext_vector_type(4)));
typedef float f32x2 __attribute__((ext_vector_type(2)));
typedef float f32x16 __attribute__((ext_vector_type(16)));
typedef unsigned u32x4 __attribute__((ext_vector_type(4)));
typedef unsigned u32x2 __attribute__((ext_vector_type(2)));
typedef __bf16 bf16x2_t __attribute__((ext_vector_type(2)));

constexpr int T = 32768, D = 1024, SEQ = 8192, NBATCH = 4, INW = 3584, NMOD = 6 * 1024;
constexpr int NEXP = 16384;
constexpr float EPS = 1e-6f;
constexpr int NTHREADS = 512;
constexpr int LDS_BYTES = 131072 + 1024;
constexpr int LDS_CTL_OFF = 131072;

constexpr size_t MiB = 1024ull * 1024ull;
constexpr size_t WS_CTL = 0;
constexpr size_t WS_MOD = 16384;
constexpr size_t WS_BINP = 114688;
constexpr size_t WS_WIN = 131072;
constexpr size_t WS_WPC = WS_WIN + 7340032;
constexpr size_t WS_WOUT = WS_WPC + 2 * MiB;
constexpr size_t WS_WQ = WS_WOUT + 2 * MiB;
constexpr size_t WS_EU = 16 * MiB;
constexpr size_t WS_EV = 32 * MiB;
constexpr size_t WS_SU = 48 * MiB;
constexpr size_t WS_SV = 48 * MiB + 65536;
constexpr size_t WS_H = 80 * MiB;
constexpr size_t WS_PG = 144 * MiB;
constexpr size_t WS_SG = 208 * MiB;
constexpr size_t WS_MC = 336 * MiB;
constexpr size_t WS_IDX = 400 * MiB;
constexpr size_t WS_GATE = 416 * MiB;
constexpr size_t WS_HB = WS_PG;
constexpr size_t WS_HS = WS_PG + 32 * MiB;
constexpr size_t WS_WG8 = WS_WIN + 1536 * 1024;
constexpr size_t WS_WGS = WS_WIN + 4 * MiB + 1536 * 4;
constexpr size_t WS_X8 = 436 * MiB;
constexpr size_t WS_X8S = 468 * MiB;
constexpr size_t WS_X1B = WS_MC;
constexpr size_t WS_A2 = 432 * MiB;
constexpr size_t WS_BIAS2 = WS_A2 + 16384;
constexpr size_t WS_SSQ = WS_A2 + 65536;
constexpr size_t WS_CO = WS_SG;
constexpr size_t WS_IDP = WS_SG + 16 * MiB;
constexpr size_t WS_COP = WS_SG + 32 * MiB;
constexpr size_t WS_CS = WS_SG + 48 * MiB;
constexpr size_t WS_WP8 = WS_WIN;
constexpr size_t WS_WP8S = WS_WIN + 4 * MiB;
constexpr size_t WS_PMAX = WS_WIN + 5 * MiB;
constexpr size_t WS_END = 469 * MiB;
static_assert(WS_WQ + 4 * MiB <= WS_EU, "weight region overflow");

struct Params;
typedef const __attribute__((address_space(4))) Params* KP;
struct Params {
    const float* in[23];
    float* out;
    unsigned char* ws;
    int ph_lo, ph_hi;
};

typedef __bf16 bf16x2v_t __attribute__((ext_vector_type(2)));
__device__ __forceinline__ unsigned cvt_pk_bf16(float lo, float hi) { return __builtin_bit_cast(unsigned, __builtin_convertvector((f32x2){lo, hi}, bf16x2v_t)); }
__device__ __forceinline__ float bf_lo(unsigned u) { return __uint_as_float(u << 16); }
__device__ __forceinline__ float bf_hi(unsigned u) { return __uint_as_float(u & 0xffff0000u); }
__device__ __forceinline__ float fast_sigmoid(float x) { return __builtin_amdgcn_rcpf(1.0f + __builtin_amdgcn_exp2f(-1.44269504089f * x)); }
__device__ __forceinline__ int lane_id_asm() { int l; asm volatile("v_mbcnt_lo_u32_b32 %0, -1, 0\n\tv_mbcnt_hi_u32_b32 %0, -1, %0" : "=v"(l)); return l; }
#define DPPI(old, x, ctrl, rmask, bc) __builtin_amdgcn_update_dpp((old), (x), (ctrl), (rmask), 0xF, (bc))
__device__ __forceinline__ float wave_sum(float v) {
    v += __int_as_float(DPPI(0, __float_as_int(v), 0xB1, 0xF, true)); v += __int_as_float(DPPI(0, __float_as_int(v), 0x4E, 0xF, true));
    v += __int_as_float(DPPI(0, __float_as_int(v), 0x141, 0xF, true)); v += __int_as_float(DPPI(0, __float_as_int(v), 0x140, 0xF, true));
    v += __int_as_float(DPPI(0, __float_as_int(v), 0x142, 0xA, false)); v += __int_as_float(DPPI(0, __float_as_int(v), 0x143, 0xC, false));
    return __int_as_float(__builtin_amdgcn_readlane(__float_as_int(v), 63));
}
__device__ __forceinline__ float wave_max(float v) {
    v = fmaxf(v, __int_as_float(DPPI(0, __float_as_int(v), 0xB1, 0xF, true))); v = fmaxf(v, __int_as_float(DPPI(0, __float_as_int(v), 0x4E, 0xF, true)));
    v = fmaxf(v, __int_as_float(DPPI(0, __float_as_int(v), 0x141, 0xF, true))); v = fmaxf(v, __int_as_float(DPPI(0, __float_as_int(v), 0x140, 0xF, true)));
    v = fmaxf(v, __int_as_float(DPPI(0, __float_as_int(v), 0x142, 0xA, false))); v = fmaxf(v, __int_as_float(DPPI(0, __float_as_int(v), 0x143, 0xC, false)));
    return __int_as_float(__builtin_amdgcn_readlane(__float_as_int(v), 63));
}
__device__ __forceinline__ int in_colmap(int n) {
    if (n < 512) return n;
    if (n < 1536) { const int t = (n - 512) >> 8, r = (n - 512) & 255; return r < 128 ? 512 + 128 * t + r : 1024 + 128 * t + (r - 128); }
    const int t = (n - 1536) >> 8, r = (n - 1536) & 255;
    return r < 128 ? 1536 + 128 * t + r : 2560 + 128 * t + (r - 128);
}

#define XB_TMO      128
#define XB_XCNT(j)  (256  + 64 * (j))
#define XB_XSUB(j)  (1280 + 64 * (j))
#define XB_XGEN(j)  (2304 + 64 * (j))
#define XB_TOP      3328
#define XB_TOPGEN   3392
#define XCD_BAR_WORDS 3456
#define XB_SPIN_CAP (1u << 22)
__device__ __forceinline__ unsigned xb_ld(unsigned* p)              { return __hip_atomic_load(p, __ATOMIC_RELAXED, __HIP_MEMORY_SCOPE_AGENT); }
__device__ __forceinline__ unsigned xb_add(unsigned* p, unsigned v) { return __hip_atomic_fetch_add(p, v, __ATOMIC_RELAXED, __HIP_MEMORY_SCOPE_AGENT); }
__device__ __forceinline__ unsigned xb_xcc_id() { return (unsigned)__builtin_amdgcn_s_getreg((3 << 11) | 20) & 0xFu; }
#define XB_SPIN(cond, bar) do { unsigned _sp = 0; while (cond) { __builtin_amdgcn_s_sleep(1); \
    if ((++_sp & 255u) == 0u) { if (xb_ld(&(bar)[XB_TMO])) break; if (_sp > XB_SPIN_CAP) { atomicAdd(&(bar)[XB_TMO], 1u); break; } } } } while (0)
struct XcdBarrier { unsigned* bar; unsigned x; volatile LAS unsigned* st; };
__device__ __forceinline__ XcdBarrier xcd_barrier_post(unsigned* bar, volatile LAS unsigned* st, int wave_s) {
    XcdBarrier b; b.bar = bar; b.x = xb_xcc_id(); b.st = st;
    if (wave_s == 0 && lane_id_asm() == 0) (void)xb_add(&bar[XB_XCNT(b.x)], 1u);
    return b;
}
__device__ __forceinline__ void xcd_barrier_complete(unsigned* bar, unsigned x, unsigned& nloc, unsigned& nx) {
    const unsigned G = gridDim.x * gridDim.y * gridDim.z;
    unsigned sum, cnt, mine, sp = 0u;
    for (;;) {
        sum = 0u; cnt = 0u; mine = 0u;
#pragma unroll
        for (unsigned j = 0; j < 16; ++j) { const unsigned c = xb_ld(&bar[XB_XCNT(j)]); sum += c; cnt += (c > 0u) ? 1u : 0u; mine = (j == x) ? c : mine; }
        if (sum == G) break;
        __builtin_amdgcn_s_sleep(1);
        if ((++sp & 255u) == 0u) { if (xb_ld(&bar[XB_TMO])) break; if (sp > XB_SPIN_CAP) { atomicAdd(&bar[XB_TMO], 1u); break; } }
    }
    nloc = mine > 0u ? mine : 1u; nx = cnt > 0u ? cnt : 1u;
}
__device__ __forceinline__ void xcd_barrier(const XcdBarrier& b, int wave_s) {
    asm volatile("s_waitcnt vmcnt(0)" ::: "memory");
    __syncthreads();
    if (wave_s == 0 && lane_id_asm() == 0) {
        unsigned* bar = b.bar;
        __builtin_amdgcn_s_waitcnt(0);
        unsigned nloc = b.st[0], nx = b.st[1];
        if (nloc == 0u) { xcd_barrier_complete(bar, b.x, nloc, nx); b.st[0] = nloc; b.st[1] = nx; }
        const unsigned old = xb_add(&bar[XB_XSUB(b.x)], 1u);
        const unsigned gen = old / nloc;
        if (old + 1u == (gen + 1u) * nloc) {
            __builtin_amdgcn_fence(__ATOMIC_RELEASE, "agent");
            asm volatile("s_waitcnt vmcnt(0)" ::: "memory");
            const unsigned og = xb_add(&bar[XB_TOP], 1u);
            const unsigned tg = og / nx;
            if (og + 1u == (tg + 1u) * nx) xb_add(&bar[XB_TOPGEN], 1u);
            else XB_SPIN(xb_ld(&bar[XB_TOPGEN]) == tg, bar);
            __builtin_amdgcn_fence(__ATOMIC_ACQUIRE, "agent");
            xb_add(&bar[XB_XGEN(b.x)], 1u);
            asm volatile("s_waitcnt vmcnt(0)" ::: "memory");
        } else {
            XB_SPIN(xb_ld(&bar[XB_XGEN(b.x)]) == gen, bar);
            __builtin_amdgcn_fence(__ATOMIC_ACQUIRE, "agent");
            asm volatile("s_waitcnt vmcnt(0)" ::: "memory");
        }
    }
    __syncthreads();
}

namespace pg8 {
constexpr int BM = 256, BK = 64, HALF = 128, HTB = HALF * BK * 2, STAGE_BYTES = 8 * HTB, NXCD = 8, WGM = 1;
__host__ __device__ __forceinline__ int lds_byte(int r, int c) { const int st = (r >> 4) * 2 + (c >> 5), rr = r & 15, cc = c & 31, ob = rr * 64 + cc * 2; return st * 1024 + (ob ^ (((ob >> 9) & 1) << 5)); }
__host__ __device__ __forceinline__ void stage_rc(int b, int& R, int& C) { const int st = b / 1024, sb = b % 1024, swz = sb ^ (((sb >> 9) & 1) << 5); R = (st >> 1) * 16 + swz / 64; C = (st & 1) * 32 + (swz % 64) / 2; }
__host__ __device__ __forceinline__ int perm32(int rho) { const int n = rho >> 4, i = rho & 15; return 8 * (i >> 2) + 4 * n + (i & 3); }
struct Unit { int pm, pn; };
struct Gemm { const bf16_t* A; const bf16_t* Bt; int M, N, K; };
struct StaticOrder {
    int nM, nN, nwg, G, c;
    __host__ __device__ void init(int M, int N, int G_, int c_) { nM = M / BM; nN = N / BM; nwg = nM * nN; G = G_; c = c_; }
    __host__ __device__ bool next(int i, Unit& u) const {
        const long L = (long)i * G + c; if (L >= nwg) return false;
        int wgid = (int)L; { const int q = nwg / NXCD, r = nwg % NXCD, xcd = wgid % NXCD, off = wgid / NXCD; wgid = (xcd < r ? xcd * (q + 1) : r * (q + 1) + (xcd - r) * q) + off; }
        const int nig = WGM * nN, gid = wgid / nig, fm = gid * WGM, gsz = (nM - fm) < WGM ? (nM - fm) : WGM;
        u.pm = fm + ((wgid % nig) % gsz); u.pn = (wgid % nig) / gsz; return true;
    }
};
typedef int i32x8_t __attribute__((ext_vector_type(8)));
typedef int i32x4_t __attribute__((ext_vector_type(4)));
template <bool FP8> struct FragT { typedef bf16x8 type[2]; };
template <> struct FragT<true> { typedef i32x8_t type; };
__device__ __forceinline__ void ldfrag(bf16x8 (&d)[2], const LAS unsigned char* p) { d[0] = *(const LAS bf16x8*)p; d[1] = *(const LAS bf16x8*)(p + 1024); }
__device__ __forceinline__ void ldfrag(i32x8_t& d, const LAS unsigned char* p) { const i32x4_t lo = *(const LAS i32x4_t*)p, hi = *(const LAS i32x4_t*)(p + 1024); d = (i32x8_t){lo[0], lo[1], lo[2], lo[3], hi[0], hi[1], hi[2], hi[3]}; }
__device__ __forceinline__ void mma1(f32x4& acc, const bf16x8 (&b)[2], const bf16x8 (&a)[2]) {
    acc = __builtin_amdgcn_mfma_f32_16x16x32_bf16(b[0], a[0], acc, 0, 0, 0); acc = __builtin_amdgcn_mfma_f32_16x16x32_bf16(b[1], a[1], acc, 0, 0, 0); }
__device__ __forceinline__ void mma1(f32x4& acc, const i32x8_t& b, const i32x8_t& a) {
    asm volatile("v_mfma_scale_f32_16x16x128_f8f6f4 %0, %1, %2, %0, %3, %3 op_sel_hi:[0,0,0]" : "+v"(acc) : "v"(b), "v"(a), "v"(0x7f7f7f7f)); }
template <class Epi>
__device__ __forceinline__ void gemm_phase(LAS unsigned char* lds, const Gemm g, const StaticOrder& S, const Epi& E, int wave_s) {
    const int lane = lane_id_asm(), wid = wave_s, tid = wid * 64 + lane, wr = wid >> 2, wc = wid & 3, fr = lane & 15, fq = lane >> 4;
    const int K = g.K, nt = K / BK;
    unsigned voffA[2], voffB[2];
#pragma unroll
    for (int i = 0; i < 2; ++i) { int R, C; stage_rc(tid * 16 + i * 8192, R, C); const int Rb = Epi::PERM ? ((R & ~31) + perm32(R & 31)) : R;
        voffA[i] = (unsigned)(R * K + C) * 2u; voffB[i] = (unsigned)(Rb * K + C) * 2u; }
    const size_t kstep = (size_t)(BK * 2);
    const size_t hstep = (size_t)HALF * K * 2;
    const size_t tstep = 2 * hstep;
    const unsigned ldsw = (unsigned)wid * 1024u;
    const int aoff = lds_byte(wr * 64 + fr, fq * 8), boff = lds_byte(wc * 32 + fr, fq * 8);
#define PG8_SA(b, h) (((b) * 2 + (h)) * HTB)
#define PG8_SB(b, h) ((4 + (b) * 2 + (h)) * HTB)
#define PG8_STAGE(bufoff, gbase, voff) do { _Pragma("unroll") for (int _i = 0; _i < 2; ++_i) \
        __builtin_amdgcn_global_load_lds((const unsigned*)((const char*)(gbase) + (voff)[_i]), (LAS unsigned*)(lds + (bufoff) + ldsw + _i * 8192), 16, 0, 0); } while (0)
#define PG8_LDA(dst, b, h) do { _Pragma("unroll") for (int m = 0; m < 4; ++m) ldfrag(dst[m], lds + PG8_SA(b, h) + aoff + m * 2048); } while (0)
#define PG8_LDB(dst, b, h) do { _Pragma("unroll") for (int n = 0; n < 2; ++n) ldfrag(dst[n], lds + PG8_SB(b, h) + boff + n * 2048); } while (0)
#define PG8_MMA(ai, bj, At, Bt) do { __builtin_amdgcn_s_setprio(1); _Pragma("unroll") for (int m = 0; m < 4; ++m) _Pragma("unroll") for (int n = 0; n < 2; ++n) mma1(acc[ai][bj][m][n], Bt[n], At[m]); __builtin_amdgcn_s_setprio(0); } while (0)
#define PG8_WAIT_V(n) asm volatile("s_waitcnt vmcnt(" #n ")" ::: "memory")
#define PG8_WAIT_L(n) asm volatile("s_waitcnt lgkmcnt(" #n ")" ::: "memory")
#define PG8_BAR __builtin_amdgcn_s_barrier()
#define PG8_SCHED __builtin_amdgcn_sched_barrier(0)
    Unit cur, nxt; int ui = 0;
    if (!S.next(0, cur)) return;
    f32x4 acc[2][2][4][2];
#pragma unroll
    for (int a = 0; a < 2; ++a)
#pragma unroll
        for (int b = 0; b < 2; ++b)
#pragma unroll
            for (int m = 0; m < 4; ++m)
#pragma unroll
                for (int n = 0; n < 2; ++n) acc[a][b][m][n] = (f32x4){0.f, 0.f, 0.f, 0.f};
    typename FragT<Epi::FP8>::type At[4], B0[2], B1[2];
    const char* cA = (const char*)g.A + (size_t)cur.pm * tstep; const char* cB = (const char*)g.Bt + (size_t)cur.pn * tstep;
    PG8_STAGE(PG8_SB(0, 0), cB, voffB); PG8_STAGE(PG8_SB(0, 1), cB + hstep, voffB); PG8_STAGE(PG8_SA(0, 0), cA, voffA); PG8_STAGE(PG8_SA(0, 1), cA + hstep, voffA);
    if (wr == 1) PG8_BAR;
    PG8_WAIT_V(2); PG8_BAR;
    PG8_STAGE(PG8_SB(1, 0), cB + kstep, voffB); PG8_STAGE(PG8_SA(1, 0), cA + kstep, voffA); PG8_STAGE(PG8_SB(1, 1), cB + hstep + kstep, voffB);
    PG8_WAIT_V(6); PG8_BAR;
    for (;;) {
        const bool has_next = S.next(ui + 1, nxt);
        const char* nA = has_next ? (const char*)g.A + (size_t)nxt.pm * tstep : cA; const char* nB = has_next ? (const char*)g.Bt + (size_t)nxt.pn * tstep : cB;
#pragma unroll 1
        for (int t = 0; t < nt; t += 2) {
            const bool last = (t == nt - 2);
            const char* a1 = cA + (size_t)(t + 1) * kstep;
            const char* a2 = last ? nA : cA + (size_t)(t + 2) * kstep; const char* b2 = last ? nB : cB + (size_t)(t + 2) * kstep;
            const char* a3 = a2 + kstep; const char* b3 = b2 + kstep;
            if constexpr (Epi::HAS_MID) { if (t == nt / 2) E.mid(acc, cur, wr, wc, fr, fq); }
            PG8_LDB(B0, 0, 0); PG8_LDB(B1, 0, 1); PG8_SCHED; PG8_LDA(At, 0, 0); PG8_STAGE(PG8_SA(1, 1), a1 + hstep, voffA);
            PG8_WAIT_V(8); PG8_WAIT_L(0); PG8_BAR; PG8_MMA(0, 0, At, B0); PG8_MMA(0, 1, At, B1); PG8_BAR; PG8_SCHED;
            PG8_LDA(At, 0, 1); PG8_STAGE(PG8_SB(0, 0), b2, voffB); PG8_STAGE(PG8_SB(0, 1), b2 + hstep, voffB); PG8_STAGE(PG8_SA(0, 0), a2, voffA);
            PG8_WAIT_V(8); PG8_WAIT_L(0); PG8_BAR; PG8_MMA(1, 0, At, B0); PG8_MMA(1, 1, At, B1); PG8_BAR; PG8_SCHED;
            PG8_LDB(B0, 1, 0); PG8_LDB(B1, 1, 1); PG8_SCHED; PG8_LDA(At, 1, 0); PG8_STAGE(PG8_SA(0, 1), a2 + hstep, voffA);
            PG8_WAIT_V(8); PG8_WAIT_L(0); PG8_BAR; PG8_MMA(0, 0, At, B0); PG8_MMA(0, 1, At, B1); PG8_BAR; PG8_SCHED;
            PG8_LDA(At, 1, 1); PG8_STAGE(PG8_SB(1, 0), b3, voffB); PG8_STAGE(PG8_SB(1, 1), b3 + hstep, voffB); PG8_STAGE(PG8_SA(1, 0), a3, voffA);
            PG8_WAIT_V(8); PG8_WAIT_L(0); PG8_BAR; PG8_MMA(1, 0, At, B0); PG8_MMA(1, 1, At, B1); PG8_BAR; PG8_SCHED;
        }
        if (wr == 0) PG8_BAR;
        E(acc, cur, wr, wc, fr, fq);
        if (!has_next) break;
#pragma unroll
        for (int a = 0; a < 2; ++a)
#pragma unroll
            for (int b = 0; b < 2; ++b)
#pragma unroll
                for (int m = 0; m < 4; ++m)
#pragma unroll
                    for (int n = 0; n < 2; ++n) acc[a][b][m][n] = (f32x4){0.f, 0.f, 0.f, 0.f};
        cur = nxt; cA = nA; cB = nB; ++ui;
        if (wr == 1) PG8_BAR;
    }
    PG8_WAIT_V(0);
    PG8_BAR;
#undef PG8_SA
#undef PG8_SB
#undef PG8_STAGE
#undef PG8_LDA
#undef PG8_LDB
#undef PG8_MMA
#undef PG8_WAIT_V
#undef PG8_WAIT_L
#undef PG8_BAR
#undef PG8_SCHED
}
}
typedef f32x4 AccT[2][2][4][2];

struct EpiProj {
    static constexpr bool PERM = true, HAS_MID = false, FP8 = true;
    const float* bias; bf16_t* PB; bf16_t* GB; const float* RS; const float* CS;
    __device__ __forceinline__ void operator()(const AccT& acc, const pg8::Unit& u, int wr, int wc, int fr, int fq) const {
        const int row0 = u.pm * 256 + wr * 64 + fr, lc0 = wc * 32 + 8 * fq;
        f32x4 bv[2][2], cv[2][2];
#pragma unroll
        for (int bj = 0; bj < 2; ++bj)
#pragma unroll
            for (int n = 0; n < 2; ++n) { bv[bj][n] = *(const f32x4*)(bias + u.pn * 256 + bj * 128 + lc0 + 4 * n); cv[bj][n] = *(const f32x4*)(CS + u.pn * 256 + bj * 128 + lc0 + 4 * n); }
        if (u.pn >= 2 && u.pn < 6) {
            const int t = u.pn - 2;
#pragma unroll
            for (int ai = 0; ai < 2; ++ai)
#pragma unroll
                for (int m = 0; m < 4; ++m) {
                    const int row = row0 + ai * 128 + m * 16; const float rs = RS[row];
                    float o[8];
#pragma unroll
                    for (int n = 0; n < 2; ++n) { const f32x4 v = acc[ai][0][m][n] * (cv[0][n] * rs) + bv[0][n], gt = acc[ai][1][m][n] * (cv[1][n] * rs) + bv[1][n];
#pragma unroll
                        for (int j = 0; j < 4; ++j) o[n * 4 + j] = v[j] * fast_sigmoid(gt[j]); }
                    u32x4 w; w.x = cvt_pk_bf16(o[0], o[1]); w.y = cvt_pk_bf16(o[2], o[3]); w.z = cvt_pk_bf16(o[4], o[5]); w.w = cvt_pk_bf16(o[6], o[7]);
                    *(u32x4*)(GB + (size_t)row * 512 + t * 128 + lc0) = w;
                }
        } else {
            const bool isp = true;
            bf16_t* base = PB; const int ldc = 512; const int colt = u.pn * 256;
#pragma unroll
            for (int ai = 0; ai < 2; ++ai)
#pragma unroll
                for (int m = 0; m < 4; ++m) {
                    const int row = row0 + ai * 128 + m * 16; const float rs = RS[row];
#pragma unroll
                    for (int bj = 0; bj < 2; ++bj) {
                        f32x4 v0 = acc[ai][bj][m][0] * (cv[bj][0] * rs) + bv[bj][0], v1 = acc[ai][bj][m][1] * (cv[bj][1] * rs) + bv[bj][1];
                        if (!isp) {
#pragma unroll
                            for (int j = 0; j < 4; ++j) { v0[j] = fast_sigmoid(v0[j]); v1[j] = fast_sigmoid(v1[j]); }
                        }
                        u32x4 w; w.x = cvt_pk_bf16(v0[0], v0[1]); w.y = cvt_pk_bf16(v0[2], v0[3]); w.z = cvt_pk_bf16(v1[0], v1[1]); w.w = cvt_pk_bf16(v1[2], v1[3]);
                        *(u32x4*)(base + (size_t)row * ldc + colt + bj * 128 + lc0) = w;
                    }
                }
        }
    }
};
struct EpiGate {
    static constexpr bool PERM = true, HAS_MID = false, FP8 = true;
    const float* bias; const float* RS; const float* CS; bf16_t* SG;
    __device__ __forceinline__ void operator()(const AccT& acc, const pg8::Unit& u, int wr, int wc, int fr, int fq) const {
        const int row0 = u.pm * 256 + wr * 64 + fr, lc0 = wc * 32 + 8 * fq, t = u.pn;
        float rs[2][4];
#pragma unroll
        for (int ai = 0; ai < 2; ++ai)
#pragma unroll
            for (int m = 0; m < 4; ++m) rs[ai][m] = RS[row0 + ai * 128 + m * 16];
#pragma unroll
        for (int n = 0; n < 2; ++n) {
            const f32x4 b1 = *(const f32x4*)(bias + 1536 + t * 256 + lc0 + 4 * n), b2 = *(const f32x4*)(bias + 1536 + t * 256 + 128 + lc0 + 4 * n);
            const f32x4 c1 = *(const f32x4*)(CS + t * 256 + lc0 + 4 * n), c2 = *(const f32x4*)(CS + t * 256 + 128 + lc0 + 4 * n);
#pragma unroll
            for (int ai = 0; ai < 2; ++ai)
#pragma unroll
                for (int m = 0; m < 4; ++m) {
                    const int row = row0 + ai * 128 + m * 16;
                    const f32x4 a1 = acc[ai][0][m][n] * (c1 * rs[ai][m]) + b1, a2 = acc[ai][1][m][n] * (c2 * rs[ai][m]) + b2;
                    float ra[4], s2[4];
#pragma unroll
                    for (int j = 0; j < 4; ++j) { const float e1 = __builtin_amdgcn_exp2f(-1.44269504089f * a1[j]), e2 = __builtin_amdgcn_exp2f(-1.44269504089f * a2[j]);
                        ra[j] = (1.0f + e2) * __builtin_amdgcn_rcpf(1.0f + e1); s2[j] = __builtin_amdgcn_rcpf(1.0f + e2); }
                    *(u32x2*)(SG + (size_t)row * 2048 + t * 128 + lc0 + 4 * n) = (u32x2){cvt_pk_bf16(ra[0], ra[1]), cvt_pk_bf16(ra[2], ra[3])};
                    *(u32x2*)(SG + (size_t)row * 2048 + 1024 + t * 128 + lc0 + 4 * n) = (u32x2){cvt_pk_bf16(s2[0], s2[1]), cvt_pk_bf16(s2[2], s2[3])};
                }
        }
    }
};
struct EpiIn {
    static constexpr bool PERM = true, HAS_MID = false, FP8 = true;
    EpiProj P; EpiGate G;
    __device__ __forceinline__ void operator()(const AccT& acc, const pg8::Unit& u, int wr, int wc, int fr, int fq) const {
        if (u.pn < 6) P(acc, u, wr, wc, fr, fq);
        else { pg8::Unit u2 = u; u2.pn = u.pn - 6; G(acc, u2, wr, wc, fr, fq); }
    }
};
struct EpiMerge {
    static constexpr bool PERM = true, HAS_MID = true, FP8 = false;
    const bf16_t* SG; bf16_t* MG;
    __device__ __forceinline__ void mid(AccT& acc, const pg8::Unit& u, int wr, int wc, int fr, int fq) const {
        const int row0 = u.pm * 256 + wr * 64 + fr, col0 = u.pn * 256 + wc * 32 + 8 * fq;
#pragma unroll
        for (int ai = 0; ai < 2; ++ai)
#pragma unroll
            for (int m = 0; m < 4; ++m) {
                const bf16_t* p = SG + (size_t)(row0 + ai * 128 + m * 16) * 2048 + col0;
                const u32x4 r0 = *(const u32x4*)p, r1 = *(const u32x4*)(p + 128);
#pragma unroll
                for (int bj = 0; bj < 2; ++bj) {
                    const unsigned a1[4] = {bj ? r1.x : r0.x, bj ? r1.y : r0.y, bj ? r1.z : r0.z, bj ? r1.w : r0.w};
#pragma unroll
                    for (int n = 0; n < 2; ++n)
#pragma unroll
                        for (int j = 0; j < 4; ++j) { const unsigned w1 = a1[n * 2 + (j >> 1)]; acc[ai][bj][m][n][j] *= (j & 1) ? bf_hi(w1) : bf_lo(w1); }
                }
                if (m & 1) asm volatile("" ::: "memory");
            }
    }
    __device__ __forceinline__ void operator()(const AccT& acc, const pg8::Unit& u, int wr, int wc, int fr, int fq) const {
        const int row0 = u.pm * 256 + wr * 64 + fr, col0 = u.pn * 256 + wc * 32 + 8 * fq;
#pragma unroll
        for (int ai = 0; ai < 2; ++ai)
#pragma unroll
            for (int m = 0; m < 4; ++m)
#pragma unroll
                for (int bj = 0; bj < 2; ++bj) {
                    const int row = row0 + ai * 128 + m * 16;
                    const u32x4 s2 = *(const u32x4*)(SG + (size_t)row * 2048 + 1024 + col0 + bj * 128);
                    const unsigned a2[4] = {s2.x, s2.y, s2.z, s2.w};
                    float o[8];
#pragma unroll
                    for (int n = 0; n < 2; ++n)
#pragma unroll
                        for (int j = 0; j < 4; ++j) {
                            const unsigned w2 = a2[n * 2 + (j >> 1)];
                            const float f2 = fmaxf((j & 1) ? bf_hi(w2) : bf_lo(w2), 1e-20f);
                            o[n * 4 + j] = acc[ai][bj][m][n][j] * f2;
                        }
                    u32x4 w; w.x = cvt_pk_bf16(o[0], o[1]); w.y = cvt_pk_bf16(o[2], o[3]); w.z = cvt_pk_bf16(o[4], o[5]); w.w = cvt_pk_bf16(o[6], o[7]);
                    *(u32x4*)(MG + (size_t)row * 1024 + col0 + bj * 128) = w;
                }
    }
};
struct EpiResid {
    static constexpr bool PERM = true, HAS_MID = false, FP8 = false;
    const float* X; const float* mod; bf16_t* X1B;
    const float* A2; bf16_t* XA; float* SSQ;
    __device__ __forceinline__ void operator()(const AccT& acc, const pg8::Unit& u, int wr, int wc, int fr, int fq) const {
        const int row0 = u.pm * 256 + wr * 64 + fr, col0 = u.pn * 256 + wc * 32 + 8 * fq;
        const int b = (u.pm * 256) / SEQ;
        const float* gt = mod + (size_t)b * NMOD; const float* a2 = A2 + b * 1024;
        f32x4 gv[2][2], av[2][2];
#pragma unroll
        for (int bj = 0; bj < 2; ++bj)
#pragma unroll
            for (int n = 0; n < 2; ++n) { gv[bj][n] = *(const f32x4*)(gt + col0 + bj * 128 + n * 4); av[bj][n] = *(const f32x4*)(a2 + col0 + bj * 128 + n * 4); }
#pragma unroll
        for (int ai = 0; ai < 2; ++ai)
#pragma unroll
            for (int m = 0; m < 4; ++m) {
                const int row = row0 + ai * 128 + m * 16;
                const size_t off = (size_t)row * 1024 + col0;
                float ss = 0.f;
#pragma unroll
                for (int bj = 0; bj < 2; ++bj) {
                    const f32x4 xv0 = *(const f32x4*)(X + off + bj * 128), xv1 = *(const f32x4*)(X + off + bj * 128 + 4);
                    const f32x4 x10 = xv0 + gv[bj][0] * acc[ai][bj][m][0], x11 = xv1 + gv[bj][1] * acc[ai][bj][m][1];
                    { u32x4 wx; wx.x = cvt_pk_bf16(x10[0], x10[1]); wx.y = cvt_pk_bf16(x10[2], x10[3]); wx.z = cvt_pk_bf16(x11[0], x11[1]); wx.w = cvt_pk_bf16(x11[2], x11[3]);
                      *(u32x4*)(X1B + off + bj * 128) = wx; }
                    ss += x10[0] * x10[0] + x10[1] * x10[1] + x10[2] * x10[2] + x10[3] * x10[3] + x11[0] * x11[0] + x11[1] * x11[1] + x11[2] * x11[2] + x11[3] * x11[3];
                    const f32x4 xa0 = x10 * av[bj][0], xa1 = x11 * av[bj][1];
                    u32x4 w; w.x = cvt_pk_bf16(xa0[0], xa0[1]); w.y = cvt_pk_bf16(xa0[2], xa0[3]); w.z = cvt_pk_bf16(xa1[0], xa1[1]); w.w = cvt_pk_bf16(xa1[2], xa1[3]);
                    *(u32x4*)(XA + off + bj * 128) = w;
                }
                ss += __shfl_xor(ss, 16); ss += __shfl_xor(ss, 32);
                if (fq == 0) __hip_atomic_fetch_add(SSQ + row, ss, __ATOMIC_RELAXED, __HIP_MEMORY_SCOPE_AGENT);
            }
    }
};
struct EpiBf16 {
    static constexpr bool PERM = true, HAS_MID = false, FP8 = false;
    bf16_t* O; int ldc;
    __device__ __forceinline__ void operator()(const AccT& acc, const pg8::Unit& u, int wr, int wc, int fr, int fq) const {
        const int row0 = u.pm * 256 + wr * 64 + fr, col0 = u.pn * 256 + wc * 32 + 8 * fq;
#pragma unroll
        for (int ai = 0; ai < 2; ++ai)
#pragma unroll
            for (int m = 0; m < 4; ++m)
#pragma unroll
                for (int bj = 0; bj < 2; ++bj) {
                    const f32x4 v0 = acc[ai][bj][m][0], v1 = acc[ai][bj][m][1];
                    u32x4 w; w.x = cvt_pk_bf16(v0[0], v0[1]); w.y = cvt_pk_bf16(v0[2], v0[3]); w.z = cvt_pk_bf16(v1[0], v1[1]); w.w = cvt_pk_bf16(v1[2], v1[3]);
                    *(u32x4*)(O + (size_t)(row0 + ai * 128 + m * 16) * ldc + col0 + bj * 128) = w;
                }
    }
};

struct EpiQ {
    static constexpr bool PERM = true, HAS_MID = false, FP8 = false;
    bf16_t* O; const float* SSQ; const float* BIAS2;
    __device__ __forceinline__ void operator()(const AccT& acc, const pg8::Unit& u, int wr, int wc, int fr, int fq) const {
        const int row0 = u.pm * 256 + wr * 64 + fr, col0 = u.pn * 256 + wc * 32 + 8 * fq;
        const float* bs = BIAS2 + ((u.pm * 256) / SEQ) * 2048 + col0;
        f32x4 bv[2][2];
#pragma unroll
        for (int bj = 0; bj < 2; ++bj)
#pragma unroll
            for (int n = 0; n < 2; ++n) bv[bj][n] = *(const f32x4*)(bs + bj * 128 + 4 * n);
#pragma unroll
        for (int ai = 0; ai < 2; ++ai)
#pragma unroll
            for (int m = 0; m < 4; ++m) {
                const int row = row0 + ai * 128 + m * 16;
                const float r = rsqrtf(SSQ[row] * (1.0f / D) + EPS);
#pragma unroll
                for (int bj = 0; bj < 2; ++bj) {
                    const f32x4 v0 = acc[ai][bj][m][0] * r + bv[bj][0], v1 = acc[ai][bj][m][1] * r + bv[bj][1];
                    u32x4 w; w.x = cvt_pk_bf16(v0[0], v0[1]); w.y = cvt_pk_bf16(v0[2], v0[3]); w.z = cvt_pk_bf16(v1[0], v1[1]); w.w = cvt_pk_bf16(v1[2], v1[3]);
                    { const int cw = wr * 2 + ai * 4 + (m >> 1), ks = 2 * wc + (fq >> 1), ln = (fq & 1) * 32 + (m & 1) * 16 + fr;
                      *(u32x4*)(O + ((size_t)(u.pm * 8 + u.pn) * 128 + (size_t)((cw * 2 + bj) * 8 + ks)) * 512 + ln * 8) = w; }
                }
            }
    }
};

#ifndef U_BITS
#define U_BITS 4
#endif
#ifndef V_BITS
#define V_BITS 4
#endif
template <int BITS> struct RowFmt;
template <> struct RowFmt<8> { typedef u32x4 row_t; static constexpr float QMAX = 224.0f; };
template <> struct RowFmt<4> { typedef u32x2 row_t; static constexpr float QMAX = 6.0f; };
template <int I> __device__ __forceinline__ f32x2 row_pair(const u32x4& r) {
    const unsigned w = (I >> 1) == 0 ? r.x : (I >> 1) == 1 ? r.y : (I >> 1) == 2 ? r.z : r.w;
    return __builtin_amdgcn_cvt_pk_f32_fp8((int)w, (I & 1) != 0);
}
template <int I> __device__ __forceinline__ f32x2 row_pair(const u32x2& r) {
    const unsigned w = (I >> 2) == 0 ? r.x : r.y;
    return __builtin_amdgcn_cvt_scalef32_pk_f32_fp4(w, 1.0f, I & 3);
}
template <class R> __device__ __forceinline__ float row_dot16(const R& r, const f32x2 (&hf)[8]) {
    f32x2 acc = {0.f, 0.f};
    acc = __builtin_elementwise_fma(row_pair<0>(r), hf[0], acc); acc = __builtin_elementwise_fma(row_pair<1>(r), hf[1], acc);
    acc = __builtin_elementwise_fma(row_pair<2>(r), hf[2], acc); acc = __builtin_elementwise_fma(row_pair<3>(r), hf[3], acc);
    acc = __builtin_elementwise_fma(row_pair<4>(r), hf[4], acc); acc = __builtin_elementwise_fma(row_pair<5>(r), hf[5], acc);
    acc = __builtin_elementwise_fma(row_pair<6>(r), hf[6], acc); acc = __builtin_elementwise_fma(row_pair<7>(r), hf[7], acc);
    return acc.x + acc.y;
}
template <class R> __device__ __forceinline__ void row_axpy16(const R& r, float c, f32x2 (&o)[8]) {
    const f32x2 c2 = {c, c};
    o[0] = __builtin_elementwise_fma(c2, row_pair<0>(r), o[0]); o[1] = __builtin_elementwise_fma(c2, row_pair<1>(r), o[1]);
    o[2] = __builtin_elementwise_fma(c2, row_pair<2>(r), o[2]); o[3] = __builtin_elementwise_fma(c2, row_pair<3>(r), o[3]);
    o[4] = __builtin_elementwise_fma(c2, row_pair<4>(r), o[4]); o[5] = __builtin_elementwise_fma(c2, row_pair<5>(r), o[5]);
    o[6] = __builtin_elementwise_fma(c2, row_pair<6>(r), o[6]); o[7] = __builtin_elementwise_fma(c2, row_pair<7>(r), o[7]);
}
template <int BITS> __device__ __forceinline__ void quant_row(const f32x4 (&v)[4], float qs, unsigned char* dst_row, int lane) {
    if constexpr (BITS == 8) {
#pragma unroll
        for (int q = 0; q < 4; ++q) { int p = 0; p = __builtin_amdgcn_cvt_pk_fp8_f32(v[q][0] * qs, v[q][1] * qs, p, false); p = __builtin_amdgcn_cvt_pk_fp8_f32(v[q][2] * qs, v[q][3] * qs, p, true);
            ((unsigned*)dst_row)[lane + 64 * q] = (unsigned)p; }
    } else {
#pragma unroll
        for (int q = 0; q < 4; ++q) { unsigned p = 0; p = __builtin_amdgcn_cvt_scalef32_pk_fp4_f32(p, v[q][0] * qs, v[q][1] * qs, 1.0f, 0); p = __builtin_amdgcn_cvt_scalef32_pk_fp4_f32(p, v[q][2] * qs, v[q][3] * qs, 1.0f, 1);
            ((unsigned short*)dst_row)[lane + 64 * q] = (unsigned short)(p & 0xffffu); }
    }
}
__device__ __forceinline__ void xpose_tile(const float* src, int ldsrc, int c0, int k0, bf16_t* dst, int lddst, int n0, int kd0, LAS float* tile, int tid) {
    { const int r = tid >> 4, c4 = tid & 15;
#pragma unroll
      for (int ps = 0; ps < 2; ++ps) { const f32x4 v = *(const f32x4*)(src + (size_t)(k0 + r + 32 * ps) * ldsrc + c0 + c4 * 4);
#pragma unroll
          for (int j = 0; j < 4; ++j) tile[(r + 32 * ps) * 65 + c4 * 4 + j] = v[j]; } }
    __syncthreads();
    { const int n = tid >> 3, kg = tid & 7; float f[8];
#pragma unroll
      for (int i = 0; i < 8; ++i) f[i] = tile[(kg * 8 + i) * 65 + n];
      u32x4 w; w.x = cvt_pk_bf16(f[0], f[1]); w.y = cvt_pk_bf16(f[2], f[3]); w.z = cvt_pk_bf16(f[4], f[5]); w.w = cvt_pk_bf16(f[6], f[7]);
      *(u32x4*)(dst + (size_t)(n0 + n) * lddst + kd0 + k0 + kg * 8) = w; }
    __syncthreads();
}
__device__ __forceinline__ void phase_prep(KP kp, LAS unsigned char* lds, int wave_s) {
    const int tid = wave_s * 64 + lane_id_asm(), G = gridDim.x;
    unsigned char* ws = kp->ws;
    const float* cvec = kp->in[1]; const float* ada_w = kp->in[2]; const float* ada_b = kp->in[3];
    float* mod = (float*)(ws + WS_MOD);
    LAS float* cact = (LAS float*)lds;
    LAS float* red = (LAS float*)(lds + 16384);
    LAS float* tile = (LAS float*)(lds + 49152);
    LAS float* pw = (LAS float*)(lds + 49152);
    if ((int)blockIdx.x < 192) {
        for (int i = tid; i < 4096; i += NTHREADS) { const float v = cvec[i]; cact[i] = v * fast_sigmoid(v); }
    }
    if (blockIdx.x == G - 1) {
        float* binp = (float*)(ws + WS_BINP); const float* b_in = kp->in[6];
        for (int i = tid; i < INW; i += NTHREADS) binp[i] = b_in[in_colmap(i)];
    }
    __syncthreads();
    constexpr int N_MOD = 192, N_WIN = 384, N_CO = 128, N_WO = 256, N_WQ = 512, N_WP = 128, N_WG = 512;
    constexpr int I1 = N_MOD, I2 = I1 + N_WIN, I3 = I2 + N_CO, I4 = I3 + N_WO, I5 = I4 + N_WQ, I6 = I5 + N_WP, I7 = I6 + N_WG;
    for (int it = blockIdx.x; it < I7; it += G) {
        if (it < I1) {
            const int n0 = it * 32, c4 = tid & 7, ks = tid >> 3;
            float a[4][4];
#pragma unroll
            for (int b = 0; b < 4; ++b)
#pragma unroll
                for (int j = 0; j < 4; ++j) a[b][j] = 0.f;
#pragma unroll 4
            for (int kk = 0; kk < 16; ++kk) { const int k = ks * 16 + kk; const f32x4 w = *(const f32x4*)(ada_w + (size_t)k * NMOD + n0 + c4 * 4);
#pragma unroll
                for (int b = 0; b < 4; ++b) { const float cv = cact[b * 1024 + k];
#pragma unroll
                    for (int j = 0; j < 4; ++j) a[b][j] += cv * w[j]; } }
#pragma unroll
            for (int b = 0; b < 4; ++b)
#pragma unroll
                for (int j = 0; j < 4; ++j) red[(ks * 4 + b) * 32 + c4 * 4 + j] = a[b][j];
            __syncthreads();
            if (tid < 128) { const int b = tid >> 5, col = tid & 31; float s = 0.f;
                for (int q = 0; q < 64; ++q) s += red[(q * 4 + b) * 32 + col];
                mod[b * NMOD + n0 + col] = s + ada_b[n0 + col]; }
            __syncthreads();
        } else if (it >= I6 || (it >= I1 && it < I2)) {
            const bool isp = it < I2;
            const int i = isp ? it - I1 : it - I6, kt = i & 15, n0 = (i >> 4) * 64 + (isp ? 0 : 1536), c0 = in_colmap(n0);
            const float* win = kp->in[5];
            LAS float* cmx = (LAS float*)(lds + 49152 + 17408);
            { const int r = tid >> 4, c4 = tid & 15;
              const f32x4 v0 = *(const f32x4*)(win + (size_t)(kt * 64 + r) * INW + c0 + c4 * 4), v1 = *(const f32x4*)(win + (size_t)(kt * 64 + r + 32) * INW + c0 + c4 * 4);
#pragma unroll
              for (int j = 0; j < 4; ++j) cmx[r * 64 + c4 * 4 + j] = fmaxf(fabsf(v0[j]), fabsf(v1[j])); }
            __syncthreads();
            if (tid < 64) { float mm = 0.f; for (int q = 0; q < 32; ++q) mm = fmaxf(mm, cmx[q * 64 + tid]); ((float*)(ws + WS_PMAX))[kt * 3584 + n0 + tid] = mm; }
            __syncthreads();
        } else if (it < I3) {
            const int i = it - I2, kt = i & 7, ntl = i >> 3;
            xpose_tile(kp->in[14], 1024, ntl * 64, kt * 64, (bf16_t*)(ws + WS_WPC), 1024, ntl * 64, 512, tile, tid);
        } else if (it < I4) {
            const int i = it - I3, kt = i & 15, ntl = i >> 4;
            xpose_tile(kp->in[15], 1024, ntl * 64, kt * 64, (bf16_t*)(ws + WS_WOUT), 1024, ntl * 64, 0, tile, tid);
        } else if (it < I5) {
            const int i = it - I4, kt = i & 15, ntl = i >> 4;
            xpose_tile(kp->in[17], 2048, ntl * 64, kt * 64, (bf16_t*)(ws + WS_WQ), 1024, ntl * 64, 0, tile, tid);
        } else {
            const int i = it - I5, nb = i & 1, cb = (i >> 1) & 15, g = i >> 5;
            const float* pool_w = kp->in[7]; const float* pool_scale = kp->in[8]; const float* pool_up = kp->in[9];
            for (int e = tid; e < 1024; e += NTHREADS) { const int ci = e >> 7, d = e & 127; pw[e] = pool_w[((size_t)g * 128 + cb * 8 + ci) * 128 + d] * pool_scale[g * 128 + d]; }
            __syncthreads();
            const int n = nb * 512 + tid; float a[8];
#pragma unroll
            for (int q = 0; q < 8; ++q) a[q] = 0.f;
#pragma unroll 4
            for (int d = 0; d < 128; ++d) { const float uv = pool_up[(size_t)(g * 128 + d) * 1024 + n];
#pragma unroll
                for (int q = 0; q < 8; ++q) a[q] += pw[q * 128 + d] * uv; }
            u32x4 w; w.x = cvt_pk_bf16(a[0], a[1]); w.y = cvt_pk_bf16(a[2], a[3]); w.z = cvt_pk_bf16(a[4], a[5]); w.w = cvt_pk_bf16(a[6], a[7]);
            *(u32x4*)((bf16_t*)(ws + WS_WPC) + (size_t)n * 1024 + g * 128 + cb * 8) = w;
            __syncthreads();
        }
    }
    {
        const int lane = tid & 63, wave = tid >> 6;
        f32x4 vn[4];
        { const int r0 = blockIdx.x * 8 + wave;
          if (r0 < 2 * NEXP) { const int tb0 = r0 >= NEXP ? 1 : 0; const f32x4* src = (const f32x4*)((tb0 ? kp->in[21] : kp->in[20]) + (size_t)(r0 - tb0 * NEXP) * D);
#pragma unroll
              for (int q = 0; q < 4; ++q) vn[q] = src[lane + 64 * q]; } }
        for (int r = blockIdx.x * 8 + wave; r < 2 * NEXP; r += G * 8) {
            const int tb = r >= NEXP ? 1 : 0, e = r - tb * NEXP;
            f32x4 v[4]; float m = 0.f;
#pragma unroll
            for (int q = 0; q < 4; ++q) v[q] = vn[q];
            { const int rn = r + G * 8;
              if (rn < 2 * NEXP) { const int tbn = rn >= NEXP ? 1 : 0; const f32x4* src = (const f32x4*)((tbn ? kp->in[21] : kp->in[20]) + (size_t)(rn - tbn * NEXP) * D);
#pragma unroll
                  for (int q = 0; q < 4; ++q) vn[q] = src[lane + 64 * q]; } }
#pragma unroll
            for (int q = 0; q < 4; ++q) m = fmaxf(m, fmaxf(fmaxf(fabsf(v[q][0]), fabsf(v[q][1])), fmaxf(fabsf(v[q][2]), fabsf(v[q][3]))));
            m = wave_max(m);
            const float qmax = tb ? RowFmt<V_BITS>::QMAX : RowFmt<U_BITS>::QMAX;
            const float qs = m > 0.f ? qmax / m : 0.f;
            if (tb) quant_row<V_BITS>(v, qs, ws + WS_EV + (size_t)e * (V_BITS * 128), lane);
            else quant_row<U_BITS>(v, qs, ws + WS_EU + (size_t)e * (U_BITS * 128), lane);
            if (lane == 0) ((float*)(ws + (tb ? WS_SV : WS_SU)))[e] = m / qmax;
        }
    }
}

__device__ __forceinline__ void phase_w8(KP kp, LAS unsigned char* lds, int wave_s) {
    const int tid = wave_s * 64 + lane_id_asm();
    unsigned char* ws = kp->ws;
    const float* win = kp->in[5]; const float* pmax = (const float*)(ws + WS_PMAX);
    LAS float* tile = (LAS float*)(lds + 49152);
    LAS float* csc = (LAS float*)(lds + 49152 + 17408);
    for (int it = blockIdx.x; it < 56 * 16; it += gridDim.x) {
        const int kt = it & 15, n0 = (it >> 4) * 64, c0 = in_colmap(n0);
        if (tid < 64) { float mm = 0.f;
#pragma unroll
            for (int q = 0; q < 16; ++q) mm = fmaxf(mm, pmax[q * 3584 + n0 + tid]);
            csc[tid] = mm > 0.f ? 224.0f / mm : 0.f; if (kt == 0) ((float*)(ws + WS_WP8S))[n0 + tid] = mm * (1.0f / 224.0f); }
        { const int r = tid >> 4, c4 = tid & 15;
#pragma unroll
          for (int ps = 0; ps < 2; ++ps) { const f32x4 v = *(const f32x4*)(win + (size_t)(kt * 64 + r + 32 * ps) * INW + c0 + c4 * 4);
#pragma unroll
              for (int j = 0; j < 4; ++j) tile[(r + 32 * ps) * 65 + c4 * 4 + j] = v[j]; } }
        __syncthreads();
        { const int n = tid >> 3, kg = tid & 7; const float qs = csc[n]; float f[8];
#pragma unroll
          for (int i = 0; i < 8; ++i) f[i] = tile[(kg * 8 + i) * 65 + n] * qs;
          int p0 = 0, p1 = 0;
          p0 = __builtin_amdgcn_cvt_pk_fp8_f32(f[0], f[1], p0, false); p0 = __builtin_amdgcn_cvt_pk_fp8_f32(f[2], f[3], p0, true);
          p1 = __builtin_amdgcn_cvt_pk_fp8_f32(f[4], f[5], p1, false); p1 = __builtin_amdgcn_cvt_pk_fp8_f32(f[6], f[7], p1, true);
          *(u32x2*)(ws + WS_WP8 + (size_t)(n0 + n) * 1024 + kt * 64 + kg * 8) = (u32x2){(unsigned)p0, (unsigned)p1}; }
        __syncthreads();
    }
}

template <bool WITH_FP8>
__device__ __forceinline__ void phase_norm_ada(const float* src, const float* gain, const float* mod, int shift_off, int scale_off, bf16_t* dst, unsigned char* dst8, float* dscale, int wave_s) {
    const int lane = lane_id_asm(), wave = wave_s;
    f32x4 vn[4];
    { const int row0 = blockIdx.x * 8 + wave;
      if (row0 < T) { const f32x4* xr = (const f32x4*)(src + (size_t)row0 * D);
#pragma unroll
          for (int j = 0; j < 4; ++j) vn[j] = xr[lane + 64 * j]; } }
    for (int row = blockIdx.x * 8 + wave; row < T; row += gridDim.x * 8) {
        const int b = row / SEQ;
        f32x4 v[4]; float ss = 0.f;
#pragma unroll
        for (int j = 0; j < 4; ++j) v[j] = vn[j];
        { const int rn = row + gridDim.x * 8;
          if (rn < T) { const f32x4* xr = (const f32x4*)(src + (size_t)rn * D);
#pragma unroll
              for (int j = 0; j < 4; ++j) vn[j] = xr[lane + 64 * j]; } }
#pragma unroll
        for (int j = 0; j < 4; ++j) ss += v[j][0] * v[j][0] + v[j][1] * v[j][1] + v[j][2] * v[j][2] + v[j][3] * v[j][3];
        ss = wave_sum(ss);
        const float r = rsqrtf(ss * (1.0f / D) + EPS);
        float am = 0.f;
#pragma unroll
        for (int j = 0; j < 4; ++j) {
            const int col = 4 * lane + 256 * j;
            const f32x4 g = *(const f32x4*)(gain + col), sc = *(const f32x4*)(mod + (size_t)b * NMOD + scale_off + col), sh = *(const f32x4*)(mod + (size_t)b * NMOD + shift_off + col);
            const f32x4 h = v[j] * r * g * (sc + 1.0f) + sh;
            u32x2 w; w.x = cvt_pk_bf16(h[0], h[1]); w.y = cvt_pk_bf16(h[2], h[3]);
            if (dst) *(u32x2*)(dst + (size_t)row * D + col) = w;
            if (WITH_FP8) { v[j] = h; am = fmaxf(am, fmaxf(fmaxf(fabsf(h[0]), fabsf(h[1])), fmaxf(fabsf(h[2]), fabsf(h[3])))); }
        }
        if (WITH_FP8) {
            am = wave_max(am);
            const float qs = am > 0.f ? 224.0f / am : 0.f;
#pragma unroll
            for (int j = 0; j < 4; ++j) { int p = 0; p = __builtin_amdgcn_cvt_pk_fp8_f32(v[j][0] * qs, v[j][1] * qs, p, false); p = __builtin_amdgcn_cvt_pk_fp8_f32(v[j][2] * qs, v[j][3] * qs, p, true);
                *(unsigned*)(dst8 + (size_t)row * D + 4 * lane + 256 * j) = (unsigned)p; }
            if (lane == 0) dscale[row] = am * (1.0f / 224.0f);
        }
    }
}

__device__ __forceinline__ void phase_aux(KP kp, LAS unsigned char* lds, int wave_s) {
    const int tid = wave_s * 64 + lane_id_asm();
    unsigned char* ws = kp->ws;
    const float* mod = (const float*)(ws + WS_MOD);
    const int bid = blockIdx.x;
    if (bid == 0) {
        float* A2 = (float*)(ws + WS_A2); const float* g2 = kp->in[16];
        for (int i = tid; i < 4096; i += NTHREADS) { const int b = i >> 10, k = i & 1023; A2[i] = g2[k] * (1.0f + mod[(size_t)b * NMOD + 4 * 1024 + k]); }
    } else if (bid <= 8) {
        float* SSQ = (float*)(ws + WS_SSQ) + (bid - 1) * 4096;
        for (int i = tid; i < 4096; i += NTHREADS) SSQ[i] = 0.f;
    } else if (bid <= 24) {
        const int n0 = (bid - 9) * 128, c4 = tid & 31, ks = tid >> 5;
        const float* wq = kp->in[17];
        LAS float* red = (LAS float*)lds;
        float a[4][4];
#pragma unroll
        for (int b = 0; b < 4; ++b)
#pragma unroll
            for (int j = 0; j < 4; ++j) a[b][j] = 0.f;
#pragma unroll 4
        for (int kk = 0; kk < 64; ++kk) { const int k = ks * 64 + kk; const f32x4 w = *(const f32x4*)(wq + (size_t)k * 2048 + n0 + c4 * 4);
#pragma unroll
            for (int b = 0; b < 4; ++b) { const float sv = mod[(size_t)b * NMOD + 3 * 1024 + k];
#pragma unroll
                for (int j = 0; j < 4; ++j) a[b][j] += sv * w[j]; } }
#pragma unroll
        for (int b = 0; b < 4; ++b)
#pragma unroll
            for (int j = 0; j < 4; ++j) red[(ks * 4 + b) * 128 + c4 * 4 + j] = a[b][j];
        __syncthreads();
        { const int b = tid >> 7, col = tid & 127; float sm = 0.f;
          for (int q = 0; q < 16; ++q) sm += red[(q * 4 + b) * 128 + col];
          ((float*)(ws + WS_BIAS2))[b * 2048 + n0 + col] = sm; }
        __syncthreads();
    }
}

template <int W>
__device__ __forceinline__ void pool_window(const float (&x0)[31], const float (&x1)[31], int spos0, bf16_t* dstp) {
#pragma unroll
    for (int i = 0; i < 16; ++i) {
        float s0 = 0.f, s1 = 0.f;
#pragma unroll
        for (int d = 0; d < W; ++d) { s0 += x0[i + 15 - d]; s1 += x1[i + 15 - d]; }
        const int sp = spos0 + i; const float inv = 1.0f / (float)(sp + 1 < W ? sp + 1 : W);
        const float m0 = s0 * inv - x0[i + 15], m1 = s1 * inv - x1[i + 15];
        *(unsigned*)(dstp + (size_t)i * 1024) = cvt_pk_bf16(m0, m1);
    }
}
__device__ __forceinline__ void phase_branches(KP kp, LAS unsigned char* lds, int wave_s) {
    const int lane = lane_id_asm(), wave = wave_s, tid = wave * 64 + lane;
    unsigned char* ws = kp->ws;
    const bf16_t* PB = (const bf16_t*)(ws + WS_PG); const bf16_t* GB = PB + (size_t)T * 512;
    bf16_t* MC = (bf16_t*)(ws + WS_MC);
    const float* dwk = kp->in[10]; const float* dwb = kp->in[11]; const float* lng = kp->in[12]; const float* lnb = kp->in[13];
    LAS unsigned* rows = (LAS unsigned*)lds;
    LAS float* ybuf = (LAS float*)(lds + 63488);
    const int cp = tid & 255, th = tid >> 8;
    float w0[31], w1[31];
#pragma unroll
    for (int j = 0; j < 31; ++j) { const f32x2 w = *(const f32x2*)(dwk + j * 512 + 2 * cp); w0[j] = w.x; w1[j] = w.y; }
    const f32x2 cb = *(const f32x2*)(dwb + 2 * cp);
    u32x4 gpre[8], ppre[6];
#define P3_LOAD_G(t0_, s0_) do { _Pragma("unroll") for (int i_ = 0; i_ < 8; ++i_) { const int e = tid + i_ * NTHREADS; const int r = e >> 6, c = e & 63; u32x4 v = {0u, 0u, 0u, 0u}; \
            if (e < 62 * 64 && (s0_) + r - 30 >= 0) v = *(const u32x4*)(GB + (size_t)((t0_) + r - 30) * 512 + c * 8); gpre[i_] = v; } } while (0)
#define P3_LOAD_P(t0_, s0_) do { _Pragma("unroll") for (int i_ = 0; i_ < 6; ++i_) { const int e = tid + i_ * NTHREADS; const int r = e >> 6, c = e & 63; u32x4 v = {0u, 0u, 0u, 0u}; \
            if (e < 47 * 64 && (s0_) + r - 15 >= 0) v = *(const u32x4*)(PB + (size_t)((t0_) + r - 15) * 512 + c * 8); ppre[i_] = v; } } while (0)
    if ((int)blockIdx.x < T / 32) { const int t0 = blockIdx.x * 32; P3_LOAD_G(t0, t0 % SEQ); }
    for (int tl = blockIdx.x; tl < T / 32; tl += gridDim.x) {
        const int t0 = tl * 32, s0 = t0 % SEQ;
#pragma unroll
        for (int i_ = 0; i_ < 8; ++i_) { const int e = tid + i_ * NTHREADS; if (e < 62 * 64) *(LAS u32x4*)(rows + (e >> 6) * 256 + (e & 63) * 4) = gpre[i_]; }
        __syncthreads();
        P3_LOAD_P(t0, s0);
        {
            float a0[16], a1[16];
#pragma unroll
            for (int i = 0; i < 16; ++i) { a0[i] = cb.x; a1[i] = cb.y; }
#pragma unroll
            for (int r = 0; r < 46; ++r) {
                const unsigned uu = rows[(th * 16 + r) * 256 + cp]; const float x0 = bf_lo(uu), x1 = bf_hi(uu);
#pragma unroll
                for (int i = 0; i < 16; ++i) { const int j = r - i; if (j >= 0 && j <= 30) { a0[i] += x0 * w0[j]; a1[i] += x1 * w1[j]; } }
            }
#pragma unroll
            for (int i = 0; i < 16; ++i) *(LAS f32x2*)(ybuf + (th * 16 + i) * 512 + 2 * cp) = (f32x2){a0[i], a1[i]};
        }
        __syncthreads();
        {
            const f32x4 g0 = *(const f32x4*)(lng + lane * 8), g1 = *(const f32x4*)(lng + lane * 8 + 4), b0 = *(const f32x4*)(lnb + lane * 8), b1 = *(const f32x4*)(lnb + lane * 8 + 4);
#pragma unroll
            for (int q = 0; q < 4; ++q) {
                const int tk = wave * 4 + q;
                const f32x4 y0 = *(const LAS f32x4*)(ybuf + tk * 512 + lane * 8), y1 = *(const LAS f32x4*)(ybuf + tk * 512 + lane * 8 + 4);
                float s = (y0[0] + y0[1]) + (y0[2] + y0[3]) + (y1[0] + y1[1]) + (y1[2] + y1[3]);
                s = wave_sum(s); const float mu = s * (1.0f / 512.0f);
                const f32x4 d0 = y0 - mu, d1 = y1 - mu;
                float qv = d0[0] * d0[0] + d0[1] * d0[1] + d0[2] * d0[2] + d0[3] * d0[3] + d1[0] * d1[0] + d1[1] * d1[1] + d1[2] * d1[2] + d1[3] * d1[3];
                qv = wave_sum(qv); const float rs = rsqrtf(qv * (1.0f / 512.0f) + EPS);
                f32x4 o0 = d0 * rs * g0 + b0, o1 = d1 * rs * g1 + b1;
#pragma unroll
                for (int j = 0; j < 4; ++j) { o0[j] = o0[j] * fast_sigmoid(o0[j]); o1[j] = o1[j] * fast_sigmoid(o1[j]); }
                u32x4 w; w.x = cvt_pk_bf16(o0[0], o0[1]); w.y = cvt_pk_bf16(o0[2], o0[3]); w.z = cvt_pk_bf16(o1[0], o1[1]); w.w = cvt_pk_bf16(o1[2], o1[3]);
                *(u32x4*)(MC + (size_t)(t0 + tk) * 1024 + 512 + lane * 8) = w;
            }
        }
        __syncthreads();
#pragma unroll
        for (int i_ = 0; i_ < 6; ++i_) { const int e = tid + i_ * NTHREADS; if (e < 47 * 64) *(LAS u32x4*)(rows + (e >> 6) * 256 + (e & 63) * 4) = ppre[i_]; }
        __syncthreads();
        { const int tn = tl + gridDim.x; if (tn < T / 32) { const int t0n = tn * 32; P3_LOAD_G(t0n, t0n % SEQ); } }
        {
            float x0[31], x1[31];
#pragma unroll
            for (int r = 0; r < 31; ++r) { const unsigned uu = rows[(th * 16 + r) * 256 + cp]; x0[r] = bf_lo(uu); x1[r] = bf_hi(uu); }
            bf16_t* dstp = MC + (size_t)(t0 + th * 16) * 1024 + 2 * cp;
            const int grp = __builtin_amdgcn_readfirstlane(cp >> 6), sp0 = s0 + th * 16;
            if (grp == 0) pool_window<2>(x0, x1, sp0, dstp);
            else if (grp == 1) pool_window<4>(x0, x1, sp0, dstp);
            else if (grp == 2) pool_window<8>(x0, x1, sp0, dstp);
            else pool_window<16>(x0, x1, sp0, dstp);
        }
        __syncthreads();
    }
}

#define CE_DESC(a, b) do { const int _hi = max(a, b), _lo = min(a, b); a = _hi; b = _lo; } while (0)
#define CE_ASC(a, b)  do { const int _hi = max(a, b), _lo = min(a, b); a = _lo; b = _hi; } while (0)
__device__ __forceinline__ void bitonic_sort16_desc(int (&v)[16]) {
#pragma unroll
    for (int k = 2; k <= 16; k <<= 1)
#pragma unroll
        for (int j = k >> 1; j > 0; j >>= 1)
#pragma unroll
            for (int i = 0; i < 16; ++i) { const int l = i ^ j; if (l > i) { if ((i & k) == 0) CE_DESC(v[i], v[l]); else CE_ASC(v[i], v[l]); } }
}
__device__ __forceinline__ void bitonic_merge16_desc(int (&v)[16]) {
#pragma unroll
    for (int j = 8; j > 0; j >>= 1)
#pragma unroll
        for (int i = 0; i < 16; ++i) { const int l = i ^ j; if (l > i) CE_DESC(v[i], v[l]); }
}
__device__ __forceinline__ void top16_merge(int (&a)[16], const int (&b)[16]) {
#pragma unroll
    for (int i = 0; i < 16; ++i) a[i] = max(a[i], b[15 - i]);
    bitonic_merge16_desc(a);
}
#define CEF_DESC(a, b) do { const float _hi = fmaxf(a, b), _lo = fminf(a, b); a = _hi; b = _lo; } while (0)
#define CEF_ASC(a, b)  do { const float _hi = fmaxf(a, b), _lo = fminf(a, b); a = _lo; b = _hi; } while (0)
__device__ __forceinline__ void fbitonic_sort16_desc(float (&v)[16]) {
#pragma unroll
    for (int k = 2; k <= 16; k <<= 1)
#pragma unroll
        for (int j = k >> 1; j > 0; j >>= 1)
#pragma unroll
            for (int i = 0; i < 16; ++i) { const int l = i ^ j; if (l > i) { if ((i & k) == 0) CEF_DESC(v[i], v[l]); else CEF_ASC(v[i], v[l]); } }
}
__device__ __forceinline__ void fsort16_desc(float (&v)[16]) {
    CEF_DESC(v[0], v[13]); CEF_DESC(v[1], v[12]); CEF_DESC(v[2], v[15]); CEF_DESC(v[3], v[14]); CEF_DESC(v[4], v[8]); CEF_DESC(v[5], v[6]); CEF_DESC(v[7], v[11]); CEF_DESC(v[9], v[10]); CEF_DESC(v[0], v[5]); CEF_DESC(v[1], v[7]); CEF_DESC(v[2], v[9]); CEF_DESC(v[3], v[4]); CEF_DESC(v[6], v[13]); CEF_DESC(v[8], v[14]); CEF_DESC(v[10], v[15]); CEF_DESC(v[11], v[12]); CEF_DESC(v[0], v[1]); CEF_DESC(v[2], v[3]); CEF_DESC(v[4], v[5]); CEF_DESC(v[6], v[8]); CEF_DESC(v[7], v[9]); CEF_DESC(v[10], v[11]); CEF_DESC(v[12], v[13]); CEF_DESC(v[14], v[15]); CEF_DESC(v[0], v[2]); CEF_DESC(v[1], v[3]); CEF_DESC(v[4], v[10]); CEF_DESC(v[5], v[11]); CEF_DESC(v[6], v[7]); CEF_DESC(v[8], v[9]); CEF_DESC(v[12], v[14]); CEF_DESC(v[13], v[15]); CEF_DESC(v[1], v[2]); CEF_DESC(v[3], v[12]); CEF_DESC(v[4], v[6]); CEF_DESC(v[5], v[7]); CEF_DESC(v[8], v[10]); CEF_DESC(v[9], v[11]); CEF_DESC(v[13], v[14]); CEF_DESC(v[1], v[4]); CEF_DESC(v[2], v[6]); CEF_DESC(v[5], v[8]); CEF_DESC(v[7], v[10]); CEF_DESC(v[9], v[13]); CEF_DESC(v[11], v[14]); CEF_DESC(v[2], v[4]); CEF_DESC(v[3], v[6]); CEF_DESC(v[9], v[12]); CEF_DESC(v[11], v[13]); CEF_DESC(v[3], v[5]); CEF_DESC(v[6], v[8]); CEF_DESC(v[7], v[9]); CEF_DESC(v[10], v[12]); CEF_DESC(v[3], v[4]); CEF_DESC(v[5], v[6]); CEF_DESC(v[7], v[8]); CEF_DESC(v[9], v[10]); CEF_DESC(v[11], v[12]); CEF_DESC(v[6], v[7]); CEF_DESC(v[8], v[9]);
}
__device__ __forceinline__ void fbitonic_merge16_desc(float (&v)[16]) {
#pragma unroll
    for (int j = 8; j > 0; j >>= 1)
#pragma unroll
        for (int i = 0; i < 16; ++i) { const int l = i ^ j; if (l > i) CEF_DESC(v[i], v[l]); }
}
__device__ __forceinline__ void ftop16_merge(float (&a)[16], const float (&b)[16]) {
#pragma unroll
    for (int i = 0; i < 16; ++i) a[i] = fmaxf(a[i], b[15 - i]);
    fbitonic_merge16_desc(a);
}
__device__ __forceinline__ int packkey(float v, int idx) { const int f = __float_as_int(v); const int s = f ^ ((f >> 31) & 0x7fffffff); return (s & ~127) | (127 - idx); }
__device__ __forceinline__ float keyval(int k) { const int s = k & ~127; return __int_as_float(s ^ ((s >> 31) & 0x7fffffff)); }
__device__ __forceinline__ void top16_of_scores(const f32x16 (&acc)[4], int hclr, float (&L)[16]) {
    float M[16];
#pragma unroll
    for (int kt = 0; kt < 4; ++kt) {
        float v[16];
#pragma unroll
        for (int r = 0; r < 16; ++r) v[r] = __int_as_float(((__float_as_int(acc[kt][r]) & ~127) | (127 - (kt * 32 + (r & 3) + 8 * (r >> 2)))) & hclr);
        fsort16_desc(v);
        if (kt == 0) {
#pragma unroll
            for (int i = 0; i < 16; ++i) L[i] = v[i];
        } else ftop16_merge(L, v);
    }
#pragma unroll
    for (int i = 0; i < 16; ++i) M[i] = __shfl_xor(L[i], 32);
    ftop16_merge(L, M);
}
__device__ __forceinline__ void phase_topk(KP kp, LAS unsigned char* lds, int wave_s) {
    const int lane = lane_id_asm(), wave = wave_s, tid = wave * 64 + lane;
    unsigned char* ws = kp->ws;
    const bf16_t* Q = (const bf16_t*)(ws + WS_SG);
    int* IDX = (int*)(ws + WS_IDX); float* GATE = (float*)(ws + WS_GATE);
    LAS unsigned* stg = (LAS unsigned*)(lds + 65536);
    for (int e = tid; e < 2 * 32 * 64; e += NTHREADS) {
        const int f = e >> 6, l = e & 63, set = f >> 5, kt = (f >> 3) & 3, ks = f & 7;
        const float* src = (set ? kp->in[19] : kp->in[18]) + (kt * 32 + (l & 31)) * 128 + ks * 16 + 8 * (l >> 5);
        const f32x4 a = *(const f32x4*)src, b = *(const f32x4*)(src + 4);
        u32x4 w; w.x = cvt_pk_bf16(a[0], a[1]); w.y = cvt_pk_bf16(a[2], a[3]); w.z = cvt_pk_bf16(b[0], b[1]); w.w = cvt_pk_bf16(b[2], b[3]);
        *(LAS u32x4*)(lds + (size_t)e * 16) = w;
    }
    __syncthreads();
    const int h = lane >> 5;
    pg8::StaticOrder SO; SO.init(T, 2048, gridDim.x, blockIdx.x);
    pg8::Unit uu;
    for (int ui = 0; SO.next(ui, uu); ++ui) {
        const int tile = uu.pm, head = uu.pn;
        const int tok = tile * 256 + wave * 32 + (lane & 31);
        const bf16_t* qfrag = Q + ((size_t)(tile * 8 + head) * 128 + (size_t)wave * 16) * 512 + lane * 8;
        float L1[16], L2[16];
#pragma unroll
        for (int set = 0; set < 2; ++set) {
            f32x16 acc[4];
#pragma unroll
            for (int kt = 0; kt < 4; ++kt)
#pragma unroll
                for (int r = 0; r < 16; ++r) acc[kt][r] = 0.f;
#pragma unroll
            for (int ks = 0; ks < 8; ++ks) {
                const bf16x8 bq = *(const bf16x8*)(qfrag + (set * 8 + ks) * 512);
#pragma unroll
                for (int kt = 0; kt < 4; ++kt) {
                    const bf16x8 ak = *(const LAS bf16x8*)(lds + (size_t)((((set * 4 + kt) * 8 + ks) * 64) + lane) * 16);
                    acc[kt] = __builtin_amdgcn_mfma_f32_32x32x16_bf16(ak, bq, acc[kt], 0, 0, 0);
                }
            }
#ifdef DBG_VALU_SCORES
            {   const float* keys = set ? kp->in[19] : kp->in[18];
                const bf16_t* qr = Q + (size_t)tok * 2048 + head * 256 + set * 128;
                for (int kt = 0; kt < 4; ++kt)
                    for (int r = 0; r < 16; ++r) {
                        const int idx = kt * 32 + (r & 3) + 8 * (r >> 2) + 4 * h; float sacc = 0.f;
                        for (int k = 0; k < 128; ++k) sacc += __uint_as_float(((unsigned)qr[k]) << 16) * keys[idx * 128 + k];
#pragma unroll
                        for (int kk = 0; kk < 4; ++kk)
#pragma unroll
                            for (int rr = 0; rr < 16; ++rr) if (kk == kt && rr == r) acc[kk][rr] = sacc;
                    }
            }
#endif
            if (set == 0) top16_of_scores(acc, ~(4 * h), L1); else top16_of_scores(acc, ~(4 * h), L2);
        }
        float v1[16], v2[16]; int i1[16], i2[16];
#pragma unroll
        for (int i = 0; i < 16; ++i) { const int k1 = __float_as_int(L1[i]), k2 = __float_as_int(L2[i]); v1[i] = __int_as_float(k1 & ~127); i1[i] = 127 - (k1 & 127); v2[i] = __int_as_float(k2 & ~127); i2[i] = 127 - (k2 & 127); }
        float thr, mx;
        {
            float A[16], B[16], C[16], Dd[16];
#pragma unroll
            for (int j = 0; j < 16; ++j) A[j] = v1[0] + v2[j];
#pragma unroll
            for (int j = 0; j < 8; ++j) { B[j] = v1[1] + v2[j]; B[8 + j] = v1[15 - j] + v2[0]; }
            fbitonic_merge16_desc(B);
            C[0] = v1[2] + v2[0]; C[1] = v1[2] + v2[1]; C[2] = v1[2] + v2[2]; C[3] = v1[2] + v2[3]; C[4] = v1[2] + v2[4];
            C[5] = v1[3] + v2[0]; C[6] = v1[3] + v2[1]; C[7] = v1[3] + v2[2]; C[8] = v1[3] + v2[3];
            C[9] = v1[4] + v2[0]; C[10] = v1[4] + v2[1]; C[11] = v1[4] + v2[2];
            C[12] = v1[5] + v2[0]; C[13] = v1[5] + v2[1]; C[14] = v1[6] + v2[0]; C[15] = v1[6] + v2[1];
            fsort16_desc(C);
            Dd[0] = v1[7] + v2[0]; Dd[1] = v1[7] + v2[1];
#pragma unroll
            for (int j = 2; j < 16; ++j) Dd[j] = -3.0e38f;
            ftop16_merge(A, B); ftop16_merge(C, Dd);
            mx = fmaxf(A[0], C[0]);
            float t = fmaxf(A[0], C[15]);
#pragma unroll
            for (int i = 1; i < 16; ++i) t = fminf(t, fmaxf(A[i], C[15 - i]));
            thr = t;
        }
        if (h == 0) {
            LAS unsigned* row = stg + (wave * 32 + (lane & 31)) * 44;
            int cnt = 0; float sum = 0.f;
#pragma unroll
            for (int i = 0; i < 16; ++i)
#pragma unroll
                for (int j = 0; j < 16; ++j) if ((i + 1) * (j + 1) <= 16) {
                    const float x = v1[i] + v2[j];
                    const bool pr = (x >= thr) && (cnt < 16);
                    const float ev = __expf(x - mx);
                    const int pos = pr ? cnt : 16;
                    row[pos] = (unsigned)(i1[i] * 128 + i2[j]); row[20 + pos] = __float_as_uint(ev);
                    sum += pr ? ev : 0.f; cnt += pr ? 1 : 0;
                }
            const float inv = 1.0f / sum;
            u32x4* ip = (u32x4*)(IDX + ((size_t)tok * 8 + head) * 16); f32x4* gp = (f32x4*)(GATE + ((size_t)tok * 8 + head) * 16);
#pragma unroll
            for (int q = 0; q < 4; ++q) {
                ip[q] = *(const LAS u32x4*)(row + 4 * q);
                const u32x4 gu = *(const LAS u32x4*)(row + 20 + 4 * q);
                gp[q] = (f32x4){__uint_as_float(gu.x) * inv, __uint_as_float(gu.y) * inv, __uint_as_float(gu.z) * inv, __uint_as_float(gu.w) * inv};
            }
        }
    }
}

__device__ __forceinline__ float gelu_tanh(float x) {
    const float y = 0.7978845608028654f * (x + 0.044715f * x * x * x);
    return x * fast_sigmoid(2.0f * y);
}
typedef int i32x8 __attribute__((ext_vector_type(8)));
#define DPPF(x, ctrl) __int_as_float(__builtin_amdgcn_update_dpp(0, __float_as_int(x), ctrl, 0xF, 0xF, true))
struct TokMeta { u32x4 hb; f32x2 hs; int e0, e1; float g0, g1, cu0, cu1, sv0, sv1; u32x4 x1[2]; f32x4 g2[4]; };
__device__ __forceinline__ void peer_load_meta(TokMeta& m, int tok, int lane, const unsigned char* HB, const f32x2* HS, const int* IDX, const float* GATE, const bf16_t* X1, const float* modp) {
    { const u32x4* xp = (const u32x4*)(X1 + (size_t)tok * D + 16 * lane); m.x1[0] = xp[0]; m.x1[1] = xp[1];
      const f32x4* gp = (const f32x4*)(modp + (size_t)(tok / SEQ) * NMOD + 5 * 1024 + 16 * lane); m.g2[0] = gp[0]; m.g2[1] = gp[1]; m.g2[2] = gp[2]; m.g2[3] = gp[3]; }
    m.hb = *(const u32x4*)(HB + (size_t)tok * 1024 + ((lane & 15) * 4 + (lane >> 4)) * 16);
    m.hs = HS[tok];
    m.e0 = IDX[(size_t)tok * 128 + lane]; m.e1 = IDX[(size_t)tok * 128 + 64 + lane];
    m.g0 = GATE[(size_t)tok * 128 + lane]; m.g1 = GATE[(size_t)tok * 128 + 64 + lane];
}
__device__ __forceinline__ void peer_load_scales(TokMeta& m, const float* SU, const float* SV) { m.cu0 = SU[m.e0]; m.cu1 = SU[m.e1]; m.sv0 = SV[m.e0]; m.sv1 = SV[m.e1]; }
typedef RowFmt<V_BITS>::row_t vrow_t;
#define PEER_LOAD(UQ, VQ, g) do { const int bb_ = (g) & 15; const bool nx_ = (g) >= 16; \
        const int src_ = bb_ < 8 ? (nx_ ? mn.e0 : m.e0) : (nx_ ? mn.e1 : m.e1); \
        _Pragma("unroll") for (int j_ = 0; j_ < 4; ++j_) { \
            const int ea_ = __builtin_amdgcn_readlane(src_, (8 * bb_ + 2 * j_) & 63), eb_ = __builtin_amdgcn_readlane(src_, (8 * bb_ + 2 * j_ + 1) & 63); \
            UQ[j_] = __builtin_bit_cast(u32x4, __builtin_amdgcn_raw_buffer_load_b128(rsU, ((mhi ? eb_ : ea_) << 9) + uoff, 0, 0)); \
            VQ[2 * j_] = __builtin_bit_cast(u32x2, __builtin_amdgcn_raw_buffer_load_b64(rsV, lane * 8, ea_ << 9, 0)); \
            VQ[2 * j_ + 1] = __builtin_bit_cast(u32x2, __builtin_amdgcn_raw_buffer_load_b64(rsV, lane * 8, eb_ << 9, 0)); } } while (0)
#define PEER_COMPUTE(UQ, VQ, bt) do { \
        float x_[4]; \
        _Pragma("unroll") for (int j_ = 0; j_ < 4; ++j_) { \
            const i32x8 a_ = {(int)UQ[j_].x, (int)UQ[j_].y, (int)UQ[j_].z, (int)UQ[j_].w, 0, 0, 0, 0}; \
            const f32x4 d_ = __builtin_amdgcn_mfma_scale_f32_16x16x128_f8f6f4(a_, hbv, (f32x4){0.f, 0.f, 0.f, 0.f}, 4, 4, 0, 0x7f7f7f7f, 0, 0x7f7f7f7f); \
            const float s_ = r0 ? d_[0] : r1 ? d_[1] : r2 ? d_[2] : d_[3]; \
            x_[j_] = s_ * st; } \
        float y2[2], q1; \
        _Pragma("unroll") for (int k_ = 0; k_ < 2; ++k_) { const float a_ = b4 ? x_[k_ + 2] : x_[k_], sd_ = b4 ? x_[k_] : x_[k_ + 2]; y2[k_] = a_ + __shfl_xor(sd_, 16); } \
        { const float a_ = b3 ? y2[1] : y2[0], sd_ = b3 ? y2[0] : y2[1]; q1 = a_ + DPPF(sd_, 0x128); }                  \
        q1 += DPPF(q1, 0xB1); q1 += DPPF(q1, 0x4E); q1 += DPPF(q1, 0x141);                                            \
        const int slot_ = (8 * (bt) + jj) & 63; \
        const float cu_ = __shfl((bt) < 8 ? m.cu0 : m.cu1, slot_), cv_ = __shfl((bt) < 8 ? m.g0 * m.sv0 : m.g1 * m.sv1, slot_); \
        const float c_ = gelu_tanh(q1 * cu_) * cv_; \
        _Pragma("unroll") for (int j_ = 0; j_ < 8; ++j_) { \
            const float cj_ = __int_as_float(__builtin_amdgcn_readlane(__float_as_int(c_), 32 * (j_ & 1) + 8 * ((j_ >> 1) & 1) + 16 * ((j_ >> 2) & 1))); \
            row_axpy16(VQ[j_], cj_, o); } } while (0)
__device__ __forceinline__ void phase_peer(KP kp, int wave_s) {
    const int lane = lane_id_asm(), wave = wave_s;
    unsigned char* ws = kp->ws;
    const __amdgpu_buffer_rsrc_t rsU = __builtin_amdgcn_make_buffer_rsrc((void*)(ws + WS_EU), 0, NEXP * U_BITS * 128, 0x00020000);
    const __amdgpu_buffer_rsrc_t rsV = __builtin_amdgcn_make_buffer_rsrc((void*)(ws + WS_EV), 0, NEXP * V_BITS * 128, 0x00020000);
    const unsigned char* HB = ws + WS_HB; const f32x2* HS = (const f32x2*)(ws + WS_HS);
    const int* IDX = (const int*)(ws + WS_IDX); const float* GATE = (const float*)(ws + WS_GATE);
    const float* SU = (const float*)(ws + WS_SU); const float* SV = (const float*)(ws + WS_SV);
    const float* mod = (const float*)(ws + WS_MOD); const float* fg = kp->in[22];
    const bf16_t* X1 = (const bf16_t*)(ws + WS_X1B); float* OUT = kp->out;
    const bool b5 = lane & 32, b4 = lane & 16, b3 = lane & 8;
    const int jj = 4 * (b4 ? 1 : 0) + 2 * (b3 ? 1 : 0) + (b5 ? 1 : 0);
    const int nn = lane & 15, qq = lane >> 4;
    const bool mhi = nn >= 8;
    const int uoff = 64 * (nn & 7) + 16 * qq;
    const bool useful = ((nn & 7) >> 2) == (qq & 1);
    const bool r0 = (nn & 3) == 0, r1 = (nn & 3) == 1, r2 = (nn & 3) == 2;
    const int tstride = gridDim.x * 8;
    int tok = blockIdx.x * 8 + wave;
    f32x4 fgv[4];
#pragma unroll
    for (int q = 0; q < 4; ++q) fgv[q] = *(const f32x4*)(fg + 16 * lane + 4 * q);
    TokMeta m, mn;
    u32x4 uqA[4], uqB[4]; vrow_t vqA[8], vqB[8];
    if (tok < T) { peer_load_meta(m, tok, lane, HB, HS, IDX, GATE, X1, mod); peer_load_scales(m, SU, SV); mn = m; PEER_LOAD(uqA, vqA, 0); }
    for (; tok < T; tok += tstride) {
        const int b = tok / SEQ;
        const bool has_next = tok + tstride < T;
        if (has_next) peer_load_meta(mn, tok + tstride, lane, HB, HS, IDX, GATE, X1, mod);
        const i32x8 hbv = {(int)m.hb.x, (int)m.hb.y, (int)m.hb.z, (int)m.hb.w, 0, 0, 0, 0};
        const float st = useful ? ((nn >> 3) ? m.hs.y : m.hs.x) : 0.f;
        f32x2 o[8];
#pragma unroll
        for (int i = 0; i < 8; ++i) o[i] = (f32x2){0.f, 0.f};
#pragma unroll 1
        for (int bt = 0; bt < 16; bt += 2) {
            PEER_LOAD(uqB, vqB, bt + 1);
            PEER_COMPUTE(uqA, vqA, bt);
            PEER_LOAD(uqA, vqA, bt + 2);
            PEER_COMPUTE(uqB, vqB, bt + 1);
        }
        if (has_next) peer_load_scales(mn, SU, SV);
        float* xr = OUT + (size_t)tok * D + 16 * lane;
        const unsigned xw[8] = {m.x1[0].x, m.x1[0].y, m.x1[0].z, m.x1[0].w, m.x1[1].x, m.x1[1].y, m.x1[1].z, m.x1[1].w};
        f32x4 xv[4]; float ss = 0.f;
#pragma unroll
        for (int q = 0; q < 4; ++q) {
            const f32x4 x1v = {bf_lo(xw[2 * q]), bf_hi(xw[2 * q]), bf_lo(xw[2 * q + 1]), bf_hi(xw[2 * q + 1])}, gv = m.g2[q];
            xv[q][0] = x1v[0] + gv[0] * o[2 * q].x; xv[q][1] = x1v[1] + gv[1] * o[2 * q].y; xv[q][2] = x1v[2] + gv[2] * o[2 * q + 1].x; xv[q][3] = x1v[3] + gv[3] * o[2 * q + 1].y;
            ss += xv[q][0] * xv[q][0] + xv[q][1] * xv[q][1] + xv[q][2] * xv[q][2] + xv[q][3] * xv[q][3];
        }
        ss = wave_sum(ss);
        const float r = rsqrtf(ss * (1.0f / D) + EPS);
#pragma unroll
        for (int q = 0; q < 4; ++q) *(f32x4*)(xr + 4 * q) = xv[q] * r * fgv[q];
        m = mn;
    }
}

__device__ __forceinline__ void quant_h2(const u32x4& xa0, const u32x4& xa1, float ssq, const LAS float* shrow, LAS unsigned char* hbuf, int lane, u32x4& hb, f32x2& hs) {
    const f32x4 s0v = *(const LAS f32x4*)(shrow + 16 * lane), s1v = *(const LAS f32x4*)(shrow + 16 * lane + 4), s2v = *(const LAS f32x4*)(shrow + 16 * lane + 8), s3v = *(const LAS f32x4*)(shrow + 16 * lane + 12);
    const float rr = rsqrtf(ssq * (1.0f / D) + EPS);
    const unsigned xw[8] = {xa0.x, xa0.y, xa0.z, xa0.w, xa1.x, xa1.y, xa1.z, xa1.w};
    const float sh[16] = {s0v[0], s0v[1], s0v[2], s0v[3], s1v[0], s1v[1], s1v[2], s1v[3], s2v[0], s2v[1], s2v[2], s2v[3], s3v[0], s3v[1], s3v[2], s3v[3]};
    float hv[16]; float am = 0.f;
#pragma unroll
    for (int i = 0; i < 8; ++i) { hv[2 * i] = bf_lo(xw[i]) * rr + sh[2 * i]; hv[2 * i + 1] = bf_hi(xw[i]) * rr + sh[2 * i + 1]; am = fmaxf(am, fmaxf(fabsf(hv[2 * i]), fabsf(hv[2 * i + 1]))); }
    am = wave_max(am);
    const float q0 = am > 0.f ? 6.0f / am : 0.f, d0 = am * (1.0f / 6.0f);
    unsigned w0[2] = {0u, 0u}, w1[2] = {0u, 0u}; float rv[16]; float am1 = 0.f;
#pragma unroll
    for (int i = 0; i < 8; ++i) {
        const int wi = i >> 2, bs = i & 3;
        if (bs == 0) w0[wi] = __builtin_amdgcn_cvt_scalef32_pk_fp4_f32(w0[wi], hv[2 * i] * q0, hv[2 * i + 1] * q0, 1.0f, 0);
        else if (bs == 1) w0[wi] = __builtin_amdgcn_cvt_scalef32_pk_fp4_f32(w0[wi], hv[2 * i] * q0, hv[2 * i + 1] * q0, 1.0f, 1);
        else if (bs == 2) w0[wi] = __builtin_amdgcn_cvt_scalef32_pk_fp4_f32(w0[wi], hv[2 * i] * q0, hv[2 * i + 1] * q0, 1.0f, 2);
        else w0[wi] = __builtin_amdgcn_cvt_scalef32_pk_fp4_f32(w0[wi], hv[2 * i] * q0, hv[2 * i + 1] * q0, 1.0f, 3);
    }
#pragma unroll
    for (int i = 0; i < 8; ++i) {
        const int wi = i >> 2, bs = i & 3;
        const f32x2 dq = bs == 0 ? __builtin_amdgcn_cvt_scalef32_pk_f32_fp4(w0[wi], 1.0f, 0) : bs == 1 ? __builtin_amdgcn_cvt_scalef32_pk_f32_fp4(w0[wi], 1.0f, 1) : bs == 2 ? __builtin_amdgcn_cvt_scalef32_pk_f32_fp4(w0[wi], 1.0f, 2) : __builtin_amdgcn_cvt_scalef32_pk_f32_fp4(w0[wi], 1.0f, 3);
        rv[2 * i] = hv[2 * i] - dq.x * d0; rv[2 * i + 1] = hv[2 * i + 1] - dq.y * d0;
        am1 = fmaxf(am1, fmaxf(fabsf(rv[2 * i]), fabsf(rv[2 * i + 1])));
    }
    am1 = wave_max(am1);
    const float q1 = am1 > 0.f ? 6.0f / am1 : 0.f, d1 = am1 * (1.0f / 6.0f);
#pragma unroll
    for (int i = 0; i < 8; ++i) {
        const int wi = i >> 2, bs = i & 3;
        if (bs == 0) w1[wi] = __builtin_amdgcn_cvt_scalef32_pk_fp4_f32(w1[wi], rv[2 * i] * q1, rv[2 * i + 1] * q1, 1.0f, 0);
        else if (bs == 1) w1[wi] = __builtin_amdgcn_cvt_scalef32_pk_fp4_f32(w1[wi], rv[2 * i] * q1, rv[2 * i + 1] * q1, 1.0f, 1);
        else if (bs == 2) w1[wi] = __builtin_amdgcn_cvt_scalef32_pk_fp4_f32(w1[wi], rv[2 * i] * q1, rv[2 * i + 1] * q1, 1.0f, 2);
        else w1[wi] = __builtin_amdgcn_cvt_scalef32_pk_fp4_f32(w1[wi], rv[2 * i] * q1, rv[2 * i + 1] * q1, 1.0f, 3);
    }
    *(LAS u32x2*)(hbuf + 8 * lane) = (u32x2){w0[0], w0[1]};
    *(LAS u32x2*)(hbuf + 512 + 8 * lane) = (u32x2){w1[0], w1[1]};
    asm volatile("" ::: "memory");
    hb = *(const LAS u32x4*)(hbuf + ((lane & 15) >> 3) * 512 + (lane & 7) * 16 + (lane >> 4) * 128);
    asm volatile("" ::: "memory");
    hs = (f32x2){d0, d1};
}
__device__ __forceinline__ void sort_words(unsigned& w0, unsigned& w1, int lane, LAS unsigned* scr) {
#pragma unroll
    for (int bit = 10; bit < 14; ++bit) {
        const bool z0 = ((w0 >> bit) & 1u) == 0u, z1 = ((w1 >> bit) & 1u) == 0u;
        const unsigned long long m0 = __ballot(z0), m1 = __ballot(z1);
        const int nz0 = __popcll(m0), nz = nz0 + __popcll(m1);
        const int r0 = __builtin_amdgcn_mbcnt_hi((unsigned)(m0 >> 32), __builtin_amdgcn_mbcnt_lo((unsigned)m0, 0u));
        const int r1 = __builtin_amdgcn_mbcnt_hi((unsigned)(m1 >> 32), __builtin_amdgcn_mbcnt_lo((unsigned)m1, 0u));
        const int p0 = z0 ? r0 : nz + lane - r0;
        const int p1 = z1 ? nz0 + r1 : nz + 64 - nz0 + lane - r1;
        scr[p0] = w0; scr[p1] = w1;
        asm volatile("" ::: "memory");
        w0 = scr[lane]; w1 = scr[64 + lane];
        asm volatile("" ::: "memory");
    }
}
struct UTok { u32x4 hb, xb; f32x2 hs; unsigned s0, s1; };
#define PU_LOAD(UQ, k, g) do { const int bb_ = (g) & 15; const bool nx_ = (g) >= 16; \
        const unsigned src_ = bb_ < 8 ? (nx_ ? nxt[k].s0 : cur[k].s0) : (nx_ ? nxt[k].s1 : cur[k].s1); \
        _Pragma("unroll") for (int j_ = 0; j_ < 4; ++j_) { \
            const int id_ = __builtin_amdgcn_ds_bpermute(4 * (((8 * bb_) & 63) + 2 * j_) + slotb, (int)src_) & 0x3fff; \
            UQ[j_] = __builtin_bit_cast(u32x4, __builtin_amdgcn_raw_buffer_load_b128(rsU, (id_ << 9) + uoff, 0, 0)); } } while (0)
#define PU_COMPUTE(UQ, k, bt) do { \
        const i32x8 hbv = {(int)cur[k].hb.x, (int)cur[k].hb.y, (int)cur[k].hb.z, (int)cur[k].hb.w, 0, 0, 0, 0}; const float st = cur[k].hs.x; \
        float x_[4]; \
        _Pragma("unroll") for (int j_ = 0; j_ < 4; ++j_) { \
            const i32x8 a_ = {(int)UQ[j_].x, (int)UQ[j_].y, (int)UQ[j_].z, (int)UQ[j_].w, 0, 0, 0, 0}; \
            const f32x4 d_ = __builtin_amdgcn_mfma_scale_f32_16x16x128_f8f6f4(a_, hbv, (f32x4){0.f, 0.f, 0.f, 0.f}, 4, 4, 0, 0x7f7f7f7f, 0, 0x7f7f7f7f); \
            x_[j_] = (d_[0] * lm0 + d_[1] * lm1 + d_[2] * lm2 + d_[3] * lm3) * st; } \
        float y2[2], q1; \
        _Pragma("unroll") for (int k_ = 0; k_ < 2; ++k_) { const float a_ = b4 ? x_[k_ + 2] : x_[k_], sd_ = b4 ? x_[k_] : x_[k_ + 2]; y2[k_] = a_ + __shfl_xor(sd_, 16); } \
        { const float a_ = b3 ? y2[1] : y2[0], sd_ = b3 ? y2[0] : y2[1]; q1 = a_ + DPPF(sd_, 0x128); } \
        q1 += DPPF(q1, 0xB1); q1 += DPPF(q1, 0x4E); q1 += DPPF(q1, 0x141); \
        const float qs_ = __shfl(q1, srcl);                                     \
        const bool mine_ = (lane >> 3) == ((bt) & 7); \
        if ((bt) < 8) qs0[k] = mine_ ? qs_ : qs0[k]; else qs1[k] = mine_ ? qs_ : qs1[k]; } while (0)
__device__ __forceinline__ void peer_u_raw(UTok& t, int tok, int lane, const bf16_t* XA, const float* SSQ, const int* IDX) {
    { const u32x4* xp = (const u32x4*)(XA + (size_t)tok * D + 16 * lane); t.hb = xp[0]; t.xb = xp[1]; }
    t.hs = (f32x2){SSQ[tok], 0.f};
    t.s0 = (unsigned)IDX[(size_t)tok * 128 + lane] | ((unsigned)lane << 14); t.s1 = (unsigned)IDX[(size_t)tok * 128 + 64 + lane] | ((unsigned)(64 + lane) << 14);
}
__device__ __forceinline__ void phase_peer_u(KP kp, LAS unsigned char* lds, int wave_s) {
    const int lane = lane_id_asm(), wave = wave_s;
    unsigned char* ws = kp->ws;
    const __amdgpu_buffer_rsrc_t rsU = __builtin_amdgcn_make_buffer_rsrc((void*)(ws + WS_EU), 0, NEXP * U_BITS * 128, 0x00020000);
    const bf16_t* XA = (const bf16_t*)(ws + WS_H); const float* SSQ = (const float*)(ws + WS_SSQ);
    const int* IDX = (const int*)(ws + WS_IDX); const float* GATE = (const float*)(ws + WS_GATE);
    const float* SU = (const float*)(ws + WS_SU); const float* SV = (const float*)(ws + WS_SV);
    LAS unsigned* scr = (LAS unsigned*)(lds + wave * 2048);
    LAS float* shl = (LAS float*)(lds + 32768);
    LAS unsigned char* hbuf = lds + 49152 + wave * 1024;
    { const float* modp = (const float*)(ws + WS_MOD); for (int i = wave * 64 + lane; i < 4096; i += NTHREADS) shl[i] = modp[(size_t)(i >> 10) * NMOD + 3 * 1024 + (i & 1023)]; }
    __syncthreads();
    const bool b4 = lane & 16, b3 = lane & 8;
    const int srcl = 32 * (lane & 1) + 16 * ((lane >> 2) & 1) + 8 * ((lane >> 1) & 1);
    const int nn = lane & 15, qq = lane >> 4;
    const int uoff = 16 * (nn & 7) + 128 * qq;
    const int slotb = 4 * (nn >> 3);
    const bool useful = ((nn & 7) >> 2) == (qq & 1);
    const float lm0 = (nn & 3) == 0 ? 1.f : 0.f, lm1 = (nn & 3) == 1 ? 1.f : 0.f, lm2 = (nn & 3) == 2 ? 1.f : 0.f, lm3 = (nn & 3) == 3 ? 1.f : 0.f;
    const int tstride = gridDim.x * 8;
    int tok0 = blockIdx.x * 8 + wave;
    if (tok0 < T) {
        UTok cur[4], nxt[4];
        u32x4 uq[4][4];
#pragma unroll
        for (int k = 0; k < 4; ++k) { const int tk = tok0 + k * tstride; peer_u_raw(cur[k], tk < T ? tk : tok0, lane, XA, SSQ, IDX); }
#pragma unroll
        for (int k = 0; k < 4; ++k) { const int tk = tok0 + k * tstride < T ? tok0 + k * tstride : tok0; sort_words(cur[k].s0, cur[k].s1, lane, scr + k * 128);
            { const u32x4 xa0 = cur[k].hb, xa1 = cur[k].xb; quant_h2(xa0, xa1, cur[k].hs.x, shl + (tk / SEQ) * 1024, hbuf, lane, cur[k].hb, cur[k].hs); }
            cur[k].hs.x = useful ? ((nn >> 3) ? cur[k].hs.y : cur[k].hs.x) : 0.f; nxt[k] = cur[k]; }
        PU_LOAD(uq[0], 0, 0); PU_LOAD(uq[1], 1, 0); PU_LOAD(uq[2], 2, 0);
        for (; tok0 < T; tok0 += 4 * tstride) {
            const bool has_next = tok0 + 4 * tstride < T;
            if (has_next) {
#pragma unroll
                for (int k = 0; k < 4; ++k) { const int tk = tok0 + (4 + k) * tstride; peer_u_raw(nxt[k], tk < T ? tk : tok0 + 4 * tstride, lane, XA, SSQ, IDX); }
            }
            float g0[4], g1[4], cu0[4], cu1[4], sv0[4], sv1[4];
#pragma unroll
            for (int k = 0; k < 4; ++k) { const int tk = tok0 + k * tstride < T ? tok0 + k * tstride : tok0;
                const int i0 = cur[k].s0 & 0x3fff, i1 = cur[k].s1 & 0x3fff;
                g0[k] = GATE[(size_t)tk * 128 + (cur[k].s0 >> 14)]; g1[k] = GATE[(size_t)tk * 128 + (cur[k].s1 >> 14)];
                cu0[k] = SU[i0]; cu1[k] = SU[i1]; sv0[k] = SV[i0]; sv1[k] = SV[i1]; }
            float qs0[4] = {0.f, 0.f, 0.f, 0.f}, qs1[4] = {0.f, 0.f, 0.f, 0.f};
#pragma unroll 1
            for (int bt = 0; bt < 16; ++bt) {
                if (bt == 8 && has_next) {
#pragma unroll
                    for (int k = 0; k < 4; ++k) { const int tk = tok0 + (4 + k) * tstride < T ? tok0 + (4 + k) * tstride : tok0 + 4 * tstride; sort_words(nxt[k].s0, nxt[k].s1, lane, scr + k * 128);
                        { const u32x4 xa0 = nxt[k].hb, xa1 = nxt[k].xb; quant_h2(xa0, xa1, nxt[k].hs.x, shl + (tk / SEQ) * 1024, hbuf, lane, nxt[k].hb, nxt[k].hs); }
                        nxt[k].hs.x = useful ? ((nn >> 3) ? nxt[k].hs.y : nxt[k].hs.x) : 0.f; }
                }
                PU_LOAD(uq[3], 3, bt);     PU_COMPUTE(uq[0], 0, bt);
                PU_LOAD(uq[0], 0, bt + 1); PU_COMPUTE(uq[1], 1, bt);
                PU_LOAD(uq[1], 1, bt + 1); PU_COMPUTE(uq[2], 2, bt);
                PU_LOAD(uq[2], 2, bt + 1); PU_COMPUTE(uq[3], 3, bt);
            }
#pragma unroll
            for (int k = 0; k < 4; ++k) { const int tok = tok0 + k * tstride;
                if (tok < T) {
                    const int e0 = (int)(cur[k].s0 & 0x3fff), e1 = (int)(cur[k].s1 & 0x3fff);
                    const float c0 = gelu_tanh(qs0[k] * cu0[k]) * (g0[k] * sv0[k]), c1 = gelu_tanh(qs1[k] * cu1[k]) * (g1[k] * sv1[k]);
                    float cm = fmaxf(fabsf(c0), fabsf(c1));
            cm = wave_max(cm);
                    const float f = cm > 0.f ? 256.0f / cm : 0.f;
                    const unsigned pk = (unsigned)__builtin_amdgcn_cvt_pk_fp8_f32(c0 * f, c1 * f, 0, false) & 0xffffu;
                    const unsigned nbe0 = (unsigned)__builtin_amdgcn_update_dpp(0, e0, 0xB1, 0xF, 0xF, true), nbe1 = (unsigned)__builtin_amdgcn_update_dpp(0, e1, 0xB1, 0xF, 0xF, true);
                    if (!(lane & 1)) {
                        const int p = lane >> 1, o0 = (p & 3) * 16 + (p >> 2), o1 = (p & 3) * 16 + 8 + (p >> 2);
                        unsigned* IDP = (unsigned*)(ws + WS_IDP) + (size_t)tok * 64;
                        IDP[o0] = (unsigned)e0 | (nbe0 << 16); IDP[o1] = (unsigned)e1 | (nbe1 << 16);
                    }
                    const unsigned nb4 = (unsigned)__shfl((int)pk, lane + 4);
                    if ((lane & 7) < 4) {
                        unsigned short* COP = (unsigned short*)(ws + WS_COP) + (size_t)tok * 64 + (lane & 3) * 16 + (lane >> 3);
                        COP[0] = (unsigned short)((pk & 0xffu) | ((nb4 & 0xffu) << 8)); COP[8] = (unsigned short)(((pk >> 8) & 0xffu) | (nb4 & 0xff00u));
                    }
                    if (lane == 0) ((float*)(ws + WS_CS))[tok] = cm * (1.0f / 256.0f);
                }
                cur[k] = nxt[k]; }
        }
    }
}
#define PV_LOADG(RB, k, g) do { const int gg_ = (g) & 15; \
        const unsigned pr_ = ((g) >= 16 ? mnx : mcu)[(k) * 96 + qq * 16 + gg_]; \
        cfr[k] = ((g) >= 16 ? mnx : mcu)[(k) * 96 + 64 + qq * 8 + (gg_ >> 1)]; \
        const int va_ = (int)((pr_ & 0xffffu) << 9) + lanebase, vb_ = (int)((pr_ >> 16) << 9) + lanebase; \
        _Pragma("unroll") for (int blk_ = 0; blk_ < 4; ++blk_) { \
            const u32x2 a_ = __builtin_bit_cast(u32x2, __builtin_amdgcn_raw_buffer_load_b64(rsV, va_ + 8 * (blk_ & 1) + 256 * (blk_ >> 1), 0, 0)); \
            const u32x2 b_ = __builtin_bit_cast(u32x2, __builtin_amdgcn_raw_buffer_load_b64(rsV, vb_ + 8 * (blk_ & 1) + 256 * (blk_ >> 1), 0, 0)); \
            RB[blk_] = (u32x4){a_.x, a_.y, b_.x, b_.y}; } } while (0)
#define PV_COMPG(RB, k, g, CW) do { const unsigned cw_ = (CW); \
        const unsigned ra_ = ((g) & 1) ? __builtin_amdgcn_perm(cw_, cw_, 0x02020202u) : __builtin_amdgcn_perm(cw_, cw_, 0x00000000u); \
        const unsigned rb_ = ((g) & 1) ? __builtin_amdgcn_perm(cw_, cw_, 0x03030303u) : __builtin_amdgcn_perm(cw_, cw_, 0x01010101u); \
        const i32x8 A_ = {(int)(ra_ & mk0), (int)(ra_ & mk1), (int)(ra_ & mk2), (int)(ra_ & mk3), (int)(rb_ & mk0), (int)(rb_ & mk1), (int)(rb_ & mk2), (int)(rb_ & mk3)}; \
        _Pragma("unroll") for (int blk_ = 0; blk_ < 4; ++blk_) { \
            const i32x8 B_ = {(int)RB[blk_].x, (int)RB[blk_].y, (int)RB[blk_].z, (int)RB[blk_].w, 0, 0, 0, 0}; \
            acc[k][blk_] = __builtin_amdgcn_mfma_scale_f32_16x16x128_f8f6f4(A_, B_, acc[k][blk_], 0, 4, 0, 0x7f7f7f7f, 0, 0x7f7f7f7f); } } while (0)
__device__ __forceinline__ void phase_peer_v(KP kp, LAS unsigned char* lds, int wave_s) {
    const int lane = lane_id_asm(), wave = wave_s;
    unsigned char* ws = kp->ws;
    const __amdgpu_buffer_rsrc_t rsV = __builtin_amdgcn_make_buffer_rsrc((void*)(ws + WS_EV), 0, NEXP * V_BITS * 128, 0x00020000);
    const float* mod = (const float*)(ws + WS_MOD); const float* fg = kp->in[22];
    const bf16_t* X1 = (const bf16_t*)(ws + WS_X1B); float* OUT = kp->out;
    const unsigned* IDP = (const unsigned*)(ws + WS_IDP); const unsigned* COP = (const unsigned*)(ws + WS_COP); const float* CS = (const float*)(ws + WS_CS);
    const int nn = lane & 15, qq = lane >> 4;
    const int lanebase = 16 * nn;
    const unsigned msel = 0xFFu << (8 * (nn & 3));
    const unsigned mk0 = (nn >> 2) == 0 ? msel : 0u, mk1 = (nn >> 2) == 1 ? msel : 0u, mk2 = (nn >> 2) == 2 ? msel : 0u, mk3 = (nn >> 2) == 3 ? msel : 0u;
    const int col0 = 32 * nn + 4 * qq;
    const int tstride = gridDim.x * 8;
    int tok0 = blockIdx.x * 8 + wave;
    LAS unsigned* mcu = (LAS unsigned*)(lds + wave * 3072);
    LAS unsigned* mnx = mcu + 384;
    if (tok0 < T) {
        unsigned idw[4], cfw[4]; float csc[4], csn[4];
#pragma unroll
        for (int k = 0; k < 4; ++k) { const int tk = tok0 + k * tstride < T ? tok0 + k * tstride : tok0;
            idw[k] = IDP[(size_t)tk * 64 + lane]; cfw[k] = COP[(size_t)tk * 32 + (lane & 31)]; csc[k] = CS[tk]; csn[k] = csc[k]; }
#pragma unroll
        for (int k = 0; k < 4; ++k) { mcu[k * 96 + lane] = idw[k]; if (lane < 32) mcu[k * 96 + 64 + lane] = cfw[k]; mnx[k * 96 + lane] = idw[k]; if (lane < 32) mnx[k * 96 + 64 + lane] = cfw[k]; }
        asm volatile("" ::: "memory");
        u32x4 rb0[4], rb1[4], rb2[4], rb3[4]; unsigned cfr[4];
        PV_LOADG(rb0, 0, 0); PV_LOADG(rb1, 1, 0); PV_LOADG(rb2, 2, 0);
        for (; tok0 < T; tok0 += 4 * tstride) {
            const bool has_next = tok0 + 4 * tstride < T;
            if (has_next) {
#pragma unroll
                for (int k = 0; k < 4; ++k) { const int tk = tok0 + (4 + k) * tstride < T ? tok0 + (4 + k) * tstride : tok0 + 4 * tstride;
                    idw[k] = IDP[(size_t)tk * 64 + lane]; cfw[k] = COP[(size_t)tk * 32 + (lane & 31)]; csn[k] = CS[tk]; }
            }
            f32x4 acc[4][4]; u32x2 xwa[4], xwb[4]; f32x4 gva[4], gvb[4];
#pragma unroll
            for (int k = 0; k < 4; ++k)
#pragma unroll
                for (int i = 0; i < 4; ++i) acc[k][i] = (f32x4){0.f, 0.f, 0.f, 0.f};
#pragma unroll 1
            for (int G = 0; G < 16; ++G) {
                if (G == 14) {
                    const bf16_t* xp = X1 + (size_t)tok0 * D + col0; const float* gp = mod + (size_t)(tok0 / SEQ) * NMOD + 5 * 1024 + col0;
#pragma unroll
                    for (int blk = 0; blk < 4; ++blk) { xwa[blk] = *(const u32x2*)(xp + 16 * (blk & 1) + 512 * (blk >> 1)); gva[blk] = *(const f32x4*)(gp + 16 * (blk & 1) + 512 * (blk >> 1)); }
                }
                if (G == 8) {
#pragma unroll
                    for (int k = 0; k < 4; ++k) { mnx[k * 96 + lane] = idw[k]; if (lane < 32) mnx[k * 96 + 64 + lane] = cfw[k]; }
                    asm volatile("" ::: "memory");
                }
                { const unsigned c_ = cfr[0]; PV_LOADG(rb3, 3, G);     PV_COMPG(rb0, 0, G, c_); }
                { const unsigned c_ = cfr[1]; PV_LOADG(rb0, 0, G + 1); PV_COMPG(rb1, 1, G, c_); }
                { const unsigned c_ = cfr[2]; PV_LOADG(rb1, 1, G + 1); PV_COMPG(rb2, 2, G, c_); }
                { const unsigned c_ = cfr[3]; PV_LOADG(rb2, 2, G + 1); PV_COMPG(rb3, 3, G, c_); }
            }
            f32x4 fgv[4];
#pragma unroll
            for (int blk = 0; blk < 4; ++blk) fgv[blk] = *(const f32x4*)(fg + col0 + 16 * (blk & 1) + 512 * (blk >> 1));
#pragma unroll
            for (int k = 0; k < 4; ++k) { const int tok = tok0 + k * tstride;
                if (k < 3) { const int tk = tok0 + (k + 1) * tstride < T ? tok0 + (k + 1) * tstride : tok0; const bf16_t* xp = X1 + (size_t)tk * D + col0; const float* gp = mod + (size_t)(tk / SEQ) * NMOD + 5 * 1024 + col0;
#pragma unroll
                    for (int blk = 0; blk < 4; ++blk) { xwb[blk] = *(const u32x2*)(xp + 16 * (blk & 1) + 512 * (blk >> 1)); gvb[blk] = *(const f32x4*)(gp + 16 * (blk & 1) + 512 * (blk >> 1)); } }
                if (tok < T) {
                    float* xr = OUT + (size_t)tok * D + col0;
                    f32x4 xv[4]; float ss = 0.f;
#pragma unroll
                    for (int blk = 0; blk < 4; ++blk) {
                        const f32x4 x1v = {bf_lo(xwa[blk].x), bf_hi(xwa[blk].x), bf_lo(xwa[blk].y), bf_hi(xwa[blk].y)};
                        xv[blk] = x1v + gva[blk] * (acc[k][blk] * csc[k]);
                        ss += xv[blk][0] * xv[blk][0] + xv[blk][1] * xv[blk][1] + xv[blk][2] * xv[blk][2] + xv[blk][3] * xv[blk][3]; }
                    ss = wave_sum(ss);
                    const float r = rsqrtf(ss * (1.0f / D) + EPS);
#pragma unroll
                    for (int blk = 0; blk < 4; ++blk) *(f32x4*)(xr + 16 * (blk & 1) + 512 * (blk >> 1)) = xv[blk] * r * fgv[blk];
                }
#pragma unroll
                for (int blk = 0; blk < 4; ++blk) { gva[blk] = gvb[blk]; xwa[blk] = xwb[blk]; }
                csc[k] = csn[k]; }
            { LAS unsigned* t_ = mcu; mcu = mnx; mnx = t_; }
        }
    }
}

__global__ void __launch_bounds__(NTHREADS, 2) fwd_megakernel(Params P_) {
    extern __shared__ __attribute__((aligned(16))) unsigned char lds_raw[];
    LAS unsigned char* lds = (LAS unsigned char*)lds_raw;
    KP kp = (KP)__builtin_amdgcn_kernarg_segment_ptr();
    volatile LAS unsigned* ctl = (volatile LAS unsigned*)(lds + LDS_CTL_OFF);
    const int wave_s = __builtin_amdgcn_readfirstlane(threadIdx.x >> 6);
    if (threadIdx.x < 4) ctl[threadIdx.x] = 0u;
    __syncthreads();
    { XcdBarrier b0 = xcd_barrier_post((unsigned*)(kp->ws + WS_CTL), ctl, wave_s); (void)b0; }
    const int lo = kp->ph_lo, hi = kp->ph_hi;
#define IN(k) (lo <= (k) && (k) < hi)
#define FRESH() asm volatile("" : "+s"(kp) :: "memory")
#define SEAM(k) do { if (IN(k) && IN((k) + 1)) { { XcdBarrier b_; b_.bar = (unsigned*)(kp->ws + WS_CTL); b_.x = xb_xcc_id(); b_.st = ctl; xcd_barrier(b_, wave_s); } } FRESH(); } while (0)

    if (IN(0)) phase_prep(kp, lds, wave_s);
#if DBG_REPEAT
    FRESH();
    if (IN(0)) phase_prep(kp, lds, wave_s);
#endif
    SEAM(0);
    if (IN(1)) { phase_aux(kp, lds, wave_s); phase_w8(kp, lds, wave_s); unsigned char* ws = kp->ws; phase_norm_ada<true>(kp->in[0], kp->in[4], (const float*)(ws + WS_MOD), 0, 1024, (bf16_t*)nullptr, ws + WS_X8, (float*)(ws + WS_X8S), wave_s); }
#if DBG_REPEAT
    FRESH();
    if (IN(1)) { unsigned char* ws = kp->ws; phase_norm_ada<true>(kp->in[0], kp->in[4], (const float*)(ws + WS_MOD), 0, 1024, (bf16_t*)nullptr, ws + WS_X8, (float*)(ws + WS_X8S), wave_s); }
#endif
    SEAM(1);
    if (IN(2)) {
        unsigned char* ws = kp->ws;
        { pg8::Gemm g{(const bf16_t*)(ws + WS_X8), (const bf16_t*)(ws + WS_WP8), T, 3584, D / 2}; pg8::StaticOrder S; S.init(T, 3584, gridDim.x, blockIdx.x);
          EpiIn E{EpiProj{(const float*)(ws + WS_BINP), (bf16_t*)(ws + WS_PG), (bf16_t*)(ws + WS_PG) + (size_t)T * 512, (const float*)(ws + WS_X8S), (const float*)(ws + WS_WP8S)},
                  EpiGate{(const float*)(ws + WS_BINP), (const float*)(ws + WS_X8S), (const float*)(ws + WS_WGS), (bf16_t*)(ws + WS_SG)}};
          pg8::gemm_phase<EpiIn>(lds, g, S, E, wave_s); }
    }
#if DBG_REPEAT
    FRESH();
    if (IN(2)) {
        unsigned char* ws = kp->ws;
        { pg8::Gemm g{(const bf16_t*)(ws + WS_X8), (const bf16_t*)(ws + WS_WP8), T, 3584, D / 2}; pg8::StaticOrder S; S.init(T, 3584, gridDim.x, blockIdx.x);
          EpiIn E{EpiProj{(const float*)(ws + WS_BINP), (bf16_t*)(ws + WS_PG), (bf16_t*)(ws + WS_PG) + (size_t)T * 512, (const float*)(ws + WS_X8S), (const float*)(ws + WS_WP8S)},
                  EpiGate{(const float*)(ws + WS_BINP), (const float*)(ws + WS_X8S), (const float*)(ws + WS_WGS), (bf16_t*)(ws + WS_SG)}};
          pg8::gemm_phase<EpiIn>(lds, g, S, E, wave_s); }
    }
#endif
    SEAM(2);
    if (IN(3)) phase_branches(kp, lds, wave_s);
#if DBG_REPEAT
    FRESH();
    if (IN(3)) phase_branches(kp, lds, wave_s);
#endif
    SEAM(3);
    if (IN(4)) {
        unsigned char* ws = kp->ws;
        pg8::Gemm g{(const bf16_t*)(ws + WS_MC), (const bf16_t*)(ws + WS_WPC), T, D, D}; pg8::StaticOrder S; S.init(T, D, gridDim.x, blockIdx.x);
        EpiMerge E{(const bf16_t*)(ws + WS_SG), (bf16_t*)(ws + WS_PG)};
        pg8::gemm_phase<EpiMerge>(lds, g, S, E, wave_s);
    }
#if DBG_REPEAT
    FRESH();
    if (IN(4)) {
        unsigned char* ws = kp->ws;
        pg8::Gemm g{(const bf16_t*)(ws + WS_MC), (const bf16_t*)(ws + WS_WPC), T, D, D}; pg8::StaticOrder S; S.init(T, D, gridDim.x, blockIdx.x);
        EpiMerge E{(const bf16_t*)(ws + WS_SG), (bf16_t*)(ws + WS_PG)};
        pg8::gemm_phase<EpiMerge>(lds, g, S, E, wave_s);
    }
#endif
    SEAM(4);
    if (IN(5)) {
        unsigned char* ws = kp->ws;
        pg8::Gemm g{(const bf16_t*)(ws + WS_PG), (const bf16_t*)(ws + WS_WOUT), T, D, D}; pg8::StaticOrder S; S.init(T, D, gridDim.x, blockIdx.x);
        EpiResid E{kp->in[0], (const float*)(ws + WS_MOD) + 2 * 1024, (bf16_t*)(ws + WS_X1B), (const float*)(ws + WS_A2), (bf16_t*)(ws + WS_H), (float*)(ws + WS_SSQ)};
        pg8::gemm_phase<EpiResid>(lds, g, S, E, wave_s);
    }
#if DBG_REPEAT
    FRESH();
    if (IN(5)) {
        unsigned char* ws = kp->ws;
        pg8::Gemm g{(const bf16_t*)(ws + WS_PG), (const bf16_t*)(ws + WS_WOUT), T, D, D}; pg8::StaticOrder S; S.init(T, D, gridDim.x, blockIdx.x);
        EpiResid E{kp->in[0], (const float*)(ws + WS_MOD) + 2 * 1024, (bf16_t*)(ws + WS_X1B), (const float*)(ws + WS_A2), (bf16_t*)(ws + WS_H), (float*)(ws + WS_SSQ)};
        pg8::gemm_phase<EpiResid>(lds, g, S, E, wave_s);
    }
#endif
    SEAM(5);
    if (IN(7)) {
        unsigned char* ws = kp->ws;
        pg8::Gemm g{(const bf16_t*)(ws + WS_H), (const bf16_t*)(ws + WS_WQ), T, 2048, D}; pg8::StaticOrder S; S.init(T, 2048, gridDim.x, blockIdx.x);
        EpiQ E{(bf16_t*)(ws + WS_SG), (const float*)(ws + WS_SSQ), (const float*)(ws + WS_BIAS2)};
        pg8::gemm_phase<EpiQ>(lds, g, S, E, wave_s);
    }
#if DBG_REPEAT
    FRESH();
    if (IN(7)) {
        unsigned char* ws = kp->ws;
        pg8::Gemm g{(const bf16_t*)(ws + WS_H), (const bf16_t*)(ws + WS_WQ), T, 2048, D}; pg8::StaticOrder S; S.init(T, 2048, gridDim.x, blockIdx.x);
        EpiQ E{(bf16_t*)(ws + WS_SG), (const float*)(ws + WS_SSQ), (const float*)(ws + WS_BIAS2)};
        pg8::gemm_phase<EpiQ>(lds, g, S, E, wave_s);
    }
#endif
    if (IN(7) && IN(8)) { asm volatile("s_waitcnt vmcnt(0)" ::: "memory"); __syncthreads();
        if (wave_s == 0 && lane_id_asm() == 0) { __builtin_amdgcn_fence(__ATOMIC_ACQUIRE, "agent"); asm volatile("s_waitcnt vmcnt(0)" ::: "memory"); }
        __syncthreads(); }
    FRESH();
    if (IN(8)) phase_topk(kp, lds, wave_s);
#if DBG_REPEAT
    FRESH();
    if (IN(8)) phase_topk(kp, lds, wave_s);
#endif
    SEAM(8);
    if (IN(9)) phase_peer_u(kp, lds, wave_s);
    SEAM(9);
    if (IN(10)) phase_peer_v(kp, lds, wave_s);
#undef IN
#undef SEAM
#undef FRESH
}

#define DBG_PHASE_SKIP(ph) (0)
#define DBG_LAST 9
#define DBG_DUMP_N ((size_t)3584 * 1024)
#define DBG_DUMP_BF16 1
#ifdef DBG_DUMP_OFF
__global__ void dbg_dump(const unsigned char* ws, float* out) {
    const size_t n = DBG_DUMP_N;
    for (size_t i = (size_t)blockIdx.x * blockDim.x + threadIdx.x; i < (size_t)T * D; i += (size_t)gridDim.x * blockDim.x) {
        const size_t j = (i * 7919ull) % n;
        float v;
        if (DBG_DUMP_BF16) v = __uint_as_float(((unsigned)((const bf16_t*)(ws + DBG_DUMP_OFF))[j]) << 16);
        else v = ((const float*)(ws + DBG_DUMP_OFF))[j];
        out[i] = v;
    }
}
#endif
#ifndef MK_N_LAUNCHES
#define MK_N_LAUNCHES 1
#endif
extern "C" void kernel_launch(void* const* d_in, const int* in_sizes, int n_in, void* d_out, int out_size, void* d_ws, size_t ws_size, hipStream_t stream) {
    static int grid = 0;
    if (grid == 0) {
        if (n_in != 23 || in_sizes[0] != T * D || out_size != T * D || ws_size < WS_END) {
            fprintf(stderr, "kernel_launch: unexpected shapes (n_in %d, in0 %d, out %d, ws %zu); nothing launched\n", n_in, n_in > 0 ? in_sizes[0] : -1, out_size, ws_size); grid = -1; return; }
        int dev = 0, cus = 0, per_cu = 0;
        if (hipGetDevice(&dev) != hipSuccess || hipDeviceGetAttribute(&cus, hipDeviceAttributeMultiprocessorCount, dev) != hipSuccess) { grid = -1; return; }
        if (hipFuncSetAttribute((const void*)fwd_megakernel, hipFuncAttributeMaxDynamicSharedMemorySize, LDS_BYTES) != hipSuccess) { fprintf(stderr, "kernel_launch: hipFuncSetAttribute failed\n"); grid = -1; return; }
        if (hipOccupancyMaxActiveBlocksPerMultiprocessor(&per_cu, (const void*)fwd_megakernel, NTHREADS, LDS_BYTES) != hipSuccess || per_cu < 1) {
            fprintf(stderr, "kernel_launch: occupancy query says %d blocks per CU; nothing launched\n", per_cu); grid = -1; return; }
        grid = cus;
    }
    if (grid < 0) return;
    (void)hipMemsetAsync((char*)d_ws + WS_CTL, 0, 16384, stream);
    Params p{};
    for (int i = 0; i < 23; ++i) p.in[i] = (const float*)d_in[i];
    p.out = (float*)d_out; p.ws = (unsigned char*)d_ws;
#if MK_N_LAUNCHES == 1
    p.ph_lo = 0; p.ph_hi = 11;
    void* args[] = {&p};
    hipError_t e = hipLaunchCooperativeKernel((const void*)fwd_megakernel, dim3(grid), dim3(NTHREADS), args, LDS_BYTES, stream);
    if (e != hipSuccess) fprintf(stderr, "kernel_launch: cooperative launch failed: %s (grid %d)\n", hipGetErrorString(e), grid);
#else
    for (int ph = 0; ph < 11; ++ph) { if (DBG_PHASE_SKIP(ph)) continue; p.ph_lo = ph; p.ph_hi = ph + 1; hipLaunchKernelGGL(fwd_megakernel, dim3(grid), dim3(NTHREADS), LDS_BYTES, stream, p); }
#ifdef DBG_DUMP_OFF
    hipLaunchKernelGGL(dbg_dump, dim3(1024), dim3(256), 0, stream, (const unsigned char*)d_ws, (float*)d_out);
#endif
#endif
}
```

```cpp
#include <hip/hip_runtime.h>
#include <hip/hip_cooperative_groups.h>
#include <cstdio>
#include <cstdint>
namespace cg = cooperative_groups;
#define DBG_NO_DOT2 1
#define DBG_REPEAT 0

#define LAS __attribute__((address_space(3)))
typedef unsigned short bf16_t;
typedef short bf16x8 __attribute__((ext_vector_type(8)));
typedef float f32x4 __attribute__((ext_vector_type(4)));
typedef float f32x2 __attribute__((ext_vector_type(2)));
typedef float f32x16 __attribute__((ext_vector_type(16)));
typedef unsigned u32x4 __attribute__((ext_vector_type(4)));
typedef unsigned u32x2 __attribute__((ext_vector_type(2)));
typedef __bf16 bf16x2_t __attribute__((ext_vector_type(2)));

constexpr int T = 32768, D = 1024, SEQ = 8192, NBATCH = 4, INW = 3584, NMOD = 6 * 1024;
constexpr int NEXP = 16384;
constexpr float EPS = 1e-6f;
constexpr int NTHREADS = 512;
constexpr int LDS_BYTES = 131072 + 1024;
constexpr int LDS_CTL_OFF = 131072;

constexpr size_t MiB = 1024ull * 1024ull;
constexpr size_t WS_CTL = 0;
constexpr size_t WS_MOD = 16384;
constexpr size_t WS_BINP = 114688;
constexpr size_t WS_WIN = 131072;
constexpr size_t WS_WPC = WS_WIN + 7340032;
constexpr size_t WS_WOUT = WS_WPC + 2 * MiB;
constexpr size_t WS_WQ = WS_WOUT + 2 * MiB;
constexpr size_t WS_EU = 16 * MiB;
constexpr size_t WS_EV = 32 * MiB;
constexpr size_t WS_SU = 48 * MiB;
constexpr size_t WS_SV = 48 * MiB + 65536;
constexpr size_t WS_H = 80 * MiB;
constexpr size_t WS_PG = 144 * MiB;
constexpr size_t WS_SG = 208 * MiB;
constexpr size_t WS_MC = 336 * MiB;
constexpr size_t WS_IDX = 400 * MiB;
constexpr size_t WS_GATE = 416 * MiB;
constexpr size_t WS_HB = WS_PG;
constexpr size_t WS_HS = WS_PG + 32 * MiB;
constexpr size_t WS_WG8 = WS_WIN + 1536 * 1024;
constexpr size_t WS_WGS = WS_WIN + 4 * MiB + 1536 * 4;
constexpr size_t WS_X8 = 436 * MiB;
constexpr size_t WS_X8S = 468 * MiB;
constexpr size_t WS_X1B = WS_MC;
constexpr size_t WS_A2 = 432 * MiB;
constexpr size_t WS_BIAS2 = WS_A2 + 16384;
constexpr size_t WS_SSQ = WS_A2 + 65536;
constexpr size_t WS_CO = WS_SG;
constexpr size_t WS_IDP = WS_SG + 16 * MiB;
constexpr size_t WS_COP = WS_SG + 32 * MiB;
constexpr size_t WS_CS = WS_SG + 48 * MiB;
constexpr size_t WS_WP8 = WS_WIN;
constexpr size_t WS_WP8S = WS_WIN + 4 * MiB;
constexpr size_t WS_PMAX = WS_WIN + 5 * MiB;
constexpr size_t WS_END = 469 * MiB;
static_assert(WS_WQ + 4 * MiB <= WS_EU, "weight region overflow");

struct Params;
typedef const __attribute__((address_space(4))) Params* KP;
struct Params {
    const float* in[23];
    float* out;
    unsigned char* ws;
    int ph_lo, ph_hi;
};

typedef __bf16 bf16x2v_t __attribute__((ext_vector_type(2)));
__device__ __forceinline__ unsigned cvt_pk_bf16(float lo, float hi) { return __builtin_bit_cast(unsigned, __builtin_convertvector((f32x2){lo, hi}, bf16x2v_t)); }
__device__ __forceinline__ float bf_lo(unsigned u) { return __uint_as_float(u << 16); }
__device__ __forceinline__ float bf_hi(unsigned u) { return __uint_as_float(u & 0xffff0000u); }
__device__ __forceinline__ float fast_sigmoid(float x) { return __builtin_amdgcn_rcpf(1.0f + __builtin_amdgcn_exp2f(-1.44269504089f * x)); }
__device__ __forceinline__ int lane_id_asm() { int l; asm volatile("v_mbcnt_lo_u32_b32 %0, -1, 0\n\tv_mbcnt_hi_u32_b32 %0, -1, %0" : "=v"(l)); return l; }
#define DPPI(old, x, ctrl, rmask, bc) __builtin_amdgcn_update_dpp((old), (x), (ctrl), (rmask), 0xF, (bc))
__device__ __forceinline__ float wave_sum(float v) {
    v += __int_as_float(DPPI(0, __float_as_int(v), 0xB1, 0xF, true)); v += __int_as_float(DPPI(0, __float_as_int(v), 0x4E, 0xF, true));
    v += __int_as_float(DPPI(0, __float_as_int(v), 0x141, 0xF, true)); v += __int_as_float(DPPI(0, __float_as_int(v), 0x140, 0xF, true));
    v += __int_as_float(DPPI(0, __float_as_int(v), 0x142, 0xA, false)); v += __int_as_float(DPPI(0, __float_as_int(v), 0x143, 0xC, false));
    return __int_as_float(__builtin_amdgcn_readlane(__float_as_int(v), 63));
}
__device__ __forceinline__ float wave_max(float v) {
    v = fmaxf(v, __int_as_float(DPPI(0, __float_as_int(v), 0xB1, 0xF, true))); v = fmaxf(v, __int_as_float(DPPI(0, __float_as_int(v), 0x4E, 0xF, true)));
    v = fmaxf(v, __int_as_float(DPPI(0, __float_as_int(v), 0x141, 0xF, true))); v = fmaxf(v, __int_as_float(DPPI(0, __float_as_int(v), 0x140, 0xF, true)));
    v = fmaxf(v, __int_as_float(DPPI(0, __float_as_int(v), 0x142, 0xA, false))); v = fmaxf(v, __int_as_float(DPPI(0, __float_as_int(v), 0x143, 0xC, false)));
    return __int_as_float(__builtin_amdgcn_readlane(__float_as_int(v), 63));
}
__device__ __forceinline__ int in_colmap(int n) {
    if (n < 512) return n;
    if (n < 1536) { const int t = (n - 512) >> 8, r = (n - 512) & 255; return r < 128 ? 512 + 128 * t + r : 1024 + 128 * t + (r - 128); }
    const int t = (n - 1536) >> 8, r = (n - 1536) & 255;
    return r < 128 ? 1536 + 128 * t + r : 2560 + 128 * t + (r - 128);
}

#define XB_TMO      128
#define XB_XCNT(j)  (256  + 64 * (j))
#define XB_XSUB(j)  (1280 + 64 * (j))
#define XB_XGEN(j)  (2304 + 64 * (j))
#define XB_TOP      3328
#define XB_TOPGEN   3392
#define XCD_BAR_WORDS 3456
#define XB_SPIN_CAP (1u << 22)
__device__ __forceinline__ unsigned xb_ld(unsigned* p)              { return __hip_atomic_load(p, __ATOMIC_RELAXED, __HIP_MEMORY_SCOPE_AGENT); }
__device__ __forceinline__ unsigned xb_add(unsigned* p, unsigned v) { return __hip_atomic_fetch_add(p, v, __ATOMIC_RELAXED, __HIP_MEMORY_SCOPE_AGENT); }
__device__ __forceinline__ unsigned xb_xcc_id() { return (unsigned)__builtin_amdgcn_s_getreg((3 << 11) | 20) & 0xFu; }
#define XB_SPIN(cond, bar) do { unsigned _sp = 0; while (cond) { __builtin_amdgcn_s_sleep(1); \
    if ((++_sp & 255u) == 0u) { if (xb_ld(&(bar)[XB_TMO])) break; if (_sp > XB_SPIN_CAP) { atomicAdd(&(bar)[XB_TMO], 1u); break; } } } } while (0)
struct XcdBarrier { unsigned* bar; unsigned x; volatile LAS unsigned* st; };
__device__ __forceinline__ XcdBarrier xcd_barrier_post(unsigned* bar, volatile LAS unsigned* st, int wave_s) {
    XcdBarrier b; b.bar = bar; b.x = xb_xcc_id(); b.st = st;
    if (wave_s == 0 && lane_id_asm() == 0) (void)xb_add(&bar[XB_XCNT(b.x)], 1u);
    return b;
}
__device__ __forceinline__ void xcd_barrier_complete(unsigned* bar, unsigned x, unsigned& nloc, unsigned& nx) {
    const unsigned G = gridDim.x * gridDim.y * gridDim.z;
    unsigned sum, cnt, mine, sp = 0u;
    for (;;) {
        sum = 0u; cnt = 0u; mine = 0u;
#pragma unroll
        for (unsigned j = 0; j < 16; ++j) { const unsigned c = xb_ld(&bar[XB_XCNT(j)]); sum += c; cnt += (c > 0u) ? 1u : 0u; mine = (j == x) ? c : mine; }
        if (sum == G) break;
        __builtin_amdgcn_s_sleep(1);
        if ((++sp & 255u) == 0u) { if (xb_ld(&bar[XB_TMO])) break; if (sp > XB_SPIN_CAP) { atomicAdd(&bar[XB_TMO], 1u); break; } }
    }
    nloc = mine > 0u ? mine : 1u; nx = cnt > 0u ? cnt : 1u;
}
__device__ __forceinline__ void xcd_barrier(const XcdBarrier& b, int wave_s) {
    asm volatile("s_waitcnt vmcnt(0)" ::: "memory");
    __syncthreads();
    if (wave_s == 0 && lane_id_asm() == 0) {
        unsigned* bar = b.bar;
        __builtin_amdgcn_s_waitcnt(0);
        unsigned nloc = b.st[0], nx = b.st[1];
        if (nloc == 0u) { xcd_barrier_complete(bar, b.x, nloc, nx); b.st[0] = nloc; b.st[1] = nx; }
        const unsigned old = xb_add(&bar[XB_XSUB(b.x)], 1u);
        const unsigned gen = old / nloc;
        if (old + 1u == (gen + 1u) * nloc) {
            __builtin_amdgcn_fence(__ATOMIC_RELEASE, "agent");
            asm volatile("s_waitcnt vmcnt(0)" ::: "memory");
            const unsigned og = xb_add(&bar[XB_TOP], 1u);
            const unsigned tg = og / nx;
            if (og + 1u == (tg + 1u) * nx) xb_add(&bar[XB_TOPGEN], 1u);
            else XB_SPIN(xb_ld(&bar[XB_TOPGEN]) == tg, bar);
            __builtin_amdgcn_fence(__ATOMIC_ACQUIRE, "agent");
            xb_add(&bar[XB_XGEN(b.x)], 1u);
            asm volatile("s_waitcnt vmcnt(0)" ::: "memory");
        } else {
            XB_SPIN(xb_ld(&bar[XB_XGEN(b.x)]) == gen, bar);
            __builtin_amdgcn_fence(__ATOMIC_ACQUIRE, "agent");
            asm volatile("s_waitcnt vmcnt(0)" ::: "memory");
        }
    }
    __syncthreads();
}

namespace pg8 {
constexpr int BM = 256, BK = 64, HALF = 128, HTB = HALF * BK * 2, STAGE_BYTES = 8 * HTB, NXCD = 8, WGM = 8;
__host__ __device__ __forceinline__ int lds_byte(int r, int c) { const int st = (r >> 4) * 2 + (c >> 5), rr = r & 15, cc = c & 31, ob = rr * 64 + cc * 2; return st * 1024 + (ob ^ (((ob >> 9) & 1) << 5)); }
__host__ __device__ __forceinline__ void stage_rc(int b, int& R, int& C) { const int st = b / 1024, sb = b % 1024, swz = sb ^ (((sb >> 9) & 1) << 5); R = (st >> 1) * 16 + swz / 64; C = (st & 1) * 32 + (swz % 64) / 2; }
__host__ __device__ __forceinline__ int perm32(int rho) { const int n = rho >> 4, i = rho & 15; return 8 * (i >> 2) + 4 * n + (i & 3); }
struct Unit { int pm, pn; };
struct Gemm { const bf16_t* A; const bf16_t* Bt; int M, N, K; };
struct StaticOrder {
    int nM, nN, nwg, G, c;
    __host__ __device__ void init(int M, int N, int G_, int c_) { nM = M / BM; nN = N / BM; nwg = nM * nN; G = G_; c = c_; }
    __host__ __device__ bool next(int i, Unit& u) const {
        const long L = (long)i * G + c; if (L >= nwg) return false;
        int wgid = (int)L; { const int q = nwg / NXCD, r = nwg % NXCD, xcd = wgid % NXCD, off = wgid / NXCD; wgid = (xcd < r ? xcd * (q + 1) : r * (q + 1) + (xcd - r) * q) + off; }
        const int nig = WGM * nN, gid = wgid / nig, fm = gid * WGM, gsz = (nM - fm) < WGM ? (nM - fm) : WGM;
        u.pm = fm + ((wgid % nig) % gsz); u.pn = (wgid % nig) / gsz; return true;
    }
};
typedef int i32x8_t __attribute__((ext_vector_type(8)));
typedef int i32x4_t __attribute__((ext_vector_type(4)));
template <bool FP8> struct FragT { typedef bf16x8 type[2]; };
template <> struct FragT<true> { typedef i32x8_t type; };
__device__ __forceinline__ void ldfrag(bf16x8 (&d)[2], const LAS unsigned char* p) { d[0] = *(const LAS bf16x8*)p; d[1] = *(const LAS bf16x8*)(p + 1024); }
__device__ __forceinline__ void ldfrag(i32x8_t& d, const LAS unsigned char* p) { const i32x4_t lo = *(const LAS i32x4_t*)p, hi = *(const LAS i32x4_t*)(p + 1024); d = (i32x8_t){lo[0], lo[1], lo[2], lo[3], hi[0], hi[1], hi[2], hi[3]}; }
__device__ __forceinline__ void mma1(f32x4& acc, const bf16x8 (&b)[2], const bf16x8 (&a)[2]) {
    acc = __builtin_amdgcn_mfma_f32_16x16x32_bf16(b[0], a[0], acc, 0, 0, 0); acc = __builtin_amdgcn_mfma_f32_16x16x32_bf16(b[1], a[1], acc, 0, 0, 0); }
__device__ __forceinline__ void mma1(f32x4& acc, const i32x8_t& b, const i32x8_t& a) {
    asm volatile("v_mfma_scale_f32_16x16x128_f8f6f4 %0, %1, %2, %0, %3, %3 op_sel_hi:[0,0,0]" : "+v"(acc) : "v"(b), "v"(a), "v"(0x7f7f7f7f)); }
template <class Epi>
__device__ __forceinline__ void gemm_phase(LAS unsigned char* lds, const Gemm g, const StaticOrder& S, const Epi& E, int wave_s) {
    const int lane = lane_id_asm(), wid = wave_s, tid = wid * 64 + lane, wr = wid >> 2, wc = wid & 3, fr = lane & 15, fq = lane >> 4;
    const int K = g.K, nt = K / BK;
    unsigned voffA[2], voffB[2];
#pragma unroll
    for (int i = 0; i < 2; ++i) { int R, C; stage_rc(tid * 16 + i * 8192, R, C); const int Rb = Epi::PERM ? ((R & ~31) + perm32(R & 31)) : R;
        voffA[i] = (unsigned)(R * K + C) * 2u; voffB[i] = (unsigned)(Rb * K + C) * 2u; }
    const size_t kstep = (size_t)(BK * 2);
    const size_t hstep = (size_t)HALF * K * 2;
    const size_t tstep = 2 * hstep;
    const unsigned ldsw = (unsigned)wid * 1024u;
    const int aoff = lds_byte(wr * 64 + fr, fq * 8), boff = lds_byte(wc * 32 + fr, fq * 8);
#define PG8_SA(b, h) (((b) * 2 + (h)) * HTB)
#define PG8_SB(b, h) ((4 + (b) * 2 + (h)) * HTB)
#define PG8_STAGE(bufoff, gbase, voff) do { _Pragma("unroll") for (int _i = 0; _i < 2; ++_i) \
        __builtin_amdgcn_global_load_lds((const unsigned*)((const char*)(gbase) + (voff)[_i]), (LAS unsigned*)(lds + (bufoff) + ldsw + _i * 8192), 16, 0, 0); } while (0)
#define PG8_LDA(dst, b, h) do { _Pragma("unroll") for (int m = 0; m < 4; ++m) ldfrag(dst[m], lds + PG8_SA(b, h) + aoff + m * 2048); } while (0)
#define PG8_LDB(dst, b, h) do { _Pragma("unroll") for (int n = 0; n < 2; ++n) ldfrag(dst[n], lds + PG8_SB(b, h) + boff + n * 2048); } while (0)
#define PG8_MMA(ai, bj, At, Bt) do { __builtin_amdgcn_s_setprio(1); _Pragma("unroll") for (int m = 0; m < 4; ++m) _Pragma("unroll") for (int n = 0; n < 2; ++n) mma1(acc[ai][bj][m][n], Bt[n], At[m]); __builtin_amdgcn_s_setprio(0); } while (0)
#define PG8_WAIT_V(n) asm volatile("s_waitcnt vmcnt(" #n ")" ::: "memory")
#define PG8_WAIT_L(n) asm volatile("s_waitcnt lgkmcnt(" #n ")" ::: "memory")
#define PG8_BAR __builtin_amdgcn_s_barrier()
#define PG8_SCHED __builtin_amdgcn_sched_barrier(0)
    Unit cur, nxt; int ui = 0;
    if (!S.next(0, cur)) return;
    f32x4 acc[2][2][4][2];
#pragma unroll
    for (int a = 0; a < 2; ++a)
#pragma unroll
        for (int b = 0; b < 2; ++b)
#pragma unroll
            for (int m = 0; m < 4; ++m)
#pragma unroll
                for (int n = 0; n < 2; ++n) acc[a][b][m][n] = (f32x4){0.f, 0.f, 0.f, 0.f};
    typename FragT<Epi::FP8>::type At[4], B0[2], B1[2];
    const char* cA = (const char*)g.A + (size_t)cur.pm * tstep; const char* cB = (const char*)g.Bt + (size_t)cur.pn * tstep;
    PG8_STAGE(PG8_SB(0, 0), cB, voffB); PG8_STAGE(PG8_SB(0, 1), cB + hstep, voffB); PG8_STAGE(PG8_SA(0, 0), cA, voffA); PG8_STAGE(PG8_SA(0, 1), cA + hstep, voffA);
    if (wr == 1) PG8_BAR;
    PG8_WAIT_V(2); PG8_BAR;
    PG8_STAGE(PG8_SB(1, 0), cB + kstep, voffB); PG8_STAGE(PG8_SA(1, 0), cA + kstep, voffA); PG8_STAGE(PG8_SB(1, 1), cB + hstep + kstep, voffB);
    PG8_WAIT_V(6); PG8_BAR;
    for (;;) {
        const bool has_next = S.next(ui + 1, nxt);
        const char* nA = has_next ? (const char*)g.A + (size_t)nxt.pm * tstep : cA; const char* nB = has_next ? (const char*)g.Bt + (size_t)nxt.pn * tstep : cB;
#pragma unroll 1
        for (int t = 0; t < nt; t += 2) {
            const bool last = (t == nt - 2);
            const char* a1 = cA + (size_t)(t + 1) * kstep;
            const char* a2 = last ? nA : cA + (size_t)(t + 2) * kstep; const char* b2 = last ? nB : cB + (size_t)(t + 2) * kstep;
            const char* a3 = a2 + kstep; const char* b3 = b2 + kstep;
            if constexpr (Epi::HAS_MID) { if (t == nt / 2) E.mid(acc, cur, wr, wc, fr, fq); }
            PG8_LDB(B0, 0, 0); PG8_LDB(B1, 0, 1); PG8_SCHED; PG8_LDA(At, 0, 0); PG8_STAGE(PG8_SA(1, 1), a1 + hstep, voffA);
            PG8_WAIT_V(8); PG8_WAIT_L(0); PG8_BAR; PG8_MMA(0, 0, At, B0); PG8_MMA(0, 1, At, B1); PG8_BAR; PG8_SCHED;
            PG8_LDA(At, 0, 1); PG8_STAGE(PG8_SB(0, 0), b2, voffB); PG8_STAGE(PG8_SB(0, 1), b2 + hstep, voffB); PG8_STAGE(PG8_SA(0, 0), a2, voffA);
            PG8_WAIT_V(8); PG8_WAIT_L(0); PG8_BAR; PG8_MMA(1, 0, At, B0); PG8_MMA(1, 1, At, B1); PG8_BAR; PG8_SCHED;
            PG8_LDB(B0, 1, 0); PG8_LDB(B1, 1, 1); PG8_SCHED; PG8_LDA(At, 1, 0); PG8_STAGE(PG8_SA(0, 1), a2 + hstep, voffA);
            PG8_WAIT_V(8); PG8_WAIT_L(0); PG8_BAR; PG8_MMA(0, 0, At, B0); PG8_MMA(0, 1, At, B1); PG8_BAR; PG8_SCHED;
            PG8_LDA(At, 1, 1); PG8_STAGE(PG8_SB(1, 0), b3, voffB); PG8_STAGE(PG8_SB(1, 1), b3 + hstep, voffB); PG8_STAGE(PG8_SA(1, 0), a3, voffA);
            PG8_WAIT_V(8); PG8_WAIT_L(0); PG8_BAR; PG8_MMA(1, 0, At, B0); PG8_MMA(1, 1, At, B1); PG8_BAR; PG8_SCHED;
        }
        if (wr == 0) PG8_BAR;
        E(acc, cur, wr, wc, fr, fq);
        if (!has_next) break;
#pragma unroll
        for (int a = 0; a < 2; ++a)
#pragma unroll
            for (int b = 0; b < 2; ++b)
#pragma unroll
                for (int m = 0; m < 4; ++m)
#pragma unroll
                    for (int n = 0; n < 2; ++n) acc[a][b][m][n] = (f32x4){0.f, 0.f, 0.f, 0.f};
        cur = nxt; cA = nA; cB = nB; ++ui;
        if (wr == 1) PG8_BAR;
    }
    PG8_WAIT_V(0);
    PG8_BAR;
#undef PG8_SA
#undef PG8_SB
#undef PG8_STAGE
#undef PG8_LDA
#undef PG8_LDB
#undef PG8_MMA
#undef PG8_WAIT_V
#undef PG8_WAIT_L
#undef PG8_BAR
#undef PG8_SCHED
}
}
typedef f32x4 AccT[2][2][4][2];

struct EpiProj {
    static constexpr bool PERM = true, HAS_MID = false, FP8 = true;
    const float* bias; bf16_t* PB; bf16_t* GB; const float* RS; const float* CS;
    __device__ __forceinline__ void operator()(const AccT& acc, const pg8::Unit& u, int wr, int wc, int fr, int fq) const {
        const int row0 = u.pm * 256 + wr * 64 + fr, lc0 = wc * 32 + 8 * fq;
        f32x4 bv[2][2], cv[2][2];
#pragma unroll
        for (int bj = 0; bj < 2; ++bj)
#pragma unroll
            for (int n = 0; n < 2; ++n) { bv[bj][n] = *(const f32x4*)(bias + u.pn * 256 + bj * 128 + lc0 + 4 * n); cv[bj][n] = *(const f32x4*)(CS + u.pn * 256 + bj * 128 + lc0 + 4 * n); }
        if (u.pn >= 2 && u.pn < 6) {
            const int t = u.pn - 2;
#pragma unroll
            for (int ai = 0; ai < 2; ++ai)
#pragma unroll
                for (int m = 0; m < 4; ++m) {
                    const int row = row0 + ai * 128 + m * 16; const float rs = RS[row];
                    float o[8];
#pragma unroll
                    for (int n = 0; n < 2; ++n) { const f32x4 v = acc[ai][0][m][n] * (cv[0][n] * rs) + bv[0][n], gt = acc[ai][1][m][n] * (cv[1][n] * rs) + bv[1][n];
#pragma unroll
                        for (int j = 0; j < 4; ++j) o[n * 4 + j] = v[j] * fast_sigmoid(gt[j]); }
                    u32x4 w; w.x = cvt_pk_bf16(o[0], o[1]); w.y = cvt_pk_bf16(o[2], o[3]); w.z = cvt_pk_bf16(o[4], o[5]); w.w = cvt_pk_bf16(o[6], o[7]);
                    *(u32x4*)(GB + (size_t)row * 512 + t * 128 + lc0) = w;
                }
        } else {
            const bool isp = true;
            bf16_t* base = PB; const int ldc = 512; const int colt = u.pn * 256;
#pragma unroll
            for (int ai = 0; ai < 2; ++ai)
#pragma unroll
                for (int m = 0; m < 4; ++m) {
                    const int row = row0 + ai * 128 + m * 16; const float rs = RS[row];
#pragma unroll
                    for (int bj = 0; bj < 2; ++bj) {
                        f32x4 v0 = acc[ai][bj][m][0] * (cv[bj][0] * rs) + bv[bj][0], v1 = acc[ai][bj][m][1] * (cv[bj][1] * rs) + bv[bj][1];
                        if (!isp) {
#pragma unroll
                            for (int j = 0; j < 4; ++j) { v0[j] = fast_sigmoid(v0[j]); v1[j] = fast_sigmoid(v1[j]); }
                        }
                        u32x4 w; w.x = cvt_pk_bf16(v0[0], v0[1]); w.y = cvt_pk_bf16(v0[2], v0[3]); w.z = cvt_pk_bf16(v1[0], v1[1]); w.w = cvt_pk_bf16(v1[2], v1[3]);
                        *(u32x4*)(base + (size_t)row * ldc + colt + bj * 128 + lc0) = w;
                    }
                }
        }
    }
};
struct EpiGate {
    static constexpr bool PERM = true, HAS_MID = false, FP8 = true;
    const float* bias; const float* RS; const float* CS; bf16_t* SG;
    __device__ __forceinline__ void operator()(const AccT& acc, const pg8::Unit& u, int wr, int wc, int fr, int fq) const {
        const int row0 = u.pm * 256 + wr * 64 + fr, lc0 = wc * 32 + 8 * fq, t = u.pn;
        f32x4 b1[2], b2[2], c1[2], c2[2];
#pragma unroll
        for (int n = 0; n < 2; ++n) {
            b1[n] = *(const f32x4*)(bias + 1536 + t * 256 + lc0 + 4 * n) * -1.44269504089f; b2[n] = *(const f32x4*)(bias + 1536 + t * 256 + 128 + lc0 + 4 * n) * -1.44269504089f;
            c1[n] = *(const f32x4*)(CS + t * 256 + lc0 + 4 * n) * -1.44269504089f; c2[n] = *(const f32x4*)(CS + t * 256 + 128 + lc0 + 4 * n) * -1.44269504089f; }
#pragma unroll
        for (int ai = 0; ai < 2; ++ai)
#pragma unroll
            for (int m = 0; m < 4; ++m) {
                const int row = row0 + ai * 128 + m * 16;
                const float rs = RS[row];
                float ra[8], s2[8];
#pragma unroll
                for (int n = 0; n < 2; ++n) {
                    const f32x4 a1 = acc[ai][0][m][n] * (c1[n] * rs) + b1[n], a2 = acc[ai][1][m][n] * (c2[n] * rs) + b2[n];
#pragma unroll
                    for (int j = 0; j < 4; ++j) { const float e1 = __builtin_amdgcn_exp2f(a1[j]), e2 = __builtin_amdgcn_exp2f(a2[j]);
                        ra[4 * n + j] = (1.0f + e2) * __builtin_amdgcn_rcpf(1.0f + e1); s2[4 * n + j] = __builtin_amdgcn_rcpf(1.0f + e2); }
                }
                *(u32x4*)(SG + (size_t)row * 2048 + t * 128 + lc0) = (u32x4){cvt_pk_bf16(ra[0], ra[1]), cvt_pk_bf16(ra[2], ra[3]), cvt_pk_bf16(ra[4], ra[5]), cvt_pk_bf16(ra[6], ra[7])};
                *(u32x4*)(SG + (size_t)row * 2048 + 1024 + t * 128 + lc0) = (u32x4){cvt_pk_bf16(s2[0], s2[1]), cvt_pk_bf16(s2[2], s2[3]), cvt_pk_bf16(s2[4], s2[5]), cvt_pk_bf16(s2[6], s2[7])};
            }
    }
};
struct EpiIn {
    static constexpr bool PERM = true, HAS_MID = false, FP8 = true;
    EpiProj P; EpiGate G;
    __device__ __forceinline__ void operator()(const AccT& acc, const pg8::Unit& u, int wr, int wc, int fr, int fq) const {
        if (u.pn < 6) P(acc, u, wr, wc, fr, fq);
        else { pg8::Unit u2 = u; u2.pn = u.pn - 6; G(acc, u2, wr, wc, fr, fq); }
    }
};
struct EpiMerge {
    static constexpr bool PERM = true, HAS_MID = true, FP8 = false;
    const bf16_t* SG; bf16_t* MG;
    __device__ __forceinline__ void mid(AccT& acc, const pg8::Unit& u, int wr, int wc, int fr, int fq) const {
        const int ln_ = lane_id_asm();
        const int row0 = u.pm * 256 + wr * 64 + (ln_ & 15), col0 = u.pn * 256 + wc * 32 + 8 * (ln_ >> 4);
#pragma unroll
        for (int ai = 0; ai < 2; ++ai)
#pragma unroll
            for (int m = 0; m < 4; ++m) {
                const bf16_t* p = SG + (size_t)(row0 + ai * 128 + m * 16) * 2048 + col0;
                const u32x4 r0 = *(const u32x4*)p, r1 = *(const u32x4*)(p + 128);
#pragma unroll
                for (int bj = 0; bj < 2; ++bj) {
                    const unsigned a1[4] = {bj ? r1.x : r0.x, bj ? r1.y : r0.y, bj ? r1.z : r0.z, bj ? r1.w : r0.w};
#pragma unroll
                    for (int n = 0; n < 2; ++n)
#pragma unroll
                        for (int j = 0; j < 4; ++j) { const unsigned w1 = a1[n * 2 + (j >> 1)]; acc[ai][bj][m][n][j] *= (j & 1) ? bf_hi(w1) : bf_lo(w1); }
                }
                if (m & 1) asm volatile("" ::: "memory");
            }
    }
    __device__ __forceinline__ void operator()(const AccT& acc, const pg8::Unit& u, int wr, int wc, int fr, int fq) const {
        const int ln_ = lane_id_asm();
        const int row0 = u.pm * 256 + wr * 64 + (ln_ & 15), col0 = u.pn * 256 + wc * 32 + 8 * (ln_ >> 4);
#pragma unroll
        for (int ai = 0; ai < 2; ++ai)
#pragma unroll
            for (int m = 0; m < 4; ++m)
#pragma unroll
                for (int bj = 0; bj < 2; ++bj) {
                    const int row = row0 + ai * 128 + m * 16;
                    const u32x4 s2 = *(const u32x4*)(SG + (size_t)row * 2048 + 1024 + col0 + bj * 128);
                    const unsigned a2[4] = {s2.x, s2.y, s2.z, s2.w};
                    float o[8];
#pragma unroll
                    for (int n = 0; n < 2; ++n)
#pragma unroll
                        for (int j = 0; j < 4; ++j) {
                            const unsigned w2 = a2[n * 2 + (j >> 1)];
                            const float f2 = fmaxf((j & 1) ? bf_hi(w2) : bf_lo(w2), 1e-20f);
                            o[n * 4 + j] = acc[ai][bj][m][n][j] * f2;
                        }
                    u32x4 w; w.x = cvt_pk_bf16(o[0], o[1]); w.y = cvt_pk_bf16(o[2], o[3]); w.z = cvt_pk_bf16(o[4], o[5]); w.w = cvt_pk_bf16(o[6], o[7]);
                    *(u32x4*)(MG + (size_t)row * 1024 + col0 + bj * 128) = w;
                }
    }
};
struct EpiResid {
    static constexpr bool PERM = true, HAS_MID = false, FP8 = false;
    const float* X; const float* mod; bf16_t* X1B;
    const float* A2; bf16_t* XA; float* SSQ;
    __device__ __forceinline__ void operator()(const AccT& acc, const pg8::Unit& u, int wr, int wc, int fr, int fq) const {
        const int row0 = u.pm * 256 + wr * 64 + fr, col0 = u.pn * 256 + wc * 32 + 8 * fq;
        const int b = (u.pm * 256) / SEQ;
        const float* gt = mod + (size_t)b * NMOD; const float* a2 = A2 + b * 1024;
        f32x4 gv[2][2], av[2][2];
#pragma unroll
        for (int bj = 0; bj < 2; ++bj)
#pragma unroll
            for (int n = 0; n < 2; ++n) { gv[bj][n] = *(const f32x4*)(gt + col0 + bj * 128 + n * 4); av[bj][n] = *(const f32x4*)(a2 + col0 + bj * 128 + n * 4); }
#pragma unroll
        for (int ai = 0; ai < 2; ++ai)
#pragma unroll
            for (int m = 0; m < 4; ++m) {
                const int row = row0 + ai * 128 + m * 16;
                const size_t off = (size_t)row * 1024 + col0;
                float ss = 0.f;
#pragma unroll
                for (int bj = 0; bj < 2; ++bj) {
                    const f32x4 xv0 = *(const f32x4*)(X + off + bj * 128), xv1 = *(const f32x4*)(X + off + bj * 128 + 4);
                    const f32x4 x10 = xv0 + gv[bj][0] * acc[ai][bj][m][0], x11 = xv1 + gv[bj][1] * acc[ai][bj][m][1];
                    { u32x4 wx; wx.x = cvt_pk_bf16(x10[0], x10[1]); wx.y = cvt_pk_bf16(x10[2], x10[3]); wx.z = cvt_pk_bf16(x11[0], x11[1]); wx.w = cvt_pk_bf16(x11[2], x11[3]);
                      *(u32x4*)(X1B + off + bj * 128) = wx; }
                    ss += x10[0] * x10[0] + x10[1] * x10[1] + x10[2] * x10[2] + x10[3] * x10[3] + x11[0] * x11[0] + x11[1] * x11[1] + x11[2] * x11[2] + x11[3] * x11[3];
                    const f32x4 xa0 = x10 * av[bj][0], xa1 = x11 * av[bj][1];
                    u32x4 w; w.x = cvt_pk_bf16(xa0[0], xa0[1]); w.y = cvt_pk_bf16(xa0[2], xa0[3]); w.z = cvt_pk_bf16(xa1[0], xa1[1]); w.w = cvt_pk_bf16(xa1[2], xa1[3]);
                    *(u32x4*)(XA + off + bj * 128) = w;
                }
                ss += __shfl_xor(ss, 16); ss += __shfl_xor(ss, 32);
                if (fq == 0) __hip_atomic_fetch_add(SSQ + row, ss, __ATOMIC_RELAXED, __HIP_MEMORY_SCOPE_AGENT);
            }
    }
};
struct EpiBf16 {
    static constexpr bool PERM = true, HAS_MID = false, FP8 = false;
    bf16_t* O; int ldc;
    __device__ __forceinline__ void operator()(const AccT& acc, const pg8::Unit& u, int wr, int wc, int fr, int fq) const {
        const int row0 = u.pm * 256 + wr * 64 + fr, col0 = u.pn * 256 + wc * 32 + 8 * fq;
#pragma unroll
        for (int ai = 0; ai < 2; ++ai)
#pragma unroll
            for (int m = 0; m < 4; ++m)
#pragma unroll
                for (int bj = 0; bj < 2; ++bj) {
                    const f32x4 v0 = acc[ai][bj][m][0], v1 = acc[ai][bj][m][1];
                    u32x4 w; w.x = cvt_pk_bf16(v0[0], v0[1]); w.y = cvt_pk_bf16(v0[2], v0[3]); w.z = cvt_pk_bf16(v1[0], v1[1]); w.w = cvt_pk_bf16(v1[2], v1[3]);
                    *(u32x4*)(O + (size_t)(row0 + ai * 128 + m * 16) * ldc + col0 + bj * 128) = w;
                }
    }
};

struct EpiQ {
    static constexpr bool PERM = true, HAS_MID = false, FP8 = false;
    bf16_t* O; const float* SSQ; const float* BIAS2;
    __device__ __forceinline__ void operator()(const AccT& acc, const pg8::Unit& u, int wr, int wc, int fr, int fq) const {
        const int row0 = u.pm * 256 + wr * 64 + fr, col0 = u.pn * 256 + wc * 32 + 8 * fq;
        const float* bs = BIAS2 + ((u.pm * 256) / SEQ) * 2048 + col0;
        f32x4 bv[2][2];
#pragma unroll
        for (int bj = 0; bj < 2; ++bj)
#pragma unroll
            for (int n = 0; n < 2; ++n) bv[bj][n] = *(const f32x4*)(bs + bj * 128 + 4 * n);
#pragma unroll
        for (int ai = 0; ai < 2; ++ai)
#pragma unroll
            for (int m = 0; m < 4; ++m) {
                const int row = row0 + ai * 128 + m * 16;
                const float r = rsqrtf(SSQ[row] * (1.0f / D) + EPS);
#pragma unroll
                for (int bj = 0; bj < 2; ++bj) {
                    const f32x4 v0 = acc[ai][bj][m][0] * r + bv[bj][0], v1 = acc[ai][bj][m][1] * r + bv[bj][1];
                    u32x4 w; w.x = cvt_pk_bf16(v0[0], v0[1]); w.y = cvt_pk_bf16(v0[2], v0[3]); w.z = cvt_pk_bf16(v1[0], v1[1]); w.w = cvt_pk_bf16(v1[2], v1[3]);
                    { const int cw = wr * 2 + ai * 4 + (m >> 1), ks = 2 * wc + (fq >> 1), ln = (fq & 1) * 32 + (m & 1) * 16 + fr;
                      *(u32x4*)(O + ((size_t)(u.pm * 8 + u.pn) * 128 + (size_t)((cw * 2 + bj) * 8 + ks)) * 512 + ln * 8) = w; }
                }
            }
    }
};

#ifndef U_BITS
#define U_BITS 4
#endif
#ifndef V_BITS
#define V_BITS 4
#endif
template <int BITS> struct RowFmt;
template <> struct RowFmt<8> { typedef u32x4 row_t; static constexpr float QMAX = 224.0f; };
template <> struct RowFmt<4> { typedef u32x2 row_t; static constexpr float QMAX = 6.0f; };
template <int I> __device__ __forceinline__ f32x2 row_pair(const u32x4& r) {
    const unsigned w = (I >> 1) == 0 ? r.x : (I >> 1) == 1 ? r.y : (I >> 1) == 2 ? r.z : r.w;
    return __builtin_amdgcn_cvt_pk_f32_fp8((int)w, (I & 1) != 0);
}
template <int I> __device__ __forceinline__ f32x2 row_pair(const u32x2& r) {
    const unsigned w = (I >> 2) == 0 ? r.x : r.y;
    return __builtin_amdgcn_cvt_scalef32_pk_f32_fp4(w, 1.0f, I & 3);
}
template <class R> __device__ __forceinline__ float row_dot16(const R& r, const f32x2 (&hf)[8]) {
    f32x2 acc = {0.f, 0.f};
    acc = __builtin_elementwise_fma(row_pair<0>(r), hf[0], acc); acc = __builtin_elementwise_fma(row_pair<1>(r), hf[1], acc);
    acc = __builtin_elementwise_fma(row_pair<2>(r), hf[2], acc); acc = __builtin_elementwise_fma(row_pair<3>(r), hf[3], acc);
    acc = __builtin_elementwise_fma(row_pair<4>(r), hf[4], acc); acc = __builtin_elementwise_fma(row_pair<5>(r), hf[5], acc);
    acc = __builtin_elementwise_fma(row_pair<6>(r), hf[6], acc); acc = __builtin_elementwise_fma(row_pair<7>(r), hf[7], acc);
    return acc.x + acc.y;
}
template <class R> __device__ __forceinline__ void row_axpy16(const R& r, float c, f32x2 (&o)[8]) {
    const f32x2 c2 = {c, c};
    o[0] = __builtin_elementwise_fma(c2, row_pair<0>(r), o[0]); o[1] = __builtin_elementwise_fma(c2, row_pair<1>(r), o[1]);
    o[2] = __builtin_elementwise_fma(c2, row_pair<2>(r), o[2]); o[3] = __builtin_elementwise_fma(c2, row_pair<3>(r), o[3]);
    o[4] = __builtin_elementwise_fma(c2, row_pair<4>(r), o[4]); o[5] = __builtin_elementwise_fma(c2, row_pair<5>(r), o[5]);
    o[6] = __builtin_elementwise_fma(c2, row_pair<6>(r), o[6]); o[7] = __builtin_elementwise_fma(c2, row_pair<7>(r), o[7]);
}
template <int BITS> __device__ __forceinline__ void quant_row(const f32x4 (&v)[4], float qs, unsigned char* dst_row, int lane) {
    if constexpr (BITS == 8) {
#pragma unroll
        for (int q = 0; q < 4; ++q) { int p = 0; p = __builtin_amdgcn_cvt_pk_fp8_f32(v[q][0] * qs, v[q][1] * qs, p, false); p = __builtin_amdgcn_cvt_pk_fp8_f32(v[q][2] * qs, v[q][3] * qs, p, true);
            ((unsigned*)dst_row)[lane + 64 * q] = (unsigned)p; }
    } else {
#pragma unroll
        for (int q = 0; q < 4; ++q) { unsigned p = 0; p = __builtin_amdgcn_cvt_scalef32_pk_fp4_f32(p, v[q][0] * qs, v[q][1] * qs, 1.0f, 0); p = __builtin_amdgcn_cvt_scalef32_pk_fp4_f32(p, v[q][2] * qs, v[q][3] * qs, 1.0f, 1);
            ((unsigned short*)dst_row)[lane + 64 * q] = (unsigned short)(p & 0xffffu); }
    }
}
__device__ __forceinline__ void xpose_tile(const float* src, int ldsrc, int c0, int k0, bf16_t* dst, int lddst, int n0, int kd0, LAS float* tile, int tid) {
    { const int r = tid >> 4, c4 = tid & 15;
#pragma unroll
      for (int ps = 0; ps < 2; ++ps) { const f32x4 v = *(const f32x4*)(src + (size_t)(k0 + r + 32 * ps) * ldsrc + c0 + c4 * 4);
#pragma unroll
          for (int j = 0; j < 4; ++j) tile[(r + 32 * ps) * 65 + c4 * 4 + j] = v[j]; } }
    __syncthreads();
    { const int n = tid >> 3, kg = tid & 7; float f[8];
#pragma unroll
      for (int i = 0; i < 8; ++i) f[i] = tile[(kg * 8 + i) * 65 + n];
      u32x4 w; w.x = cvt_pk_bf16(f[0], f[1]); w.y = cvt_pk_bf16(f[2], f[3]); w.z = cvt_pk_bf16(f[4], f[5]); w.w = cvt_pk_bf16(f[6], f[7]);
      *(u32x4*)(dst + (size_t)(n0 + n) * lddst + kd0 + k0 + kg * 8) = w; }
    __syncthreads();
}
__device__ __forceinline__ void phase_prep(KP kp, LAS unsigned char* lds, int wave_s) {
    const int tid = wave_s * 64 + lane_id_asm(), G = gridDim.x;
    unsigned char* ws = kp->ws;
    const float* cvec = kp->in[1]; const float* ada_w = kp->in[2]; const float* ada_b = kp->in[3];
    float* mod = (float*)(ws + WS_MOD);
    LAS float* cact = (LAS float*)lds;
    LAS float* red = (LAS float*)(lds + 16384);
    LAS float* tile = (LAS float*)(lds + 49152);
    LAS float* pw = (LAS float*)(lds + 49152);
    if ((int)blockIdx.x < 192) {
        for (int i = tid; i < 4096; i += NTHREADS) { const float v = cvec[i]; cact[i] = v * fast_sigmoid(v); }
    }
    if (blockIdx.x == G - 1) {
        float* binp = (float*)(ws + WS_BINP); const float* b_in = kp->in[6];
        for (int i = tid; i < INW; i += NTHREADS) binp[i] = b_in[in_colmap(i)];
    }
    __syncthreads();
    constexpr int N_MOD = 192, N_WIN = 384, N_CO = 128, N_WO = 256, N_WQ = 512, N_WP = 128, N_WG = 512;
    constexpr int I1 = N_MOD, I2 = I1 + N_WIN, I3 = I2 + N_CO, I4 = I3 + N_WO, I5 = I4 + N_WQ, I6 = I5 + N_WP, I7 = I6 + N_WG;
    for (int it = blockIdx.x; it < I7; it += G) {
        if (it < I1) {
            const int n0 = it * 32, c4 = tid & 7, ks = tid >> 3;
            float a[4][4];
#pragma unroll
            for (int b = 0; b < 4; ++b)
#pragma unroll
                for (int j = 0; j < 4; ++j) a[b][j] = 0.f;
#pragma unroll 4
            for (int kk = 0; kk < 16; ++kk) { const int k = ks * 16 + kk; const f32x4 w = *(const f32x4*)(ada_w + (size_t)k * NMOD + n0 + c4 * 4);
#pragma unroll
                for (int b = 0; b < 4; ++b) { const float cv = cact[b * 1024 + k];
#pragma unroll
                    for (int j = 0; j < 4; ++j) a[b][j] += cv * w[j]; } }
#pragma unroll
            for (int b = 0; b < 4; ++b)
#pragma unroll
                for (int j = 0; j < 4; ++j) red[(ks * 4 + b) * 32 + c4 * 4 + j] = a[b][j];
            __syncthreads();
            if (tid < 128) { const int b = tid >> 5, col = tid & 31; float s = 0.f;
                for (int q = 0; q < 64; ++q) s += red[(q * 4 + b) * 32 + col];
                mod[b * NMOD + n0 + col] = s + ada_b[n0 + col]; }
            __syncthreads();
        } else if (it >= I6 || (it >= I1 && it < I2)) {
            const bool isp = it < I2;
            const int i = isp ? it - I1 : it - I6, kt = i & 15, n0 = (i >> 4) * 64 + (isp ? 0 : 1536), c0 = in_colmap(n0);
            const float* win = kp->in[5];
            LAS float* cmx = (LAS float*)(lds + 49152 + 17408);
            { const int r = tid >> 4, c4 = tid & 15;
              const f32x4 v0 = *(const f32x4*)(win + (size_t)(kt * 64 + r) * INW + c0 + c4 * 4), v1 = *(const f32x4*)(win + (size_t)(kt * 64 + r + 32) * INW + c0 + c4 * 4);
#pragma unroll
              for (int j = 0; j < 4; ++j) cmx[r * 64 + c4 * 4 + j] = fmaxf(fabsf(v0[j]), fabsf(v1[j])); }
            __syncthreads();
            if (tid < 64) { float mm = 0.f; for (int q = 0; q < 32; ++q) mm = fmaxf(mm, cmx[q * 64 + tid]); ((float*)(ws + WS_PMAX))[kt * 3584 + n0 + tid] = mm; }
            __syncthreads();
        } else if (it < I3) {
            const int i = it - I2, kt = i & 7, ntl = i >> 3;
            xpose_tile(kp->in[14], 1024, ntl * 64, kt * 64, (bf16_t*)(ws + WS_WPC), 1024, ntl * 64, 512, tile, tid);
        } else if (it < I4) {
            const int i = it - I3, kt = i & 15, ntl = i >> 4;
            xpose_tile(kp->in[15], 1024, ntl * 64, kt * 64, (bf16_t*)(ws + WS_WOUT), 1024, ntl * 64, 0, tile, tid);
        } else if (it < I5) {
            const int i = it - I4, kt = i & 15, ntl = i >> 4;
            xpose_tile(kp->in[17], 2048, ntl * 64, kt * 64, (bf16_t*)(ws + WS_WQ), 1024, ntl * 64, 0, tile, tid);
        } else {
            const int i = it - I5, nb = i & 1, cb = (i >> 1) & 15, g = i >> 5;
            const float* pool_w = kp->in[7]; const float* pool_scale = kp->in[8]; const float* pool_up = kp->in[9];
            for (int e = tid; e < 1024; e += NTHREADS) { const int ci = e >> 7, d = e & 127; pw[e] = pool_w[((size_t)g * 128 + cb * 8 + ci) * 128 + d] * pool_scale[g * 128 + d]; }
            __syncthreads();
            const int n = nb * 512 + tid; float a[8];
#pragma unroll
            for (int q = 0; q < 8; ++q) a[q] = 0.f;
#pragma unroll 4
            for (int d = 0; d < 128; ++d) { const float uv = pool_up[(size_t)(g * 128 + d) * 1024 + n];
#pragma unroll
                for (int q = 0; q < 8; ++q) a[q] += pw[q * 128 + d] * uv; }
            u32x4 w; w.x = cvt_pk_bf16(a[0], a[1]); w.y = cvt_pk_bf16(a[2], a[3]); w.z = cvt_pk_bf16(a[4], a[5]); w.w = cvt_pk_bf16(a[6], a[7]);
            *(u32x4*)((bf16_t*)(ws + WS_WPC) + (size_t)n * 1024 + g * 128 + cb * 8) = w;
            __syncthreads();
        }
    }
    {
        const int lane = tid & 63, wave = tid >> 6;
        f32x4 vn[4];
        { const int r0 = blockIdx.x * 8 + wave;
          if (r0 < 2 * NEXP) { const int tb0 = r0 >= NEXP ? 1 : 0; const f32x4* src = (const f32x4*)((tb0 ? kp->in[21] : kp->in[20]) + (size_t)(r0 - tb0 * NEXP) * D);
#pragma unroll
              for (int q = 0; q < 4; ++q) vn[q] = src[lane + 64 * q]; } }
        for (int r = blockIdx.x * 8 + wave; r < 2 * NEXP; r += G * 8) {
            const int tb = r >= NEXP ? 1 : 0, e = r - tb * NEXP;
            f32x4 v[4]; float m = 0.f;
#pragma unroll
            for (int q = 0; q < 4; ++q) v[q] = vn[q];
            { const int rn = r + G * 8;
              if (rn < 2 * NEXP) { const int tbn = rn >= NEXP ? 1 : 0; const f32x4* src = (const f32x4*)((tbn ? kp->in[21] : kp->in[20]) + (size_t)(rn - tbn * NEXP) * D);
#pragma unroll
                  for (int q = 0; q < 4; ++q) vn[q] = src[lane + 64 * q]; } }
#pragma unroll
            for (int q = 0; q < 4; ++q) m = fmaxf(m, fmaxf(fmaxf(fabsf(v[q][0]), fabsf(v[q][1])), fmaxf(fabsf(v[q][2]), fabsf(v[q][3]))));
            m = wave_max(m);
            const float qmax = tb ? RowFmt<V_BITS>::QMAX : RowFmt<U_BITS>::QMAX;
            const float qs = m > 0.f ? qmax / m : 0.f;
            if (tb) quant_row<V_BITS>(v, qs, ws + WS_EV + (size_t)e * (V_BITS * 128), lane);
            else quant_row<U_BITS>(v, qs, ws + WS_EU + (size_t)e * (U_BITS * 128), lane);
            if (lane == 0) ((float*)(ws + (tb ? WS_SV : WS_SU)))[e] = m / qmax;
        }
    }
}

__device__ __forceinline__ void phase_w8(KP kp, LAS unsigned char* lds, int wave_s) {
    const int tid = wave_s * 64 + lane_id_asm();
    unsigned char* ws = kp->ws;
    const float* win = kp->in[5]; const float* pmax = (const float*)(ws + WS_PMAX);
    LAS float* tile = (LAS float*)(lds + 49152);
    LAS float* csc = (LAS float*)(lds + 49152 + 17408);
    for (int it = blockIdx.x; it < 56 * 16; it += gridDim.x) {
        const int kt = it & 15, n0 = (it >> 4) * 64, c0 = in_colmap(n0);
        if (tid < 64) { float mm = 0.f;
#pragma unroll
            for (int q = 0; q < 16; ++q) mm = fmaxf(mm, pmax[q * 3584 + n0 + tid]);
            csc[tid] = mm > 0.f ? 224.0f / mm : 0.f; if (kt == 0) ((float*)(ws + WS_WP8S))[n0 + tid] = mm * (1.0f / 224.0f); }
        { const int r = tid >> 4, c4 = tid & 15;
#pragma unroll
          for (int ps = 0; ps < 2; ++ps) { const f32x4 v = *(const f32x4*)(win + (size_t)(kt * 64 + r + 32 * ps) * INW + c0 + c4 * 4);
#pragma unroll
              for (int j = 0; j < 4; ++j) tile[(r + 32 * ps) * 65 + c4 * 4 + j] = v[j]; } }
        __syncthreads();
        { const int n = tid >> 3, kg = tid & 7; const float qs = csc[n]; float f[8];
#pragma unroll
          for (int i = 0; i < 8; ++i) f[i] = tile[(kg * 8 + i) * 65 + n] * qs;
          int p0 = 0, p1 = 0;
          p0 = __builtin_amdgcn_cvt_pk_fp8_f32(f[0], f[1], p0, false); p0 = __builtin_amdgcn_cvt_pk_fp8_f32(f[2], f[3], p0, true);
          p1 = __builtin_amdgcn_cvt_pk_fp8_f32(f[4], f[5], p1, false); p1 = __builtin_amdgcn_cvt_pk_fp8_f32(f[6], f[7], p1, true);
          *(u32x2*)(ws + WS_WP8 + (size_t)(n0 + n) * 1024 + kt * 64 + kg * 8) = (u32x2){(unsigned)p0, (unsigned)p1}; }
        __syncthreads();
    }
}

template <bool WITH_FP8>
__device__ __forceinline__ void phase_norm_ada(const float* src, const float* gain, const float* mod, int shift_off, int scale_off, bf16_t* dst, unsigned char* dst8, float* dscale, int wave_s) {
    const int lane = lane_id_asm(), wave = wave_s;
    f32x4 vn[4];
    { const int row0 = blockIdx.x * 8 + wave;
      if (row0 < T) { const f32x4* xr = (const f32x4*)(src + (size_t)row0 * D);
#pragma unroll
          for (int j = 0; j < 4; ++j) vn[j] = xr[lane + 64 * j]; } }
    for (int row = blockIdx.x * 8 + wave; row < T; row += gridDim.x * 8) {
        const int b = row / SEQ;
        f32x4 v[4]; float ss = 0.f;
#pragma unroll
        for (int j = 0; j < 4; ++j) v[j] = vn[j];
        { const int rn = row + gridDim.x * 8;
          if (rn < T) { const f32x4* xr = (const f32x4*)(src + (size_t)rn * D);
#pragma unroll
              for (int j = 0; j < 4; ++j) vn[j] = xr[lane + 64 * j]; } }
#pragma unroll
        for (int j = 0; j < 4; ++j) ss += v[j][0] * v[j][0] + v[j][1] * v[j][1] + v[j][2] * v[j][2] + v[j][3] * v[j][3];
        ss = wave_sum(ss);
        const float r = rsqrtf(ss * (1.0f / D) + EPS);
        float am = 0.f;
#pragma unroll
        for (int j = 0; j < 4; ++j) {
            const int col = 4 * lane + 256 * j;
            const f32x4 g = *(const f32x4*)(gain + col), sc = *(const f32x4*)(mod + (size_t)b * NMOD + scale_off + col), sh = *(const f32x4*)(mod + (size_t)b * NMOD + shift_off + col);
            const f32x4 h = v[j] * r * g * (sc + 1.0f) + sh;
            u32x2 w; w.x = cvt_pk_bf16(h[0], h[1]); w.y = cvt_pk_bf16(h[2], h[3]);
            if (dst) *(u32x2*)(dst + (size_t)row * D + col) = w;
            if (WITH_FP8) { v[j] = h; am = fmaxf(am, fmaxf(fmaxf(fabsf(h[0]), fabsf(h[1])), fmaxf(fabsf(h[2]), fabsf(h[3])))); }
        }
        if (WITH_FP8) {
            am = wave_max(am);
            const float qs = am > 0.f ? 224.0f / am : 0.f;
#pragma unroll
            for (int j = 0; j < 4; ++j) { int p = 0; p = __builtin_amdgcn_cvt_pk_fp8_f32(v[j][0] * qs, v[j][1] * qs, p, false); p = __builtin_amdgcn_cvt_pk_fp8_f32(v[j][2] * qs, v[j][3] * qs, p, true);
                *(unsigned*)(dst8 + (size_t)row * D + 4 * lane + 256 * j) = (unsigned)p; }
            if (lane == 0) dscale[row] = am * (1.0f / 224.0f);
        }
    }
}

__device__ __forceinline__ void phase_aux(KP kp, LAS unsigned char* lds, int wave_s) {
    const int tid = wave_s * 64 + lane_id_asm();
    unsigned char* ws = kp->ws;
    const float* mod = (const float*)(ws + WS_MOD);
    const int bid = blockIdx.x;
    if (bid == 0) {
        float* A2 = (float*)(ws + WS_A2); const float* g2 = kp->in[16];
        for (int i = tid; i < 4096; i += NTHREADS) { const int b = i >> 10, k = i & 1023; A2[i] = g2[k] * (1.0f + mod[(size_t)b * NMOD + 4 * 1024 + k]); }
    } else if (bid <= 8) {
        float* SSQ = (float*)(ws + WS_SSQ) + (bid - 1) * 4096;
        for (int i = tid; i < 4096; i += NTHREADS) SSQ[i] = 0.f;
    } else if (bid <= 24) {
        const int n0 = (bid - 9) * 128, c4 = tid & 31, ks = tid >> 5;
        const float* wq = kp->in[17];
        LAS float* red = (LAS float*)lds;
        float a[4][4];
#pragma unroll
        for (int b = 0; b < 4; ++b)
#pragma unroll
            for (int j = 0; j < 4; ++j) a[b][j] = 0.f;
#pragma unroll 4
        for (int kk = 0; kk < 64; ++kk) { const int k = ks * 64 + kk; const f32x4 w = *(const f32x4*)(wq + (size_t)k * 2048 + n0 + c4 * 4);
#pragma unroll
            for (int b = 0; b < 4; ++b) { const float sv = mod[(size_t)b * NMOD + 3 * 1024 + k];
#pragma unroll
                for (int j = 0; j < 4; ++j) a[b][j] += sv * w[j]; } }
#pragma unroll
        for (int b = 0; b < 4; ++b)
#pragma unroll
            for (int j = 0; j < 4; ++j) red[(ks * 4 + b) * 128 + c4 * 4 + j] = a[b][j];
        __syncthreads();
        { const int b = tid >> 7, col = tid & 127; float sm = 0.f;
          for (int q = 0; q < 16; ++q) sm += red[(q * 4 + b) * 128 + col];
          ((float*)(ws + WS_BIAS2))[b * 2048 + n0 + col] = sm; }
        __syncthreads();
    }
}

template <int W>
__device__ __forceinline__ void pool_window(const float (&x0)[31], const float (&x1)[31], int spos0, bf16_t* dstp) {
    float s0 = 0.f, s1 = 0.f;
#pragma unroll
    for (int d = 0; d < W; ++d) { s0 += x0[15 - d]; s1 += x1[15 - d]; }
#pragma unroll
    for (int i = 0; i < 16; ++i) {
        const int sp = spos0 + i; const float inv = 1.0f / (float)(sp + 1 < W ? sp + 1 : W);
        const float m0 = s0 * inv - x0[i + 15], m1 = s1 * inv - x1[i + 15];
        *(unsigned*)(dstp + (size_t)i * 1024) = cvt_pk_bf16(m0, m1);
        if (i < 15) { s0 += x0[i + 16] - x0[i + 16 - W]; s1 += x1[i + 16] - x1[i + 16 - W]; }
    }
}
__device__ __forceinline__ void phase_branches(KP kp, LAS unsigned char* lds, int wave_s) {
    const int lane = lane_id_asm(), wave = wave_s, tid = wave * 64 + lane;
    unsigned char* ws = kp->ws;
    const bf16_t* PB = (const bf16_t*)(ws + WS_PG); const bf16_t* GB = PB + (size_t)T * 512;
    bf16_t* MC = (bf16_t*)(ws + WS_MC);
    const float* dwk = kp->in[10]; const float* dwb = kp->in[11]; const float* lng = kp->in[12]; const float* lnb = kp->in[13];
    LAS unsigned* rows = (LAS unsigned*)lds;
    LAS float* ybuf = (LAS float*)(lds + 63488);
    const int cp = tid & 255, th = tid >> 8;
    float w0[31], w1[31];
#pragma unroll
    for (int j = 0; j < 31; ++j) { const f32x2 w = *(const f32x2*)(dwk + j * 512 + 2 * cp); w0[j] = w.x; w1[j] = w.y; }
    const f32x2 cb = *(const f32x2*)(dwb + 2 * cp);
    u32x4 gpre[8], ppre[6];
#define P3_LOAD_G(t0_, s0_) do { _Pragma("unroll") for (int i_ = 0; i_ < 8; ++i_) { const int e = tid + i_ * NTHREADS; const int r = e >> 6, c = e & 63; u32x4 v = {0u, 0u, 0u, 0u}; \
            if (e < 62 * 64 && (s0_) + r - 30 >= 0) v = *(const u32x4*)(GB + (size_t)((t0_) + r - 30) * 512 + c * 8); gpre[i_] = v; } } while (0)
#define P3_LOAD_P(t0_, s0_) do { _Pragma("unroll") for (int i_ = 0; i_ < 6; ++i_) { const int e = tid + i_ * NTHREADS; const int r = e >> 6, c = e & 63; u32x4 v = {0u, 0u, 0u, 0u}; \
            if (e < 47 * 64 && (s0_) + r - 15 >= 0) v = *(const u32x4*)(PB + (size_t)((t0_) + r - 15) * 512 + c * 8); ppre[i_] = v; } } while (0)
    if ((int)blockIdx.x < T / 32) { const int t0 = blockIdx.x * 32; P3_LOAD_G(t0, t0 % SEQ); }
    for (int tl = blockIdx.x; tl < T / 32; tl += gridDim.x) {
        const int t0 = tl * 32, s0 = t0 % SEQ;
#pragma unroll
        for (int i_ = 0; i_ < 8; ++i_) { const int e = tid + i_ * NTHREADS; if (e < 62 * 64) *(LAS u32x4*)(rows + (e >> 6) * 256 + (e & 63) * 4) = gpre[i_]; }
        __syncthreads();
        P3_LOAD_P(t0, s0);
        {
            float a0[16], a1[16];
#pragma unroll
            for (int i = 0; i < 16; ++i) { a0[i] = cb.x; a1[i] = cb.y; }
#pragma unroll
            for (int r = 0; r < 46; ++r) {
                const unsigned uu = rows[(th * 16 + r) * 256 + cp]; const float x0 = bf_lo(uu), x1 = bf_hi(uu);
#pragma unroll
                for (int i = 0; i < 16; ++i) { const int j = r - i; if (j >= 0 && j <= 30) { a0[i] += x0 * w0[j]; a1[i] += x1 * w1[j]; } }
            }
#pragma unroll
            for (int i = 0; i < 16; ++i) *(LAS f32x2*)(ybuf + (th * 16 + i) * 512 + 2 * cp) = (f32x2){a0[i], a1[i]};
        }
        __syncthreads();
        {
            const f32x4 g0 = *(const f32x4*)(lng + lane * 8), g1 = *(const f32x4*)(lng + lane * 8 + 4), b0 = *(const f32x4*)(lnb + lane * 8), b1 = *(const f32x4*)(lnb + lane * 8 + 4);
#pragma unroll
            for (int q = 0; q < 4; ++q) {
                const int tk = wave * 4 + q;
                const f32x4 y0 = *(const LAS f32x4*)(ybuf + tk * 512 + lane * 8), y1 = *(const LAS f32x4*)(ybuf + tk * 512 + lane * 8 + 4);
                float s = (y0[0] + y0[1]) + (y0[2] + y0[3]) + (y1[0] + y1[1]) + (y1[2] + y1[3]);
                s = wave_sum(s); const float mu = s * (1.0f / 512.0f);
                const f32x4 d0 = y0 - mu, d1 = y1 - mu;
                float qv = d0[0] * d0[0] + d0[1] * d0[1] + d0[2] * d0[2] + d0[3] * d0[3] + d1[0] * d1[0] + d1[1] * d1[1] + d1[2] * d1[2] + d1[3] * d1[3];
                qv = wave_sum(qv); const float rs = rsqrtf(qv * (1.0f / 512.0f) + EPS);
                f32x4 o0 = d0 * rs * g0 + b0, o1 = d1 * rs * g1 + b1;
#pragma unroll
                for (int j = 0; j < 4; ++j) { o0[j] = o0[j] * fast_sigmoid(o0[j]); o1[j] = o1[j] * fast_sigmoid(o1[j]); }
                u32x4 w; w.x = cvt_pk_bf16(o0[0], o0[1]); w.y = cvt_pk_bf16(o0[2], o0[3]); w.z = cvt_pk_bf16(o1[0], o1[1]); w.w = cvt_pk_bf16(o1[2], o1[3]);
                *(u32x4*)(MC + (size_t)(t0 + tk) * 1024 + 512 + lane * 8) = w;
            }
        }
        __syncthreads();
#pragma unroll
        for (int i_ = 0; i_ < 6; ++i_) { const int e = tid + i_ * NTHREADS; if (e < 47 * 64) *(LAS u32x4*)(rows + (e >> 6) * 256 + (e & 63) * 4) = ppre[i_]; }
        __syncthreads();
        { const int tn = tl + gridDim.x; if (tn < T / 32) { const int t0n = tn * 32; P3_LOAD_G(t0n, t0n % SEQ); } }
        {
            float x0[31], x1[31];
#pragma unroll
            for (int r = 0; r < 31; ++r) { const unsigned uu = rows[(th * 16 + r) * 256 + cp]; x0[r] = bf_lo(uu); x1[r] = bf_hi(uu); }
            bf16_t* dstp = MC + (size_t)(t0 + th * 16) * 1024 + 2 * cp;
            const int grp = __builtin_amdgcn_readfirstlane(cp >> 6), sp0 = s0 + th * 16;
            if (grp == 0) pool_window<2>(x0, x1, sp0, dstp);
            else if (grp == 1) pool_window<4>(x0, x1, sp0, dstp);
            else if (grp == 2) pool_window<8>(x0, x1, sp0, dstp);
            else pool_window<16>(x0, x1, sp0, dstp);
        }
        __syncthreads();
    }
}

#define CE_DESC(a, b) do { const int _hi = max(a, b), _lo = min(a, b); a = _hi; b = _lo; } while (0)
#define CE_ASC(a, b)  do { const int _hi = max(a, b), _lo = min(a, b); a = _lo; b = _hi; } while (0)
__device__ __forceinline__ void bitonic_sort16_desc(int (&v)[16]) {
#pragma unroll
    for (int k = 2; k <= 16; k <<= 1)
#pragma unroll
        for (int j = k >> 1; j > 0; j >>= 1)
#pragma unroll
            for (int i = 0; i < 16; ++i) { const int l = i ^ j; if (l > i) { if ((i & k) == 0) CE_DESC(v[i], v[l]); else CE_ASC(v[i], v[l]); } }
}
__device__ __forceinline__ void bitonic_merge16_desc(int (&v)[16]) {
#pragma unroll
    for (int j = 8; j > 0; j >>= 1)
#pragma unroll
        for (int i = 0; i < 16; ++i) { const int l = i ^ j; if (l > i) CE_DESC(v[i], v[l]); }
}
__device__ __forceinline__ void top16_merge(int (&a)[16], const int (&b)[16]) {
#pragma unroll
    for (int i = 0; i < 16; ++i) a[i] = max(a[i], b[15 - i]);
    bitonic_merge16_desc(a);
}
#define CEF_DESC(a, b) do { const float _hi = fmaxf(a, b), _lo = fminf(a, b); a = _hi; b = _lo; } while (0)
#define CEF_ASC(a, b)  do { const float _hi = fmaxf(a, b), _lo = fminf(a, b); a = _lo; b = _hi; } while (0)
__device__ __forceinline__ void fbitonic_sort16_desc(float (&v)[16]) {
#pragma unroll
    for (int k = 2; k <= 16; k <<= 1)
#pragma unroll
        for (int j = k >> 1; j > 0; j >>= 1)
#pragma unroll
            for (int i = 0; i < 16; ++i) { const int l = i ^ j; if (l > i) { if ((i & k) == 0) CEF_DESC(v[i], v[l]); else CEF_ASC(v[i], v[l]); } }
}
__device__ __forceinline__ void fsort16_desc(float (&v)[16]) {
    CEF_DESC(v[0], v[13]); CEF_DESC(v[1], v[12]); CEF_DESC(v[2], v[15]); CEF_DESC(v[3], v[14]); CEF_DESC(v[4], v[8]); CEF_DESC(v[5], v[6]); CEF_DESC(v[7], v[11]); CEF_DESC(v[9], v[10]); CEF_DESC(v[0], v[5]); CEF_DESC(v[1], v[7]); CEF_DESC(v[2], v[9]); CEF_DESC(v[3], v[4]); CEF_DESC(v[6], v[13]); CEF_DESC(v[8], v[14]); CEF_DESC(v[10], v[15]); CEF_DESC(v[11], v[12]); CEF_DESC(v[0], v[1]); CEF_DESC(v[2], v[3]); CEF_DESC(v[4], v[5]); CEF_DESC(v[6], v[8]); CEF_DESC(v[7], v[9]); CEF_DESC(v[10], v[11]); CEF_DESC(v[12], v[13]); CEF_DESC(v[14], v[15]); CEF_DESC(v[0], v[2]); CEF_DESC(v[1], v[3]); CEF_DESC(v[4], v[10]); CEF_DESC(v[5], v[11]); CEF_DESC(v[6], v[7]); CEF_DESC(v[8], v[9]); CEF_DESC(v[12], v[14]); CEF_DESC(v[13], v[15]); CEF_DESC(v[1], v[2]); CEF_DESC(v[3], v[12]); CEF_DESC(v[4], v[6]); CEF_DESC(v[5], v[7]); CEF_DESC(v[8], v[10]); CEF_DESC(v[9], v[11]); CEF_DESC(v[13], v[14]); CEF_DESC(v[1], v[4]); CEF_DESC(v[2], v[6]); CEF_DESC(v[5], v[8]); CEF_DESC(v[7], v[10]); CEF_DESC(v[9], v[13]); CEF_DESC(v[11], v[14]); CEF_DESC(v[2], v[4]); CEF_DESC(v[3], v[6]); CEF_DESC(v[9], v[12]); CEF_DESC(v[11], v[13]); CEF_DESC(v[3], v[5]); CEF_DESC(v[6], v[8]); CEF_DESC(v[7], v[9]); CEF_DESC(v[10], v[12]); CEF_DESC(v[3], v[4]); CEF_DESC(v[5], v[6]); CEF_DESC(v[7], v[8]); CEF_DESC(v[9], v[10]); CEF_DESC(v[11], v[12]); CEF_DESC(v[6], v[7]); CEF_DESC(v[8], v[9]);
}
__device__ __forceinline__ void fbitonic_merge16_desc(float (&v)[16]) {
#pragma unroll
    for (int j = 8; j > 0; j >>= 1)
#pragma unroll
        for (int i = 0; i < 16; ++i) { const int l = i ^ j; if (l > i) CEF_DESC(v[i], v[l]); }
}
__device__ __forceinline__ void ftop16_merge(float (&a)[16], const float (&b)[16]) {
#pragma unroll
    for (int i = 0; i < 16; ++i) a[i] = fmaxf(a[i], b[15 - i]);
    fbitonic_merge16_desc(a);
}
__device__ __forceinline__ int packkey(float v, int idx) { const int f = __float_as_int(v); const int s = f ^ ((f >> 31) & 0x7fffffff); return (s & ~127) | (127 - idx); }
__device__ __forceinline__ float keyval(int k) { const int s = k & ~127; return __int_as_float(s ^ ((s >> 31) & 0x7fffffff)); }
__device__ __forceinline__ void top16_of_scores(const f32x16 (&acc)[4], int hclr, float (&L)[16]) {
    float M[16];
#pragma unroll
    for (int kt = 0; kt < 4; ++kt) {
        float v[16];
#pragma unroll
        for (int r = 0; r < 16; ++r) v[r] = __int_as_float(((__float_as_int(acc[kt][r]) & ~127) | (127 - (kt * 32 + (r & 3) + 8 * (r >> 2)))) & hclr);
        fsort16_desc(v);
        if (kt == 0) {
#pragma unroll
            for (int i = 0; i < 16; ++i) L[i] = v[i];
        } else ftop16_merge(L, v);
    }
#pragma unroll
    for (int i = 0; i < 16; ++i) M[i] = __shfl_xor(L[i], 32);
    ftop16_merge(L, M);
}
__device__ __forceinline__ void phase_topk(KP kp, LAS unsigned char* lds, int wave_s) {
    const int lane = lane_id_asm(), wave = wave_s, tid = wave * 64 + lane;
    unsigned char* ws = kp->ws;
    const bf16_t* Q = (const bf16_t*)(ws + WS_SG);
    int* IDX = (int*)(ws + WS_IDX); float* GATE = (float*)(ws + WS_GATE);
    LAS unsigned* stg = (LAS unsigned*)(lds + 65536);
    for (int e = tid; e < 2 * 32 * 64; e += NTHREADS) {
        const int f = e >> 6, l = e & 63, set = f >> 5, kt = (f >> 3) & 3, ks = f & 7;
        const float* src = (set ? kp->in[19] : kp->in[18]) + (kt * 32 + (l & 31)) * 128 + ks * 16 + 8 * (l >> 5);
        const f32x4 a = *(const f32x4*)src, b = *(const f32x4*)(src + 4);
        u32x4 w; w.x = cvt_pk_bf16(a[0], a[1]); w.y = cvt_pk_bf16(a[2], a[3]); w.z = cvt_pk_bf16(b[0], b[1]); w.w = cvt_pk_bf16(b[2], b[3]);
        *(LAS u32x4*)(lds + (size_t)e * 16) = w;
    }
    __syncthreads();
    const int h = lane >> 5;
    pg8::StaticOrder SO; SO.init(T, 2048, gridDim.x, blockIdx.x);
    pg8::Unit uu;
    for (int ui = 0; SO.next(ui, uu); ++ui) {
        const int tile = uu.pm, head = uu.pn;
        const int tok = tile * 256 + wave * 32 + (lane & 31);
        const bf16_t* qfrag = Q + ((size_t)(tile * 8 + head) * 128 + (size_t)wave * 16) * 512 + lane * 8;
        float L1[16], L2[16];
#pragma unroll
        for (int set = 0; set < 2; ++set) {
            f32x16 acc[4];
#pragma unroll
            for (int kt = 0; kt < 4; ++kt)
#pragma unroll
                for (int r = 0; r < 16; ++r) acc[kt][r] = 0.f;
#pragma unroll
            for (int ks = 0; ks < 8; ++ks) {
                const bf16x8 bq = *(const bf16x8*)(qfrag + (set * 8 + ks) * 512);
#pragma unroll
                for (int kt = 0; kt < 4; ++kt) {
                    const bf16x8 ak = *(const LAS bf16x8*)(lds + (size_t)((((set * 4 + kt) * 8 + ks) * 64) + lane) * 16);
                    acc[kt] = __builtin_amdgcn_mfma_f32_32x32x16_bf16(ak, bq, acc[kt], 0, 0, 0);
                }
            }
#ifdef DBG_VALU_SCORES
            {   const float* keys = set ? kp->in[19] : kp->in[18];
                const bf16_t* qr = Q + (size_t)tok * 2048 + head * 256 + set * 128;
                for (int kt = 0; kt < 4; ++kt)
                    for (int r = 0; r < 16; ++r) {
                        const int idx = kt * 32 + (r & 3) + 8 * (r >> 2) + 4 * h; float sacc = 0.f;
                        for (int k = 0; k < 128; ++k) sacc += __uint_as_float(((unsigned)qr[k]) << 16) * keys[idx * 128 + k];
#pragma unroll
                        for (int kk = 0; kk < 4; ++kk)
#pragma unroll
                            for (int rr = 0; rr < 16; ++rr) if (kk == kt && rr == r) acc[kk][rr] = sacc;
                    }
            }
#endif
            if (set == 0) top16_of_scores(acc, ~(4 * h), L1); else top16_of_scores(acc, ~(4 * h), L2);
        }
        float v1[16], v2[16]; int i1[16], i2[16];
#pragma unroll
        for (int i = 0; i < 16; ++i) { const int k1 = __float_as_int(L1[i]), k2 = __float_as_int(L2[i]); v1[i] = __int_as_float(k1 & ~127); i1[i] = 127 - (k1 & 127); v2[i] = __int_as_float(k2 & ~127); i2[i] = 127 - (k2 & 127); }
        float thr, mx;
        {
            float A[16], B[16], C[16], Dd[16];
#pragma unroll
            for (int j = 0; j < 16; ++j) A[j] = v1[0] + v2[j];
#pragma unroll
            for (int j = 0; j < 8; ++j) { B[j] = v1[1] + v2[j]; B[8 + j] = v1[15 - j] + v2[0]; }
            fbitonic_merge16_desc(B);
            C[0] = v1[2] + v2[0]; C[1] = v1[2] + v2[1]; C[2] = v1[2] + v2[2]; C[3] = v1[2] + v2[3]; C[4] = v1[2] + v2[4];
            C[5] = v1[3] + v2[0]; C[6] = v1[3] + v2[1]; C[7] = v1[3] + v2[2]; C[8] = v1[3] + v2[3];
            C[9] = v1[4] + v2[0]; C[10] = v1[4] + v2[1]; C[11] = v1[4] + v2[2];
            C[12] = v1[5] + v2[0]; C[13] = v1[5] + v2[1]; C[14] = v1[6] + v2[0]; C[15] = v1[6] + v2[1];
            fsort16_desc(C);
            Dd[0] = v1[7] + v2[0]; Dd[1] = v1[7] + v2[1];
#pragma unroll
            for (int j = 2; j < 16; ++j) Dd[j] = -3.0e38f;
            ftop16_merge(A, B); ftop16_merge(C, Dd);
            mx = fmaxf(A[0], C[0]);
            float t = fmaxf(A[0], C[15]);
#pragma unroll
            for (int i = 1; i < 16; ++i) t = fminf(t, fmaxf(A[i], C[15 - i]));
            thr = t;
        }
        if (h == 0) {
            LAS unsigned* row = stg + (wave * 32 + (lane & 31)) * 44;
            int cnt = 0;
#pragma unroll
            for (int i = 0; i < 16; ++i)
#pragma unroll
                for (int j = 0; j < 16; ++j) if ((i + 1) * (j + 1) <= 16) {
                    const float x = v1[i] + v2[j];
                    const bool pr = (x >= thr) && (cnt < 16);
                    const int pos = pr ? cnt : 16;
                    row[pos] = (unsigned)(i1[i] * 128 + i2[j]); row[20 + pos] = __float_as_uint(x);
                    cnt += pr ? 1 : 0;
                }
            u32x4* ip = (u32x4*)(IDX + ((size_t)tok * 8 + head) * 16);
            f32x4 ev[4]; float sum = 0.f;
            u32x4 idq[4];
#pragma unroll
            for (int q = 0; q < 4; ++q) {
                idq[q] = *(const LAS u32x4*)(row + 4 * q);
                const u32x4 gu = *(const LAS u32x4*)(row + 20 + 4 * q);
                ev[q] = (f32x4){__expf(__uint_as_float(gu.x) - mx), __expf(__uint_as_float(gu.y) - mx), __expf(__uint_as_float(gu.z) - mx), __expf(__uint_as_float(gu.w) - mx)};
                sum += (ev[q][0] + ev[q][1]) + (ev[q][2] + ev[q][3]);
            }
            const float inv = 1.0f / sum;
#pragma unroll
            for (int q = 0; q < 4; ++q) { const f32x4 g = ev[q] * inv;
                ip[q] = (u32x4){idq[q].x | (__float_as_uint(g[0]) & 0xffff0000u), idq[q].y | (__float_as_uint(g[1]) & 0xffff0000u), idq[q].z | (__float_as_uint(g[2]) & 0xffff0000u), idq[q].w | (__float_as_uint(g[3]) & 0xffff0000u)}; }
        }
    }
}

__device__ __forceinline__ float gelu_tanh(float x) {
    const float y = 0.7978845608028654f * (x + 0.044715f * x * x * x);
    return x * fast_sigmoid(2.0f * y);
}
typedef int i32x8 __attribute__((ext_vector_type(8)));
#define DPPF(x, ctrl) __int_as_float(__builtin_amdgcn_update_dpp(0, __float_as_int(x), ctrl, 0xF, 0xF, true))
struct TokMeta { u32x4 hb; f32x2 hs; int e0, e1; float g0, g1, cu0, cu1, sv0, sv1; u32x4 x1[2]; f32x4 g2[4]; };
__device__ __forceinline__ void peer_load_meta(TokMeta& m, int tok, int lane, const unsigned char* HB, const f32x2* HS, const int* IDX, const float* GATE, const bf16_t* X1, const float* modp) {
    { const u32x4* xp = (const u32x4*)(X1 + (size_t)tok * D + 16 * lane); m.x1[0] = xp[0]; m.x1[1] = xp[1];
      const f32x4* gp = (const f32x4*)(modp + (size_t)(tok / SEQ) * NMOD + 5 * 1024 + 16 * lane); m.g2[0] = gp[0]; m.g2[1] = gp[1]; m.g2[2] = gp[2]; m.g2[3] = gp[3]; }
    m.hb = *(const u32x4*)(HB + (size_t)tok * 1024 + ((lane & 15) * 4 + (lane >> 4)) * 16);
    m.hs = HS[tok];
    m.e0 = IDX[(size_t)tok * 128 + lane]; m.e1 = IDX[(size_t)tok * 128 + 64 + lane];
    m.g0 = GATE[(size_t)tok * 128 + lane]; m.g1 = GATE[(size_t)tok * 128 + 64 + lane];
}
__device__ __forceinline__ void peer_load_scales(TokMeta& m, const float* SU, const float* SV) { m.cu0 = SU[m.e0]; m.cu1 = SU[m.e1]; m.sv0 = SV[m.e0]; m.sv1 = SV[m.e1]; }
typedef RowFmt<V_BITS>::row_t vrow_t;
#define PEER_LOAD(UQ, VQ, g) do { const int bb_ = (g) & 15; const bool nx_ = (g) >= 16; \
        const int src_ = bb_ < 8 ? (nx_ ? mn.e0 : m.e0) : (nx_ ? mn.e1 : m.e1); \
        _Pragma("unroll") for (int j_ = 0; j_ < 4; ++j_) { \
            const int ea_ = __builtin_amdgcn_readlane(src_, (8 * bb_ + 2 * j_) & 63), eb_ = __builtin_amdgcn_readlane(src_, (8 * bb_ + 2 * j_ + 1) & 63); \
            UQ[j_] = __builtin_bit_cast(u32x4, __builtin_amdgcn_raw_buffer_load_b128(rsU, ((mhi ? eb_ : ea_) << 9) + uoff, 0, 0)); \
            VQ[2 * j_] = __builtin_bit_cast(u32x2, __builtin_amdgcn_raw_buffer_load_b64(rsV, lane * 8, ea_ << 9, 0)); \
            VQ[2 * j_ + 1] = __builtin_bit_cast(u32x2, __builtin_amdgcn_raw_buffer_load_b64(rsV, lane * 8, eb_ << 9, 0)); } } while (0)
#define PEER_COMPUTE(UQ, VQ, bt) do { \
        float x_[4]; \
        _Pragma("unroll") for (int j_ = 0; j_ < 4; ++j_) { \
            const i32x8 a_ = {(int)UQ[j_].x, (int)UQ[j_].y, (int)UQ[j_].z, (int)UQ[j_].w, 0, 0, 0, 0}; \
            const f32x4 d_ = __builtin_amdgcn_mfma_scale_f32_16x16x128_f8f6f4(a_, hbv, (f32x4){0.f, 0.f, 0.f, 0.f}, 4, 4, 0, 0x7f7f7f7f, 0, 0x7f7f7f7f); \
            const float s_ = r0 ? d_[0] : r1 ? d_[1] : r2 ? d_[2] : d_[3]; \
            x_[j_] = s_ * st; } \
        float y2[2], q1; \
        _Pragma("unroll") for (int k_ = 0; k_ < 2; ++k_) { const float a_ = b4 ? x_[k_ + 2] : x_[k_], sd_ = b4 ? x_[k_] : x_[k_ + 2]; y2[k_] = a_ + __shfl_xor(sd_, 16); } \
        { const float a_ = b3 ? y2[1] : y2[0], sd_ = b3 ? y2[0] : y2[1]; q1 = a_ + DPPF(sd_, 0x128); }                  \
        q1 += DPPF(q1, 0xB1); q1 += DPPF(q1, 0x4E); q1 += DPPF(q1, 0x141);                                            \
        const int slot_ = (8 * (bt) + jj) & 63; \
        const float cu_ = __shfl((bt) < 8 ? m.cu0 : m.cu1, slot_), cv_ = __shfl((bt) < 8 ? m.g0 * m.sv0 : m.g1 * m.sv1, slot_); \
        const float c_ = gelu_tanh(q1 * cu_) * cv_; \
        _Pragma("unroll") for (int j_ = 0; j_ < 8; ++j_) { \
            const float cj_ = __int_as_float(__builtin_amdgcn_readlane(__float_as_int(c_), 32 * (j_ & 1) + 8 * ((j_ >> 1) & 1) + 16 * ((j_ >> 2) & 1))); \
            row_axpy16(VQ[j_], cj_, o); } } while (0)
__device__ __forceinline__ void phase_peer(KP kp, int wave_s) {
    const int lane = lane_id_asm(), wave = wave_s;
    unsigned char* ws = kp->ws;
    const __amdgpu_buffer_rsrc_t rsU = __builtin_amdgcn_make_buffer_rsrc((void*)(ws + WS_EU), 0, NEXP * U_BITS * 128, 0x00020000);
    const __amdgpu_buffer_rsrc_t rsV = __builtin_amdgcn_make_buffer_rsrc((void*)(ws + WS_EV), 0, NEXP * V_BITS * 128, 0x00020000);
    const unsigned char* HB = ws + WS_HB; const f32x2* HS = (const f32x2*)(ws + WS_HS);
    const int* IDX = (const int*)(ws + WS_IDX); const float* GATE = (const float*)(ws + WS_GATE);
    const float* SU = (const float*)(ws + WS_SU); const float* SV = (const float*)(ws + WS_SV);
    const float* mod = (const float*)(ws + WS_MOD); const float* fg = kp->in[22];
    const bf16_t* X1 = (const bf16_t*)(ws + WS_X1B); float* OUT = kp->out;
    const bool b5 = lane & 32, b4 = lane & 16, b3 = lane & 8;
    const int jj = 4 * (b4 ? 1 : 0) + 2 * (b3 ? 1 : 0) + (b5 ? 1 : 0);
    const int nn = lane & 15, qq = lane >> 4;
    const bool mhi = nn >= 8;
    const int uoff = 64 * (nn & 7) + 16 * qq;
    const bool useful = ((nn & 7) >> 2) == (qq & 1);
    const bool r0 = (nn & 3) == 0, r1 = (nn & 3) == 1, r2 = (nn & 3) == 2;
    const int tstride = gridDim.x * 8;
    int tok = blockIdx.x * 8 + wave;
    f32x4 fgv[4];
#pragma unroll
    for (int q = 0; q < 4; ++q) fgv[q] = *(const f32x4*)(fg + 16 * lane + 4 * q);
    TokMeta m, mn;
    u32x4 uqA[4], uqB[4]; vrow_t vqA[8], vqB[8];
    if (tok < T) { peer_load_meta(m, tok, lane, HB, HS, IDX, GATE, X1, mod); peer_load_scales(m, SU, SV); mn = m; PEER_LOAD(uqA, vqA, 0); }
    for (; tok < T; tok += tstride) {
        const int b = tok / SEQ;
        const bool has_next = tok + tstride < T;
        if (has_next) peer_load_meta(mn, tok + tstride, lane, HB, HS, IDX, GATE, X1, mod);
        const i32x8 hbv = {(int)m.hb.x, (int)m.hb.y, (int)m.hb.z, (int)m.hb.w, 0, 0, 0, 0};
        const float st = useful ? ((nn >> 3) ? m.hs.y : m.hs.x) : 0.f;
        f32x2 o[8];
#pragma unroll
        for (int i = 0; i < 8; ++i) o[i] = (f32x2){0.f, 0.f};
#pragma unroll 1
        for (int bt = 0; bt < 16; bt += 2) {
            PEER_LOAD(uqB, vqB, bt + 1);
            PEER_COMPUTE(uqA, vqA, bt);
            PEER_LOAD(uqA, vqA, bt + 2);
            PEER_COMPUTE(uqB, vqB, bt + 1);
        }
        if (has_next) peer_load_scales(mn, SU, SV);
        float* xr = OUT + (size_t)tok * D + 16 * lane;
        const unsigned xw[8] = {m.x1[0].x, m.x1[0].y, m.x1[0].z, m.x1[0].w, m.x1[1].x, m.x1[1].y, m.x1[1].z, m.x1[1].w};
        f32x4 xv[4]; float ss = 0.f;
#pragma unroll
        for (int q = 0; q < 4; ++q) {
            const f32x4 x1v = {bf_lo(xw[2 * q]), bf_hi(xw[2 * q]), bf_lo(xw[2 * q + 1]), bf_hi(xw[2 * q + 1])}, gv = m.g2[q];
            xv[q][0] = x1v[0] + gv[0] * o[2 * q].x; xv[q][1] = x1v[1] + gv[1] * o[2 * q].y; xv[q][2] = x1v[2] + gv[2] * o[2 * q + 1].x; xv[q][3] = x1v[3] + gv[3] * o[2 * q + 1].y;
            ss += xv[q][0] * xv[q][0] + xv[q][1] * xv[q][1] + xv[q][2] * xv[q][2] + xv[q][3] * xv[q][3];
        }
        ss = wave_sum(ss);
        const float r = rsqrtf(ss * (1.0f / D) + EPS);
#pragma unroll
        for (int q = 0; q < 4; ++q) *(f32x4*)(xr + 4 * q) = xv[q] * r * fgv[q];
        m = mn;
    }
}

__device__ __forceinline__ void quant_h2(const u32x4& xa0, const u32x4& xa1, float ssq, const LAS float* shrow, LAS unsigned char* hbuf, int lane, u32x4& hb, f32x2& hs) {
    const f32x4 s0v = *(const LAS f32x4*)(shrow + 16 * lane), s1v = *(const LAS f32x4*)(shrow + 16 * lane + 4), s2v = *(const LAS f32x4*)(shrow + 16 * lane + 8), s3v = *(const LAS f32x4*)(shrow + 16 * lane + 12);
    const float rr = rsqrtf(ssq * (1.0f / D) + EPS);
    const unsigned xw[8] = {xa0.x, xa0.y, xa0.z, xa0.w, xa1.x, xa1.y, xa1.z, xa1.w};
    const float sh[16] = {s0v[0], s0v[1], s0v[2], s0v[3], s1v[0], s1v[1], s1v[2], s1v[3], s2v[0], s2v[1], s2v[2], s2v[3], s3v[0], s3v[1], s3v[2], s3v[3]};
    float hv[16]; float am = 0.f;
#pragma unroll
    for (int i = 0; i < 8; ++i) { hv[2 * i] = bf_lo(xw[i]) * rr + sh[2 * i]; hv[2 * i + 1] = bf_hi(xw[i]) * rr + sh[2 * i + 1]; am = fmaxf(am, fmaxf(fabsf(hv[2 * i]), fabsf(hv[2 * i + 1]))); }
    am = wave_max(am);
    const float q0 = am > 0.f ? 6.0f / am : 0.f, d0 = am * (1.0f / 6.0f);
    unsigned w0[2] = {0u, 0u}, w1[2] = {0u, 0u}; float rv[16]; float am1 = 0.f;
#pragma unroll
    for (int i = 0; i < 8; ++i) {
        const int wi = i >> 2, bs = i & 3;
        if (bs == 0) w0[wi] = __builtin_amdgcn_cvt_scalef32_pk_fp4_f32(w0[wi], hv[2 * i] * q0, hv[2 * i + 1] * q0, 1.0f, 0);
        else if (bs == 1) w0[wi] = __builtin_amdgcn_cvt_scalef32_pk_fp4_f32(w0[wi], hv[2 * i] * q0, hv[2 * i + 1] * q0, 1.0f, 1);
        else if (bs == 2) w0[wi] = __builtin_amdgcn_cvt_scalef32_pk_fp4_f32(w0[wi], hv[2 * i] * q0, hv[2 * i + 1] * q0, 1.0f, 2);
        else w0[wi] = __builtin_amdgcn_cvt_scalef32_pk_fp4_f32(w0[wi], hv[2 * i] * q0, hv[2 * i + 1] * q0, 1.0f, 3);
    }
#pragma unroll
    for (int i = 0; i < 8; ++i) {
        const int wi = i >> 2, bs = i & 3;
        const f32x2 dq = bs == 0 ? __builtin_amdgcn_cvt_scalef32_pk_f32_fp4(w0[wi], 1.0f, 0) : bs == 1 ? __builtin_amdgcn_cvt_scalef32_pk_f32_fp4(w0[wi], 1.0f, 1) : bs == 2 ? __builtin_amdgcn_cvt_scalef32_pk_f32_fp4(w0[wi], 1.0f, 2) : __builtin_amdgcn_cvt_scalef32_pk_f32_fp4(w0[wi], 1.0f, 3);
        rv[2 * i] = hv[2 * i] - dq.x * d0; rv[2 * i + 1] = hv[2 * i + 1] - dq.y * d0;
        am1 = fmaxf(am1, fmaxf(fabsf(rv[2 * i]), fabsf(rv[2 * i + 1])));
    }
    am1 = wave_max(am1);
    const float q1 = am1 > 0.f ? 6.0f / am1 : 0.f, d1 = am1 * (1.0f / 6.0f);
#pragma unroll
    for (int i = 0; i < 8; ++i) {
        const int wi = i >> 2, bs = i & 3;
        if (bs == 0) w1[wi] = __builtin_amdgcn_cvt_scalef32_pk_fp4_f32(w1[wi], rv[2 * i] * q1, rv[2 * i + 1] * q1, 1.0f, 0);
        else if (bs == 1) w1[wi] = __builtin_amdgcn_cvt_scalef32_pk_fp4_f32(w1[wi], rv[2 * i] * q1, rv[2 * i + 1] * q1, 1.0f, 1);
        else if (bs == 2) w1[wi] = __builtin_amdgcn_cvt_scalef32_pk_fp4_f32(w1[wi], rv[2 * i] * q1, rv[2 * i + 1] * q1, 1.0f, 2);
        else w1[wi] = __builtin_amdgcn_cvt_scalef32_pk_fp4_f32(w1[wi], rv[2 * i] * q1, rv[2 * i + 1] * q1, 1.0f, 3);
    }
    *(LAS u32x2*)(hbuf + 8 * lane) = (u32x2){w0[0], w0[1]};
    *(LAS u32x2*)(hbuf + 512 + 8 * lane) = (u32x2){w1[0], w1[1]};
    asm volatile("" ::: "memory");
    hb = *(const LAS u32x4*)(hbuf + ((lane & 15) >> 3) * 512 + (lane & 7) * 16 + (lane >> 4) * 128);
    asm volatile("" ::: "memory");
    hs = (f32x2){d0, d1};
}
__device__ __forceinline__ void sort_words(unsigned& w0, unsigned& w1, int lane, LAS unsigned* scr) {
#pragma unroll
    for (int bit = 10; bit < 14; ++bit) {
        const bool z0 = ((w0 >> bit) & 1u) == 0u, z1 = ((w1 >> bit) & 1u) == 0u;
        const unsigned long long m0 = __ballot(z0), m1 = __ballot(z1);
        const int nz0 = __popcll(m0), nz = nz0 + __popcll(m1);
        const int r0 = __builtin_amdgcn_mbcnt_hi((unsigned)(m0 >> 32), __builtin_amdgcn_mbcnt_lo((unsigned)m0, 0u));
        const int r1 = __builtin_amdgcn_mbcnt_hi((unsigned)(m1 >> 32), __builtin_amdgcn_mbcnt_lo((unsigned)m1, 0u));
        const int p0 = z0 ? r0 : nz + lane - r0;
        const int p1 = z1 ? nz0 + r1 : nz + 64 - nz0 + lane - r1;
        scr[p0] = w0; scr[p1] = w1;
        asm volatile("" ::: "memory");
        w0 = scr[lane]; w1 = scr[64 + lane];
        asm volatile("" ::: "memory");
    }
}
struct UTok { u32x4 hb, xb; f32x2 hs; unsigned s0, s1; };
#define PU_LOAD(UQ, k, NX, g) do { const int bb_ = (g); const bool nx_ = (NX); \
        const unsigned src_ = bb_ < 8 ? (nx_ ? nxt[k].s0 : cur[k].s0) : (nx_ ? nxt[k].s1 : cur[k].s1); \
        _Pragma("unroll") for (int j_ = 0; j_ < 4; ++j_) { \
            const int id_ = __builtin_amdgcn_ds_bpermute(4 * (((8 * bb_) & 63) + 2 * j_) + slotb, (int)src_) & 0x3fff; \
            UQ[j_] = __builtin_bit_cast(u32x4, __builtin_amdgcn_raw_buffer_load_b128(rsU, (id_ << 9) + uoff, 0, 0)); } } while (0)
#define PU_COMPUTE(UQ, k, bt) do { \
        const i32x8 hbv = {(int)cur[k].hb.x, (int)cur[k].hb.y, (int)cur[k].hb.z, (int)cur[k].hb.w, 0, 0, 0, 0}; const float st = cur[k].hs.x; \
        float x_[4]; \
        _Pragma("unroll") for (int j_ = 0; j_ < 4; ++j_) { \
            const i32x8 a_ = {(int)UQ[j_].x, (int)UQ[j_].y, (int)UQ[j_].z, (int)UQ[j_].w, 0, 0, 0, 0}; \
            const f32x4 d_ = __builtin_amdgcn_mfma_scale_f32_16x16x128_f8f6f4(a_, hbv, (f32x4){0.f, 0.f, 0.f, 0.f}, 4, 4, 0, 0x7f7f7f7f, 0, 0x7f7f7f7f); \
            x_[j_] = (d_[0] * lm0 + d_[1] * lm1 + d_[2] * lm2 + d_[3] * lm3) * st; } \
        float y2[2], q1; \
        _Pragma("unroll") for (int k_ = 0; k_ < 2; ++k_) { const float a_ = b4 ? x_[k_ + 2] : x_[k_], sd_ = b4 ? x_[k_] : x_[k_ + 2]; y2[k_] = a_ + __shfl_xor(sd_, 16); } \
        { const float a_ = b3 ? y2[1] : y2[0], sd_ = b3 ? y2[0] : y2[1]; q1 = a_ + DPPF(sd_, 0x128); } \
        q1 += DPPF(q1, 0xB1); q1 += DPPF(q1, 0x4E); q1 += DPPF(q1, 0x141); \
        const float qs_ = __shfl(q1, srcl);                                     \
        const bool mine_ = (lane >> 3) == ((bt) & 7); \
        if ((bt) < 8) qs0[k] = mine_ ? qs_ : qs0[k]; else qs1[k] = mine_ ? qs_ : qs1[k]; } while (0)
__device__ __forceinline__ void peer_u_raw(UTok& t, int tok, int lane, const bf16_t* XA, const float* SSQ, const int* IDX) {
    { const u32x4* xp = (const u32x4*)(XA + (size_t)tok * D + 16 * lane); t.hb = xp[0]; t.xb = xp[1]; }
    t.hs = (f32x2){SSQ[tok], 0.f};
    t.s0 = ((unsigned)IDX[(size_t)tok * 128 + lane] & 0x3fffu) | ((unsigned)lane << 14); t.s1 = ((unsigned)IDX[(size_t)tok * 128 + 64 + lane] & 0x3fffu) | ((unsigned)(64 + lane) << 14);
}
__device__ __forceinline__ void phase_peer_u(KP kp, LAS unsigned char* lds, int wave_s) {
    const int lane = lane_id_asm(), wave = wave_s;
    unsigned char* ws = kp->ws;
    const __amdgpu_buffer_rsrc_t rsU = __builtin_amdgcn_make_buffer_rsrc((void*)(ws + WS_EU), 0, NEXP * U_BITS * 128, 0x00020000);
    const bf16_t* XA = (const bf16_t*)(ws + WS_H); const float* SSQ = (const float*)(ws + WS_SSQ);
    const int* IDX = (const int*)(ws + WS_IDX); const float* GATE = (const float*)(ws + WS_GATE);
    const float* SU = (const float*)(ws + WS_SU); const float* SV = (const float*)(ws + WS_SV);
    LAS unsigned* scr = (LAS unsigned*)(lds + wave * 2048);
    LAS float* shl = (LAS float*)(lds + 32768);
    LAS unsigned char* hbuf = lds + 49152 + wave * 1024;
    { const float* modp = (const float*)(ws + WS_MOD); for (int i = wave * 64 + lane; i < 4096; i += NTHREADS) shl[i] = modp[(size_t)(i >> 10) * NMOD + 3 * 1024 + (i & 1023)]; }
    __syncthreads();
    const bool b4 = lane & 16, b3 = lane & 8;
    const int srcl = 32 * (lane & 1) + 16 * ((lane >> 2) & 1) + 8 * ((lane >> 1) & 1);
    const int nn = lane & 15, qq = lane >> 4;
    const int uoff = 16 * (nn & 7) + 128 * qq;
    const int slotb = 4 * (nn >> 3);
    const bool useful = ((nn & 7) >> 2) == (qq & 1);
    const float lm0 = (nn & 3) == 0 ? 1.f : 0.f, lm1 = (nn & 3) == 1 ? 1.f : 0.f, lm2 = (nn & 3) == 2 ? 1.f : 0.f, lm3 = (nn & 3) == 3 ? 1.f : 0.f;
    const int tstride = gridDim.x * 8;
    int tok0 = blockIdx.x * 8 + wave;
    if (tok0 < T) {
        UTok cur[4], nxt[4];
        u32x4 uq[4][4];
#pragma unroll
        for (int k = 0; k < 4; ++k) { const int tk = tok0 + k * tstride; peer_u_raw(cur[k], tk < T ? tk : tok0, lane, XA, SSQ, IDX); }
#pragma unroll
        for (int k = 0; k < 4; ++k) { const int tk = tok0 + k * tstride < T ? tok0 + k * tstride : tok0; sort_words(cur[k].s0, cur[k].s1, lane, scr + k * 128);
            { const u32x4 xa0 = cur[k].hb, xa1 = cur[k].xb; quant_h2(xa0, xa1, cur[k].hs.x, shl + (tk / SEQ) * 1024, hbuf, lane, cur[k].hb, cur[k].hs); }
            cur[k].hs.x = useful ? ((nn >> 3) ? cur[k].hs.y : cur[k].hs.x) : 0.f; nxt[k] = cur[k]; }
        const int rot = 2 * ((int)xb_xcc_id() & 7);
        PU_LOAD(uq[0], 0, false, rot); PU_LOAD(uq[1], 1, false, rot); PU_LOAD(uq[2], 2, false, rot);
        for (; tok0 < T; tok0 += 4 * tstride) {
            const bool has_next = tok0 + 4 * tstride < T;
            if (has_next) {
#pragma unroll
                for (int k = 0; k < 4; ++k) { const int tk = tok0 + (4 + k) * tstride; peer_u_raw(nxt[k], tk < T ? tk : tok0 + 4 * tstride, lane, XA, SSQ, IDX); }
            }
            float g0[4], g1[4], cu0[4], cu1[4], sv0[4], sv1[4];
#pragma unroll
            for (int k = 0; k < 4; ++k) { const int tk = tok0 + k * tstride < T ? tok0 + k * tstride : tok0;
                const int i0 = cur[k].s0 & 0x3fff, i1 = cur[k].s1 & 0x3fff;
                g0[k] = __uint_as_float((unsigned)IDX[(size_t)tk * 128 + (cur[k].s0 >> 14)] & 0xffff0000u); g1[k] = __uint_as_float((unsigned)IDX[(size_t)tk * 128 + (cur[k].s1 >> 14)] & 0xffff0000u);
                cu0[k] = SU[i0]; cu1[k] = SU[i1]; sv0[k] = SV[i0]; sv1[k] = SV[i1]; }
            float qs0[4] = {0.f, 0.f, 0.f, 0.f}, qs1[4] = {0.f, 0.f, 0.f, 0.f};
#pragma unroll 1
            for (int bt = 0; bt < 16; ++bt) {
                if (bt == 8 && has_next) {
#pragma unroll
                    for (int k = 0; k < 4; ++k) { const int tk = tok0 + (4 + k) * tstride < T ? tok0 + (4 + k) * tstride : tok0 + 4 * tstride; sort_words(nxt[k].s0, nxt[k].s1, lane, scr + k * 128);
                        { const u32x4 xa0 = nxt[k].hb, xa1 = nxt[k].xb; quant_h2(xa0, xa1, nxt[k].hs.x, shl + (tk / SEQ) * 1024, hbuf, lane, nxt[k].hb, nxt[k].hs); }
                        nxt[k].hs.x = useful ? ((nn >> 3) ? nxt[k].hs.y : nxt[k].hs.x) : 0.f; }
                }
                const int bp = (bt + rot) & 15; const bool nx1 = bt == 15; const int bn = (bt + 1 + rot) & 15;
                PU_LOAD(uq[3], 3, false, bp); PU_COMPUTE(uq[0], 0, bp);
                PU_LOAD(uq[0], 0, nx1, bn);   PU_COMPUTE(uq[1], 1, bp);
                PU_LOAD(uq[1], 1, nx1, bn);   PU_COMPUTE(uq[2], 2, bp);
                PU_LOAD(uq[2], 2, nx1, bn);   PU_COMPUTE(uq[3], 3, bp);
            }
#pragma unroll
            for (int k = 0; k < 4; ++k) { const int tok = tok0 + k * tstride;
                if (tok < T) {
                    const int e0 = (int)(cur[k].s0 & 0x3fff), e1 = (int)(cur[k].s1 & 0x3fff);
                    const float c0 = gelu_tanh(qs0[k] * cu0[k]) * (g0[k] * sv0[k]), c1 = gelu_tanh(qs1[k] * cu1[k]) * (g1[k] * sv1[k]);
                    float cm = fmaxf(fabsf(c0), fabsf(c1));
            cm = wave_max(cm);
                    const float f = cm > 0.f ? 256.0f / cm : 0.f;
                    const unsigned pk = (unsigned)__builtin_amdgcn_cvt_pk_fp8_f32(c0 * f, c1 * f, 0, false) & 0xffffu;
                    const unsigned nbe0 = (unsigned)__builtin_amdgcn_update_dpp(0, e0, 0xB1, 0xF, 0xF, true), nbe1 = (unsigned)__builtin_amdgcn_update_dpp(0, e1, 0xB1, 0xF, 0xF, true);
                    if (!(lane & 1)) {
                        const int p = lane >> 1, o0 = (p & 3) * 16 + (p >> 2), o1 = (p & 3) * 16 + 8 + (p >> 2);
                        unsigned* IDP = (unsigned*)(ws + WS_IDP) + (size_t)tok * 64;
                        IDP[o0] = (unsigned)e0 | (nbe0 << 16); IDP[o1] = (unsigned)e1 | (nbe1 << 16);
                    }
                    const unsigned nb4 = (unsigned)__shfl((int)pk, lane + 4);
                    if ((lane & 7) < 4) {
                        unsigned short* COP = (unsigned short*)(ws + WS_COP) + (size_t)tok * 64 + (lane & 3) * 16 + (lane >> 3);
                        COP[0] = (unsigned short)((pk & 0xffu) | ((nb4 & 0xffu) << 8)); COP[8] = (unsigned short)(((pk >> 8) & 0xffu) | (nb4 & 0xff00u));
                    }
                    if (lane == 0) ((float*)(ws + WS_CS))[tok] = cm * (1.0f / 256.0f);
                }
                cur[k] = nxt[k]; }
        }
    }
}
#define PV_LOADG(RB, k, NX, g) do { const int gg_ = (g); \
        const unsigned pr_ = ((NX) ? mnx : mcu)[(k) * 96 + qq * 16 + gg_]; \
        cfr[k] = ((NX) ? mnx : mcu)[(k) * 96 + 64 + qq * 8 + (gg_ >> 1)]; \
        const int va_ = (int)((pr_ & 0xffffu) << 9) + lanebase, vb_ = (int)((pr_ >> 16) << 9) + lanebase; \
        _Pragma("unroll") for (int blk_ = 0; blk_ < 4; ++blk_) { \
            const u32x2 a_ = __builtin_bit_cast(u32x2, __builtin_amdgcn_raw_buffer_load_b64(rsV, va_ + 8 * (blk_ & 1) + 256 * (blk_ >> 1), 0, 0)); \
            const u32x2 b_ = __builtin_bit_cast(u32x2, __builtin_amdgcn_raw_buffer_load_b64(rsV, vb_ + 8 * (blk_ & 1) + 256 * (blk_ >> 1), 0, 0)); \
            RB[blk_] = (u32x4){a_.x, a_.y, b_.x, b_.y}; } } while (0)
#define PV_COMPG(RB, k, g, CW) do { const unsigned cw_ = (CW); \
        const unsigned ra_ = ((g) & 1) ? __builtin_amdgcn_perm(cw_, cw_, 0x02020202u) : __builtin_amdgcn_perm(cw_, cw_, 0x00000000u); \
        const unsigned rb_ = ((g) & 1) ? __builtin_amdgcn_perm(cw_, cw_, 0x03030303u) : __builtin_amdgcn_perm(cw_, cw_, 0x01010101u); \
        const i32x8 A_ = {(int)(ra_ & mk0), (int)(ra_ & mk1), (int)(ra_ & mk2), (int)(ra_ & mk3), (int)(rb_ & mk0), (int)(rb_ & mk1), (int)(rb_ & mk2), (int)(rb_ & mk3)}; \
        __builtin_amdgcn_s_setprio(1); \
        _Pragma("unroll") for (int blk_ = 0; blk_ < 4; ++blk_) { \
            const i32x8 B_ = {(int)RB[blk_].x, (int)RB[blk_].y, (int)RB[blk_].z, (int)RB[blk_].w, 0, 0, 0, 0}; \
            acc[k][blk_] = __builtin_amdgcn_mfma_scale_f32_16x16x128_f8f6f4(A_, B_, acc[k][blk_], 0, 4, 0, 0x7f7f7f7f, 0, 0x7f7f7f7f); } \
        __builtin_amdgcn_s_setprio(0); } while (0)
__device__ __forceinline__ void phase_peer_v(KP kp, LAS unsigned char* lds, int wave_s) {
    const int lane = lane_id_asm(), wave = wave_s;
    unsigned char* ws = kp->ws;
    const __amdgpu_buffer_rsrc_t rsV = __builtin_amdgcn_make_buffer_rsrc((void*)(ws + WS_EV), 0, NEXP * V_BITS * 128, 0x00020000);
    const float* mod = (const float*)(ws + WS_MOD); const float* fg = kp->in[22];
    const bf16_t* X1 = (const bf16_t*)(ws + WS_X1B); float* OUT = kp->out;
    const unsigned* IDP = (const unsigned*)(ws + WS_IDP); const unsigned* COP = (const unsigned*)(ws + WS_COP); const float* CS = (const float*)(ws + WS_CS);
    const int nn = lane & 15, qq = lane >> 4;
    const int lanebase = 16 * nn;
    const unsigned msel = 0xFFu << (8 * (nn & 3));
    const unsigned mk0 = (nn >> 2) == 0 ? msel : 0u, mk1 = (nn >> 2) == 1 ? msel : 0u, mk2 = (nn >> 2) == 2 ? msel : 0u, mk3 = (nn >> 2) == 3 ? msel : 0u;
    const int col0 = 32 * nn + 4 * qq;
    const int tstride = gridDim.x * 8;
    int tok0 = blockIdx.x * 8 + wave;
    LAS unsigned* mcu = (LAS unsigned*)(lds + wave * 3072);
    LAS unsigned* mnx = mcu + 384;
    if (tok0 < T) {
        unsigned idw[4], cfw[4]; float csc[4], csn[4];
#pragma unroll
        for (int k = 0; k < 4; ++k) { const int tk = tok0 + k * tstride < T ? tok0 + k * tstride : tok0;
            idw[k] = IDP[(size_t)tk * 64 + lane]; cfw[k] = COP[(size_t)tk * 32 + (lane & 31)]; csc[k] = CS[tk]; csn[k] = csc[k]; }
#pragma unroll
        for (int k = 0; k < 4; ++k) { mcu[k * 96 + lane] = idw[k]; if (lane < 32) mcu[k * 96 + 64 + lane] = cfw[k]; mnx[k * 96 + lane] = idw[k]; if (lane < 32) mnx[k * 96 + 64 + lane] = cfw[k]; }
        asm volatile("" ::: "memory");
        u32x4 rb0[4], rb1[4], rb2[4], rb3[4]; unsigned cfr[4];
        const int rot = 2 * ((int)xb_xcc_id() & 7);
        PV_LOADG(rb0, 0, false, rot); PV_LOADG(rb1, 1, false, rot); PV_LOADG(rb2, 2, false, rot);
        for (; tok0 < T; tok0 += 4 * tstride) {
            const bool has_next = tok0 + 4 * tstride < T;
            if (has_next) {
#pragma unroll
                for (int k = 0; k < 4; ++k) { const int tk = tok0 + (4 + k) * tstride < T ? tok0 + (4 + k) * tstride : tok0 + 4 * tstride;
                    idw[k] = IDP[(size_t)tk * 64 + lane]; cfw[k] = COP[(size_t)tk * 32 + (lane & 31)]; csn[k] = CS[tk]; }
            }
            f32x4 acc[4][4]; u32x2 xwa[4], xwb[4]; f32x4 gva[4], gvb[4];
#pragma unroll
            for (int k = 0; k < 4; ++k)
#pragma unroll
                for (int i = 0; i < 4; ++i) acc[k][i] = (f32x4){0.f, 0.f, 0.f, 0.f};
#pragma unroll 1
            for (int G = 0; G < 16; ++G) {
                if (G == 14) {
                    const bf16_t* xp = X1 + (size_t)tok0 * D + col0; const float* gp = mod + (size_t)(tok0 / SEQ) * NMOD + 5 * 1024 + col0;
#pragma unroll
                    for (int blk = 0; blk < 4; ++blk) { xwa[blk] = *(const u32x2*)(xp + 16 * (blk & 1) + 512 * (blk >> 1)); gva[blk] = *(const f32x4*)(gp + 16 * (blk & 1) + 512 * (blk >> 1)); }
                }
                if (G == 8) {
#pragma unroll
                    for (int k = 0; k < 4; ++k) { mnx[k * 96 + lane] = idw[k]; if (lane < 32) mnx[k * 96 + 64 + lane] = cfw[k]; }
                    asm volatile("" ::: "memory");
                }
                const int Gp = (G + rot) & 15; const bool nx1 = G == 15; const int Gn = (G + 1 + rot) & 15;
                { const unsigned c_ = cfr[0]; PV_LOADG(rb3, 3, false, Gp); PV_COMPG(rb0, 0, Gp, c_); }
                { const unsigned c_ = cfr[1]; PV_LOADG(rb0, 0, nx1, Gn);   PV_COMPG(rb1, 1, Gp, c_); }
                { const unsigned c_ = cfr[2]; PV_LOADG(rb1, 1, nx1, Gn);   PV_COMPG(rb2, 2, Gp, c_); }
                { const unsigned c_ = cfr[3]; PV_LOADG(rb2, 2, nx1, Gn);   PV_COMPG(rb3, 3, Gp, c_); }
            }
            f32x4 fgv[4];
#pragma unroll
            for (int blk = 0; blk < 4; ++blk) fgv[blk] = *(const f32x4*)(fg + col0 + 16 * (blk & 1) + 512 * (blk >> 1));
#pragma unroll
            for (int k = 0; k < 4; ++k) { const int tok = tok0 + k * tstride;
                if (k < 3) { const int tk = tok0 + (k + 1) * tstride < T ? tok0 + (k + 1) * tstride : tok0; const bf16_t* xp = X1 + (size_t)tk * D + col0; const float* gp = mod + (size_t)(tk / SEQ) * NMOD + 5 * 1024 + col0;
#pragma unroll
                    for (int blk = 0; blk < 4; ++blk) { xwb[blk] = *(const u32x2*)(xp + 16 * (blk & 1) + 512 * (blk >> 1)); gvb[blk] = *(const f32x4*)(gp + 16 * (blk & 1) + 512 * (blk >> 1)); } }
                if (tok < T) {
                    float* xr = OUT + (size_t)tok * D + col0;
                    f32x4 xv[4]; float ss = 0.f;
#pragma unroll
                    for (int blk = 0; blk < 4; ++blk) {
                        const f32x4 x1v = {bf_lo(xwa[blk].x), bf_hi(xwa[blk].x), bf_lo(xwa[blk].y), bf_hi(xwa[blk].y)};
                        xv[blk] = x1v + gva[blk] * (acc[k][blk] * csc[k]);
                        ss += xv[blk][0] * xv[blk][0] + xv[blk][1] * xv[blk][1] + xv[blk][2] * xv[blk][2] + xv[blk][3] * xv[blk][3]; }
                    ss = wave_sum(ss);
                    const float r = rsqrtf(ss * (1.0f / D) + EPS);
#pragma unroll
                    for (int blk = 0; blk < 4; ++blk) *(f32x4*)(xr + 16 * (blk & 1) + 512 * (blk >> 1)) = xv[blk] * r * fgv[blk];
                }
#pragma unroll
                for (int blk = 0; blk < 4; ++blk) { gva[blk] = gvb[blk]; xwa[blk] = xwb[blk]; }
                csc[k] = csn[k]; }
            { LAS unsigned* t_ = mcu; mcu = mnx; mnx = t_; }
        }
    }
}

__global__ void __launch_bounds__(NTHREADS, 2) fwd_megakernel(Params P_) {
    extern __shared__ __attribute__((aligned(16))) unsigned char lds_raw[];
    LAS unsigned char* lds = (LAS unsigned char*)lds_raw;
    KP kp = (KP)__builtin_amdgcn_kernarg_segment_ptr();
    volatile LAS unsigned* ctl = (volatile LAS unsigned*)(lds + LDS_CTL_OFF);
    const int wave_s = __builtin_amdgcn_readfirstlane(threadIdx.x >> 6);
    if (threadIdx.x < 4) ctl[threadIdx.x] = 0u;
    __syncthreads();
    { XcdBarrier b0 = xcd_barrier_post((unsigned*)(kp->ws + WS_CTL), ctl, wave_s); (void)b0; }
    const int lo = kp->ph_lo, hi = kp->ph_hi;
#define IN(k) (lo <= (k) && (k) < hi)
#define FRESH() asm volatile("" : "+s"(kp) :: "memory")
#define SEAM(k) do { if (IN(k) && IN((k) + 1)) { { XcdBarrier b_; b_.bar = (unsigned*)(kp->ws + WS_CTL); b_.x = xb_xcc_id(); b_.st = ctl; xcd_barrier(b_, wave_s); } } FRESH(); } while (0)

    if (IN(0)) phase_prep(kp, lds, wave_s);
#if DBG_REPEAT
    FRESH();
    if (IN(0)) phase_prep(kp, lds, wave_s);
#endif
    SEAM(0);
    if (IN(1)) { phase_aux(kp, lds, wave_s); phase_w8(kp, lds, wave_s); unsigned char* ws = kp->ws; phase_norm_ada<true>(kp->in[0], kp->in[4], (const float*)(ws + WS_MOD), 0, 1024, (bf16_t*)nullptr, ws + WS_X8, (float*)(ws + WS_X8S), wave_s); }
#if DBG_REPEAT
    FRESH();
    if (IN(1)) { unsigned char* ws = kp->ws; phase_norm_ada<true>(kp->in[0], kp->in[4], (const float*)(ws + WS_MOD), 0, 1024, (bf16_t*)nullptr, ws + WS_X8, (float*)(ws + WS_X8S), wave_s); }
#endif
    SEAM(1);
    if (IN(2)) {
        unsigned char* ws = kp->ws;
        { pg8::Gemm g{(const bf16_t*)(ws + WS_X8), (const bf16_t*)(ws + WS_WP8), T, 3584, D / 2}; pg8::StaticOrder S; S.init(T, 3584, gridDim.x, blockIdx.x);
          EpiIn E{EpiProj{(const float*)(ws + WS_BINP), (bf16_t*)(ws + WS_PG), (bf16_t*)(ws + WS_PG) + (size_t)T * 512, (const float*)(ws + WS_X8S), (const float*)(ws + WS_WP8S)},
                  EpiGate{(const float*)(ws + WS_BINP), (const float*)(ws + WS_X8S), (const float*)(ws + WS_WGS), (bf16_t*)(ws + WS_SG)}};
          pg8::gemm_phase<EpiIn>(lds, g, S, E, wave_s); }
    }
#if DBG_REPEAT
    FRESH();
    if (IN(2)) {
        unsigned char* ws = kp->ws;
        { pg8::Gemm g{(const bf16_t*)(ws + WS_X8), (const bf16_t*)(ws + WS_WP8), T, 3584, D / 2}; pg8::StaticOrder S; S.init(T, 3584, gridDim.x, blockIdx.x);
          EpiIn E{EpiProj{(const float*)(ws + WS_BINP), (bf16_t*)(ws + WS_PG), (bf16_t*)(ws + WS_PG) + (size_t)T * 512, (const float*)(ws + WS_X8S), (const float*)(ws + WS_WP8S)},
                  EpiGate{(const float*)(ws + WS_BINP), (const float*)(ws + WS_X8S), (const float*)(ws + WS_WGS), (bf16_t*)(ws + WS_SG)}};
          pg8::gemm_phase<EpiIn>(lds, g, S, E, wave_s); }
    }
#endif
    SEAM(2);
    if (IN(3)) phase_branches(kp, lds, wave_s);
#if DBG_REPEAT
    FRESH();
    if (IN(3)) phase_branches(kp, lds, wave_s);
#endif
    SEAM(3);
    if (IN(4)) {
        unsigned char* ws = kp->ws;
        pg8::Gemm g{(const bf16_t*)(ws + WS_MC), (const bf16_t*)(ws + WS_WPC), T, D, D}; pg8::StaticOrder S; S.init(T, D, gridDim.x, blockIdx.x);
        EpiMerge E{(const bf16_t*)(ws + WS_SG), (bf16_t*)(ws + WS_PG)};
        pg8::gemm_phase<EpiMerge>(lds, g, S, E, wave_s);
    }
#if DBG_REPEAT
    FRESH();
    if (IN(4)) {
        unsigned char* ws = kp->ws;
        pg8::Gemm g{(const bf16_t*)(ws + WS_MC), (const bf16_t*)(ws + WS_WPC), T, D, D}; pg8::StaticOrder S; S.init(T, D, gridDim.x, blockIdx.x);
        EpiMerge E{(const bf16_t*)(ws + WS_SG), (bf16_t*)(ws + WS_PG)};
        pg8::gemm_phase<EpiMerge>(lds, g, S, E, wave_s);
    }
#endif
    SEAM(4);
    if (IN(5)) {
        unsigned char* ws = kp->ws;
        pg8::Gemm g{(const bf16_t*)(ws + WS_PG), (const bf16_t*)(ws + WS_WOUT), T, D, D}; pg8::StaticOrder S; S.init(T, D, gridDim.x, blockIdx.x);
        EpiResid E{kp->in[0], (const float*)(ws + WS_MOD) + 2 * 1024, (bf16_t*)(ws + WS_X1B), (const float*)(ws + WS_A2), (bf16_t*)(ws + WS_H), (float*)(ws + WS_SSQ)};
        pg8::gemm_phase<EpiResid>(lds, g, S, E, wave_s);
    }
#if DBG_REPEAT
    FRESH();
    if (IN(5)) {
        unsigned char* ws = kp->ws;
        pg8::Gemm g{(const bf16_t*)(ws + WS_PG), (const bf16_t*)(ws + WS_WOUT), T, D, D}; pg8::StaticOrder S; S.init(T, D, gridDim.x, blockIdx.x);
        EpiResid E{kp->in[0], (const float*)(ws + WS_MOD) + 2 * 1024, (bf16_t*)(ws + WS_X1B), (const float*)(ws + WS_A2), (bf16_t*)(ws + WS_H), (float*)(ws + WS_SSQ)};
        pg8::gemm_phase<EpiResid>(lds, g, S, E, wave_s);
    }
#endif
    SEAM(5);
    if (IN(7)) {
        unsigned char* ws = kp->ws;
        pg8::Gemm g{(const bf16_t*)(ws + WS_H), (const bf16_t*)(ws + WS_WQ), T, 2048, D}; pg8::StaticOrder S; S.init(T, 2048, gridDim.x, blockIdx.x);
        EpiQ E{(bf16_t*)(ws + WS_SG), (const float*)(ws + WS_SSQ), (const float*)(ws + WS_BIAS2)};
        pg8::gemm_phase<EpiQ>(lds, g, S, E, wave_s);
    }
#if DBG_REPEAT
    FRESH();
    if (IN(7)) {
        unsigned char* ws = kp->ws;
        pg8::Gemm g{(const bf16_t*)(ws + WS_H), (const bf16_t*)(ws + WS_WQ), T, 2048, D}; pg8::StaticOrder S; S.init(T, 2048, gridDim.x, blockIdx.x);
        EpiQ E{(bf16_t*)(ws + WS_SG), (const float*)(ws + WS_SSQ), (const float*)(ws + WS_BIAS2)};
        pg8::gemm_phase<EpiQ>(lds, g, S, E, wave_s);
    }
#endif
    if (IN(7) && IN(8)) { asm volatile("s_waitcnt vmcnt(0)" ::: "memory"); __syncthreads();
        if (wave_s == 0 && lane_id_asm() == 0) { __builtin_amdgcn_fence(__ATOMIC_ACQUIRE, "agent"); asm volatile("s_waitcnt vmcnt(0)" ::: "memory"); }
        __syncthreads(); }
    FRESH();
    if (IN(8)) phase_topk(kp, lds, wave_s);
#if DBG_REPEAT
    FRESH();
    if (IN(8)) phase_topk(kp, lds, wave_s);
#endif
    SEAM(8);
    if (IN(9)) phase_peer_u(kp, lds, wave_s);
    SEAM(9);
    if (IN(10)) phase_peer_v(kp, lds, wave_s);
#undef IN
#undef SEAM
#undef FRESH
}

#define DBG_PHASE_SKIP(ph) (0)
#define DBG_LAST 9
#define DBG_DUMP_N ((size_t)3584 * 1024)
#define DBG_DUMP_BF16 1
#ifdef DBG_DUMP_OFF
__global__ void dbg_dump(const unsigned char* ws, float* out) {
    const size_t n = DBG_DUMP_N;
    for (size_t i = (size_t)blockIdx.x * blockDim.x + threadIdx.x; i < (size_t)T * D; i += (size_t)gridDim.x * blockDim.x) {
        const size_t j = (i * 7919ull) % n;
        float v;
        if (DBG_DUMP_BF16) v = __uint_as_float(((unsigned)((const bf16_t*)(ws + DBG_DUMP_OFF))[j]) << 16);
        else v = ((const float*)(ws + DBG_DUMP_OFF))[j];
        out[i] = v;
    }
}
#endif
#ifndef MK_N_LAUNCHES
#define MK_N_LAUNCHES 1
#endif
extern "C" void kernel_launch(void* const* d_in, const int* in_sizes, int n_in, void* d_out, int out_size, void* d_ws, size_t ws_size, hipStream_t stream) {
    static int grid = 0;
    if (grid == 0) {
        if (n_in != 23 || in_sizes[0] != T * D || out_size != T * D || ws_size < WS_END) {
            fprintf(stderr, "kernel_launch: unexpected shapes (n_in %d, in0 %d, out %d, ws %zu); nothing launched\n", n_in, n_in > 0 ? in_sizes[0] : -1, out_size, ws_size); grid = -1; return; }
        int dev = 0, cus = 0, per_cu = 0;
        if (hipGetDevice(&dev) != hipSuccess || hipDeviceGetAttribute(&cus, hipDeviceAttributeMultiprocessorCount, dev) != hipSuccess) { grid = -1; return; }
        if (hipFuncSetAttribute((const void*)fwd_megakernel, hipFuncAttributeMaxDynamicSharedMemorySize, LDS_BYTES) != hipSuccess) { fprintf(stderr, "kernel_launch: hipFuncSetAttribute failed\n"); grid = -1; return; }
        if (hipOccupancyMaxActiveBlocksPerMultiprocessor(&per_cu, (const void*)fwd_megakernel, NTHREADS, LDS_BYTES) != hipSuccess || per_cu < 1) {
            fprintf(stderr, "kernel_launch: occupancy query says %d blocks per CU; nothing launched\n", per_cu); grid = -1; return; }
        grid = cus;
    }
    if (grid < 0) return;
    (void)hipMemsetAsync((char*)d_ws + WS_CTL, 0, 16384, stream);
    Params p{};
    for (int i = 0; i < 23; ++i) p.in[i] = (const float*)d_in[i];
    p.out = (float*)d_out; p.ws = (unsigned char*)d_ws;
#if MK_N_LAUNCHES == 1
    p.ph_lo = 0; p.ph_hi = 11;
    void* args[] = {&p};
    hipError_t e = hipLaunchCooperativeKernel((const void*)fwd_megakernel, dim3(grid), dim3(NTHREADS), args, LDS_BYTES, stream);
    if (e != hipSuccess) fprintf(stderr, "kernel_launch: cooperative launch failed: %s (grid %d)\n", hipGetErrorString(e), grid);
#else
    for (int ph = 0; ph < 11; ++ph) { if (DBG_PHASE_SKIP(ph)) continue; p.ph_lo = ph; p.ph_hi = ph + 1; hipLaunchKernelGGL(fwd_megakernel, dim3(grid), dim3(NTHREADS), LDS_BYTES, stream, p); }
#ifdef DBG_DUMP_OFF
    hipLaunchKernelGGL(dbg_dump, dim3(1024), dim3(256), 0, stream, (const unsigned char*)d_ws, (float*)d_out);
#endif
#endif
}
```
